# Optimizing an MI355X kernel written in HIP

```python
import jax, jax.numpy as jnp
from jax import lax
import numpy as np

D_MODEL = 1024
BATCH = 8
SEQ = 2048
DEPTH = 2
DEC_BATCH = 32
DEC_SEQ = 64
PAST_LEN = 2048

CHUNK = 64
N_MIXERS = 2
N_GLA_LAYERS = (DEPTH + 1) // 2
N_FOX_LAYERS = DEPTH // 2

GLA_HEADS = 4
GLA_DK = D_MODEL // 2 // GLA_HEADS
GLA_DV = D_MODEL // GLA_HEADS
GLA_HK = GLA_HEADS * GLA_DK
GLA_HV = GLA_HEADS * GLA_DV
GLA_GATE_RANK = 16
GLA_GATE_TAU = 16.0
GLA_IN = 2 * GLA_HK + 2 * GLA_HV + GLA_GATE_RANK

FOX_HEADS = 16
FOX_HD = D_MODEL // FOX_HEADS
FOX_HW = FOX_HEADS * FOX_HD
FOX_IN = 3 * FOX_HW + FOX_HEADS
FOX_QBLOCK = 128
FOX_FORGET_BIAS_INIT = 3.0

D_FF = -(-8 * D_MODEL // (3 * 256)) * 256
EPS = 1e-6
MASK_VALUE = -1e30

kernel_name = "gla_fox_hybrid_stream_step"


def rmsnorm(x, g):
    xf = x.astype(jnp.float32)
    y = xf * lax.rsqrt(jnp.mean(xf * xf, axis=-1, keepdims=True) + EPS)
    return (y * g.astype(jnp.float32)).astype(x.dtype)


def swiglu(h, w_in, w_down):
    gu = h @ w_in
    gate, up = jnp.split(gu, [D_FF], axis=-1)
    return (jax.nn.silu(gate) * up) @ w_down


def gla_recurrence(q, k, v, g, s0):
    B, T = q.shape[:2]
    n = -(-T // CHUNK)
    pad = n * CHUNK - T

    def pad_t(a):
        return jnp.pad(a, ((0, 0), (0, pad), (0, 0), (0, 0)))

    def to_blocks(a):
        return a.reshape(B, n, CHUNK, a.shape[2], a.shape[3]).transpose(1, 0, 3, 2, 4)

    qc = to_blocks(pad_t(q)).astype(jnp.float32)
    kc = to_blocks(pad_t(k)).astype(jnp.float32)
    vc = to_blocks(pad_t(v)).astype(jnp.float32)
    gc = to_blocks(pad_t(g)).astype(jnp.float32)
    b = jnp.cumsum(gc, axis=3)
    b_last = b[:, :, :, -1:, :]
    qe = qc * jnp.exp(b) * (GLA_DK ** -0.5)
    ke = kc * jnp.exp(-b)
    kd = kc * jnp.exp(b_last - b)
    causal = jnp.tril(jnp.ones((CHUNK, CHUNK), dtype=bool))
    a = jnp.where(causal, jnp.einsum('nbhtd,nbhsd->nbhts', qe, ke), 0.0)
    o_intra = jnp.einsum('nbhts,nbhsv->nbhtv', a, vc)

    def step(s, xs):
        qe_c, kd_c, v_c, dec_c = xs
        o = jnp.einsum('bhtd,bhdv->bhtv', qe_c, s)
        s = s * dec_c[..., None] + jnp.einsum('bhsd,bhsv->bhdv', kd_c, v_c)
        return s, o

    s_fin, o_inter = lax.scan(step, s0.astype(jnp.float32),
                              (qe, kd, vc, jnp.exp(b_last[:, :, :, 0, :])))
    o = (o_intra + o_inter).transpose(1, 0, 3, 2, 4).reshape(B, n * CHUNK, GLA_HEADS, GLA_DV)[:, :T]
    return o.astype(q.dtype), s_fin.astype(s0.dtype)


def gla_mixer(h, s0, w_in, w_g2, b_g, norm_g, w_out):
    B, T, _ = h.shape
    proj = h @ w_in
    q, k, v, r, gl = jnp.split(proj, [GLA_HK, 2 * GLA_HK, 2 * GLA_HK + GLA_HV, 2 * GLA_HK + 2 * GLA_HV], axis=-1)
    q = q.reshape(B, T, GLA_HEADS, GLA_DK)
    k = k.reshape(B, T, GLA_HEADS, GLA_DK)
    v = v.reshape(B, T, GLA_HEADS, GLA_DV)
    g = (jax.nn.log_sigmoid((gl @ w_g2 + b_g).astype(jnp.float32)) / GLA_GATE_TAU)
    g = g.reshape(B, T, GLA_HEADS, GLA_DK)
    o, s = gla_recurrence(q, k, v, g, s0)
    o = rmsnorm(o, norm_g.reshape(GLA_HEADS, GLA_DV)).reshape(B, T, GLA_HV)
    return (o * jax.nn.silu(r)) @ w_out, s


def fox_attend(q, k, v, c_q, c_k, q_pos, k_pos):
    s = jnp.einsum('bqhd,bkhd->bhqk', q, k).astype(jnp.float32) * (FOX_HD ** -0.5)
    bias = c_q.transpose(0, 2, 1)[:, :, :, None] - c_k.transpose(0, 2, 1)[:, :, None, :]
    mask = k_pos[None, :] <= q_pos[:, None]
    p = jax.nn.softmax(jnp.where(mask, s + bias, MASK_VALUE), axis=-1)
    return jnp.einsum('bhqk,bkhd->bqhd', p.astype(v.dtype), v)


def fox_project(h, w_in, b_f):
    B, T, _ = h.shape
    proj = h @ w_in
    q, k, v, fl = jnp.split(proj, [FOX_HW, 2 * FOX_HW, 3 * FOX_HW], axis=-1)
    q = q.reshape(B, T, FOX_HEADS, FOX_HD)
    k = k.reshape(B, T, FOX_HEADS, FOX_HD)
    v = v.reshape(B, T, FOX_HEADS, FOX_HD)
    logf = jax.nn.log_sigmoid((fl + b_f).astype(jnp.float32))
    return q, k, v, logf


def fox_mixer_prompt(h, w_in, b_f, w_out):
    B, T, _ = h.shape
    q, k, v, logf = fox_project(h, w_in, b_f)
    c = jnp.cumsum(logf, axis=1)
    nb = T // FOX_QBLOCK
    qb = q.reshape(B, nb, FOX_QBLOCK, FOX_HEADS, FOX_HD).transpose(1, 0, 2, 3, 4)
    cb = c.reshape(B, nb, FOX_QBLOCK, FOX_HEADS).transpose(1, 0, 2, 3)
    pos = jnp.arange(T, dtype=jnp.int32)
    pb = pos.reshape(nb, FOX_QBLOCK)
    o = lax.map(lambda xs: fox_attend(xs[0], k, v, xs[1], c, xs[2], pos), (qb, cb, pb))
    o = o.transpose(1, 0, 2, 3, 4).reshape(B, T, FOX_HW)
    return o @ w_out, k, v, logf.astype(h.dtype)


def fox_mixer_sample(h, k_cache, v_cache, logf_cache, w_in, b_f, w_out):
    B, S, _ = h.shape
    P = k_cache.shape[1]
    q, k, v, logf = fox_project(h, w_in, b_f)
    k_all = jnp.concatenate([k_cache.astype(k.dtype), k], axis=1)
    v_all = jnp.concatenate([v_cache.astype(v.dtype), v], axis=1)
    c = jnp.cumsum(jnp.concatenate([logf_cache.astype(jnp.float32), logf], axis=1), axis=1)
    k_pos = jnp.arange(P + S, dtype=jnp.int32)
    q_pos = P + jnp.arange(S, dtype=jnp.int32)
    o = fox_attend(q, k_all, v_all, c[:, P:], c, q_pos, k_pos).reshape(B, S, FOX_HW)
    return o @ w_out, k, v, logf.astype(h.dtype)


def setup_inputs(seed: int = 0) -> dict:
    key = jax.random.key(seed)
    ks = jax.random.split(key, 24)
    nrm = lambda k, shape, scale: jax.random.normal(k, shape, jnp.float32) * scale
    return {
        "x_prompt": nrm(ks[0], (BATCH, SEQ, D_MODEL), 1.0),
        "x_sample": nrm(ks[1], (DEC_BATCH, DEC_SEQ, D_MODEL), 1.0),
        "state_gla": nrm(ks[2], (N_GLA_LAYERS, DEC_BATCH, GLA_HEADS, GLA_DK, GLA_DV), 0.5),
        "cache_fox_k": nrm(ks[3], (N_FOX_LAYERS, DEC_BATCH, PAST_LEN, FOX_HEADS, FOX_HD), 1.0),
        "cache_fox_v": nrm(ks[4], (N_FOX_LAYERS, DEC_BATCH, PAST_LEN, FOX_HEADS, FOX_HD), 1.0),
        "cache_fox_logf": jax.nn.log_sigmoid(FOX_FORGET_BIAS_INIT + nrm(ks[5], (N_FOX_LAYERS, DEC_BATCH, PAST_LEN, FOX_HEADS), 1.0)),
        "norm_mix": 1.0 + nrm(ks[6], (DEPTH, D_MODEL), 0.02),
        "gla_w_in": nrm(ks[7], (N_GLA_LAYERS, D_MODEL, GLA_IN), D_MODEL ** -0.5),
        "gla_w_g2": nrm(ks[8], (N_GLA_LAYERS, GLA_GATE_RANK, GLA_HK), GLA_GATE_RANK ** -0.5),
        "gla_b_g": nrm(ks[9], (N_GLA_LAYERS, GLA_HK), 0.1),
        "gla_norm": 1.0 + nrm(ks[10], (N_GLA_LAYERS, GLA_HV), 0.02),
        "gla_w_out": nrm(ks[11], (N_GLA_LAYERS, GLA_HV, D_MODEL), GLA_HV ** -0.5),
        "fox_w_in": nrm(ks[12], (N_FOX_LAYERS, D_MODEL, FOX_IN), D_MODEL ** -0.5),
        "fox_b_f": FOX_FORGET_BIAS_INIT + nrm(ks[13], (N_FOX_LAYERS, FOX_HEADS), 0.1),
        "fox_w_out": nrm(ks[14], (N_FOX_LAYERS, FOX_HW, D_MODEL), FOX_HW ** -0.5),
        "norm_ffn": 1.0 + nrm(ks[15], (DEPTH, D_MODEL), 0.02),
        "ffn_w_in": nrm(ks[16], (DEPTH, D_MODEL, 2 * D_FF), D_MODEL ** -0.5),
        "ffn_w_down": nrm(ks[17], (DEPTH, D_FF, D_MODEL), D_FF ** -0.5),
        "norm_final": 1.0 + nrm(ks[18], (D_MODEL,), 0.02),
    }


def reference(x_prompt, x_sample, state_gla, cache_fox_k, cache_fox_v, cache_fox_logf,
              norm_mix, gla_w_in, gla_w_g2, gla_b_g, gla_norm, gla_w_out,
              fox_w_in, fox_b_f, fox_w_out, norm_ffn, ffn_w_in, ffn_w_down, norm_final):
    xp, xs = x_prompt, x_sample
    gla_sp, gla_ss = [], []
    fox_kp, fox_vp, fox_fp, fox_ks, fox_vs, fox_fs = [], [], [], [], [], []
    for i in range(DEPTH):
        j = i // N_MIXERS
        hp = rmsnorm(xp, norm_mix[i])
        hs = rmsnorm(xs, norm_mix[i])
        if i % N_MIXERS == 0:
            s0 = jnp.zeros((xp.shape[0], GLA_HEADS, GLA_DK, GLA_DV), xp.dtype)
            op, sp = gla_mixer(hp, s0, gla_w_in[j], gla_w_g2[j], gla_b_g[j], gla_norm[j], gla_w_out[j])
            os_, ss = gla_mixer(hs, state_gla[j], gla_w_in[j], gla_w_g2[j], gla_b_g[j], gla_norm[j], gla_w_out[j])
            gla_sp.append(sp)
            gla_ss.append(ss)
        else:
            op, kp, vp, fp = fox_mixer_prompt(hp, fox_w_in[j], fox_b_f[j], fox_w_out[j])
            os_, ks_, vs_, fs_ = fox_mixer_sample(hs, cache_fox_k[j], cache_fox_v[j], cache_fox_logf[j],
                                                 fox_w_in[j], fox_b_f[j], fox_w_out[j])
            fox_kp.append(kp); fox_vp.append(vp); fox_fp.append(fp)
            fox_ks.append(ks_); fox_vs.append(vs_); fox_fs.append(fs_)
        xp = xp + op
        xs = xs + os_
        xp = xp + swiglu(rmsnorm(xp, norm_ffn[i]), ffn_w_in[i], ffn_w_down[i])
        xs = xs + swiglu(rmsnorm(xs, norm_ffn[i]), ffn_w_in[i], ffn_w_down[i])
    y_prompt = rmsnorm(xp, norm_final)
    y_sample = rmsnorm(xs, norm_final)
    gla_state_p = jnp.stack(gla_sp, axis=0)
    gla_state_s = jnp.stack(gla_ss, axis=0)
    fox_k_p = jnp.stack(fox_kp, axis=0)
    fox_v_p = jnp.stack(fox_vp, axis=0)
    fox_logf_p = jnp.stack(fox_fp, axis=0)
    fox_k_s = jnp.stack(fox_ks, axis=0)
    fox_v_s = jnp.stack(fox_vs, axis=0)
    fox_logf_s = jnp.stack(fox_fs, axis=0)
    return (y_prompt, y_sample, gla_state_p, fox_k_p, fox_v_p, fox_logf_p,
            gla_state_s, fox_k_s, fox_v_s, fox_logf_s)
```

```cpp
#include <hip/hip_runtime.h>
#include <hip/hip_cooperative_groups.h>
#include <cstdio>
#include <cstdint>
#include <cmath>
namespace cg = cooperative_groups;
#define MK_MULTI 0
namespace pg8 {
#define PG8_LAS __attribute__((address_space(3)))
typedef unsigned short bf16_t;
typedef short bf16x8 __attribute__((ext_vector_type(8)));
typedef float f32x4 __attribute__((ext_vector_type(4)));
typedef unsigned u32x4 __attribute__((ext_vector_type(4)));
constexpr int BM = 256, BK = 64, HALF = 128, HTB = HALF * BK * 2  , STAGE_BYTES = 8 * HTB, NXCD = 8, WGM = 8;

__host__ __device__ __forceinline__ int lds_byte(int r, int c) { const int st = (r >> 4) * 2 + (c >> 5), rr = r & 15, cc = c & 31, ob = rr * 64 + cc * 2; return st * 1024 + (ob ^ (((ob >> 9) & 1) << 5)); }
__host__ __device__ __forceinline__ void stage_rc(int b, int& R, int& C) { const int st = b / 1024, sb = b % 1024, swz = sb ^ (((sb >> 9) & 1) << 5); R = (st >> 1) * 16 + swz / 64; C = (st & 1) * 32 + (swz % 64) / 2; }
__host__ __device__ __forceinline__ int perm32(int rho) { const int n = rho >> 4, i = rho & 15; return 8 * (i >> 2) + 4 * n + (i & 3); }

struct Unit { int pm, pn; };
struct Gemm { const bf16_t* A; const bf16_t* Bt; int M, N, K; };

struct StaticOrder {
    int nM, nN, nwg, G, c;
    __host__ __device__ void init(int M, int N, int G_, int c_) { nM = M / BM; nN = N / BM; nwg = nM * nN; G = G_; c = c_; }
    __host__ __device__ bool next(int i, Unit& u) const {
        const long L = (long)i * G + c; if (L >= nwg) return false;
        int wgid = (int)L; { const int q = nwg / NXCD, r = nwg % NXCD, xcd = wgid % NXCD, off = wgid / NXCD; wgid = (xcd < r ? xcd * (q + 1) : r * (q + 1) + (xcd - r) * q) + off; }
        const int nig = WGM * nN, gid = wgid / nig, fm = gid * WGM, gsz = (nM - fm) < WGM ? (nM - fm) : WGM;
        u.pm = fm + ((wgid % nig) % gsz); u.pn = (wgid % nig) / gsz; return true;
    }
    __device__ __forceinline__ void a_ready(const Unit&) const {}
    __device__ __forceinline__ void done(const Unit&) const {}
};

__device__ __forceinline__ unsigned cvt_pk_bf16(float lo, float hi) { unsigned r; asm volatile("v_cvt_pk_bf16_f32 %0, %1, %2" : "=v"(r) : "v"(lo), "v"(hi)); return r; }
template <class Epi, class Sched, bool ALIGN_EPI = false, bool SP2 = false>
__device__ __forceinline__ void gemm_phase(PG8_LAS unsigned char* lds, const Gemm g, const Sched& S, const Epi& E) {
    const int tid = threadIdx.x, wid = __builtin_amdgcn_readfirstlane(tid >> 6), lane = tid & 63, wr = wid >> 2, wc = wid & 3, fr = lane & 15, fq = lane >> 4;
    const int K = g.K, nt = K / BK;
    unsigned voffA[2], voffB[2];
#pragma unroll
    for (int i = 0; i < 2; ++i) { int R, C; stage_rc(tid * 16 + i * 8192, R, C); const int Rb = Epi::PERM ? ((R & ~31) + perm32(R & 31)) : R;
        voffA[i] = (unsigned)(R * K + C) * 2u; voffB[i] = (unsigned)(Rb * K + C) * 2u; }
    const size_t kstep = (size_t)(BK * 2);
    const size_t hstep = (size_t)HALF * K * 2;
    const size_t tstep = 2 * hstep;
    const unsigned ldsw = (unsigned)wid * 1024u;
    const int aoff = lds_byte(wr * 64 + fr, fq * 8), boff = lds_byte(wc * 32 + fr, fq * 8);
#define PG8_SA(b, h) (((b) * 2 + (h)) * HTB)
#define PG8_SB(b, h) ((4 + (b) * 2 + (h)) * HTB)
#define PG8_STAGE(bufoff, gbase, voff) do { _Pragma("unroll") for (int _i = 0; _i < 2; ++_i) \
        __builtin_amdgcn_global_load_lds((const unsigned*)((const char*)(gbase) + (voff)[_i]), (PG8_LAS unsigned*)(lds + (bufoff) + ldsw + _i * 8192), 16, 0, 0); } while (0)
#define PG8_LDA(dst, b, h) do { _Pragma("unroll") for (int m = 0; m < 4; ++m) _Pragma("unroll") for (int k = 0; k < 2; ++k) dst[m][k] = *(const PG8_LAS bf16x8*)(lds + PG8_SA(b, h) + aoff + m * 2048 + k * 1024); } while (0)
#define PG8_LDB(dst, b, h) do { _Pragma("unroll") for (int n = 0; n < 2; ++n) _Pragma("unroll") for (int k = 0; k < 2; ++k) dst[n][k] = *(const PG8_LAS bf16x8*)(lds + PG8_SB(b, h) + boff + n * 2048 + k * 1024); } while (0)
#define PG8_MMA(ai, bj, At, Bt) do { __builtin_amdgcn_s_setprio(1); _Pragma("unroll") for (int m = 0; m < 4; ++m) _Pragma("unroll") for (int n = 0; n < 2; ++n) _Pragma("unroll") for (int k = 0; k < 2; ++k) \
        acc[ai][bj][m][n] = __builtin_amdgcn_mfma_f32_16x16x32_bf16(Bt[n][k], At[m][k], acc[ai][bj][m][n], 0, 0, 0); __builtin_amdgcn_s_setprio(0); } while (0)
#define PG8_WAIT_V(n) asm volatile("s_waitcnt vmcnt(" #n ")" ::: "memory")
#define PG8_WAIT_L(n) asm volatile("s_waitcnt lgkmcnt(" #n ")" ::: "memory")
#define PG8_BAR __builtin_amdgcn_s_barrier()
#define PG8_SCHED __builtin_amdgcn_sched_barrier(0)
    Unit cur, nxt; int ui = 0;
    if (!S.next(0, cur)) return;
    f32x4 acc[2][2][4][2];
#pragma unroll
    for (int a = 0; a < 2; ++a)
#pragma unroll
        for (int b = 0; b < 2; ++b)
#pragma unroll
            for (int m = 0; m < 4; ++m)
#pragma unroll
                for (int n = 0; n < 2; ++n) acc[a][b][m][n] = (f32x4){0.f, 0.f, 0.f, 0.f};
    bf16x8 At[4][2], B0[2][2], B1[2][2];
    const char* cA = (const char*)g.A + (size_t)cur.pm * tstep; const char* cB = (const char*)g.Bt + (size_t)cur.pn * tstep;
    S.a_ready(cur);
    if constexpr (SP2) {
        PG8_STAGE(PG8_SB(0, 0), cB, voffB); PG8_STAGE(PG8_SB(0, 1), cB + hstep, voffB); PG8_STAGE(PG8_SA(0, 0), cA, voffA); PG8_STAGE(PG8_SA(0, 1), cA + hstep, voffA);
        if (wr == 1) PG8_BAR;
        PG8_WAIT_V(2); PG8_BAR;
        PG8_STAGE(PG8_SB(1, 0), cB + kstep, voffB); PG8_STAGE(PG8_SA(1, 0), cA + kstep, voffA); PG8_STAGE(PG8_SB(1, 1), cB + hstep + kstep, voffB);
        PG8_WAIT_V(6); PG8_BAR;
    } else {
        PG8_STAGE(PG8_SB(0, 0), cB, voffB); PG8_STAGE(PG8_SA(0, 0), cA, voffA); PG8_STAGE(PG8_SB(0, 1), cB + hstep, voffB); PG8_STAGE(PG8_SA(0, 1), cA + hstep, voffA);
        if (wr == 1) PG8_BAR;
        PG8_WAIT_V(4); PG8_BAR;
        PG8_STAGE(PG8_SB(1, 0), cB + kstep, voffB); PG8_STAGE(PG8_SA(1, 0), cA + kstep, voffA); PG8_STAGE(PG8_SB(1, 1), cB + hstep + kstep, voffB);
        PG8_WAIT_V(6); PG8_BAR;
    }
    for (;;) {
        const bool has_next = S.next(ui + 1, nxt);
        const char* nA = has_next ? (const char*)g.A + (size_t)nxt.pm * tstep : cA; const char* nB = has_next ? (const char*)g.Bt + (size_t)nxt.pn * tstep : cB;
        for (int t = 0; t < nt; t += 2) {
            const bool last = (t == nt - 2);
            const char* a1 = cA + (size_t)(t + 1) * kstep;
            const char* a2 = last ? nA : cA + (size_t)(t + 2) * kstep; const char* b2 = last ? nB : cB + (size_t)(t + 2) * kstep;
            const char* a3 = a2 + kstep; const char* b3 = b2 + kstep;
            if (last && has_next) S.a_ready(nxt);
            if constexpr (SP2) {
            PG8_LDB(B0, 0, 0); PG8_LDB(B1, 0, 1); PG8_SCHED; PG8_LDA(At, 0, 0); PG8_STAGE(PG8_SA(1, 1), a1 + hstep, voffA);
            PG8_WAIT_V(8); PG8_WAIT_L(0); PG8_BAR; PG8_MMA(0, 0, At, B0); PG8_MMA(0, 1, At, B1); PG8_BAR; PG8_SCHED;
            PG8_LDA(At, 0, 1); PG8_STAGE(PG8_SB(0, 0), b2, voffB); PG8_STAGE(PG8_SB(0, 1), b2 + hstep, voffB); PG8_STAGE(PG8_SA(0, 0), a2, voffA);
            PG8_WAIT_V(8); PG8_WAIT_L(0); PG8_BAR; PG8_MMA(1, 0, At, B0); PG8_MMA(1, 1, At, B1); PG8_BAR; PG8_SCHED;
            PG8_LDB(B0, 1, 0); PG8_LDB(B1, 1, 1); PG8_SCHED; PG8_LDA(At, 1, 0); PG8_STAGE(PG8_SA(0, 1), a2 + hstep, voffA);
            PG8_WAIT_V(8); PG8_WAIT_L(0); PG8_BAR; PG8_MMA(0, 0, At, B0); PG8_MMA(0, 1, At, B1); PG8_BAR; PG8_SCHED;
            PG8_LDA(At, 1, 1); PG8_STAGE(PG8_SB(1, 0), b3, voffB); PG8_STAGE(PG8_SB(1, 1), b3 + hstep, voffB); PG8_STAGE(PG8_SA(1, 0), a3, voffA);
            PG8_WAIT_V(8); PG8_WAIT_L(0); PG8_BAR; PG8_MMA(1, 0, At, B0); PG8_MMA(1, 1, At, B1); PG8_BAR; PG8_SCHED;
            } else {
            PG8_LDB(B0, 0, 0); PG8_SCHED; PG8_LDA(At, 0, 0); PG8_STAGE(PG8_SA(1, 1), a1 + hstep, voffA);
            PG8_WAIT_L(8); PG8_BAR; PG8_WAIT_L(0); PG8_MMA(0, 0, At, B0); PG8_BAR; PG8_SCHED;
            PG8_LDB(B1, 0, 1); PG8_STAGE(PG8_SB(0, 0), b2, voffB);
            PG8_BAR; PG8_WAIT_L(0); PG8_MMA(0, 1, At, B1); PG8_BAR;
            PG8_LDA(At, 0, 1); PG8_STAGE(PG8_SA(0, 0), a2, voffA);
            PG8_BAR; PG8_WAIT_L(0); PG8_MMA(1, 0, At, B0); PG8_BAR; PG8_SCHED;
            PG8_STAGE(PG8_SB(0, 1), b2 + hstep, voffB);
            PG8_WAIT_V(6); PG8_BAR; PG8_MMA(1, 1, At, B1); PG8_BAR;
            PG8_LDB(B0, 1, 0); PG8_SCHED; PG8_LDA(At, 1, 0); PG8_STAGE(PG8_SA(0, 1), a2 + hstep, voffA);
            PG8_WAIT_L(8); PG8_BAR; PG8_WAIT_L(0); PG8_MMA(0, 0, At, B0); PG8_BAR; PG8_SCHED;
            PG8_LDB(B1, 1, 1); PG8_STAGE(PG8_SB(1, 0), b3, voffB);
            PG8_BAR; PG8_WAIT_L(0); PG8_MMA(0, 1, At, B1); PG8_BAR;
            PG8_LDA(At, 1, 1); PG8_STAGE(PG8_SA(1, 0), a3, voffA);
            PG8_BAR; PG8_WAIT_L(0); PG8_MMA(1, 0, At, B0); PG8_BAR; PG8_SCHED;
            PG8_STAGE(PG8_SB(1, 1), b3 + hstep, voffB);
            PG8_WAIT_V(6); PG8_BAR; PG8_MMA(1, 1, At, B1); PG8_BAR;
            }
        }
        if constexpr (ALIGN_EPI) { if (wr == 0) PG8_BAR; }
        if constexpr (!Epi::AFTER_DRAIN) { E(acc, cur, wr, wc, fr, fq); S.done(cur); }
        if (!has_next) break;
#pragma unroll
        for (int a = 0; a < 2; ++a)
#pragma unroll
            for (int b = 0; b < 2; ++b)
#pragma unroll
                for (int m = 0; m < 4; ++m)
#pragma unroll
                    for (int n = 0; n < 2; ++n) acc[a][b][m][n] = (f32x4){0.f, 0.f, 0.f, 0.f};
        cur = nxt; cA = nA; cB = nB; ++ui;
        if constexpr (ALIGN_EPI) { if (wr == 1) PG8_BAR; }
    }
    PG8_WAIT_V(0);
    if constexpr (!ALIGN_EPI) { if (wr == 0) PG8_BAR; }
    PG8_BAR;
    if constexpr (Epi::AFTER_DRAIN) { E.fused(acc, cur, wr, wc, fr, fq, lds, wid, lane); S.done(cur); }
#undef PG8_SA
#undef PG8_SB
#undef PG8_STAGE
#undef PG8_LDA
#undef PG8_LDB
#undef PG8_MMA
#undef PG8_WAIT_V
#undef PG8_WAIT_L
#undef PG8_BAR
#undef PG8_SCHED
}
}

#define LAS __attribute__((address_space(3)))
typedef unsigned short bf16_t;
typedef short bf16x8 __attribute__((ext_vector_type(8)));
typedef float f32x4 __attribute__((ext_vector_type(4)));
typedef float f32x16 __attribute__((ext_vector_type(16)));
typedef unsigned u32x4 __attribute__((ext_vector_type(4)));
typedef unsigned u32x2 __attribute__((ext_vector_type(2)));

#ifndef MK_MULTI
#define MK_MULTI 0
#endif

constexpr int DM = 1024, MP = 16384, MS = 2048, MT = MP + MS;
constexpr int NPROJ = 3328, NPJ = 3072, DFF = 2816;
constexpr float EPS = 1e-6f;
constexpr float LOG2E = 1.4426950408889634f;
constexpr float QSCALE2 = 0.125f * LOG2E;
constexpr size_t O_Y = 0, O_GSP = 18874368, O_FKP = 19922944, O_FVP = 36700160, O_FLP = 53477376, O_GSS = 53739520, O_FKS = 57933824, O_FVS = 60030976, O_FLS = 62128128;
constexpr size_t MiB = 1u << 20;
constexpr size_t WS_CTL = 0, CTL_BYTES = 2 * MiB;
constexpr size_t WS_SS = 65536;
constexpr size_t WS_WGIN = 2 * MiB, WS_WFIN = 9 * MiB, WS_WGOUT = 16 * MiB, WS_WFOUT = 18 * MiB, WS_WFFI = 20 * MiB  , WS_WFFD = 42 * MiB  ;
constexpr size_t WS_XB = 54 * MiB, WS_XR = 90 * MiB, WS_PROJ = 162 * MiB, WS_GL = 270 * MiB, WS_DST = 272 * MiB, WS_DEC = 400 * MiB, WS_SPREV = 401 * MiB;
constexpr size_t WS_OG = 465 * MiB, WS_ACT = 501 * MiB, WS_CP = 600 * MiB, WS_CS = 601 * MiB, WS_END = 606 * MiB;
constexpr int LDS_BYTES = 135168;

struct Args {
    const float* in[19];
    float* out; unsigned char* ws;
    int ph_lo, ph_hi;
};
enum { I_XP = 0, I_XS, I_STATE, I_CK, I_CV, I_CLF, I_NMIX, I_GWIN, I_GWG2, I_GBG, I_GNORM, I_GWOUT, I_FWIN, I_FBF, I_FWOUT, I_NFFN, I_FFIN, I_FFDN, I_NFIN };

__device__ __forceinline__ float bf2f(unsigned u) { return __uint_as_float(u << 16); }
__device__ __forceinline__ unsigned f2bf(float f) { unsigned u = __float_as_uint(f); return (u + 0x7fffu + ((u >> 16) & 1u)) >> 16; }
__device__ __forceinline__ unsigned pk(float lo, float hi) { return pg8::cvt_pk_bf16(lo, hi); }
__device__ __forceinline__ float wave_sum(float v) {
#pragma unroll
    for (int o = 1; o < 64; o <<= 1) v += __shfl_xor(v, o);
    return v;
}
__device__ __forceinline__ float log_sigmoid(float z) { return fminf(z, 0.f) - __logf(1.f + __expf(-fabsf(z))); }
__device__ __forceinline__ int crow(int r, int hi) { return (r & 3) + 8 * (r >> 2) + 4 * hi; }
__device__ __forceinline__ float dot4(f32x4 v) { return (v[0] * v[0] + v[1] * v[1]) + (v[2] * v[2] + v[3] * v[3]); }
#define MFMA32(a, b, c) __builtin_amdgcn_mfma_f32_32x32x16_bf16((a), (b), (c), 0, 0, 0)

__device__ __forceinline__ void tr_item(const float* __restrict__ W, int K, int N, int nsrc0, bf16_t* WT, int drow0, const float* __restrict__ gain, LAS float* scr, int k0, int lane) {
    const int n = nsrc0 + (lane & 31);
#pragma unroll 8
    for (int i = 0; i < 32; ++i) {
        const int kk = 2 * i + (lane >> 5);
        float v = (n < N) ? W[(size_t)(k0 + kk) * N + n] : 0.f;
        if (gain) v *= gain[k0 + kk];
        scr[kk * 33 + (lane & 31)] = v;
    }
    asm volatile("s_waitcnt lgkmcnt(0)" ::: "memory");
    const int c = lane & 7;
#pragma unroll
    for (int j = 0; j < 4; ++j) {
        const int nn = (lane >> 3) + 8 * j; const LAS float* s = scr + (8 * c) * 33 + nn;
        u32x4 o; o.x = pk(s[0 * 33], s[1 * 33]); o.y = pk(s[2 * 33], s[3 * 33]); o.z = pk(s[4 * 33], s[5 * 33]); o.w = pk(s[6 * 33], s[7 * 33]);
        *(u32x4*)(WT + (size_t)(drow0 + nn) * K + k0 + 8 * c) = o;
    }
    asm volatile("s_waitcnt lgkmcnt(0)" ::: "memory");
}

__device__ __forceinline__ void p0_prologue(const Args& a, LAS unsigned char* lds, int vcu, int G) {
    const int tid = threadIdx.x, lane = tid & 63, wave = tid >> 6;
    LAS float* scr = (LAS float*)(lds + wave * 16384);
    const int gw = vcu * 8 + wave, NGW = G * 8;
    unsigned char* ws = a.ws;
    constexpr int I_IN = 16 * 104, I_OUT = 16 * 32, I_FI = 16 * 176, I_FD = 44 * 32;
    constexpr int NITEMS = 2 * I_IN + 2 * I_OUT + 2 * I_FI + 2 * I_FD;
    for (int it = gw; it < NITEMS; it += NGW) {
        int r = it;
        if (r < I_IN) { const int kb = r / 104, nb = r % 104; tr_item(a.in[I_GWIN], 1024, 3088, 32 * nb, (bf16_t*)(ws + WS_WGIN), 32 * nb, a.in[I_NMIX], scr, 64 * kb, lane); continue; } r -= I_IN;
        if (r < I_IN) { const int kb = r / 104, nb = r % 104; tr_item(a.in[I_FWIN], 1024, 3088, 32 * nb, (bf16_t*)(ws + WS_WFIN), 32 * nb, a.in[I_NMIX] + 1024, scr, 64 * kb, lane); continue; } r -= I_IN;
        if (r < I_OUT) { const int kb = r / 32, nb = r % 32; tr_item(a.in[I_GWOUT], 1024, 1024, 32 * nb, (bf16_t*)(ws + WS_WGOUT), 32 * nb, nullptr, scr, 64 * kb, lane); continue; } r -= I_OUT;
        if (r < I_OUT) { const int kb = r / 32, nb = r % 32; tr_item(a.in[I_FWOUT], 1024, 1024, 32 * nb, (bf16_t*)(ws + WS_WFOUT), 32 * nb, nullptr, scr, 64 * kb, lane); continue; } r -= I_OUT;
        if (r < 2 * I_FI) { const int li = r / I_FI; r -= li * I_FI; const int kb = r / 176, nb = r % 176, ns = 32 * nb, bj = ns / DFF, j = ns % DFF, drow = 256 * (j / 128) + 128 * bj + (j % 128);
            tr_item(a.in[I_FFIN] + (size_t)li * 1024 * 5632, 1024, 5632, ns, (bf16_t*)(ws + WS_WFFI + (size_t)li * 11 * MiB), drow, a.in[I_NFFN] + li * 1024, scr, 64 * kb, lane); continue; } r -= 2 * I_FI;
        { const int li = r / I_FD; r -= li * I_FD; const int kb = r / 32, nb = r % 32;
            tr_item(a.in[I_FFDN] + (size_t)li * DFF * 1024, DFF, 1024, 32 * nb, (bf16_t*)(ws + WS_WFFD + (size_t)li * 6 * MiB), 32 * nb, nullptr, scr, 64 * kb, lane); }
    }
    float* ss0 = (float*)(ws + WS_SS);
    bf16_t* XB = (bf16_t*)(ws + WS_XB);
    for (int m = gw; m < MT; m += NGW) {
        const float* xr = (m < MP) ? a.in[I_XP] + (size_t)m * DM : a.in[I_XS] + (size_t)(m - MP) * DM;
        f32x4 v[4]; float s = 0.f;
#pragma unroll
        for (int j = 0; j < 4; ++j) { v[j] = ((const f32x4*)xr)[lane + 64 * j]; s += dot4(v[j]); }
        s = wave_sum(s);
        if (lane == 0) ss0[m] = s;
#pragma unroll
        for (int j = 0; j < 4; ++j) { u32x2 o; o.x = pk(v[j][0], v[j][1]); o.y = pk(v[j][2], v[j][3]); ((u32x2*)(XB + (size_t)m * DM))[lane + 64 * j] = o; }
    }
}

__device__ __forceinline__ void p_final(const Args& a, int vcu, int G) {
    const int tid = threadIdx.x, lane = tid & 63, wave = tid >> 6;
    const int gw = vcu * 8 + wave, NGW = G * 8;
    const float* ss = (const float*)(a.ws + WS_SS + 4 * 131072);
    const float* XR = (const float*)(a.ws + WS_XR);
    const float* g = a.in[I_NFIN];
    f32x4 gv[4];
#pragma unroll
    for (int j = 0; j < 4; ++j) gv[j] = ((const f32x4*)g)[lane + 64 * j];
    for (int m = gw; m < MT; m += NGW) {
        const float rs = rsqrtf(ss[m] * (1.f / DM) + EPS);
#pragma unroll
        for (int j = 0; j < 4; ++j) { f32x4 v = ((const f32x4*)(XR + (size_t)m * DM))[lane + 64 * j]; ((f32x4*)(a.out + O_Y + (size_t)m * DM))[lane + 64 * j] = v * rs * gv[j]; }
    }
}

struct EpiGlaProj {
    static constexpr bool PERM = true, AFTER_DRAIN = false;
    const float* ss; bf16_t* proj; float* gl;
    __device__ __forceinline__ void operator()(const pg8::f32x4 (&acc)[2][2][4][2], const pg8::Unit& u, int wr, int wc, int fr, int fq) const {
        const int row0 = u.pm * 256 + wr * 64 + fr;
#pragma unroll
        for (int ai = 0; ai < 2; ++ai)
#pragma unroll
            for (int m = 0; m < 4; ++m) {
                const int row = row0 + ai * 128 + m * 16; const float rs = rsqrtf(ss[row] * (1.f / DM) + EPS);
                if (u.pn < 12) {
#pragma unroll
                    for (int bj = 0; bj < 2; ++bj) { const f32x4 v0 = acc[ai][bj][m][0] * rs, v1 = acc[ai][bj][m][1] * rs;
                        u32x4 w; w.x = pk(v0[0], v0[1]); w.y = pk(v0[2], v0[3]); w.z = pk(v1[0], v1[1]); w.w = pk(v1[2], v1[3]);
                        *(u32x4*)(proj + (size_t)row * NPJ + u.pn * 256 + bj * 128 + wc * 32 + 8 * fq) = w; }
                } else if (wc == 0 && fq < 2) {
#pragma unroll
                    for (int n = 0; n < 2; ++n) *(f32x4*)(gl + (size_t)row * 16 + 8 * fq + 4 * n) = acc[ai][0][m][n] * rs;
                }
            }
    }
};
struct EpiResid {
    static constexpr bool PERM = true, AFTER_DRAIN = false;
    const float* xin_p; const float* xin_s; float* xout; bf16_t* xb; float* ssout;
    __device__ __forceinline__ void operator()(const pg8::f32x4 (&acc)[2][2][4][2], const pg8::Unit& u, int wr, int wc, int fr, int fq) const {
        const int row0 = u.pm * 256 + wr * 64 + fr;
#pragma unroll
        for (int ai = 0; ai < 2; ++ai)
#pragma unroll
            for (int m = 0; m < 4; ++m) {
                const int row = row0 + ai * 128 + m * 16;
                const float* xi = (row < MP) ? xin_p + (size_t)row * DM : xin_s + (size_t)(row - MP) * DM;
                float sq = 0.f;
#pragma unroll
                for (int bj = 0; bj < 2; ++bj) { const int col = u.pn * 256 + bj * 128 + wc * 32 + 8 * fq;
                    const f32x4 a0 = *(const f32x4*)(xi + col) + acc[ai][bj][m][0], a1 = *(const f32x4*)(xi + col + 4) + acc[ai][bj][m][1];
                    *(f32x4*)(xout + (size_t)row * DM + col) = a0; *(f32x4*)(xout + (size_t)row * DM + col + 4) = a1;
                    u32x4 w; w.x = pk(a0[0], a0[1]); w.y = pk(a0[2], a0[3]); w.z = pk(a1[0], a1[1]); w.w = pk(a1[2], a1[3]);
                    *(u32x4*)(xb + (size_t)row * DM + col) = w;
                    sq += dot4(a0) + dot4(a1); }
                sq += __shfl_xor(sq, 16); sq += __shfl_xor(sq, 32);
                if (fq == 0) atomicAdd(ssout + row, sq);
            }
    }
};
struct EpiSwiglu {
    static constexpr bool PERM = true, AFTER_DRAIN = false;
    const float* ss; bf16_t* act;
    __device__ __forceinline__ void operator()(const pg8::f32x4 (&acc)[2][2][4][2], const pg8::Unit& u, int wr, int wc, int fr, int fq) const {
        const int row0 = u.pm * 256 + wr * 64 + fr;
#pragma unroll
        for (int ai = 0; ai < 2; ++ai)
#pragma unroll
            for (int m = 0; m < 4; ++m) {
                const int row = row0 + ai * 128 + m * 16; const float rs = rsqrtf(ss[row] * (1.f / DM) + EPS);
                float y[8];
#pragma unroll
                for (int n = 0; n < 2; ++n)
#pragma unroll
                    for (int i = 0; i < 4; ++i) { const float g = acc[ai][0][m][n][i] * rs, up = acc[ai][1][m][n][i] * rs; y[4 * n + i] = g * up * __builtin_amdgcn_rcpf(1.f + __expf(-g)); }
                u32x4 w; w.x = pk(y[0], y[1]); w.y = pk(y[2], y[3]); w.z = pk(y[4], y[5]); w.w = pk(y[6], y[7]);
                *(u32x4*)(act + (size_t)row * DFF + u.pn * 128 + wc * 32 + 8 * fq) = w;
            }
    }
};
struct EpiFoxProj {
    static constexpr bool PERM = true, AFTER_DRAIN = false;
    const float* ss; bf16_t* qkv; float* out; const float* bf;
    __device__ __forceinline__ void operator()(const pg8::f32x4 (&acc)[2][2][4][2], const pg8::Unit& u, int wr, int wc, int fr, int fq) const {
        const int row0 = u.pm * 256 + wr * 64 + fr;
        const int sect = u.pn >> 2;
#pragma unroll
        for (int ai = 0; ai < 2; ++ai)
#pragma unroll
            for (int m = 0; m < 4; ++m) {
                const int row = row0 + ai * 128 + m * 16; const float rs = rsqrtf(ss[row] * (1.f / DM) + EPS);
                if (u.pn < 12) {
                    const float sc = (sect == 0) ? rs * QSCALE2 : rs;
                    float* fdst = nullptr;
                    if (sect == 1) fdst = (row < MP) ? out + O_FKP + (size_t)row * DM : out + O_FKS + (size_t)(row - MP) * DM;
                    if (sect == 2) fdst = (row < MP) ? out + O_FVP + (size_t)row * DM : out + O_FVS + (size_t)(row - MP) * DM;
#pragma unroll
                    for (int bj = 0; bj < 2; ++bj) { const f32x4 v0 = acc[ai][bj][m][0] * sc, v1 = acc[ai][bj][m][1] * sc;
                        u32x4 w; w.x = pk(v0[0], v0[1]); w.y = pk(v0[2], v0[3]); w.z = pk(v1[0], v1[1]); w.w = pk(v1[2], v1[3]);
                        const int cl = bj * 128 + wc * 32 + 8 * fq;
                        *(u32x4*)(qkv + (size_t)row * NPJ + u.pn * 256 + cl) = w;
                        if (sect > 0) { float* d = fdst + (u.pn & 3) * 256 + cl; *(f32x4*)d = v0; *(f32x4*)(d + 4) = v1; } }
                } else if (wc == 0 && fq < 2) {
                    float* d = (row < MP) ? out + O_FLP + (size_t)row * 16 : out + O_FLS + (size_t)(row - MP) * 16;
#pragma unroll
                    for (int n = 0; n < 2; ++n) { const f32x4 v = acc[ai][0][m][n] * rs; f32x4 o;
#pragma unroll
                        for (int i = 0; i < 4; ++i) o[i] = log_sigmoid(v[i] + bf[8 * fq + 4 * n + i]);
                        *(f32x4*)(d + 8 * fq + 4 * n) = o; }
                }
            }
    }
};

constexpr int GL_OFF = 0, GSUM_OFF = 4096, DECS_OFF = 6144, QE_OFF = 8192, KE_OFF = 25600, VT_OFF = 43008, AL_OFF = 79872, KDT_OFF = 8192, OL_OFF = 8192;
constexpr int QES = 136, VTS = 72, OLS = 260;

template <int MODE> __device__ __forceinline__ void gla_item(const Args& a, LAS unsigned char* lds, int cid, int h) {
    const int tid = threadIdx.x, lane = tid & 63, w = tid >> 6, l31 = lane & 31, hi = lane >> 5;
    const int row0 = cid * 64;
    const bool prompt = cid < 256;
    LAS float* GLs = (LAS float*)(lds + GL_OFF); LAS float* GSUM = (LAS float*)(lds + GSUM_OFF); LAS float* DECS = (LAS float*)(lds + DECS_OFF);
    LAS bf16_t* QE = (LAS bf16_t*)(lds + QE_OFF); LAS bf16_t* KE = (LAS bf16_t*)(lds + KE_OFF); LAS bf16_t* VT = (LAS bf16_t*)(lds + VT_OFF);
    LAS bf16_t* AL = (LAS bf16_t*)(lds + AL_OFF); LAS bf16_t* KDT = (LAS bf16_t*)(lds + KDT_OFF);
    const bf16_t* P = (const bf16_t*)(a.ws + WS_PROJ) + (size_t)row0 * NPJ;
    const float* GL = (const float*)(a.ws + WS_GL);
    const float* state = a.in[I_STATE];

    bf16x8 sfr[8];
    if (MODE == 1) {
        if (prompt) {
            const bf16_t* sp = (const bf16_t*)(a.ws + WS_SPREV) + ((size_t)(cid * 4 + h) * 256 + 32 * w + l31) * 128 + 8 * hi;
#pragma unroll
            for (int ks = 0; ks < 8; ++ks) sfr[ks] = *(const bf16x8*)(sp + 16 * ks);
        } else {
            const float* s0 = state + ((size_t)((cid - 256) * 4 + h) * 128) * 256 + 32 * w + l31;
#pragma unroll
            for (int ks = 0; ks < 8; ++ks) { float f[8];
#pragma unroll
                for (int j = 0; j < 8; ++j) f[j] = s0[(size_t)(16 * ks + 8 * hi + j) * 256];
                u32x4 o; o.x = pk(f[0], f[1]); o.y = pk(f[2], f[3]); o.z = pk(f[4], f[5]); o.w = pk(f[6], f[7]); sfr[ks] = __builtin_bit_cast(bf16x8, o); }
        }
    }
    if (tid < 256) ((LAS f32x4*)GLs)[tid] = *(const f32x4*)(GL + (size_t)(row0 + (tid >> 2)) * 16 + (tid & 3) * 4);
    {
        const int dvv = tid & 255, th = tid >> 8; const bf16_t* vp = P + (size_t)(32 * th) * NPJ + 1024 + h * 256 + dvv;
#pragma unroll
        for (int q4 = 0; q4 < 4; ++q4) { unsigned e[8];
#pragma unroll
            for (int i = 0; i < 8; ++i) e[i] = vp[(size_t)(8 * q4 + i) * NPJ];
            u32x4 o; o.x = e[0] | (e[1] << 16); o.y = e[2] | (e[3] << 16); o.z = e[4] | (e[5] << 16); o.w = e[6] | (e[7] << 16);
            *(LAS u32x4*)(VT + dvv * VTS + 32 * th + 8 * q4) = o; }
    }
    __syncthreads();
    const int dk = tid & 127, tg = tid >> 7;
    float bc[16];
    {
        float wv[16];
#pragma unroll
        for (int j = 0; j < 16; ++j) wv[j] = a.in[I_GWG2][j * 512 + h * 128 + dk];
        const float bias = a.in[I_GBG][h * 128 + dk];
        float run = 0.f;
#pragma unroll
        for (int i = 0; i < 16; ++i) { const LAS f32x4* gp = (const LAS f32x4*)(GLs + (16 * tg + i) * 16); float z = bias;
#pragma unroll
            for (int j4 = 0; j4 < 4; ++j4) { const f32x4 gq = gp[j4]; z += gq[0] * wv[4 * j4] + gq[1] * wv[4 * j4 + 1] + gq[2] * wv[4 * j4 + 2] + gq[3] * wv[4 * j4 + 3]; }
            run += log_sigmoid(z) * (1.f / 16.f); bc[i] = run; }
        GSUM[tg * 128 + dk] = run;
    }
    __syncthreads();
    float off = 0.f, blast = 0.f;
#pragma unroll
    for (int g = 0; g < 4; ++g) { const float s = GSUM[g * 128 + dk]; blast += s; if (g < tg) off += s; }
    const bf16_t* kp = P + (size_t)(16 * tg) * NPJ + 512 + h * 128 + dk;
    if (MODE == 0) {
        float kd[16];
#pragma unroll
        for (int i = 0; i < 16; ++i) { const float b = bc[i] + off; kd[i] = bf2f(kp[(size_t)i * NPJ]) * __expf(blast - b); }
        u32x4 o0, o1; o0.x = pk(kd[0], kd[1]); o0.y = pk(kd[2], kd[3]); o0.z = pk(kd[4], kd[5]); o0.w = pk(kd[6], kd[7]);
        o1.x = pk(kd[8], kd[9]); o1.y = pk(kd[10], kd[11]); o1.z = pk(kd[12], kd[13]); o1.w = pk(kd[14], kd[15]);
        *(LAS u32x4*)(KDT + dk * VTS + 16 * tg) = o0; *(LAS u32x4*)(KDT + dk * VTS + 16 * tg + 8) = o1;
        if (tg == 0) { const float d = __expf(blast); DECS[dk] = d; if (prompt) ((float*)(a.ws + WS_DEC))[(size_t)(cid * 4 + h) * 128 + dk] = d; }
    } else {
        const bf16_t* qp = P + (size_t)(16 * tg) * NPJ + h * 128 + dk;
#pragma unroll
        for (int i = 0; i < 16; ++i) { const float b = bc[i] + off; const int t = 16 * tg + i;
            const float qe = bf2f(qp[(size_t)i * NPJ]) * __expf(b) * 0.08838834764831845f, ke = bf2f(kp[(size_t)i * NPJ]) * __expf(-b);
            QE[t * QES + dk] = (bf16_t)f2bf(qe); KE[t * QES + dk] = (bf16_t)f2bf(ke); }
    }
    __syncthreads();
    if (MODE == 0) {
        bf16x8 vf[4];
#pragma unroll
        for (int ks = 0; ks < 4; ++ks) vf[ks] = *(const LAS bf16x8*)(VT + (32 * w + l31) * VTS + 16 * ks + 8 * hi);
        f32x16 acc[4];
#pragma unroll
        for (int d = 0; d < 4; ++d) acc[d] = f32x16{};
#pragma unroll
        for (int d = 0; d < 4; ++d)
#pragma unroll
            for (int ks = 0; ks < 4; ++ks) { const bf16x8 kf = *(const LAS bf16x8*)(KDT + (32 * d + l31) * VTS + 16 * ks + 8 * hi);
                acc[d] = prompt ? MFMA32(vf[ks], kf, acc[d]) : MFMA32(kf, vf[ks], acc[d]); }
        if (prompt) {
            float* dst = (float*)(a.ws + WS_DST) + ((size_t)(cid * 4 + h) * 256 + 32 * w) * 128;
#pragma unroll
            for (int d = 0; d < 4; ++d)
#pragma unroll
                for (int r = 0; r < 16; ++r) dst[(size_t)crow(r, hi) * 128 + 32 * d + l31] = acc[d][r];
        } else {
            const size_t base = ((size_t)((cid - 256) * 4 + h) * 128) * 256;
            float* outs = a.out + O_GSS;
#pragma unroll
            for (int d = 0; d < 4; ++d)
#pragma unroll
                for (int r = 0; r < 16; ++r) { const int dkk = 32 * d + crow(r, hi); const size_t idx = base + (size_t)dkk * 256 + 32 * w + l31; outs[idx] = state[idx] * DECS[dkk] + acc[d][r]; }
        }
    } else {
        f32x16 o[2]; o[0] = f32x16{}; o[1] = f32x16{};
#pragma unroll
        for (int tb = 0; tb < 2; ++tb)
#pragma unroll
            for (int ks = 0; ks < 8; ++ks) { const bf16x8 qa = *(const LAS bf16x8*)(QE + (32 * tb + l31) * QES + 16 * ks + 8 * hi); o[tb] = MFMA32(qa, sfr[ks], o[tb]); }
        if (w < 3) {
            const int tb = (w > 0) ? 1 : 0, sb = (w == 2) ? 1 : 0;
            f32x16 am = f32x16{};
#pragma unroll
            for (int ks = 0; ks < 8; ++ks) { const bf16x8 qa = *(const LAS bf16x8*)(QE + (32 * tb + l31) * QES + 16 * ks + 8 * hi), kb = *(const LAS bf16x8*)(KE + (32 * sb + l31) * QES + 16 * ks + 8 * hi);
                am = MFMA32(qa, kb, am); }
#pragma unroll
            for (int r = 0; r < 16; ++r) { const int tl = crow(r, hi); float v = am[r]; if (tb == sb && l31 > tl) v = 0.f; AL[(32 * tb + tl) * VTS + 32 * sb + l31] = (bf16_t)f2bf(v); }
        }
        __syncthreads();
#pragma unroll
        for (int tb = 0; tb < 2; ++tb)
#pragma unroll
            for (int ks = 0; ks < 4; ++ks) { if (tb == 0 && ks >= 2) continue;
                const bf16x8 aa = *(const LAS bf16x8*)(AL + (32 * tb + l31) * VTS + 16 * ks + 8 * hi), vb = *(const LAS bf16x8*)(VT + (32 * w + l31) * VTS + 16 * ks + 8 * hi);
                o[tb] = MFMA32(aa, vb, o[tb]); }
        __syncthreads();
        LAS float* OL = (LAS float*)(lds + OL_OFF);
#pragma unroll
        for (int tb = 0; tb < 2; ++tb)
#pragma unroll
            for (int r = 0; r < 16; ++r) OL[(32 * tb + crow(r, hi)) * OLS + 32 * w + l31] = o[tb][r];
        __syncthreads();
        const f32x4 ng = *(const f32x4*)(a.in[I_GNORM] + h * 256 + 4 * lane);
        bf16_t* OG = (bf16_t*)(a.ws + WS_OG);
#pragma unroll
        for (int i = 0; i < 8; ++i) { const int t = 8 * w + i; const f32x4 v = *(const LAS f32x4*)(OL + t * OLS + 4 * lane);
            const float rs = rsqrtf(wave_sum(dot4(v)) * (1.f / 256.f) + EPS);
            const u32x2 rr = *(const u32x2*)(P + (size_t)t * NPJ + 2048 + h * 256 + 4 * lane);
            float rv[4] = {bf2f(rr.x & 0xffffu), bf2f(rr.x >> 16), bf2f(rr.y & 0xffffu), bf2f(rr.y >> 16)}; float y[4];
#pragma unroll
            for (int j = 0; j < 4; ++j) y[j] = v[j] * rs * ng[j] * rv[j] * __builtin_amdgcn_rcpf(1.f + __expf(-rv[j]));
            u32x2 ov; ov.x = pk(y[0], y[1]); ov.y = pk(y[2], y[3]);
            *(u32x2*)(OG + (size_t)(row0 + t) * DM + h * 256 + 4 * lane) = ov; }
    }
    __syncthreads();
}

__device__ __forceinline__ void gla_scan(const Args& a, int vcu, int G) {
    const int gt = vcu * 512 + threadIdx.x, NT_ = G * 512;
    const float* DST = (const float*)(a.ws + WS_DST); const float* DEC = (const float*)(a.ws + WS_DEC); bf16_t* SP = (bf16_t*)(a.ws + WS_SPREV);
    for (int it = gt; it < 32 * 8192; it += NT_) {
        const int bh = it >> 13, e4 = it & 8191, dv = e4 >> 5, dk4 = (e4 & 31) * 4, b = bh >> 2, h = bh & 3;
        f32x4 S = (f32x4){0.f, 0.f, 0.f, 0.f};
#pragma unroll 8
        for (int c = 0; c < 32; ++c) {
            const size_t ch = (size_t)((b * 32 + c) * 4 + h); const size_t base = (ch * 256 + dv) * 128 + dk4;
            const f32x4 ds = *(const f32x4*)(DST + base), de = *(const f32x4*)(DEC + ch * 128 + dk4);
            u32x2 o; o.x = pk(S[0], S[1]); o.y = pk(S[2], S[3]); *(u32x2*)(SP + base) = o;
            S = S * de + ds;
        }
        float* og = a.out + O_GSP + ((size_t)bh * 128 + dk4) * 256 + dv;
#pragma unroll
        for (int i = 0; i < 4; ++i) og[(size_t)i * 256] = S[i];
    }
}

__device__ __forceinline__ void fox_cumsum(const Args& a, LAS unsigned char* lds, int vcu, int G) {
    const int tid = threadIdx.x, hh = tid & 15, seg = tid >> 4;
    LAS float* SEG = (LAS float*)lds;
    for (int it = vcu; it < 40; it += G) {
        const bool prompt = it < 8; const int b = prompt ? it : it - 8; const int L = prompt ? 64 : 66, LT = prompt ? 2048 : 2112;
        const float* src0 = prompt ? a.out + O_FLP + (size_t)b * 2048 * 16 : a.in[I_CLF] + (size_t)b * 2048 * 16;
        const float* src1 = a.out + O_FLS + (size_t)b * 64 * 16;
        float* dst = (float*)(a.ws + (prompt ? WS_CP : WS_CS)) + (size_t)(b * 16 + hh) * LT;
        float s = 0.f;
        for (int i = 0; i < L; ++i) { const int t = seg * L + i; s += (t < 2048) ? src0[(size_t)t * 16 + hh] : src1[(size_t)(t - 2048) * 16 + hh]; }
        SEG[seg * 16 + hh] = s;
        __syncthreads();
        float run = 0.f;
        for (int g = 0; g < seg; ++g) run += SEG[g * 16 + hh];
        for (int i = 0; i < L; ++i) { const int t = seg * L + i; run += (t < 2048) ? src0[(size_t)t * 16 + hh] : src1[(size_t)(t - 2048) * 16 + hh]; dst[t] = run; }
        __syncthreads();
    }
}

constexpr int AT_KS = 72, AT_VS = 68, AT_BUF = 18176, AT_VOFF = 9216, AT_COFF = 17920;
struct TileRegs { u32x4 k0, k1, v0, v1; float ck; };

template <bool SAMPLE> __device__ __forceinline__ void attn_load(TileRegs& R, const Args& a, int b, int h, int t, const float* cbase, int tid) {
    const int kvl = tid >> 3, ch = tid & 7, kp = tid >> 4, c4 = tid & 15;
    if (SAMPLE && t < 32) {
        const float* kptr = a.in[I_CK] + (((size_t)b * 2048 + 64 * t + kvl) * 16 + h) * 64 + 8 * ch;
        R.k0 = *(const u32x4*)kptr; R.k1 = *(const u32x4*)(kptr + 4);
        const float* vptr = a.in[I_CV] + (((size_t)b * 2048 + 64 * t + 2 * kp) * 16 + h) * 64 + 4 * c4;
        R.v0 = *(const u32x4*)vptr; R.v1 = *(const u32x4*)(vptr + 1024);
    } else {
        const size_t rowbase = SAMPLE ? (size_t)(MP + b * 64) : (size_t)(b * 2048 + 64 * t);
        const bf16_t* qkv = (const bf16_t*)(a.ws + WS_PROJ);
        R.k0 = *(const u32x4*)(qkv + (rowbase + kvl) * NPJ + 1024 + h * 64 + 8 * ch);
        const bf16_t* vptr = qkv + (rowbase + 2 * kp) * NPJ + 2048 + h * 64 + 4 * c4;
        const u32x2 x0 = *(const u32x2*)vptr, x1 = *(const u32x2*)(vptr + NPJ);
        R.v0.x = x0.x; R.v0.y = x0.y; R.v1.x = x1.x; R.v1.y = x1.y;
    }
    if (tid < 64) R.ck = cbase[64 * t + tid] * LOG2E;
}
__device__ __forceinline__ void attn_store(const TileRegs& R, LAS unsigned char* buf, bool f32src, int tid) {
    const int kvl = tid >> 3, ch = tid & 7, kp = tid >> 4, c4 = tid & 15;
    LAS unsigned* VT32 = (LAS unsigned*)(buf + AT_VOFF);
    if (f32src) {
        u32x4 o; o.x = pk(__uint_as_float(R.k0.x), __uint_as_float(R.k0.y)); o.y = pk(__uint_as_float(R.k0.z), __uint_as_float(R.k0.w));
        o.z = pk(__uint_as_float(R.k1.x), __uint_as_float(R.k1.y)); o.w = pk(__uint_as_float(R.k1.z), __uint_as_float(R.k1.w));
        *(LAS u32x4*)(buf + (kvl * AT_KS + 8 * ch) * 2) = o;
#pragma unroll
        for (int i = 0; i < 4; ++i) VT32[(4 * c4 + i) * (AT_VS / 2) + kp] = pk(__uint_as_float(R.v0[i]), __uint_as_float(R.v1[i]));
    } else {
        *(LAS u32x4*)(buf + (kvl * AT_KS + 8 * ch) * 2) = R.k0;
        VT32[(4 * c4 + 0) * (AT_VS / 2) + kp] = (R.v0.x & 0xffffu) | (R.v1.x << 16);
        VT32[(4 * c4 + 1) * (AT_VS / 2) + kp] = (R.v0.x >> 16) | (R.v1.x & 0xffff0000u);
        VT32[(4 * c4 + 2) * (AT_VS / 2) + kp] = (R.v0.y & 0xffffu) | (R.v1.y << 16);
        VT32[(4 * c4 + 3) * (AT_VS / 2) + kp] = (R.v0.y >> 16) | (R.v1.y & 0xffff0000u);
    }
    if (tid < 64) ((LAS float*)(buf + AT_COFF))[tid] = R.ck;
}

template <bool SAMPLE> __device__ __forceinline__ void attn_unit(const Args& a, LAS unsigned char* lds, int b, int h, int qb) {
    const int tid = threadIdx.x, lane = tid & 63, w = tid >> 6, l31 = lane & 31, hi = lane >> 5;
    const int NT = SAMPLE ? 33 : 4 * (qb + 1);
    const bool active = SAMPLE ? (w < 2) : true;
    const int qpos = SAMPLE ? 2048 + 32 * (w & 1) + l31 : 256 * qb + 32 * w + l31;
    const size_t qrow = SAMPLE ? (size_t)(MP + b * 64 + 32 * (w & 1) + l31) : (size_t)(b * 2048 + qpos);
    const float* cbase = SAMPLE ? (const float*)(a.ws + WS_CS) + (size_t)(b * 16 + h) * 2112 : (const float*)(a.ws + WS_CP) + (size_t)(b * 16 + h) * 2048;
    const bf16_t* qkv = (const bf16_t*)(a.ws + WS_PROJ);
    bf16x8 qf[4];
#pragma unroll
    for (int ks = 0; ks < 4; ++ks) qf[ks] = *(const bf16x8*)(qkv + qrow * NPJ + h * 64 + 16 * ks + 8 * hi);
    const float cq2 = cbase[qpos] * LOG2E;
    const int qmax_w = SAMPLE ? 4096 : 256 * qb + 32 * w + 31;
    TileRegs R;
    attn_load<SAMPLE>(R, a, b, h, 0, cbase, tid);
    attn_store(R, lds, SAMPLE, tid);
    __syncthreads();
    float mrun = -INFINITY, lrun = 0.f;
    f32x16 ot[2]; ot[0] = f32x16{}; ot[1] = f32x16{};
    for (int t = 0; t < NT; ++t) {
        if (t + 1 < NT) attn_load<SAMPLE>(R, a, b, h, t + 1, cbase, tid);
        if (active && 64 * t <= qmax_w) {
            LAS unsigned char* buf = lds + (t & 1) * AT_BUF;
            const LAS bf16_t* Ks = (const LAS bf16_t*)buf; const LAS bf16_t* VTs = (const LAS bf16_t*)(buf + AT_VOFF); const LAS float* CKs = (const LAS float*)(buf + AT_COFF);
            f32x16 p0, p1;
#pragma unroll
            for (int r = 0; r < 16; ++r) { p0[r] = cq2; p1[r] = cq2; }
#pragma unroll
            for (int ks = 0; ks < 4; ++ks) { const bf16x8 k0 = *(const LAS bf16x8*)(Ks + l31 * AT_KS + 16 * ks + 8 * hi), k1 = *(const LAS bf16x8*)(Ks + (32 + l31) * AT_KS + 16 * ks + 8 * hi);
                p0 = MFMA32(k0, qf[ks], p0); p1 = MFMA32(k1, qf[ks], p1); }
#pragma unroll
            for (int j = 0; j < 4; ++j) { const f32x4 c0 = *(const LAS f32x4*)(CKs + 8 * j + 4 * hi), c1 = *(const LAS f32x4*)(CKs + 32 + 8 * j + 4 * hi);
#pragma unroll
                for (int i = 0; i < 4; ++i) { p0[4 * j + i] -= c0[i]; p1[4 * j + i] -= c1[i]; } }
            const bool diag = SAMPLE ? (t == 32) : (t >= 4 * qb);
            if (diag) {
#pragma unroll
                for (int r = 0; r < 16; ++r) { const int kv = 64 * t + crow(r, hi); if (kv > qpos) p0[r] = -INFINITY; if (kv + 32 > qpos) p1[r] = -INFINITY; }
            }
            float rm = fmaxf(p0[0], p1[0]);
#pragma unroll
            for (int r = 1; r < 16; ++r) rm = fmaxf(rm, fmaxf(p0[r], p1[r]));
            rm = fmaxf(rm, __shfl_xor(rm, 32));
            const float mn = fmaxf(mrun, rm), alpha = __builtin_amdgcn_exp2f(mrun - mn);
            mrun = mn;
            float rs = 0.f;
#pragma unroll
            for (int r = 0; r < 16; ++r) { p0[r] = __builtin_amdgcn_exp2f(p0[r] - mn); p1[r] = __builtin_amdgcn_exp2f(p1[r] - mn); rs += p0[r] + p1[r]; }
            lrun = lrun * alpha + rs;
#pragma unroll
            for (int r = 0; r < 16; ++r) { ot[0][r] *= alpha; ot[1][r] *= alpha; }
            bf16x8 pf[4];
            { u32x4 x; x.x = pk(p0[0], p0[1]); x.y = pk(p0[2], p0[3]); x.z = pk(p0[4], p0[5]); x.w = pk(p0[6], p0[7]); pf[0] = __builtin_bit_cast(bf16x8, x);
              x.x = pk(p0[8], p0[9]); x.y = pk(p0[10], p0[11]); x.z = pk(p0[12], p0[13]); x.w = pk(p0[14], p0[15]); pf[1] = __builtin_bit_cast(bf16x8, x);
              x.x = pk(p1[0], p1[1]); x.y = pk(p1[2], p1[3]); x.z = pk(p1[4], p1[5]); x.w = pk(p1[6], p1[7]); pf[2] = __builtin_bit_cast(bf16x8, x);
              x.x = pk(p1[8], p1[9]); x.y = pk(p1[10], p1[11]); x.z = pk(p1[12], p1[13]); x.w = pk(p1[14], p1[15]); pf[3] = __builtin_bit_cast(bf16x8, x); }
#pragma unroll
            for (int db = 0; db < 2; ++db)
#pragma unroll
                for (int ks = 0; ks < 4; ++ks) { const LAS bf16_t* vp = VTs + (32 * db + l31) * AT_VS + 16 * ks + 4 * hi;
                    const u32x2 lo = *(const LAS u32x2*)vp, hh2 = *(const LAS u32x2*)(vp + 8);
                    u32x4 x; x.x = lo.x; x.y = lo.y; x.z = hh2.x; x.w = hh2.y;
                    ot[db] = MFMA32(__builtin_bit_cast(bf16x8, x), pf[ks], ot[db]); }
        }
        if (t + 1 < NT) attn_store(R, lds + ((t + 1) & 1) * AT_BUF, SAMPLE && (t + 1 < 32), tid);
        __syncthreads();
    }
    if (active) {
        lrun += __shfl_xor(lrun, 32);
        const float inv = 1.f / lrun;
        bf16_t* og = (bf16_t*)(a.ws + WS_OG) + qrow * DM + h * 64;
#pragma unroll
        for (int db = 0; db < 2; ++db)
#pragma unroll
            for (int j = 0; j < 4; ++j) { u32x2 o; o.x = pk(ot[db][4 * j] * inv, ot[db][4 * j + 1] * inv); o.y = pk(ot[db][4 * j + 2] * inv, ot[db][4 * j + 3] * inv);
                *(u32x2*)(og + 32 * db + 8 * j + 4 * hi) = o; }
    }
}

__device__ __forceinline__ void fox_attention(const Args& a, LAS unsigned char* lds, int vcu, int G) {
    if (G == 256) {
        const int bh = vcu >> 1, s0 = 2 * (vcu & 1);
#pragma unroll 1
        for (int i = 0; i < 4; ++i) attn_unit<false>(a, lds, bh >> 4, bh & 15, (i & 1) ? s0 + (i >> 1) : 7 - s0 - (i >> 1));
    } else {
#pragma unroll 1
        for (int u = vcu; u < 1024; u += G) attn_unit<false>(a, lds, (u & 127) >> 4, u & 15, 7 - (u >> 7));
    }
#pragma unroll 1
    for (int u = vcu; u < 512; u += G) attn_unit<true>(a, lds, u >> 4, u & 15, 0);
}

#ifndef PH_MASK
#define PH_MASK 0x7fff
#endif
#define IN(k) (((PH_MASK >> (k)) & 1) && a.ph_lo <= (k) && (k) < a.ph_hi)
#define SEAM(k) do { if (IN(k) && IN((k) + 1)) cg::this_grid().sync(); } while (0)
template <int L> __device__ __forceinline__ void common_gemms(const Args& a, LAS unsigned char* lds, int G, int bx) {
    unsigned char* ws = a.ws;
    float* SS = (float*)(ws + WS_SS);
    bf16_t* XB = (bf16_t*)(ws + WS_XB); float* XR = (float*)(ws + WS_XR); bf16_t* OG = (bf16_t*)(ws + WS_OG); bf16_t* ACT = (bf16_t*)(ws + WS_ACT);
    constexpr int po = L ? 11 : 5;
    if (IN(po)) { pg8::Gemm g{OG, (const bf16_t*)(ws + (L ? WS_WFOUT : WS_WGOUT)), MT, DM, DM}; pg8::StaticOrder S; S.init(MT, DM, G, bx);
        EpiResid E{L ? XR : a.in[I_XP], L ? XR + (size_t)MP * DM : a.in[I_XS], XR, XB, SS + (L ? 3 : 1) * 32768};
        pg8::gemm_phase<EpiResid, pg8::StaticOrder, true, true>(lds, g, S, E); }
    SEAM(po);
    if (IN(po + 1)) { pg8::Gemm g{XB, (const bf16_t*)(ws + WS_WFFI + (size_t)L * 11 * MiB), MT, 2 * DFF, DM}; pg8::StaticOrder S; S.init(MT, 2 * DFF, G, bx);
        EpiSwiglu E{SS + (L ? 3 : 1) * 32768, ACT}; pg8::gemm_phase<EpiSwiglu, pg8::StaticOrder, true, true>(lds, g, S, E); }
    SEAM(po + 1);
    if (IN(po + 2)) { pg8::Gemm g{ACT, (const bf16_t*)(ws + WS_WFFD + (size_t)L * 6 * MiB), MT, DM, DFF}; pg8::StaticOrder S; S.init(MT, DM, G, bx);
        EpiResid E{XR, XR + (size_t)MP * DM, XR, XB, SS + (L ? 4 : 2) * 32768};
        pg8::gemm_phase<EpiResid, pg8::StaticOrder, true, true>(lds, g, S, E); }
    SEAM(po + 2);
}
constexpr int NPH = 15;
__global__ void __launch_bounds__(512, 2) fwd(Args a) {
    extern __shared__ __attribute__((aligned(16))) unsigned char lds_raw[];
    LAS unsigned char* lds = (LAS unsigned char*)lds_raw;
    const int G = gridDim.x, bx = blockIdx.x;
    const int vcu = (G % 8 == 0) ? (bx % 8) * (G / 8) + bx / 8 : bx;
    unsigned char* ws = a.ws;
    float* SS = (float*)(ws + WS_SS);
    bf16_t* XB = (bf16_t*)(ws + WS_XB); bf16_t* PROJ = (bf16_t*)(ws + WS_PROJ);

    if (IN(0)) p0_prologue(a, lds, vcu, G);
    SEAM(0);
    if (IN(1)) { pg8::Gemm g{XB, (const bf16_t*)(ws + WS_WGIN), MT, NPROJ, DM}; pg8::StaticOrder S; S.init(MT, NPROJ, G, bx);
        EpiGlaProj E{SS, PROJ, (float*)(ws + WS_GL)}; pg8::gemm_phase<EpiGlaProj, pg8::StaticOrder, true, true>(lds, g, S, E); }
    SEAM(1);
    if (IN(2)) {
#pragma unroll 1
        for (int it = vcu; it < 1152; it += G) gla_item<0>(a, lds, it >> 2, it & 3); }
    SEAM(2);
    if (IN(3)) gla_scan(a, vcu, G);
    SEAM(3);
    if (IN(4)) {
#pragma unroll 1
        for (int it = vcu; it < 1152; it += G) gla_item<1>(a, lds, it >> 2, it & 3); }
    SEAM(4);
    common_gemms<0>(a, lds, G, bx);
    if (IN(8)) { pg8::Gemm g{XB, (const bf16_t*)(ws + WS_WFIN), MT, NPROJ, DM}; pg8::StaticOrder S; S.init(MT, NPROJ, G, bx);
        EpiFoxProj E{SS + 2 * 32768, PROJ, a.out, a.in[I_FBF]}; pg8::gemm_phase<EpiFoxProj, pg8::StaticOrder, true, true>(lds, g, S, E); }
    SEAM(8);
    if (IN(9)) fox_cumsum(a, lds, vcu, G);
    SEAM(9);
    if (IN(10)) fox_attention(a, lds, vcu, G);
    SEAM(10);
    common_gemms<1>(a, lds, G, bx);
    if (IN(14)) p_final(a, vcu, G);
#undef IN
#undef SEAM
}

extern "C" void kernel_launch(void* const* d_in, const int* in_sizes, int n_in, void* d_out, int out_size, void* d_ws, size_t ws_size, hipStream_t stream) {
    static int grid = 0;
    if (grid == 0) {
        if (n_in != 19 || ws_size < WS_END || out_size != 62160896) { fprintf(stderr, "kernel_launch: unexpected problem shape (n_in %d, out %d, ws %zu)\n", n_in, out_size, ws_size); grid = -1; return; }
        if (hipFuncSetAttribute((const void*)fwd, hipFuncAttributeMaxDynamicSharedMemorySize, LDS_BYTES) != hipSuccess) { fprintf(stderr, "kernel_launch: hipFuncSetAttribute failed\n"); grid = -1; return; }
        int dev = 0, cus = 0, per_cu = 0;
        (void)hipGetDevice(&dev); (void)hipDeviceGetAttribute(&cus, hipDeviceAttributeMultiprocessorCount, dev);
        (void)hipOccupancyMaxActiveBlocksPerMultiprocessor(&per_cu, (const void*)fwd, 512, LDS_BYTES);
        (void)hipGetLastError();
        if (per_cu < 1) per_cu = 1;
        grid = cus * 1;
        if (grid <= 0) grid = 256;
    }
    if (grid < 0) return;
    (void)hipMemsetAsync((char*)d_ws + WS_CTL, 0, CTL_BYTES, stream);
    Args a{};
    for (int i = 0; i < 19; ++i) a.in[i] = (const float*)d_in[i];
    a.out = (float*)d_out; a.ws = (unsigned char*)d_ws;
#if MK_MULTI
    for (int ph = 0; ph < NPH; ++ph) { a.ph_lo = ph; a.ph_hi = ph + 1; hipLaunchKernelGGL(fwd, dim3(grid), dim3(512), LDS_BYTES, stream, a); }
#else
    a.ph_lo = 0; a.ph_hi = NPH;
    void* args[] = {&a};
    hipError_t e = hipLaunchCooperativeKernel((const void*)fwd, dim3(grid), dim3(512), args, LDS_BYTES, stream);
    if (e != hipSuccess) fprintf(stderr, "kernel_launch: cooperative launch failed: %s (grid %d)\n", hipGetErrorString(e), grid);
#endif
}
```

```cpp
#include <hip/hip_runtime.h>
#include <hip/hip_cooperative_groups.h>
#include <cstdio>
#include <cstdint>
#include <cmath>
namespace cg = cooperative_groups;
#define MK_MULTI 0
namespace pg8 {
#define PG8_LAS __attribute__((address_space(3)))
typedef unsigned short bf16_t;
typedef short bf16x8 __attribute__((ext_vector_type(8)));
typedef float f32x4 __attribute__((ext_vector_type(4)));
typedef unsigned u32x4 __attribute__((ext_vector_type(4)));
constexpr int BM = 256, BK = 64, HALF = 128, HTB = HALF * BK * 2  , STAGE_BYTES = 8 * HTB, NXCD = 8, WGM = 8;

__host__ __device__ __forceinline__ int lds_byte(int r, int c) { const int st = (r >> 4) * 2 + (c >> 5), rr = r & 15, cc = c & 31, ob = rr * 64 + cc * 2; return st * 1024 + (ob ^ (((ob >> 9) & 1) << 5)); }
__host__ __device__ __forceinline__ void stage_rc(int b, int& R, int& C) { const int st = b / 1024, sb = b % 1024, swz = sb ^ (((sb >> 9) & 1) << 5); R = (st >> 1) * 16 + swz / 64; C = (st & 1) * 32 + (swz % 64) / 2; }
__host__ __device__ __forceinline__ int perm32(int rho) { const int n = rho >> 4, i = rho & 15; return 8 * (i >> 2) + 4 * n + (i & 3); }

struct Unit { int pm, pn; };
struct Gemm { const bf16_t* A; const bf16_t* Bt; int M, N, K; };

struct StaticOrder {
    int nM, nN, nwg, G, c;
    __host__ __device__ void init(int M, int N, int G_, int c_) { nM = M / BM; nN = N / BM; nwg = nM * nN; G = G_; c = c_; }
    __host__ __device__ bool next(int i, Unit& u) const {
        const long L = (long)i * G + c; if (L >= nwg) return false;
        int wgid = (int)L; { const int q = nwg / NXCD, r = nwg % NXCD, xcd = wgid % NXCD, off = wgid / NXCD; wgid = (xcd < r ? xcd * (q + 1) : r * (q + 1) + (xcd - r) * q) + off; }
        const int nig = WGM * nN, gid = wgid / nig, fm = gid * WGM, gsz = (nM - fm) < WGM ? (nM - fm) : WGM;
        u.pm = fm + ((wgid % nig) % gsz); u.pn = (wgid % nig) / gsz; return true;
    }
    __device__ __forceinline__ void a_ready(const Unit&) const {}
    __device__ __forceinline__ void done(const Unit&) const {}
};

__device__ __forceinline__ unsigned cvt_pk_bf16(float lo, float hi) { unsigned r; asm volatile("v_cvt_pk_bf16_f32 %0, %1, %2" : "=v"(r) : "v"(lo), "v"(hi)); return r; }
template <class Epi, class Sched, bool ALIGN_EPI = false, bool SP2 = false>
__device__ __forceinline__ void gemm_phase(PG8_LAS unsigned char* lds, const Gemm g, const Sched& S, const Epi& E) {
    const int tid = threadIdx.x, wid = __builtin_amdgcn_readfirstlane(tid >> 6), lane = tid & 63, wr = wid >> 2, wc = wid & 3, fr = lane & 15, fq = lane >> 4;
    const int K = g.K, nt = K / BK;
    unsigned voffA[2], voffB[2];
#pragma unroll
    for (int i = 0; i < 2; ++i) { int R, C; stage_rc(tid * 16 + i * 8192, R, C); const int Rb = Epi::PERM ? ((R & ~31) + perm32(R & 31)) : R;
        voffA[i] = (unsigned)(R * K + C) * 2u; voffB[i] = (unsigned)(Rb * K + C) * 2u; }
    const size_t kstep = (size_t)(BK * 2);
    const size_t hstep = (size_t)HALF * K * 2;
    const size_t tstep = 2 * hstep;
    const unsigned ldsw = (unsigned)wid * 1024u;
    const int aoff = lds_byte(wr * 64 + fr, fq * 8), boff = lds_byte(wc * 32 + fr, fq * 8);
#define PG8_SA(b, h) (((b) * 2 + (h)) * HTB)
#define PG8_SB(b, h) ((4 + (b) * 2 + (h)) * HTB)
#define PG8_STAGE(bufoff, gbase, voff) do { _Pragma("unroll") for (int _i = 0; _i < 2; ++_i) \
        __builtin_amdgcn_global_load_lds((const unsigned*)((const char*)(gbase) + (voff)[_i]), (PG8_LAS unsigned*)(lds + (bufoff) + ldsw + _i * 8192), 16, 0, 0); } while (0)
#define PG8_LDA(dst, b, h) do { _Pragma("unroll") for (int m = 0; m < 4; ++m) _Pragma("unroll") for (int k = 0; k < 2; ++k) dst[m][k] = *(const PG8_LAS bf16x8*)(lds + PG8_SA(b, h) + aoff + m * 2048 + k * 1024); } while (0)
#define PG8_LDB(dst, b, h) do { _Pragma("unroll") for (int n = 0; n < 2; ++n) _Pragma("unroll") for (int k = 0; k < 2; ++k) dst[n][k] = *(const PG8_LAS bf16x8*)(lds + PG8_SB(b, h) + boff + n * 2048 + k * 1024); } while (0)
#define PG8_MMA(ai, bj, At, Bt) do { __builtin_amdgcn_s_setprio(1); _Pragma("unroll") for (int m = 0; m < 4; ++m) _Pragma("unroll") for (int n = 0; n < 2; ++n) _Pragma("unroll") for (int k = 0; k < 2; ++k) \
        acc[ai][bj][m][n] = __builtin_amdgcn_mfma_f32_16x16x32_bf16(Bt[n][k], At[m][k], acc[ai][bj][m][n], 0, 0, 0); __builtin_amdgcn_s_setprio(0); } while (0)
#define PG8_WAIT_V(n) asm volatile("s_waitcnt vmcnt(" #n ")" ::: "memory")
#define PG8_WAIT_L(n) asm volatile("s_waitcnt lgkmcnt(" #n ")" ::: "memory")
#define PG8_BAR __builtin_amdgcn_s_barrier()
#define PG8_SCHED __builtin_amdgcn_sched_barrier(0)
    Unit cur, nxt; int ui = 0;
    if (!S.next(0, cur)) return;
    f32x4 acc[2][2][4][2];
#pragma unroll
    for (int a = 0; a < 2; ++a)
#pragma unroll
        for (int b = 0; b < 2; ++b)
#pragma unroll
            for (int m = 0; m < 4; ++m)
#pragma unroll
                for (int n = 0; n < 2; ++n) acc[a][b][m][n] = (f32x4){0.f, 0.f, 0.f, 0.f};
    bf16x8 At[4][2], B0[2][2], B1[2][2];
    const char* cA = (const char*)g.A + (size_t)cur.pm * tstep; const char* cB = (const char*)g.Bt + (size_t)cur.pn * tstep;
    S.a_ready(cur);
    if constexpr (SP2) {
        PG8_STAGE(PG8_SB(0, 0), cB, voffB); PG8_STAGE(PG8_SB(0, 1), cB + hstep, voffB); PG8_STAGE(PG8_SA(0, 0), cA, voffA); PG8_STAGE(PG8_SA(0, 1), cA + hstep, voffA);
        if (wr == 1) PG8_BAR;
        PG8_WAIT_V(2); PG8_BAR;
        PG8_STAGE(PG8_SB(1, 0), cB + kstep, voffB); PG8_STAGE(PG8_SA(1, 0), cA + kstep, voffA); PG8_STAGE(PG8_SB(1, 1), cB + hstep + kstep, voffB);
        PG8_WAIT_V(6); PG8_BAR;
    } else {
        PG8_STAGE(PG8_SB(0, 0), cB, voffB); PG8_STAGE(PG8_SA(0, 0), cA, voffA); PG8_STAGE(PG8_SB(0, 1), cB + hstep, voffB); PG8_STAGE(PG8_SA(0, 1), cA + hstep, voffA);
        if (wr == 1) PG8_BAR;
        PG8_WAIT_V(4); PG8_BAR;
        PG8_STAGE(PG8_SB(1, 0), cB + kstep, voffB); PG8_STAGE(PG8_SA(1, 0), cA + kstep, voffA); PG8_STAGE(PG8_SB(1, 1), cB + hstep + kstep, voffB);
        PG8_WAIT_V(6); PG8_BAR;
    }
    for (;;) {
        const bool has_next = S.next(ui + 1, nxt);
        const char* nA = has_next ? (const char*)g.A + (size_t)nxt.pm * tstep : cA; const char* nB = has_next ? (const char*)g.Bt + (size_t)nxt.pn * tstep : cB;
        for (int t = 0; t < nt; t += 2) {
            const bool last = (t == nt - 2);
            const char* a1 = cA + (size_t)(t + 1) * kstep;
            const char* a2 = last ? nA : cA + (size_t)(t + 2) * kstep; const char* b2 = last ? nB : cB + (size_t)(t + 2) * kstep;
            const char* a3 = a2 + kstep; const char* b3 = b2 + kstep;
            if (last && has_next) S.a_ready(nxt);
            if constexpr (SP2) {
            PG8_LDB(B0, 0, 0); PG8_LDB(B1, 0, 1); PG8_SCHED; PG8_LDA(At, 0, 0); PG8_STAGE(PG8_SA(1, 1), a1 + hstep, voffA);
            PG8_WAIT_V(8); PG8_WAIT_L(0); PG8_BAR; PG8_MMA(0, 0, At, B0); PG8_MMA(0, 1, At, B1); PG8_BAR; PG8_SCHED;
            PG8_LDA(At, 0, 1); PG8_STAGE(PG8_SB(0, 0), b2, voffB); PG8_STAGE(PG8_SB(0, 1), b2 + hstep, voffB); PG8_STAGE(PG8_SA(0, 0), a2, voffA);
            PG8_WAIT_V(8); PG8_WAIT_L(0); PG8_BAR; PG8_MMA(1, 0, At, B0); PG8_MMA(1, 1, At, B1); PG8_BAR; PG8_SCHED;
            PG8_LDB(B0, 1, 0); PG8_LDB(B1, 1, 1); PG8_SCHED; PG8_LDA(At, 1, 0); PG8_STAGE(PG8_SA(0, 1), a2 + hstep, voffA);
            PG8_WAIT_V(8); PG8_WAIT_L(0); PG8_BAR; PG8_MMA(0, 0, At, B0); PG8_MMA(0, 1, At, B1); PG8_BAR; PG8_SCHED;
            PG8_LDA(At, 1, 1); PG8_STAGE(PG8_SB(1, 0), b3, voffB); PG8_STAGE(PG8_SB(1, 1), b3 + hstep, voffB); PG8_STAGE(PG8_SA(1, 0), a3, voffA);
            PG8_WAIT_V(8); PG8_WAIT_L(0); PG8_BAR; PG8_MMA(1, 0, At, B0); PG8_MMA(1, 1, At, B1); PG8_BAR; PG8_SCHED;
            } else {
            PG8_LDB(B0, 0, 0); PG8_SCHED; PG8_LDA(At, 0, 0); PG8_STAGE(PG8_SA(1, 1), a1 + hstep, voffA);
            PG8_WAIT_L(8); PG8_BAR; PG8_WAIT_L(0); PG8_MMA(0, 0, At, B0); PG8_BAR; PG8_SCHED;
            PG8_LDB(B1, 0, 1); PG8_STAGE(PG8_SB(0, 0), b2, voffB);
            PG8_BAR; PG8_WAIT_L(0); PG8_MMA(0, 1, At, B1); PG8_BAR;
            PG8_LDA(At, 0, 1); PG8_STAGE(PG8_SA(0, 0), a2, voffA);
            PG8_BAR; PG8_WAIT_L(0); PG8_MMA(1, 0, At, B0); PG8_BAR; PG8_SCHED;
            PG8_STAGE(PG8_SB(0, 1), b2 + hstep, voffB);
            PG8_WAIT_V(6); PG8_BAR; PG8_MMA(1, 1, At, B1); PG8_BAR;
            PG8_LDB(B0, 1, 0); PG8_SCHED; PG8_LDA(At, 1, 0); PG8_STAGE(PG8_SA(0, 1), a2 + hstep, voffA);
            PG8_WAIT_L(8); PG8_BAR; PG8_WAIT_L(0); PG8_MMA(0, 0, At, B0); PG8_BAR; PG8_SCHED;
            PG8_LDB(B1, 1, 1); PG8_STAGE(PG8_SB(1, 0), b3, voffB);
            PG8_BAR; PG8_WAIT_L(0); PG8_MMA(0, 1, At, B1); PG8_BAR;
            PG8_LDA(At, 1, 1); PG8_STAGE(PG8_SA(1, 0), a3, voffA);
            PG8_BAR; PG8_WAIT_L(0); PG8_MMA(1, 0, At, B0); PG8_BAR; PG8_SCHED;
            PG8_STAGE(PG8_SB(1, 1), b3 + hstep, voffB);
            PG8_WAIT_V(6); PG8_BAR; PG8_MMA(1, 1, At, B1); PG8_BAR;
            }
        }
        if constexpr (ALIGN_EPI) { if (wr == 0) PG8_BAR; }
        if constexpr (!Epi::AFTER_DRAIN) { E(acc, cur, wr, wc, fr, fq); S.done(cur); }
        if (!has_next) break;
#pragma unroll
        for (int a = 0; a < 2; ++a)
#pragma unroll
            for (int b = 0; b < 2; ++b)
#pragma unroll
                for (int m = 0; m < 4; ++m)
#pragma unroll
                    for (int n = 0; n < 2; ++n) acc[a][b][m][n] = (f32x4){0.f, 0.f, 0.f, 0.f};
        cur = nxt; cA = nA; cB = nB; ++ui;
        if constexpr (ALIGN_EPI) { if (wr == 1) PG8_BAR; }
    }
    PG8_WAIT_V(0);
    if constexpr (!ALIGN_EPI) { if (wr == 0) PG8_BAR; }
    PG8_BAR;
    if constexpr (Epi::AFTER_DRAIN) { E.fused(acc, cur, wr, wc, fr, fq, lds, wid, lane); S.done(cur); }
#undef PG8_SA
#undef PG8_SB
#undef PG8_STAGE
#undef PG8_LDA
#undef PG8_LDB
#undef PG8_MMA
#undef PG8_WAIT_V
#undef PG8_WAIT_L
#undef PG8_BAR
#undef PG8_SCHED
}
}

#define LAS __attribute__((address_space(3)))
typedef unsigned short bf16_t;
typedef short bf16x8 __attribute__((ext_vector_type(8)));
typedef float f32x4 __attribute__((ext_vector_type(4)));
typedef float f32x16 __attribute__((ext_vector_type(16)));
typedef unsigned u32x4 __attribute__((ext_vector_type(4)));
typedef unsigned u32x2 __attribute__((ext_vector_type(2)));

#ifndef MK_MULTI
#define MK_MULTI 0
#endif

constexpr int DM = 1024, MP = 16384, MS = 2048, MT = MP + MS;
constexpr int NPROJ = 3328, NPJ = 3072, DFF = 2816;
constexpr float EPS = 1e-6f;
constexpr float LOG2E = 1.4426950408889634f;
constexpr float QSCALE2 = 0.125f * LOG2E;
constexpr size_t O_Y = 0, O_GSP = 18874368, O_FKP = 19922944, O_FVP = 36700160, O_FLP = 53477376, O_GSS = 53739520, O_FKS = 57933824, O_FVS = 60030976, O_FLS = 62128128;
constexpr size_t MiB = 1u << 20;
constexpr size_t WS_CTL = 0, CTL_BYTES = 2 * MiB;
constexpr size_t WS_SS = 65536;
constexpr size_t WS_WGIN = 2 * MiB, WS_WFIN = 9 * MiB, WS_WGOUT = 16 * MiB, WS_WFOUT = 18 * MiB, WS_WFFI = 20 * MiB  , WS_WFFD = 42 * MiB  ;
constexpr size_t WS_XB = 54 * MiB, WS_XR = 90 * MiB, WS_PROJ = 162 * MiB, WS_GL = 270 * MiB, WS_DST = 272 * MiB, WS_DEC = 400 * MiB, WS_SPREV = 401 * MiB;
constexpr size_t WS_OG = 465 * MiB, WS_ACT = 501 * MiB, WS_CP = 600 * MiB, WS_CS = 601 * MiB, WS_END = 606 * MiB;
constexpr int LDS_BYTES = 135168;

struct Args {
    const float* in[19];
    float* out; unsigned char* ws;
    int ph_lo, ph_hi;
};
enum { I_XP = 0, I_XS, I_STATE, I_CK, I_CV, I_CLF, I_NMIX, I_GWIN, I_GWG2, I_GBG, I_GNORM, I_GWOUT, I_FWIN, I_FBF, I_FWOUT, I_NFFN, I_FFIN, I_FFDN, I_NFIN };

__device__ __forceinline__ float bf2f(unsigned u) { return __uint_as_float(u << 16); }
__device__ __forceinline__ unsigned f2bf(float f) { unsigned u = __float_as_uint(f); return (u + 0x7fffu + ((u >> 16) & 1u)) >> 16; }
__device__ __forceinline__ unsigned pk(float lo, float hi) { return pg8::cvt_pk_bf16(lo, hi); }
__device__ __forceinline__ float wave_sum(float v) {
#pragma unroll
    for (int o = 1; o < 64; o <<= 1) v += __shfl_xor(v, o);
    return v;
}
__device__ __forceinline__ float log_sigmoid(float z) { return fminf(z, 0.f) - __logf(1.f + __expf(-fabsf(z))); }
__device__ __forceinline__ int crow(int r, int hi) { return (r & 3) + 8 * (r >> 2) + 4 * hi; }
__device__ __forceinline__ float dot4(f32x4 v) { return (v[0] * v[0] + v[1] * v[1]) + (v[2] * v[2] + v[3] * v[3]); }
#define MFMA32(a, b, c) __builtin_amdgcn_mfma_f32_32x32x16_bf16((a), (b), (c), 0, 0, 0)

#define XB_TMO      128
#define XB_XCNT(j)  (256  + 64 * (j))
#define XB_XSUB(j)  (1280 + 64 * (j))
#define XB_XGEN(j)  (2304 + 64 * (j))
#define XB_TOP      3328
#define XB_TOPGEN   3392
#define XCD_BAR_WORDS 3456
#define XB_SPIN_CAP (1u << 18)

__device__ __forceinline__ unsigned xb_ld(unsigned* p)              { return __hip_atomic_load(p, __ATOMIC_RELAXED, __HIP_MEMORY_SCOPE_AGENT); }
__device__ __forceinline__ unsigned xb_add(unsigned* p, unsigned v) { return __hip_atomic_fetch_add(p, v, __ATOMIC_RELAXED, __HIP_MEMORY_SCOPE_AGENT); }
__device__ __forceinline__ unsigned xb_xcc_id() { return (unsigned)__builtin_amdgcn_s_getreg((3 << 11) | 20) & 0xFu; }
#define XB_SPIN(cond, bar) do { unsigned _sp = 0; while (cond) { __builtin_amdgcn_s_sleep(1); \
    if ((++_sp & 255u) == 0u) { if (xb_ld(&(bar)[XB_TMO])) break; if (_sp > XB_SPIN_CAP) { atomicAdd(&(bar)[XB_TMO], 1u); break; } } } } while (0)

struct XcdBarrier {
    unsigned* bar; unsigned x;
    volatile LAS unsigned* st;
};

__device__ __forceinline__ XcdBarrier xcd_barrier_post(unsigned* bar, volatile LAS unsigned* st) {
    XcdBarrier b; b.bar = bar; b.x = xb_xcc_id(); b.st = st;
    if (threadIdx.x == 0) (void)xb_add(&bar[XB_XCNT(b.x)], 1u);
    return b;
}
__device__ __forceinline__ void xcd_barrier_complete(unsigned* bar, unsigned x, unsigned& nloc, unsigned& nx) {
    const unsigned G = gridDim.x * gridDim.y * gridDim.z;
    unsigned sum, cnt, mine, sp = 0u;
    for (;;) {
        sum = 0u; cnt = 0u; mine = 0u;
#pragma unroll
        for (unsigned j = 0; j < 16; ++j) { const unsigned c = xb_ld(&bar[XB_XCNT(j)]); sum += c; cnt += (c > 0u) ? 1u : 0u; mine = (j == x) ? c : mine; }
        if (sum == G) break;
        __builtin_amdgcn_s_sleep(1);
        if ((++sp & 255u) == 0u) { if (xb_ld(&bar[XB_TMO])) break; if (sp > XB_SPIN_CAP) { atomicAdd(&bar[XB_TMO], 1u); break; } }
    }
    nloc = mine > 0u ? mine : 1u; nx = cnt > 0u ? cnt : 1u;
}

__device__ __forceinline__ void xcd_barrier(const XcdBarrier& b) {
    asm volatile("s_waitcnt vmcnt(0)" ::: "memory");
    __syncthreads();
    if (threadIdx.x == 0) {
        unsigned* bar = b.bar;
        __builtin_amdgcn_s_waitcnt(0);
        unsigned nloc = b.st[0], nx = b.st[1];
        if (nloc == 0u) { xcd_barrier_complete(bar, b.x, nloc, nx); b.st[0] = nloc; b.st[1] = nx; }
        const unsigned old = xb_add(&bar[XB_XSUB(b.x)], 1u);
        const unsigned gen = old / nloc;
        if (old + 1u == (gen + 1u) * nloc) {
            __builtin_amdgcn_fence(__ATOMIC_RELEASE, "agent");
            asm volatile("s_waitcnt vmcnt(0)" ::: "memory");
            const unsigned og = xb_add(&bar[XB_TOP], 1u);
            const unsigned tg = og / nx;
            if (og + 1u == (tg + 1u) * nx) xb_add(&bar[XB_TOPGEN], 1u);
            else XB_SPIN(xb_ld(&bar[XB_TOPGEN]) == tg, bar);
            __builtin_amdgcn_fence(__ATOMIC_ACQUIRE, "agent");
            xb_add(&bar[XB_XGEN(b.x)], 1u);
            asm volatile("s_waitcnt vmcnt(0)" ::: "memory");
        } else {
            XB_SPIN(xb_ld(&bar[XB_XGEN(b.x)]) == gen, bar);
            __builtin_amdgcn_fence(__ATOMIC_ACQUIRE, "agent");
            asm volatile("s_waitcnt vmcnt(0)" ::: "memory");
        }
    }
    __syncthreads();
}

__device__ __forceinline__ void tr_item(const float* __restrict__ W, int K, int N, int nsrc0, bf16_t* WT, int drow0, const float* __restrict__ gain, LAS float* scr, int k0, int lane) {
    const int n = nsrc0 + (lane & 31);
#pragma unroll 8
    for (int i = 0; i < 32; ++i) {
        const int kk = 2 * i + (lane >> 5);
        float v = (n < N) ? W[(size_t)(k0 + kk) * N + n] : 0.f;
        if (gain) v *= gain[k0 + kk];
        scr[kk * 33 + (lane & 31)] = v;
    }
    asm volatile("s_waitcnt lgkmcnt(0)" ::: "memory");
    const int c = lane & 7;
#pragma unroll
    for (int j = 0; j < 4; ++j) {
        const int nn = (lane >> 3) + 8 * j; const LAS float* s = scr + (8 * c) * 33 + nn;
        u32x4 o; o.x = pk(s[0 * 33], s[1 * 33]); o.y = pk(s[2 * 33], s[3 * 33]); o.z = pk(s[4 * 33], s[5 * 33]); o.w = pk(s[6 * 33], s[7 * 33]);
        *(u32x4*)(WT + (size_t)(drow0 + nn) * K + k0 + 8 * c) = o;
    }
    asm volatile("s_waitcnt lgkmcnt(0)" ::: "memory");
}

__device__ __forceinline__ void p0_prologue(const Args& a, LAS unsigned char* lds, int vcu, int G) {
    const int tid = threadIdx.x, lane = tid & 63, wave = tid >> 6;
    LAS float* scr = (LAS float*)(lds + wave * 16384);
    const int gw = vcu * 8 + wave, NGW = G * 8;
    unsigned char* ws = a.ws;
    constexpr int I_IN = 16 * 104, I_OUT = 16 * 32, I_FI = 16 * 176, I_FD = 44 * 32;
    constexpr int NITEMS = 2 * I_IN + 2 * I_OUT + 2 * I_FI + 2 * I_FD;
    for (int it = gw; it < NITEMS; it += NGW) {
        int r = it;
        if (r < I_IN) { const int kb = r / 104, nb = r % 104; tr_item(a.in[I_GWIN], 1024, 3088, 32 * nb, (bf16_t*)(ws + WS_WGIN), 32 * nb, a.in[I_NMIX], scr, 64 * kb, lane); continue; } r -= I_IN;
        if (r < I_IN) { const int kb = r / 104, nb = r % 104; tr_item(a.in[I_FWIN], 1024, 3088, 32 * nb, (bf16_t*)(ws + WS_WFIN), 32 * nb, a.in[I_NMIX] + 1024, scr, 64 * kb, lane); continue; } r -= I_IN;
        if (r < I_OUT) { const int kb = r / 32, nb = r % 32; tr_item(a.in[I_GWOUT], 1024, 1024, 32 * nb, (bf16_t*)(ws + WS_WGOUT), 32 * nb, nullptr, scr, 64 * kb, lane); continue; } r -= I_OUT;
        if (r < I_OUT) { const int kb = r / 32, nb = r % 32; tr_item(a.in[I_FWOUT], 1024, 1024, 32 * nb, (bf16_t*)(ws + WS_WFOUT), 32 * nb, nullptr, scr, 64 * kb, lane); continue; } r -= I_OUT;
        if (r < 2 * I_FI) { const int li = r / I_FI; r -= li * I_FI; const int kb = r / 176, nb = r % 176, ns = 32 * nb, bj = ns / DFF, j = ns % DFF, drow = 256 * (j / 128) + 128 * bj + (j % 128);
            tr_item(a.in[I_FFIN] + (size_t)li * 1024 * 5632, 1024, 5632, ns, (bf16_t*)(ws + WS_WFFI + (size_t)li * 11 * MiB), drow, a.in[I_NFFN] + li * 1024, scr, 64 * kb, lane); continue; } r -= 2 * I_FI;
        { const int li = r / I_FD; r -= li * I_FD; const int kb = r / 32, nb = r % 32;
            tr_item(a.in[I_FFDN] + (size_t)li * DFF * 1024, DFF, 1024, 32 * nb, (bf16_t*)(ws + WS_WFFD + (size_t)li * 6 * MiB), 32 * nb, nullptr, scr, 64 * kb, lane); }
    }
    float* ss0 = (float*)(ws + WS_SS);
    bf16_t* XB = (bf16_t*)(ws + WS_XB);
    for (int m = gw; m < MT; m += NGW) {
        const float* xr = (m < MP) ? a.in[I_XP] + (size_t)m * DM : a.in[I_XS] + (size_t)(m - MP) * DM;
        f32x4 v[4]; float s = 0.f;
#pragma unroll
        for (int j = 0; j < 4; ++j) { v[j] = ((const f32x4*)xr)[lane + 64 * j]; s += dot4(v[j]); }
        s = wave_sum(s);
        if (lane == 0) ss0[m] = s;
#pragma unroll
        for (int j = 0; j < 4; ++j) { u32x2 o; o.x = pk(v[j][0], v[j][1]); o.y = pk(v[j][2], v[j][3]); ((u32x2*)(XB + (size_t)m * DM))[lane + 64 * j] = o; }
    }
}

__device__ __forceinline__ void p_final(const Args& a, int vcu, int G) {
    const int tid = threadIdx.x, lane = tid & 63, wave = tid >> 6;
    const int gw = vcu * 8 + wave, NGW = G * 8;
    const float* ss = (const float*)(a.ws + WS_SS + 4 * 131072);
    const float* XR = (const float*)(a.ws + WS_XR);
    const float* g = a.in[I_NFIN];
    f32x4 gv[4];
#pragma unroll
    for (int j = 0; j < 4; ++j) gv[j] = ((const f32x4*)g)[lane + 64 * j];
    for (int m = gw; m < MT; m += NGW) {
        const float rs = rsqrtf(ss[m] * (1.f / DM) + EPS);
#pragma unroll
        for (int j = 0; j < 4; ++j) { f32x4 v = ((const f32x4*)(XR + (size_t)m * DM))[lane + 64 * j]; ((f32x4*)(a.out + O_Y + (size_t)m * DM))[lane + 64 * j] = v * rs * gv[j]; }
    }
}

struct EpiGlaProj {
    static constexpr bool PERM = true, AFTER_DRAIN = false;
    const float* ss; bf16_t* proj; float* gl;
    __device__ __forceinline__ void operator()(const pg8::f32x4 (&acc)[2][2][4][2], const pg8::Unit& u, int wr, int wc, int fr, int fq) const {
        const int row0 = u.pm * 256 + wr * 64 + fr;
#pragma unroll
        for (int ai = 0; ai < 2; ++ai)
#pragma unroll
            for (int m = 0; m < 4; ++m) {
                const int row = row0 + ai * 128 + m * 16; const float rs = rsqrtf(ss[row] * (1.f / DM) + EPS);
                if (u.pn < 12) {
#pragma unroll
                    for (int bj = 0; bj < 2; ++bj) { const f32x4 v0 = acc[ai][bj][m][0] * rs, v1 = acc[ai][bj][m][1] * rs;
                        u32x4 w; w.x = pk(v0[0], v0[1]); w.y = pk(v0[2], v0[3]); w.z = pk(v1[0], v1[1]); w.w = pk(v1[2], v1[3]);
                        *(u32x4*)(proj + (size_t)row * NPJ + u.pn * 256 + bj * 128 + wc * 32 + 8 * fq) = w; }
                } else if (wc == 0 && fq < 2) {
#pragma unroll
                    for (int n = 0; n < 2; ++n) *(f32x4*)(gl + (size_t)row * 16 + 8 * fq + 4 * n) = acc[ai][0][m][n] * rs;
                }
            }
    }
};
struct EpiResid {
    static constexpr bool PERM = true, AFTER_DRAIN = false;
    const float* xin_p; const float* xin_s; float* xout; bf16_t* xb; float* ssout;
    __device__ __forceinline__ void operator()(const pg8::f32x4 (&acc)[2][2][4][2], const pg8::Unit& u, int wr, int wc, int fr, int fq) const {
        const int row0 = u.pm * 256 + wr * 64 + fr;
#pragma unroll
        for (int ai = 0; ai < 2; ++ai)
#pragma unroll
            for (int m = 0; m < 4; ++m) {
                const int row = row0 + ai * 128 + m * 16;
                const float* xi = (row < MP) ? xin_p + (size_t)row * DM : xin_s + (size_t)(row - MP) * DM;
                float sq = 0.f;
#pragma unroll
                for (int bj = 0; bj < 2; ++bj) { const int col = u.pn * 256 + bj * 128 + wc * 32 + 8 * fq;
                    const f32x4 a0 = *(const f32x4*)(xi + col) + acc[ai][bj][m][0], a1 = *(const f32x4*)(xi + col + 4) + acc[ai][bj][m][1];
                    *(f32x4*)(xout + (size_t)row * DM + col) = a0; *(f32x4*)(xout + (size_t)row * DM + col + 4) = a1;
                    u32x4 w; w.x = pk(a0[0], a0[1]); w.y = pk(a0[2], a0[3]); w.z = pk(a1[0], a1[1]); w.w = pk(a1[2], a1[3]);
                    *(u32x4*)(xb + (size_t)row * DM + col) = w;
                    sq += dot4(a0) + dot4(a1); }
                sq += __shfl_xor(sq, 16); sq += __shfl_xor(sq, 32);
                if (fq == 0) atomicAdd(ssout + row, sq);
            }
    }
};
struct EpiSwiglu {
    static constexpr bool PERM = true, AFTER_DRAIN = false;
    const float* ss; bf16_t* act;
    __device__ __forceinline__ void operator()(const pg8::f32x4 (&acc)[2][2][4][2], const pg8::Unit& u, int wr, int wc, int fr, int fq) const {
        const int row0 = u.pm * 256 + wr * 64 + fr;
#pragma unroll
        for (int ai = 0; ai < 2; ++ai)
#pragma unroll
            for (int m = 0; m < 4; ++m) {
                const int row = row0 + ai * 128 + m * 16; const float rs = rsqrtf(ss[row] * (1.f / DM) + EPS);
                float y[8];
#pragma unroll
                for (int n = 0; n < 2; ++n)
#pragma unroll
                    for (int i = 0; i < 4; ++i) { const float g = acc[ai][0][m][n][i] * rs, up = acc[ai][1][m][n][i] * rs; y[4 * n + i] = g * up * __builtin_amdgcn_rcpf(1.f + __expf(-g)); }
                u32x4 w; w.x = pk(y[0], y[1]); w.y = pk(y[2], y[3]); w.z = pk(y[4], y[5]); w.w = pk(y[6], y[7]);
                *(u32x4*)(act + (size_t)row * DFF + u.pn * 128 + wc * 32 + 8 * fq) = w;
            }
    }
};
struct EpiFoxProj {
    static constexpr bool PERM = true, AFTER_DRAIN = false;
    const float* ss; bf16_t* qkv; float* out; const float* bf;
    __device__ __forceinline__ void operator()(const pg8::f32x4 (&acc)[2][2][4][2], const pg8::Unit& u, int wr, int wc, int fr, int fq) const {
        const int row0 = u.pm * 256 + wr * 64 + fr;
        const int sect = u.pn >> 2;
#pragma unroll
        for (int ai = 0; ai < 2; ++ai)
#pragma unroll
            for (int m = 0; m < 4; ++m) {
                const int row = row0 + ai * 128 + m * 16; const float rs = rsqrtf(ss[row] * (1.f / DM) + EPS);
                if (u.pn < 12) {
                    const float sc = (sect == 0) ? rs * QSCALE2 : rs;
                    float* fdst = nullptr;
                    if (sect == 1) fdst = (row < MP) ? out + O_FKP + (size_t)row * DM : out + O_FKS + (size_t)(row - MP) * DM;
                    if (sect == 2) fdst = (row < MP) ? out + O_FVP + (size_t)row * DM : out + O_FVS + (size_t)(row - MP) * DM;
#pragma unroll
                    for (int bj = 0; bj < 2; ++bj) { const f32x4 v0 = acc[ai][bj][m][0] * sc, v1 = acc[ai][bj][m][1] * sc;
                        u32x4 w; w.x = pk(v0[0], v0[1]); w.y = pk(v0[2], v0[3]); w.z = pk(v1[0], v1[1]); w.w = pk(v1[2], v1[3]);
                        const int cl = bj * 128 + wc * 32 + 8 * fq;
                        *(u32x4*)(qkv + (size_t)row * NPJ + u.pn * 256 + cl) = w;
                        if (sect > 0) { float* d = fdst + (u.pn & 3) * 256 + cl; *(f32x4*)d = v0; *(f32x4*)(d + 4) = v1; } }
                } else if (wc == 0 && fq < 2) {
                    float* d = (row < MP) ? out + O_FLP + (size_t)row * 16 : out + O_FLS + (size_t)(row - MP) * 16;
#pragma unroll
                    for (int n = 0; n < 2; ++n) { const f32x4 v = acc[ai][0][m][n] * rs; f32x4 o;
#pragma unroll
                        for (int i = 0; i < 4; ++i) o[i] = log_sigmoid(v[i] + bf[8 * fq + 4 * n + i]);
                        *(f32x4*)(d + 8 * fq + 4 * n) = o; }
                }
            }
    }
};

constexpr int GL_OFF = 0, GSUM_OFF = 4096, DECS_OFF = 6144, QE_OFF = 8192, KE_OFF = 25600, VT_OFF = 43008, AL_OFF = 79872, KDT_OFF = 8192, OL_OFF = 8192;
constexpr int QES = 136, VTS = 72, OLS = 260;

template <int MODE> __device__ __forceinline__ void gla_item(const Args& a, LAS unsigned char* lds, int cid, int h) {
    const int tid = threadIdx.x, lane = tid & 63, w = tid >> 6, l31 = lane & 31, hi = lane >> 5;
    const int row0 = cid * 64;
    const bool prompt = cid < 256;
    LAS float* GLs = (LAS float*)(lds + GL_OFF); LAS float* GSUM = (LAS float*)(lds + GSUM_OFF); LAS float* DECS = (LAS float*)(lds + DECS_OFF);
    LAS bf16_t* QE = (LAS bf16_t*)(lds + QE_OFF); LAS bf16_t* KE = (LAS bf16_t*)(lds + KE_OFF); LAS bf16_t* VT = (LAS bf16_t*)(lds + VT_OFF);
    LAS bf16_t* AL = (LAS bf16_t*)(lds + AL_OFF); LAS bf16_t* KDT = (LAS bf16_t*)(lds + KDT_OFF);
    const bf16_t* P = (const bf16_t*)(a.ws + WS_PROJ) + (size_t)row0 * NPJ;
    const float* GL = (const float*)(a.ws + WS_GL);
    const float* state = a.in[I_STATE];

    bf16x8 sfr[8];
    if (MODE == 1) {
        if (prompt) {
            const bf16_t* sp = (const bf16_t*)(a.ws + WS_SPREV) + ((size_t)(cid * 4 + h) * 256 + 32 * w + l31) * 128 + 8 * hi;
#pragma unroll
            for (int ks = 0; ks < 8; ++ks) sfr[ks] = *(const bf16x8*)(sp + 16 * ks);
        } else {
            const float* s0 = state + ((size_t)((cid - 256) * 4 + h) * 128) * 256 + 32 * w + l31;
#pragma unroll
            for (int ks = 0; ks < 8; ++ks) { float f[8];
#pragma unroll
                for (int j = 0; j < 8; ++j) f[j] = s0[(size_t)(16 * ks + 8 * hi + j) * 256];
                u32x4 o; o.x = pk(f[0], f[1]); o.y = pk(f[2], f[3]); o.z = pk(f[4], f[5]); o.w = pk(f[6], f[7]); sfr[ks] = __builtin_bit_cast(bf16x8, o); }
        }
    }
    if (tid < 256) ((LAS f32x4*)GLs)[tid] = *(const f32x4*)(GL + (size_t)(row0 + (tid >> 2)) * 16 + (tid & 3) * 4);
    {
        const int dvv = tid & 255, th = tid >> 8; const bf16_t* vp = P + (size_t)(32 * th) * NPJ + 1024 + h * 256 + dvv;
#pragma unroll
        for (int q4 = 0; q4 < 4; ++q4) { unsigned e[8];
#pragma unroll
            for (int i = 0; i < 8; ++i) e[i] = vp[(size_t)(8 * q4 + i) * NPJ];
            u32x4 o; o.x = e[0] | (e[1] << 16); o.y = e[2] | (e[3] << 16); o.z = e[4] | (e[5] << 16); o.w = e[6] | (e[7] << 16);
            *(LAS u32x4*)(VT + dvv * VTS + 32 * th + 8 * q4) = o; }
    }
    __syncthreads();
    const int dk = tid & 127, tg = tid >> 7;
    float bc[16];
    {
        float wv[16];
#pragma unroll
        for (int j = 0; j < 16; ++j) wv[j] = a.in[I_GWG2][j * 512 + h * 128 + dk];
        const float bias = a.in[I_GBG][h * 128 + dk];
        float run = 0.f;
#pragma unroll
        for (int i = 0; i < 16; ++i) { const LAS f32x4* gp = (const LAS f32x4*)(GLs + (16 * tg + i) * 16); float z = bias;
#pragma unroll
            for (int j4 = 0; j4 < 4; ++j4) { const f32x4 gq = gp[j4]; z += gq[0] * wv[4 * j4] + gq[1] * wv[4 * j4 + 1] + gq[2] * wv[4 * j4 + 2] + gq[3] * wv[4 * j4 + 3]; }
            run += log_sigmoid(z) * (1.f / 16.f); bc[i] = run; }
        GSUM[tg * 128 + dk] = run;
    }
    __syncthreads();
    float off = 0.f, blast = 0.f;
#pragma unroll
    for (int g = 0; g < 4; ++g) { const float s = GSUM[g * 128 + dk]; blast += s; if (g < tg) off += s; }
    const bf16_t* kp = P + (size_t)(16 * tg) * NPJ + 512 + h * 128 + dk;
    if (MODE == 0) {
        float kd[16];
#pragma unroll
        for (int i = 0; i < 16; ++i) { const float b = bc[i] + off; kd[i] = bf2f(kp[(size_t)i * NPJ]) * __expf(blast - b); }
        u32x4 o0, o1; o0.x = pk(kd[0], kd[1]); o0.y = pk(kd[2], kd[3]); o0.z = pk(kd[4], kd[5]); o0.w = pk(kd[6], kd[7]);
        o1.x = pk(kd[8], kd[9]); o1.y = pk(kd[10], kd[11]); o1.z = pk(kd[12], kd[13]); o1.w = pk(kd[14], kd[15]);
        *(LAS u32x4*)(KDT + dk * VTS + 16 * tg) = o0; *(LAS u32x4*)(KDT + dk * VTS + 16 * tg + 8) = o1;
        if (tg == 0) { const float d = __expf(blast); DECS[dk] = d; if (prompt) ((float*)(a.ws + WS_DEC))[(size_t)(cid * 4 + h) * 128 + dk] = d; }
    } else {
        const bf16_t* qp = P + (size_t)(16 * tg) * NPJ + h * 128 + dk;
#pragma unroll
        for (int i = 0; i < 16; ++i) { const float b = bc[i] + off; const int t = 16 * tg + i;
            const float qe = bf2f(qp[(size_t)i * NPJ]) * __expf(b) * 0.08838834764831845f, ke = bf2f(kp[(size_t)i * NPJ]) * __expf(-b);
            QE[t * QES + dk] = (bf16_t)f2bf(qe); KE[t * QES + dk] = (bf16_t)f2bf(ke); }
    }
    __syncthreads();
    if (MODE == 0) {
        bf16x8 vf[4];
#pragma unroll
        for (int ks = 0; ks < 4; ++ks) vf[ks] = *(const LAS bf16x8*)(VT + (32 * w + l31) * VTS + 16 * ks + 8 * hi);
        f32x16 acc[4];
#pragma unroll
        for (int d = 0; d < 4; ++d) acc[d] = f32x16{};
#pragma unroll
        for (int d = 0; d < 4; ++d)
#pragma unroll
            for (int ks = 0; ks < 4; ++ks) { const bf16x8 kf = *(const LAS bf16x8*)(KDT + (32 * d + l31) * VTS + 16 * ks + 8 * hi);
                acc[d] = prompt ? MFMA32(vf[ks], kf, acc[d]) : MFMA32(kf, vf[ks], acc[d]); }
        if (prompt) {
            float* dst = (float*)(a.ws + WS_DST) + ((size_t)(cid * 4 + h) * 256 + 32 * w) * 128;
#pragma unroll
            for (int d = 0; d < 4; ++d)
#pragma unroll
                for (int r = 0; r < 16; ++r) dst[(size_t)crow(r, hi) * 128 + 32 * d + l31] = acc[d][r];
        } else {
            const size_t base = ((size_t)((cid - 256) * 4 + h) * 128) * 256;
            float* outs = a.out + O_GSS;
#pragma unroll
            for (int d = 0; d < 4; ++d)
#pragma unroll
                for (int r = 0; r < 16; ++r) { const int dkk = 32 * d + crow(r, hi); const size_t idx = base + (size_t)dkk * 256 + 32 * w + l31; outs[idx] = state[idx] * DECS[dkk] + acc[d][r]; }
        }
    } else {
        f32x16 o[2]; o[0] = f32x16{}; o[1] = f32x16{};
#pragma unroll
        for (int tb = 0; tb < 2; ++tb)
#pragma unroll
            for (int ks = 0; ks < 8; ++ks) { const bf16x8 qa = *(const LAS bf16x8*)(QE + (32 * tb + l31) * QES + 16 * ks + 8 * hi); o[tb] = MFMA32(qa, sfr[ks], o[tb]); }
        if (w < 3) {
            const int tb = (w > 0) ? 1 : 0, sb = (w == 2) ? 1 : 0;
            f32x16 am = f32x16{};
#pragma unroll
            for (int ks = 0; ks < 8; ++ks) { const bf16x8 qa = *(const LAS bf16x8*)(QE + (32 * tb + l31) * QES + 16 * ks + 8 * hi), kb = *(const LAS bf16x8*)(KE + (32 * sb + l31) * QES + 16 * ks + 8 * hi);
                am = MFMA32(qa, kb, am); }
#pragma unroll
            for (int r = 0; r < 16; ++r) { const int tl = crow(r, hi); float v = am[r]; if (tb == sb && l31 > tl) v = 0.f; AL[(32 * tb + tl) * VTS + 32 * sb + l31] = (bf16_t)f2bf(v); }
        }
        __syncthreads();
#pragma unroll
        for (int tb = 0; tb < 2; ++tb)
#pragma unroll
            for (int ks = 0; ks < 4; ++ks) { if (tb == 0 && ks >= 2) continue;
                const bf16x8 aa = *(const LAS bf16x8*)(AL + (32 * tb + l31) * VTS + 16 * ks + 8 * hi), vb = *(const LAS bf16x8*)(VT + (32 * w + l31) * VTS + 16 * ks + 8 * hi);
                o[tb] = MFMA32(aa, vb, o[tb]); }
        __syncthreads();
        LAS float* OL = (LAS float*)(lds + OL_OFF);
#pragma unroll
        for (int tb = 0; tb < 2; ++tb)
#pragma unroll
            for (int r = 0; r < 16; ++r) OL[(32 * tb + crow(r, hi)) * OLS + 32 * w + l31] = o[tb][r];
        __syncthreads();
        const f32x4 ng = *(const f32x4*)(a.in[I_GNORM] + h * 256 + 4 * lane);
        bf16_t* OG = (bf16_t*)(a.ws + WS_OG);
#pragma unroll
        for (int i = 0; i < 8; ++i) { const int t = 8 * w + i; const f32x4 v = *(const LAS f32x4*)(OL + t * OLS + 4 * lane);
            const float rs = rsqrtf(wave_sum(dot4(v)) * (1.f / 256.f) + EPS);
            const u32x2 rr = *(const u32x2*)(P + (size_t)t * NPJ + 2048 + h * 256 + 4 * lane);
            float rv[4] = {bf2f(rr.x & 0xffffu), bf2f(rr.x >> 16), bf2f(rr.y & 0xffffu), bf2f(rr.y >> 16)}; float y[4];
#pragma unroll
            for (int j = 0; j < 4; ++j) y[j] = v[j] * rs * ng[j] * rv[j] * __builtin_amdgcn_rcpf(1.f + __expf(-rv[j]));
            u32x2 ov; ov.x = pk(y[0], y[1]); ov.y = pk(y[2], y[3]);
            *(u32x2*)(OG + (size_t)(row0 + t) * DM + h * 256 + 4 * lane) = ov; }
    }
    __syncthreads();
}

__device__ __forceinline__ void gla_scan(const Args& a, int vcu, int G) {
    const int gt = vcu * 512 + threadIdx.x, NT_ = G * 512;
    const float* DST = (const float*)(a.ws + WS_DST); const float* DEC = (const float*)(a.ws + WS_DEC); bf16_t* SP = (bf16_t*)(a.ws + WS_SPREV);
    for (int it = gt; it < 32 * 8192; it += NT_) {
        const int bh = it >> 13, e4 = it & 8191, dv = e4 >> 5, dk4 = (e4 & 31) * 4, b = bh >> 2, h = bh & 3;
        f32x4 S = (f32x4){0.f, 0.f, 0.f, 0.f};
#pragma unroll 8
        for (int c = 0; c < 32; ++c) {
            const size_t ch = (size_t)((b * 32 + c) * 4 + h); const size_t base = (ch * 256 + dv) * 128 + dk4;
            const f32x4 ds = *(const f32x4*)(DST + base), de = *(const f32x4*)(DEC + ch * 128 + dk4);
            u32x2 o; o.x = pk(S[0], S[1]); o.y = pk(S[2], S[3]); *(u32x2*)(SP + base) = o;
            S = S * de + ds;
        }
        float* og = a.out + O_GSP + ((size_t)bh * 128 + dk4) * 256 + dv;
#pragma unroll
        for (int i = 0; i < 4; ++i) og[(size_t)i * 256] = S[i];
    }
}

__device__ __forceinline__ void fox_cumsum(const Args& a, LAS unsigned char* lds, int vcu, int G) {
    const int tid = threadIdx.x, hh = tid & 15, seg = tid >> 4;
    LAS float* SEG = (LAS float*)lds;
    for (int it = vcu; it < 40; it += G) {
        const bool prompt = it < 8; const int b = prompt ? it : it - 8; const int L = prompt ? 64 : 66, LT = prompt ? 2048 : 2112;
        const float* src0 = prompt ? a.out + O_FLP + (size_t)b * 2048 * 16 : a.in[I_CLF] + (size_t)b * 2048 * 16;
        const float* src1 = a.out + O_FLS + (size_t)b * 64 * 16;
        float* dst = (float*)(a.ws + (prompt ? WS_CP : WS_CS)) + (size_t)(b * 16 + hh) * LT;
        float s = 0.f;
        for (int i = 0; i < L; ++i) { const int t = seg * L + i; s += (t < 2048) ? src0[(size_t)t * 16 + hh] : src1[(size_t)(t - 2048) * 16 + hh]; }
        SEG[seg * 16 + hh] = s;
        __syncthreads();
        float run = 0.f;
        for (int g = 0; g < seg; ++g) run += SEG[g * 16 + hh];
        for (int i = 0; i < L; ++i) { const int t = seg * L + i; run += (t < 2048) ? src0[(size_t)t * 16 + hh] : src1[(size_t)(t - 2048) * 16 + hh]; dst[t] = run; }
        __syncthreads();
    }
}

constexpr int AT_KS = 72, AT_VS = 68, AT_BUF = 18176, AT_VOFF = 9216, AT_COFF = 17920;
struct TileRegs { u32x4 k0, k1, v0, v1; float ck; };

template <bool SAMPLE> __device__ __forceinline__ void attn_load(TileRegs& R, const Args& a, int b, int h, int t, const float* cbase, int tid) {
    const int kvl = tid >> 3, ch = tid & 7, kp = tid >> 4, c4 = tid & 15;
    if (SAMPLE && t < 32) {
        const float* kptr = a.in[I_CK] + (((size_t)b * 2048 + 64 * t + kvl) * 16 + h) * 64 + 8 * ch;
        R.k0 = *(const u32x4*)kptr; R.k1 = *(const u32x4*)(kptr + 4);
        const float* vptr = a.in[I_CV] + (((size_t)b * 2048 + 64 * t + 2 * kp) * 16 + h) * 64 + 4 * c4;
        R.v0 = *(const u32x4*)vptr; R.v1 = *(const u32x4*)(vptr + 1024);
    } else {
        const size_t rowbase = SAMPLE ? (size_t)(MP + b * 64) : (size_t)(b * 2048 + 64 * t);
        const bf16_t* qkv = (const bf16_t*)(a.ws + WS_PROJ);
        R.k0 = *(const u32x4*)(qkv + (rowbase + kvl) * NPJ + 1024 + h * 64 + 8 * ch);
        const bf16_t* vptr = qkv + (rowbase + 2 * kp) * NPJ + 2048 + h * 64 + 4 * c4;
        const u32x2 x0 = *(const u32x2*)vptr, x1 = *(const u32x2*)(vptr + NPJ);
        R.v0.x = x0.x; R.v0.y = x0.y; R.v1.x = x1.x; R.v1.y = x1.y;
    }
    if (tid < 64) R.ck = cbase[64 * t + tid] * LOG2E;
}
__device__ __forceinline__ void attn_store(const TileRegs& R, LAS unsigned char* buf, bool f32src, int tid) {
    const int kvl = tid >> 3, ch = tid & 7, kp = tid >> 4, c4 = tid & 15;
    LAS unsigned* VT32 = (LAS unsigned*)(buf + AT_VOFF);
    if (f32src) {
        u32x4 o; o.x = pk(__uint_as_float(R.k0.x), __uint_as_float(R.k0.y)); o.y = pk(__uint_as_float(R.k0.z), __uint_as_float(R.k0.w));
        o.z = pk(__uint_as_float(R.k1.x), __uint_as_float(R.k1.y)); o.w = pk(__uint_as_float(R.k1.z), __uint_as_float(R.k1.w));
        *(LAS u32x4*)(buf + (kvl * AT_KS + 8 * ch) * 2) = o;
#pragma unroll
        for (int i = 0; i < 4; ++i) VT32[(4 * c4 + i) * (AT_VS / 2) + kp] = pk(__uint_as_float(R.v0[i]), __uint_as_float(R.v1[i]));
    } else {
        *(LAS u32x4*)(buf + (kvl * AT_KS + 8 * ch) * 2) = R.k0;
        VT32[(4 * c4 + 0) * (AT_VS / 2) + kp] = (R.v0.x & 0xffffu) | (R.v1.x << 16);
        VT32[(4 * c4 + 1) * (AT_VS / 2) + kp] = (R.v0.x >> 16) | (R.v1.x & 0xffff0000u);
        VT32[(4 * c4 + 2) * (AT_VS / 2) + kp] = (R.v0.y & 0xffffu) | (R.v1.y << 16);
        VT32[(4 * c4 + 3) * (AT_VS / 2) + kp] = (R.v0.y >> 16) | (R.v1.y & 0xffff0000u);
    }
    if (tid < 64) ((LAS float*)(buf + AT_COFF))[tid] = R.ck;
}

template <bool SAMPLE> __device__ __forceinline__ void attn_unit(const Args& a, LAS unsigned char* lds, int b, int h, int qb) {
    const int tid = threadIdx.x, lane = tid & 63, w = tid >> 6, l31 = lane & 31, hi = lane >> 5;
    const int NT = SAMPLE ? 33 : 4 * (qb + 1);
    const bool active = SAMPLE ? (w < 2) : true;
    const int qpos = SAMPLE ? 2048 + 32 * (w & 1) + l31 : 256 * qb + 32 * w + l31;
    const size_t qrow = SAMPLE ? (size_t)(MP + b * 64 + 32 * (w & 1) + l31) : (size_t)(b * 2048 + qpos);
    const float* cbase = SAMPLE ? (const float*)(a.ws + WS_CS) + (size_t)(b * 16 + h) * 2112 : (const float*)(a.ws + WS_CP) + (size_t)(b * 16 + h) * 2048;
    const bf16_t* qkv = (const bf16_t*)(a.ws + WS_PROJ);
    bf16x8 qf[4];
#pragma unroll
    for (int ks = 0; ks < 4; ++ks) qf[ks] = *(const bf16x8*)(qkv + qrow * NPJ + h * 64 + 16 * ks + 8 * hi);
    const float cq2 = cbase[qpos] * LOG2E;
    const int qmax_w = SAMPLE ? 4096 : 256 * qb + 32 * w + 31;
    TileRegs R;
    attn_load<SAMPLE>(R, a, b, h, 0, cbase, tid);
    attn_store(R, lds, SAMPLE, tid);
    __syncthreads();
    float mrun = -INFINITY, lrun = 0.f;
    f32x16 ot[2]; ot[0] = f32x16{}; ot[1] = f32x16{};
    for (int t = 0; t < NT; ++t) {
        if (t + 1 < NT) attn_load<SAMPLE>(R, a, b, h, t + 1, cbase, tid);
        if (active && 64 * t <= qmax_w) {
            LAS unsigned char* buf = lds + (t & 1) * AT_BUF;
            const LAS bf16_t* Ks = (const LAS bf16_t*)buf; const LAS bf16_t* VTs = (const LAS bf16_t*)(buf + AT_VOFF); const LAS float* CKs = (const LAS float*)(buf + AT_COFF);
            f32x16 p0, p1;
#pragma unroll
            for (int r = 0; r < 16; ++r) { p0[r] = cq2; p1[r] = cq2; }
#pragma unroll
            for (int ks = 0; ks < 4; ++ks) { const bf16x8 k0 = *(const LAS bf16x8*)(Ks + l31 * AT_KS + 16 * ks + 8 * hi), k1 = *(const LAS bf16x8*)(Ks + (32 + l31) * AT_KS + 16 * ks + 8 * hi);
                p0 = MFMA32(k0, qf[ks], p0); p1 = MFMA32(k1, qf[ks], p1); }
#pragma unroll
            for (int j = 0; j < 4; ++j) { const f32x4 c0 = *(const LAS f32x4*)(CKs + 8 * j + 4 * hi), c1 = *(const LAS f32x4*)(CKs + 32 + 8 * j + 4 * hi);
#pragma unroll
                for (int i = 0; i < 4; ++i) { p0[4 * j + i] -= c0[i]; p1[4 * j + i] -= c1[i]; } }
            const bool diag = SAMPLE ? (t == 32) : (t >= 4 * qb);
            if (diag) {
#pragma unroll
                for (int r = 0; r < 16; ++r) { const int kv = 64 * t + crow(r, hi); if (kv > qpos) p0[r] = -INFINITY; if (kv + 32 > qpos) p1[r] = -INFINITY; }
            }
            float rm = fmaxf(p0[0], p1[0]);
#pragma unroll
            for (int r = 1; r < 16; ++r) rm = fmaxf(rm, fmaxf(p0[r], p1[r]));
            rm = fmaxf(rm, __shfl_xor(rm, 32));
            const float mn = fmaxf(mrun, rm), alpha = __builtin_amdgcn_exp2f(mrun - mn);
            mrun = mn;
            float rs = 0.f;
#pragma unroll
            for (int r = 0; r < 16; ++r) { p0[r] = __builtin_amdgcn_exp2f(p0[r] - mn); p1[r] = __builtin_amdgcn_exp2f(p1[r] - mn); rs += p0[r] + p1[r]; }
            lrun = lrun * alpha + rs;
#pragma unroll
            for (int r = 0; r < 16; ++r) { ot[0][r] *= alpha; ot[1][r] *= alpha; }
            bf16x8 pf[4];
            { u32x4 x; x.x = pk(p0[0], p0[1]); x.y = pk(p0[2], p0[3]); x.z = pk(p0[4], p0[5]); x.w = pk(p0[6], p0[7]); pf[0] = __builtin_bit_cast(bf16x8, x);
              x.x = pk(p0[8], p0[9]); x.y = pk(p0[10], p0[11]); x.z = pk(p0[12], p0[13]); x.w = pk(p0[14], p0[15]); pf[1] = __builtin_bit_cast(bf16x8, x);
              x.x = pk(p1[0], p1[1]); x.y = pk(p1[2], p1[3]); x.z = pk(p1[4], p1[5]); x.w = pk(p1[6], p1[7]); pf[2] = __builtin_bit_cast(bf16x8, x);
              x.x = pk(p1[8], p1[9]); x.y = pk(p1[10], p1[11]); x.z = pk(p1[12], p1[13]); x.w = pk(p1[14], p1[15]); pf[3] = __builtin_bit_cast(bf16x8, x); }
#pragma unroll
            for (int db = 0; db < 2; ++db)
#pragma unroll
                for (int ks = 0; ks < 4; ++ks) { const LAS bf16_t* vp = VTs + (32 * db + l31) * AT_VS + 16 * ks + 4 * hi;
                    const u32x2 lo = *(const LAS u32x2*)vp, hh2 = *(const LAS u32x2*)(vp + 8);
                    u32x4 x; x.x = lo.x; x.y = lo.y; x.z = hh2.x; x.w = hh2.y;
                    ot[db] = MFMA32(__builtin_bit_cast(bf16x8, x), pf[ks], ot[db]); }
        }
        if (t + 1 < NT) attn_store(R, lds + ((t + 1) & 1) * AT_BUF, SAMPLE && (t + 1 < 32), tid);
        __syncthreads();
    }
    if (active) {
        lrun += __shfl_xor(lrun, 32);
        const float inv = 1.f / lrun;
        bf16_t* og = (bf16_t*)(a.ws + WS_OG) + qrow * DM + h * 64;
#pragma unroll
        for (int db = 0; db < 2; ++db)
#pragma unroll
            for (int j = 0; j < 4; ++j) { u32x2 o; o.x = pk(ot[db][4 * j] * inv, ot[db][4 * j + 1] * inv); o.y = pk(ot[db][4 * j + 2] * inv, ot[db][4 * j + 3] * inv);
                *(u32x2*)(og + 32 * db + 8 * j + 4 * hi) = o; }
    }
}

__device__ __forceinline__ void fox_attention(const Args& a, LAS unsigned char* lds, int vcu, int G) {
    if (G == 256) {
        const int bh = vcu >> 1, s0 = 2 * (vcu & 1);
#pragma unroll 1
        for (int i = 0; i < 4; ++i) attn_unit<false>(a, lds, bh >> 4, bh & 15, (i & 1) ? s0 + (i >> 1) : 7 - s0 - (i >> 1));
    } else {
#pragma unroll 1
        for (int u = vcu; u < 1024; u += G) attn_unit<false>(a, lds, (u & 127) >> 4, u & 15, 7 - (u >> 7));
    }
#pragma unroll 1
    for (int u = vcu; u < 512; u += G) attn_unit<true>(a, lds, u >> 4, u & 15, 0);
}

#ifndef PH_MASK
#define PH_MASK 0x7fff
#endif
#define IN(k) (((PH_MASK >> (k)) & 1) && a.ph_lo <= (k) && (k) < a.ph_hi)
#define SEAM(k) do { if (IN(k) && IN((k) + 1)) { if ((k) == 0) cg::this_grid().sync(); else xcd_barrier(xbar); } } while (0)
#ifndef DUP_MASK
#define DUP_MASK 0
#endif
#define REP(k) _Pragma("unroll 1") for (int rep_ = 0; rep_ < ((((DUP_MASK) >> (k)) & 1) ? 2 : 1); ++rep_)
#define REPSYNC(k) do { if ((((DUP_MASK) >> (k)) & 1)) xcd_barrier(xbar); } while (0)
template <int L> __device__ __forceinline__ void common_gemms(const Args& a, LAS unsigned char* lds, int G, int bx, const XcdBarrier& xbar) {
    unsigned char* ws = a.ws;
    float* SS = (float*)(ws + WS_SS);
    bf16_t* XB = (bf16_t*)(ws + WS_XB); float* XR = (float*)(ws + WS_XR); bf16_t* OG = (bf16_t*)(ws + WS_OG); bf16_t* ACT = (bf16_t*)(ws + WS_ACT);
    constexpr int po = L ? 11 : 5;
    if (IN(po)) { pg8::Gemm g{OG, (const bf16_t*)(ws + (L ? WS_WFOUT : WS_WGOUT)), MT, DM, DM}; pg8::StaticOrder S; S.init(MT, DM, G, bx);
        EpiResid E{L ? XR : a.in[I_XP], L ? XR + (size_t)MP * DM : a.in[I_XS], XR, XB, SS + (L ? 3 : 1) * 32768};
        pg8::gemm_phase<EpiResid, pg8::StaticOrder, true, true>(lds, g, S, E); }
    SEAM(po);
    if (IN(po + 1)) REP(po + 1) { pg8::Gemm g{XB, (const bf16_t*)(ws + WS_WFFI + (size_t)L * 11 * MiB), MT, 2 * DFF, DM}; pg8::StaticOrder S; S.init(MT, 2 * DFF, G, bx);
        EpiSwiglu E{SS + (L ? 3 : 1) * 32768, ACT}; pg8::gemm_phase<EpiSwiglu, pg8::StaticOrder, true, true>(lds, g, S, E); REPSYNC(po + 1); }
    SEAM(po + 1);
    if (IN(po + 2)) { pg8::Gemm g{ACT, (const bf16_t*)(ws + WS_WFFD + (size_t)L * 6 * MiB), MT, DM, DFF}; pg8::StaticOrder S; S.init(MT, DM, G, bx);
        EpiResid E{XR, XR + (size_t)MP * DM, XR, XB, SS + (L ? 4 : 2) * 32768};
        pg8::gemm_phase<EpiResid, pg8::StaticOrder, true, true>(lds, g, S, E); }
    SEAM(po + 2);
}
constexpr int NPH = 15;
__global__ void __launch_bounds__(512, 2) fwd(Args a) {
    extern __shared__ __attribute__((aligned(16))) unsigned char lds_raw[];
    LAS unsigned char* lds = (LAS unsigned char*)lds_raw;
    const int G = gridDim.x, bx = blockIdx.x;
    const int vcu = (G % 8 == 0) ? (bx % 8) * (G / 8) + bx / 8 : bx;
    unsigned char* ws = a.ws;
    float* SS = (float*)(ws + WS_SS);
    bf16_t* XB = (bf16_t*)(ws + WS_XB); bf16_t* PROJ = (bf16_t*)(ws + WS_PROJ);

    volatile LAS unsigned* MISC = (volatile LAS unsigned*)(lds + 131072);
    if (threadIdx.x < 64) MISC[threadIdx.x] = 0u;
    __syncthreads();
    XcdBarrier xbar; xbar.bar = (unsigned*)ws; xbar.x = 0; xbar.st = nullptr;
    if (a.ph_hi - a.ph_lo > 1) xbar = xcd_barrier_post((unsigned*)ws, MISC + 8);
    if (IN(0)) REP(0) { p0_prologue(a, lds, vcu, G); REPSYNC(0); }
    SEAM(0);
    if (IN(1)) { pg8::Gemm g{XB, (const bf16_t*)(ws + WS_WGIN), MT, NPROJ, DM}; pg8::StaticOrder S; S.init(MT, NPROJ, G, bx);
        EpiGlaProj E{SS, PROJ, (float*)(ws + WS_GL)}; pg8::gemm_phase<EpiGlaProj, pg8::StaticOrder, true, true>(lds, g, S, E); }
    SEAM(1);
    if (IN(2)) REP(2) {
#pragma unroll 1
        for (int it = vcu; it < 1152; it += G) gla_item<0>(a, lds, it >> 2, it & 3);
        REPSYNC(2); }
    SEAM(2);
    if (IN(3)) REP(3) { gla_scan(a, vcu, G); REPSYNC(3); }
    SEAM(3);
    if (IN(4)) REP(4) {
#pragma unroll 1
        for (int it = vcu; it < 1152; it += G) gla_item<1>(a, lds, it >> 2, it & 3);
        REPSYNC(4); }
    SEAM(4);
    common_gemms<0>(a, lds, G, bx, xbar);
    if (IN(8)) { pg8::Gemm g{XB, (const bf16_t*)(ws + WS_WFIN), MT, NPROJ, DM}; pg8::StaticOrder S; S.init(MT, NPROJ, G, bx);
        EpiFoxProj E{SS + 2 * 32768, PROJ, a.out, a.in[I_FBF]}; pg8::gemm_phase<EpiFoxProj, pg8::StaticOrder, true, true>(lds, g, S, E); }
    SEAM(8);
    if (IN(9)) REP(9) { fox_cumsum(a, lds, vcu, G); REPSYNC(9); }
    SEAM(9);
    if (IN(10)) REP(10) { fox_attention(a, lds, vcu, G); REPSYNC(10); }
    SEAM(10);
    common_gemms<1>(a, lds, G, bx, xbar);
#ifdef EXTRA_SYNCS
    for (int i_ = 0; i_ < EXTRA_SYNCS; ++i_) xcd_barrier(xbar);
#endif
    if (IN(14)) p_final(a, vcu, G);
#undef IN
#undef SEAM
}

extern "C" void kernel_launch(void* const* d_in, const int* in_sizes, int n_in, void* d_out, int out_size, void* d_ws, size_t ws_size, hipStream_t stream) {
    static int grid = 0;
    if (grid == 0) {
        if (n_in != 19 || ws_size < WS_END || out_size != 62160896) { fprintf(stderr, "kernel_launch: unexpected problem shape (n_in %d, out %d, ws %zu)\n", n_in, out_size, ws_size); grid = -1; return; }
        if (hipFuncSetAttribute((const void*)fwd, hipFuncAttributeMaxDynamicSharedMemorySize, LDS_BYTES) != hipSuccess) { fprintf(stderr, "kernel_launch: hipFuncSetAttribute failed\n"); grid = -1; return; }
        int dev = 0, cus = 0, per_cu = 0;
        (void)hipGetDevice(&dev); (void)hipDeviceGetAttribute(&cus, hipDeviceAttributeMultiprocessorCount, dev);
        (void)hipOccupancyMaxActiveBlocksPerMultiprocessor(&per_cu, (const void*)fwd, 512, LDS_BYTES);
        (void)hipGetLastError();
        if (per_cu < 1) per_cu = 1;
        grid = cus * 1;
        if (grid <= 0) grid = 256;
    }
    if (grid < 0) return;
    (void)hipMemsetAsync((char*)d_ws + WS_CTL, 0, CTL_BYTES, stream);
    Args a{};
    for (int i = 0; i < 19; ++i) a.in[i] = (const float*)d_in[i];
    a.out = (float*)d_out; a.ws = (unsigned char*)d_ws;
#if MK_MULTI
    for (int ph = 0; ph < NPH; ++ph) { a.ph_lo = ph; a.ph_hi = ph + 1; hipLaunchKernelGGL(fwd, dim3(grid), dim3(512), LDS_BYTES, stream, a); }
#else
    a.ph_lo = 0; a.ph_hi = NPH;
    void* args[] = {&a};
    hipError_t e = hipLaunchCooperativeKernel((const void*)fwd, dim3(grid), dim3(512), args, LDS_BYTES, stream);
    if (e != hipSuccess) fprintf(stderr, "kernel_launch: cooperative launch failed: %s (grid %d)\n", hipGetErrorString(e), grid);
#endif
}
```

```cpp
#include <hip/hip_runtime.h>
#include <hip/hip_cooperative_groups.h>
#include <cstdio>
#include <cstdint>
#include <cmath>
namespace cg = cooperative_groups;
#define MK_MULTI 0
namespace pg8 {
#define PG8_LAS __attribute__((address_space(3)))
typedef unsigned short bf16_t;
typedef short bf16x8 __attribute__((ext_vector_type(8)));
typedef float f32x4 __attribute__((ext_vector_type(4)));
typedef unsigned u32x4 __attribute__((ext_vector_type(4)));
constexpr int BM = 256, BK = 64, HALF = 128, HTB = HALF * BK * 2  , STAGE_BYTES = 8 * HTB, NXCD = 8, WGM = 8;

__host__ __device__ __forceinline__ int lds_byte(int r, int c) { const int st = (r >> 4) * 2 + (c >> 5), rr = r & 15, cc = c & 31, ob = rr * 64 + cc * 2; return st * 1024 + (ob ^ (((ob >> 9) & 1) << 5)); }
__host__ __device__ __forceinline__ void stage_rc(int b, int& R, int& C) { const int st = b / 1024, sb = b % 1024, swz = sb ^ (((sb >> 9) & 1) << 5); R = (st >> 1) * 16 + swz / 64; C = (st & 1) * 32 + (swz % 64) / 2; }
__host__ __device__ __forceinline__ int perm32(int rho) { const int n = rho >> 4, i = rho & 15; return 8 * (i >> 2) + 4 * n + (i & 3); }

struct Unit { int pm, pn; };
struct Gemm { const bf16_t* A; const bf16_t* Bt; int M, N, K; };

struct StaticOrder {
    int nM, nN, nwg, G, c;
    __host__ __device__ void init(int M, int N, int G_, int c_) { nM = M / BM; nN = N / BM; nwg = nM * nN; G = G_; c = c_; }
    __host__ __device__ bool next(int i, Unit& u) const {
        const long L = (long)i * G + c; if (L >= nwg) return false;
        int wgid = (int)L; { const int q = nwg / NXCD, r = nwg % NXCD, xcd = wgid % NXCD, off = wgid / NXCD; wgid = (xcd < r ? xcd * (q + 1) : r * (q + 1) + (xcd - r) * q) + off; }
        const int nig = WGM * nN, gid = wgid / nig, fm = gid * WGM, gsz = (nM - fm) < WGM ? (nM - fm) : WGM;
        u.pm = fm + ((wgid % nig) % gsz); u.pn = (wgid % nig) / gsz; return true;
    }
    __device__ __forceinline__ void a_ready(const Unit&) const {}
    __device__ __forceinline__ void done(const Unit&) const {}
};

__device__ __forceinline__ unsigned cvt_pk_bf16(float lo, float hi) { unsigned r; asm volatile("v_cvt_pk_bf16_f32 %0, %1, %2" : "=v"(r) : "v"(lo), "v"(hi)); return r; }
template <class Epi, class Sched, bool ALIGN_EPI = false, bool SP2 = false>
__device__ __forceinline__ void gemm_phase(PG8_LAS unsigned char* lds, const Gemm g, const Sched& S, const Epi& E) {
    const int tid = threadIdx.x, wid = __builtin_amdgcn_readfirstlane(tid >> 6), lane = tid & 63, wr = wid >> 2, wc = wid & 3, fr = lane & 15, fq = lane >> 4;
    const int K = g.K, nt = K / BK;
    unsigned voffA[2], voffB[2];
#pragma unroll
    for (int i = 0; i < 2; ++i) { int R, C; stage_rc(tid * 16 + i * 8192, R, C); const int Rb = Epi::PERM ? ((R & ~31) + perm32(R & 31)) : R;
        voffA[i] = (unsigned)(R * K + C) * 2u; voffB[i] = (unsigned)(Rb * K + C) * 2u; }
    const size_t kstep = (size_t)(BK * 2);
    const size_t hstep = (size_t)HALF * K * 2;
    const size_t tstep = 2 * hstep;
    const unsigned ldsw = (unsigned)wid * 1024u;
    const int aoff = lds_byte(wr * 64 + fr, fq * 8), boff = lds_byte(wc * 32 + fr, fq * 8);
#define PG8_SA(b, h) (((b) * 2 + (h)) * HTB)
#define PG8_SB(b, h) ((4 + (b) * 2 + (h)) * HTB)
#define PG8_STAGE(bufoff, gbase, voff) do { _Pragma("unroll") for (int _i = 0; _i < 2; ++_i) \
        __builtin_amdgcn_global_load_lds((const unsigned*)((const char*)(gbase) + (voff)[_i]), (PG8_LAS unsigned*)(lds + (bufoff) + ldsw + _i * 8192), 16, 0, 0); } while (0)
#define PG8_LDA(dst, b, h) do { _Pragma("unroll") for (int m = 0; m < 4; ++m) _Pragma("unroll") for (int k = 0; k < 2; ++k) dst[m][k] = *(const PG8_LAS bf16x8*)(lds + PG8_SA(b, h) + aoff + m * 2048 + k * 1024); } while (0)
#define PG8_LDB(dst, b, h) do { _Pragma("unroll") for (int n = 0; n < 2; ++n) _Pragma("unroll") for (int k = 0; k < 2; ++k) dst[n][k] = *(const PG8_LAS bf16x8*)(lds + PG8_SB(b, h) + boff + n * 2048 + k * 1024); } while (0)
#define PG8_MMA(ai, bj, At, Bt) do { __builtin_amdgcn_s_setprio(1); _Pragma("unroll") for (int m = 0; m < 4; ++m) _Pragma("unroll") for (int n = 0; n < 2; ++n) _Pragma("unroll") for (int k = 0; k < 2; ++k) \
        acc[ai][bj][m][n] = __builtin_amdgcn_mfma_f32_16x16x32_bf16(Bt[n][k], At[m][k], acc[ai][bj][m][n], 0, 0, 0); __builtin_amdgcn_s_setprio(0); } while (0)
#define PG8_WAIT_V(n) asm volatile("s_waitcnt vmcnt(" #n ")" ::: "memory")
#define PG8_WAIT_L(n) asm volatile("s_waitcnt lgkmcnt(" #n ")" ::: "memory")
#define PG8_BAR __builtin_amdgcn_s_barrier()
#define PG8_SCHED __builtin_amdgcn_sched_barrier(0)
    Unit cur, nxt; int ui = 0;
    if (!S.next(0, cur)) return;
    f32x4 acc[2][2][4][2];
#pragma unroll
    for (int a = 0; a < 2; ++a)
#pragma unroll
        for (int b = 0; b < 2; ++b)
#pragma unroll
            for (int m = 0; m < 4; ++m)
#pragma unroll
                for (int n = 0; n < 2; ++n) acc[a][b][m][n] = (f32x4){0.f, 0.f, 0.f, 0.f};
    bf16x8 At[4][2], B0[2][2], B1[2][2];
    const char* cA = (const char*)g.A + (size_t)cur.pm * tstep; const char* cB = (const char*)g.Bt + (size_t)cur.pn * tstep;
    S.a_ready(cur);
    if constexpr (SP2) {
        PG8_STAGE(PG8_SB(0, 0), cB, voffB); PG8_STAGE(PG8_SB(0, 1), cB + hstep, voffB); PG8_STAGE(PG8_SA(0, 0), cA, voffA); PG8_STAGE(PG8_SA(0, 1), cA + hstep, voffA);
        if (wr == 1) PG8_BAR;
        PG8_WAIT_V(2); PG8_BAR;
        PG8_STAGE(PG8_SB(1, 0), cB + kstep, voffB); PG8_STAGE(PG8_SA(1, 0), cA + kstep, voffA); PG8_STAGE(PG8_SB(1, 1), cB + hstep + kstep, voffB);
        PG8_WAIT_V(6); PG8_BAR;
    } else {
        PG8_STAGE(PG8_SB(0, 0), cB, voffB); PG8_STAGE(PG8_SA(0, 0), cA, voffA); PG8_STAGE(PG8_SB(0, 1), cB + hstep, voffB); PG8_STAGE(PG8_SA(0, 1), cA + hstep, voffA);
        if (wr == 1) PG8_BAR;
        PG8_WAIT_V(4); PG8_BAR;
        PG8_STAGE(PG8_SB(1, 0), cB + kstep, voffB); PG8_STAGE(PG8_SA(1, 0), cA + kstep, voffA); PG8_STAGE(PG8_SB(1, 1), cB + hstep + kstep, voffB);
        PG8_WAIT_V(6); PG8_BAR;
    }
    for (;;) {
        const bool has_next = S.next(ui + 1, nxt);
        const char* nA = has_next ? (const char*)g.A + (size_t)nxt.pm * tstep : cA; const char* nB = has_next ? (const char*)g.Bt + (size_t)nxt.pn * tstep : cB;
        for (int t = 0; t < nt; t += 2) {
            const bool last = (t == nt - 2);
            const char* a1 = cA + (size_t)(t + 1) * kstep;
            const char* a2 = last ? nA : cA + (size_t)(t + 2) * kstep; const char* b2 = last ? nB : cB + (size_t)(t + 2) * kstep;
            const char* a3 = a2 + kstep; const char* b3 = b2 + kstep;
            if (last && has_next) S.a_ready(nxt);
            if constexpr (SP2) {
            PG8_LDB(B0, 0, 0); PG8_LDB(B1, 0, 1); PG8_SCHED; PG8_LDA(At, 0, 0); PG8_STAGE(PG8_SA(1, 1), a1 + hstep, voffA);
            PG8_WAIT_V(8); PG8_WAIT_L(0); PG8_BAR; PG8_MMA(0, 0, At, B0); PG8_MMA(0, 1, At, B1); PG8_BAR; PG8_SCHED;
            PG8_LDA(At, 0, 1); PG8_STAGE(PG8_SB(0, 0), b2, voffB); PG8_STAGE(PG8_SB(0, 1), b2 + hstep, voffB); PG8_STAGE(PG8_SA(0, 0), a2, voffA);
            PG8_WAIT_V(8); PG8_WAIT_L(0); PG8_BAR; PG8_MMA(1, 0, At, B0); PG8_MMA(1, 1, At, B1); PG8_BAR; PG8_SCHED;
            PG8_LDB(B0, 1, 0); PG8_LDB(B1, 1, 1); PG8_SCHED; PG8_LDA(At, 1, 0); PG8_STAGE(PG8_SA(0, 1), a2 + hstep, voffA);
            PG8_WAIT_V(8); PG8_WAIT_L(0); PG8_BAR; PG8_MMA(0, 0, At, B0); PG8_MMA(0, 1, At, B1); PG8_BAR; PG8_SCHED;
            PG8_LDA(At, 1, 1); PG8_STAGE(PG8_SB(1, 0), b3, voffB); PG8_STAGE(PG8_SB(1, 1), b3 + hstep, voffB); PG8_STAGE(PG8_SA(1, 0), a3, voffA);
            PG8_WAIT_V(8); PG8_WAIT_L(0); PG8_BAR; PG8_MMA(1, 0, At, B0); PG8_MMA(1, 1, At, B1); PG8_BAR; PG8_SCHED;
            } else {
            PG8_LDB(B0, 0, 0); PG8_SCHED; PG8_LDA(At, 0, 0); PG8_STAGE(PG8_SA(1, 1), a1 + hstep, voffA);
            PG8_WAIT_L(8); PG8_BAR; PG8_WAIT_L(0); PG8_MMA(0, 0, At, B0); PG8_BAR; PG8_SCHED;
            PG8_LDB(B1, 0, 1); PG8_STAGE(PG8_SB(0, 0), b2, voffB);
            PG8_BAR; PG8_WAIT_L(0); PG8_MMA(0, 1, At, B1); PG8_BAR;
            PG8_LDA(At, 0, 1); PG8_STAGE(PG8_SA(0, 0), a2, voffA);
            PG8_BAR; PG8_WAIT_L(0); PG8_MMA(1, 0, At, B0); PG8_BAR; PG8_SCHED;
            PG8_STAGE(PG8_SB(0, 1), b2 + hstep, voffB);
            PG8_WAIT_V(6); PG8_BAR; PG8_MMA(1, 1, At, B1); PG8_BAR;
            PG8_LDB(B0, 1, 0); PG8_SCHED; PG8_LDA(At, 1, 0); PG8_STAGE(PG8_SA(0, 1), a2 + hstep, voffA);
            PG8_WAIT_L(8); PG8_BAR; PG8_WAIT_L(0); PG8_MMA(0, 0, At, B0); PG8_BAR; PG8_SCHED;
            PG8_LDB(B1, 1, 1); PG8_STAGE(PG8_SB(1, 0), b3, voffB);
            PG8_BAR; PG8_WAIT_L(0); PG8_MMA(0, 1, At, B1); PG8_BAR;
            PG8_LDA(At, 1, 1); PG8_STAGE(PG8_SA(1, 0), a3, voffA);
            PG8_BAR; PG8_WAIT_L(0); PG8_MMA(1, 0, At, B0); PG8_BAR; PG8_SCHED;
            PG8_STAGE(PG8_SB(1, 1), b3 + hstep, voffB);
            PG8_WAIT_V(6); PG8_BAR; PG8_MMA(1, 1, At, B1); PG8_BAR;
            }
        }
        if constexpr (ALIGN_EPI) { if (wr == 0) PG8_BAR; }
        if constexpr (!Epi::AFTER_DRAIN) { E(acc, cur, wr, wc, fr, fq); S.done(cur); }
        if (!has_next) break;
#pragma unroll
        for (int a = 0; a < 2; ++a)
#pragma unroll
            for (int b = 0; b < 2; ++b)
#pragma unroll
                for (int m = 0; m < 4; ++m)
#pragma unroll
                    for (int n = 0; n < 2; ++n) acc[a][b][m][n] = (f32x4){0.f, 0.f, 0.f, 0.f};
        cur = nxt; cA = nA; cB = nB; ++ui;
        if constexpr (ALIGN_EPI) { if (wr == 1) PG8_BAR; }
    }
    PG8_WAIT_V(0);
    if constexpr (!ALIGN_EPI) { if (wr == 0) PG8_BAR; }
    PG8_BAR;
    if constexpr (Epi::AFTER_DRAIN) { E.fused(acc, cur, wr, wc, fr, fq, lds, wid, lane); S.done(cur); }
#undef PG8_SA
#undef PG8_SB
#undef PG8_STAGE
#undef PG8_LDA
#undef PG8_LDB
#undef PG8_MMA
#undef PG8_WAIT_V
#undef PG8_WAIT_L
#undef PG8_BAR
#undef PG8_SCHED
}
}

#define LAS __attribute__((address_space(3)))
typedef unsigned short bf16_t;
typedef short bf16x8 __attribute__((ext_vector_type(8)));
typedef float f32x4 __attribute__((ext_vector_type(4)));
typedef float f32x16 __attribute__((ext_vector_type(16)));
typedef unsigned u32x4 __attribute__((ext_vector_type(4)));
typedef unsigned u32x2 __attribute__((ext_vector_type(2)));

#ifndef MK_MULTI
#define MK_MULTI 0
#endif

constexpr int DM = 1024, MP = 16384, MS = 2048, MT = MP + MS;
constexpr int NPROJ = 3328, NPJ = 3072, DFF = 2816;
constexpr float EPS = 1e-6f;
constexpr float LOG2E = 1.4426950408889634f;
constexpr float QSCALE2 = 0.125f * LOG2E;
constexpr size_t O_Y = 0, O_GSP = 18874368, O_FKP = 19922944, O_FVP = 36700160, O_FLP = 53477376, O_GSS = 53739520, O_FKS = 57933824, O_FVS = 60030976, O_FLS = 62128128;
constexpr size_t MiB = 1u << 20;
constexpr size_t WS_CTL = 0, CTL_BYTES = 2 * MiB;
constexpr size_t WS_SS = 65536;
constexpr size_t WS_WGIN = 2 * MiB, WS_WFIN = 9 * MiB, WS_WGOUT = 16 * MiB, WS_WFOUT = 18 * MiB, WS_WFFI = 20 * MiB  , WS_WFFD = 42 * MiB  ;
constexpr size_t WS_XB = 54 * MiB, WS_XR = 90 * MiB, WS_PROJ = 162 * MiB, WS_GL = 270 * MiB, WS_DST = 272 * MiB, WS_DEC = 400 * MiB, WS_SPREV = 401 * MiB;
constexpr size_t WS_OG = 465 * MiB, WS_ACT = 501 * MiB, WS_CP = 600 * MiB, WS_CS = 601 * MiB, WS_END = 606 * MiB;
constexpr int LDS_BYTES = 135168;

struct Args {
    const float* in[19];
    float* out; unsigned char* ws;
    int ph_lo, ph_hi;
};
enum { I_XP = 0, I_XS, I_STATE, I_CK, I_CV, I_CLF, I_NMIX, I_GWIN, I_GWG2, I_GBG, I_GNORM, I_GWOUT, I_FWIN, I_FBF, I_FWOUT, I_NFFN, I_FFIN, I_FFDN, I_NFIN };

__device__ __forceinline__ float bf2f(unsigned u) { return __uint_as_float(u << 16); }
__device__ __forceinline__ unsigned f2bf(float f) { unsigned u = __float_as_uint(f); return (u + 0x7fffu + ((u >> 16) & 1u)) >> 16; }
__device__ __forceinline__ unsigned pk(float lo, float hi) { return pg8::cvt_pk_bf16(lo, hi); }
__device__ __forceinline__ float wave_sum(float v) {
#pragma unroll
    for (int o = 1; o < 64; o <<= 1) v += __shfl_xor(v, o);
    return v;
}
__device__ __forceinline__ float log_sigmoid(float z) { return fminf(z, 0.f) - __logf(1.f + __expf(-fabsf(z))); }
__device__ __forceinline__ int crow(int r, int hi) { return (r & 3) + 8 * (r >> 2) + 4 * hi; }
__device__ __forceinline__ float dot4(f32x4 v) { return (v[0] * v[0] + v[1] * v[1]) + (v[2] * v[2] + v[3] * v[3]); }
#define MFMA32(a, b, c) __builtin_amdgcn_mfma_f32_32x32x16_bf16((a), (b), (c), 0, 0, 0)

#define XB_TMO      128
#define XB_XCNT(j)  (256  + 64 * (j))
#define XB_XSUB(j)  (1280 + 64 * (j))
#define XB_XGEN(j)  (2304 + 64 * (j))
#define XB_TOP      3328
#define XB_TOPGEN   3392
#define XCD_BAR_WORDS 3456
#define XB_SPIN_CAP (1u << 18)

__device__ __forceinline__ unsigned xb_ld(unsigned* p)              { return __hip_atomic_load(p, __ATOMIC_RELAXED, __HIP_MEMORY_SCOPE_AGENT); }
__device__ __forceinline__ unsigned xb_add(unsigned* p, unsigned v) { return __hip_atomic_fetch_add(p, v, __ATOMIC_RELAXED, __HIP_MEMORY_SCOPE_AGENT); }
__device__ __forceinline__ unsigned xb_xcc_id() { return (unsigned)__builtin_amdgcn_s_getreg((3 << 11) | 20) & 0xFu; }
#define XB_SPIN(cond, bar) do { unsigned _sp = 0; while (cond) { __builtin_amdgcn_s_sleep(1); \
    if ((++_sp & 255u) == 0u) { if (xb_ld(&(bar)[XB_TMO])) break; if (_sp > XB_SPIN_CAP) { atomicAdd(&(bar)[XB_TMO], 1u); break; } } } } while (0)

struct XcdBarrier {
    unsigned* bar; unsigned x;
    volatile LAS unsigned* st;
};

__device__ __forceinline__ XcdBarrier xcd_barrier_post(unsigned* bar, volatile LAS unsigned* st) {
    XcdBarrier b; b.bar = bar; b.x = xb_xcc_id(); b.st = st;
    if (threadIdx.x == 0) (void)xb_add(&bar[XB_XCNT(b.x)], 1u);
    return b;
}
__device__ __forceinline__ void xcd_barrier_complete(unsigned* bar, unsigned x, unsigned& nloc, unsigned& nx) {
    const unsigned G = gridDim.x * gridDim.y * gridDim.z;
    unsigned sum, cnt, mine, sp = 0u;
    for (;;) {
        sum = 0u; cnt = 0u; mine = 0u;
#pragma unroll
        for (unsigned j = 0; j < 16; ++j) { const unsigned c = xb_ld(&bar[XB_XCNT(j)]); sum += c; cnt += (c > 0u) ? 1u : 0u; mine = (j == x) ? c : mine; }
        if (sum == G) break;
        __builtin_amdgcn_s_sleep(1);
        if ((++sp & 255u) == 0u) { if (xb_ld(&bar[XB_TMO])) break; if (sp > XB_SPIN_CAP) { atomicAdd(&bar[XB_TMO], 1u); break; } }
    }
    nloc = mine > 0u ? mine : 1u; nx = cnt > 0u ? cnt : 1u;
}

__device__ __forceinline__ void xcd_barrier(const XcdBarrier& b) {
    asm volatile("s_waitcnt vmcnt(0)" ::: "memory");
    __syncthreads();
    if (threadIdx.x == 0) {
        unsigned* bar = b.bar;
        __builtin_amdgcn_s_waitcnt(0);
        unsigned nloc = b.st[0], nx = b.st[1];
        if (nloc == 0u) { xcd_barrier_complete(bar, b.x, nloc, nx); b.st[0] = nloc; b.st[1] = nx; }
        const unsigned old = xb_add(&bar[XB_XSUB(b.x)], 1u);
        const unsigned gen = old / nloc;
        if (old + 1u == (gen + 1u) * nloc) {
            __builtin_amdgcn_fence(__ATOMIC_RELEASE, "agent");
            asm volatile("s_waitcnt vmcnt(0)" ::: "memory");
            const unsigned og = xb_add(&bar[XB_TOP], 1u);
            const unsigned tg = og / nx;
            if (og + 1u == (tg + 1u) * nx) xb_add(&bar[XB_TOPGEN], 1u);
            else XB_SPIN(xb_ld(&bar[XB_TOPGEN]) == tg, bar);
            __builtin_amdgcn_fence(__ATOMIC_ACQUIRE, "agent");
            xb_add(&bar[XB_XGEN(b.x)], 1u);
            asm volatile("s_waitcnt vmcnt(0)" ::: "memory");
        } else {
            XB_SPIN(xb_ld(&bar[XB_XGEN(b.x)]) == gen, bar);
            __builtin_amdgcn_fence(__ATOMIC_ACQUIRE, "agent");
            asm volatile("s_waitcnt vmcnt(0)" ::: "memory");
        }
    }
    __syncthreads();
}

__device__ __forceinline__ void tr_item(const float* __restrict__ W, int K, int N, int nsrc0, bf16_t* WT, int drow0, const float* __restrict__ gain, LAS float* scr, int k0, int lane) {
    const int n = nsrc0 + (lane & 31);
#pragma unroll 8
    for (int i = 0; i < 32; ++i) {
        const int kk = 2 * i + (lane >> 5);
        float v = (n < N) ? W[(size_t)(k0 + kk) * N + n] : 0.f;
        if (gain) v *= gain[k0 + kk];
        scr[kk * 33 + (lane & 31)] = v;
    }
    asm volatile("s_waitcnt lgkmcnt(0)" ::: "memory");
    const int c = lane & 7;
#pragma unroll
    for (int j = 0; j < 4; ++j) {
        const int nn = (lane >> 3) + 8 * j; const LAS float* s = scr + (8 * c) * 33 + nn;
        u32x4 o; o.x = pk(s[0 * 33], s[1 * 33]); o.y = pk(s[2 * 33], s[3 * 33]); o.z = pk(s[4 * 33], s[5 * 33]); o.w = pk(s[6 * 33], s[7 * 33]);
        *(u32x4*)(WT + (size_t)(drow0 + nn) * K + k0 + 8 * c) = o;
    }
    asm volatile("s_waitcnt lgkmcnt(0)" ::: "memory");
}

__device__ __forceinline__ void p0_prologue(const Args& a, LAS unsigned char* lds, int vcu, int G) {
    const int tid = threadIdx.x, lane = tid & 63, wave = tid >> 6;
    LAS float* scr = (LAS float*)(lds + wave * 16384);
    const int gw = vcu * 8 + wave, NGW = G * 8;
    unsigned char* ws = a.ws;
    constexpr int I_IN = 16 * 104, I_OUT = 16 * 32, I_FI = 16 * 176, I_FD = 44 * 32;
    constexpr int NITEMS = 2 * I_IN + 2 * I_OUT + 2 * I_FI + 2 * I_FD;
    for (int it = gw; it < NITEMS; it += NGW) {
        int r = it;
        if (r < I_IN) { const int kb = r / 104, nb = r % 104; tr_item(a.in[I_GWIN], 1024, 3088, 32 * nb, (bf16_t*)(ws + WS_WGIN), 32 * nb, a.in[I_NMIX], scr, 64 * kb, lane); continue; } r -= I_IN;
        if (r < I_IN) { const int kb = r / 104, nb = r % 104; tr_item(a.in[I_FWIN], 1024, 3088, 32 * nb, (bf16_t*)(ws + WS_WFIN), 32 * nb, a.in[I_NMIX] + 1024, scr, 64 * kb, lane); continue; } r -= I_IN;
        if (r < I_OUT) { const int kb = r / 32, nb = r % 32; tr_item(a.in[I_GWOUT], 1024, 1024, 32 * nb, (bf16_t*)(ws + WS_WGOUT), 32 * nb, nullptr, scr, 64 * kb, lane); continue; } r -= I_OUT;
        if (r < I_OUT) { const int kb = r / 32, nb = r % 32; tr_item(a.in[I_FWOUT], 1024, 1024, 32 * nb, (bf16_t*)(ws + WS_WFOUT), 32 * nb, nullptr, scr, 64 * kb, lane); continue; } r -= I_OUT;
        if (r < 2 * I_FI) { const int li = r / I_FI; r -= li * I_FI; const int kb = r / 176, nb = r % 176, ns = 32 * nb, bj = ns / DFF, j = ns % DFF, drow = 256 * (j / 128) + 128 * bj + (j % 128);
            tr_item(a.in[I_FFIN] + (size_t)li * 1024 * 5632, 1024, 5632, ns, (bf16_t*)(ws + WS_WFFI + (size_t)li * 11 * MiB), drow, a.in[I_NFFN] + li * 1024, scr, 64 * kb, lane); continue; } r -= 2 * I_FI;
        { const int li = r / I_FD; r -= li * I_FD; const int kb = r / 32, nb = r % 32;
            tr_item(a.in[I_FFDN] + (size_t)li * DFF * 1024, DFF, 1024, 32 * nb, (bf16_t*)(ws + WS_WFFD + (size_t)li * 6 * MiB), 32 * nb, nullptr, scr, 64 * kb, lane); }
    }
    float* ss0 = (float*)(ws + WS_SS);
    bf16_t* XB = (bf16_t*)(ws + WS_XB);
    for (int m = gw; m < MT; m += NGW) {
        const float* xr = (m < MP) ? a.in[I_XP] + (size_t)m * DM : a.in[I_XS] + (size_t)(m - MP) * DM;
        f32x4 v[4]; float s = 0.f;
#pragma unroll
        for (int j = 0; j < 4; ++j) { v[j] = ((const f32x4*)xr)[lane + 64 * j]; s += dot4(v[j]); }
        s = wave_sum(s);
        if (lane == 0) ss0[m] = s;
#pragma unroll
        for (int j = 0; j < 4; ++j) { u32x2 o; o.x = pk(v[j][0], v[j][1]); o.y = pk(v[j][2], v[j][3]); ((u32x2*)(XB + (size_t)m * DM))[lane + 64 * j] = o; }
    }
}

__device__ __forceinline__ void p_final(const Args& a, int vcu, int G) {
    const int tid = threadIdx.x, lane = tid & 63, wave = tid >> 6;
    const int gw = vcu * 8 + wave, NGW = G * 8;
    const float* ss = (const float*)(a.ws + WS_SS + 4 * 131072);
    const float* XR = (const float*)(a.ws + WS_XR);
    const float* g = a.in[I_NFIN];
    f32x4 gv[4];
#pragma unroll
    for (int j = 0; j < 4; ++j) gv[j] = ((const f32x4*)g)[lane + 64 * j];
    for (int m = gw; m < MT; m += NGW) {
        const float rs = rsqrtf(ss[m] * (1.f / DM) + EPS);
#pragma unroll
        for (int j = 0; j < 4; ++j) { f32x4 v = ((const f32x4*)(XR + (size_t)m * DM))[lane + 64 * j]; ((f32x4*)(a.out + O_Y + (size_t)m * DM))[lane + 64 * j] = v * rs * gv[j]; }
    }
}

struct EpiGlaProj {
    static constexpr bool PERM = true, AFTER_DRAIN = false;
    const float* ss; bf16_t* proj; float* gl;
    __device__ __forceinline__ void operator()(const pg8::f32x4 (&acc)[2][2][4][2], const pg8::Unit& u, int wr, int wc, int fr, int fq) const {
        const int row0 = u.pm * 256 + wr * 64 + fr;
#pragma unroll
        for (int ai = 0; ai < 2; ++ai)
#pragma unroll
            for (int m = 0; m < 4; ++m) {
                const int row = row0 + ai * 128 + m * 16; const float rs = rsqrtf(ss[row] * (1.f / DM) + EPS);
                if (u.pn < 12) {
#pragma unroll
                    for (int bj = 0; bj < 2; ++bj) { const f32x4 v0 = acc[ai][bj][m][0] * rs, v1 = acc[ai][bj][m][1] * rs;
                        u32x4 w; w.x = pk(v0[0], v0[1]); w.y = pk(v0[2], v0[3]); w.z = pk(v1[0], v1[1]); w.w = pk(v1[2], v1[3]);
                        *(u32x4*)(proj + (size_t)row * NPJ + u.pn * 256 + bj * 128 + wc * 32 + 8 * fq) = w; }
                } else if (wc == 0 && fq < 2) {
#pragma unroll
                    for (int n = 0; n < 2; ++n) *(f32x4*)(gl + (size_t)row * 16 + 8 * fq + 4 * n) = acc[ai][0][m][n] * rs;
                }
            }
    }
};
struct EpiResid {
    static constexpr bool PERM = true, AFTER_DRAIN = false;
    const float* xin_p; const float* xin_s; float* xout; bf16_t* xb; float* ssout;
    __device__ __forceinline__ void operator()(const pg8::f32x4 (&acc)[2][2][4][2], const pg8::Unit& u, int wr, int wc, int fr, int fq) const {
        const int row0 = u.pm * 256 + wr * 64 + fr;
#pragma unroll
        for (int ai = 0; ai < 2; ++ai)
#pragma unroll
            for (int m = 0; m < 4; ++m) {
                const int row = row0 + ai * 128 + m * 16;
                const float* xi = (row < MP) ? xin_p + (size_t)row * DM : xin_s + (size_t)(row - MP) * DM;
                float sq = 0.f;
#pragma unroll
                for (int bj = 0; bj < 2; ++bj) { const int col = u.pn * 256 + bj * 128 + wc * 32 + 8 * fq;
                    const f32x4 a0 = *(const f32x4*)(xi + col) + acc[ai][bj][m][0], a1 = *(const f32x4*)(xi + col + 4) + acc[ai][bj][m][1];
                    *(f32x4*)(xout + (size_t)row * DM + col) = a0; *(f32x4*)(xout + (size_t)row * DM + col + 4) = a1;
                    u32x4 w; w.x = pk(a0[0], a0[1]); w.y = pk(a0[2], a0[3]); w.z = pk(a1[0], a1[1]); w.w = pk(a1[2], a1[3]);
                    *(u32x4*)(xb + (size_t)row * DM + col) = w;
                    sq += dot4(a0) + dot4(a1); }
                sq += __shfl_xor(sq, 16); sq += __shfl_xor(sq, 32);
                if (fq == 0) atomicAdd(ssout + row, sq);
            }
    }
};
struct EpiSwiglu {
    static constexpr bool PERM = true, AFTER_DRAIN = false;
    const float* ss; bf16_t* act;
    __device__ __forceinline__ void operator()(const pg8::f32x4 (&acc)[2][2][4][2], const pg8::Unit& u, int wr, int wc, int fr, int fq) const {
        const int row0 = u.pm * 256 + wr * 64 + fr;
#pragma unroll
        for (int ai = 0; ai < 2; ++ai)
#pragma unroll
            for (int m = 0; m < 4; ++m) {
                const int row = row0 + ai * 128 + m * 16; const float rs = rsqrtf(ss[row] * (1.f / DM) + EPS);
                float y[8];
#pragma unroll
                for (int n = 0; n < 2; ++n)
#pragma unroll
                    for (int i = 0; i < 4; ++i) { const float g = acc[ai][0][m][n][i] * rs, up = acc[ai][1][m][n][i] * rs; y[4 * n + i] = g * up * __builtin_amdgcn_rcpf(1.f + __expf(-g)); }
                u32x4 w; w.x = pk(y[0], y[1]); w.y = pk(y[2], y[3]); w.z = pk(y[4], y[5]); w.w = pk(y[6], y[7]);
                *(u32x4*)(act + (size_t)row * DFF + u.pn * 128 + wc * 32 + 8 * fq) = w;
            }
    }
};
struct EpiFoxProj {
    static constexpr bool PERM = true, AFTER_DRAIN = false;
    const float* ss; bf16_t* qkv; float* out; const float* bf;
    __device__ __forceinline__ void operator()(const pg8::f32x4 (&acc)[2][2][4][2], const pg8::Unit& u, int wr, int wc, int fr, int fq) const {
        const int row0 = u.pm * 256 + wr * 64 + fr;
        const int sect = u.pn >> 2;
#pragma unroll
        for (int ai = 0; ai < 2; ++ai)
#pragma unroll
            for (int m = 0; m < 4; ++m) {
                const int row = row0 + ai * 128 + m * 16; const float rs = rsqrtf(ss[row] * (1.f / DM) + EPS);
                if (u.pn < 12) {
                    const float sc = (sect == 0) ? rs * QSCALE2 : rs;
                    float* fdst = nullptr;
                    if (sect == 1) fdst = (row < MP) ? out + O_FKP + (size_t)row * DM : out + O_FKS + (size_t)(row - MP) * DM;
                    if (sect == 2) fdst = (row < MP) ? out + O_FVP + (size_t)row * DM : out + O_FVS + (size_t)(row - MP) * DM;
#pragma unroll
                    for (int bj = 0; bj < 2; ++bj) { const f32x4 v0 = acc[ai][bj][m][0] * sc, v1 = acc[ai][bj][m][1] * sc;
                        u32x4 w; w.x = pk(v0[0], v0[1]); w.y = pk(v0[2], v0[3]); w.z = pk(v1[0], v1[1]); w.w = pk(v1[2], v1[3]);
                        const int cl = bj * 128 + wc * 32 + 8 * fq;
                        *(u32x4*)(qkv + (size_t)row * NPJ + u.pn * 256 + cl) = w;
                        if (sect > 0) { float* d = fdst + (u.pn & 3) * 256 + cl; *(f32x4*)d = v0; *(f32x4*)(d + 4) = v1; } }
                } else if (wc == 0 && fq < 2) {
                    float* d = (row < MP) ? out + O_FLP + (size_t)row * 16 : out + O_FLS + (size_t)(row - MP) * 16;
#pragma unroll
                    for (int n = 0; n < 2; ++n) { const f32x4 v = acc[ai][0][m][n] * rs; f32x4 o;
#pragma unroll
                        for (int i = 0; i < 4; ++i) o[i] = log_sigmoid(v[i] + bf[8 * fq + 4 * n + i]);
                        *(f32x4*)(d + 8 * fq + 4 * n) = o; }
                }
            }
    }
};

constexpr int GL_OFF = 0, GSUM_OFF = 4096, DECS_OFF = 6144, QE_OFF = 8192, KE_OFF = 25600, VT_OFF = 43008, AL_OFF = 79872, KDT_OFF = 8192, OL_OFF = 8192;
constexpr int QES = 136, VTS = 72, OLS = 260;

template <int MODE> __device__ __forceinline__ void gla_item(const Args& a, LAS unsigned char* lds, int cid, int h) {
    const int tid = threadIdx.x, lane = tid & 63, w = tid >> 6, l31 = lane & 31, hi = lane >> 5;
    const int row0 = cid * 64;
    const bool prompt = cid < 256;
    LAS float* GLs = (LAS float*)(lds + GL_OFF); LAS float* GSUM = (LAS float*)(lds + GSUM_OFF); LAS float* DECS = (LAS float*)(lds + DECS_OFF);
    LAS bf16_t* QE = (LAS bf16_t*)(lds + QE_OFF); LAS bf16_t* KE = (LAS bf16_t*)(lds + KE_OFF); LAS bf16_t* VT = (LAS bf16_t*)(lds + VT_OFF);
    LAS bf16_t* AL = (LAS bf16_t*)(lds + AL_OFF); LAS bf16_t* KDT = (LAS bf16_t*)(lds + KDT_OFF);
    const bf16_t* P = (const bf16_t*)(a.ws + WS_PROJ) + (size_t)row0 * NPJ;
    const float* GL = (const float*)(a.ws + WS_GL);
    const float* state = a.in[I_STATE];

    bf16x8 sfr[8];
    if (MODE == 1) {
        if (prompt) {
            const bf16_t* sp = (const bf16_t*)(a.ws + WS_SPREV) + ((size_t)(cid * 4 + h) * 256 + 32 * w + l31) * 128 + 8 * hi;
#pragma unroll
            for (int ks = 0; ks < 8; ++ks) sfr[ks] = *(const bf16x8*)(sp + 16 * ks);
        } else {
            const float* s0 = state + ((size_t)((cid - 256) * 4 + h) * 128) * 256 + 32 * w + l31;
#pragma unroll
            for (int ks = 0; ks < 8; ++ks) { float f[8];
#pragma unroll
                for (int j = 0; j < 8; ++j) f[j] = s0[(size_t)(16 * ks + 8 * hi + j) * 256];
                u32x4 o; o.x = pk(f[0], f[1]); o.y = pk(f[2], f[3]); o.z = pk(f[4], f[5]); o.w = pk(f[6], f[7]); sfr[ks] = __builtin_bit_cast(bf16x8, o); }
        }
    }
    if (tid < 256) ((LAS f32x4*)GLs)[tid] = *(const f32x4*)(GL + (size_t)(row0 + (tid >> 2)) * 16 + (tid & 3) * 4);
    {
        const int dvv = tid & 255, th = tid >> 8; const bf16_t* vp = P + (size_t)(32 * th) * NPJ + 1024 + h * 256 + dvv;
#pragma unroll
        for (int q4 = 0; q4 < 4; ++q4) { unsigned e[8];
#pragma unroll
            for (int i = 0; i < 8; ++i) e[i] = vp[(size_t)(8 * q4 + i) * NPJ];
            u32x4 o; o.x = e[0] | (e[1] << 16); o.y = e[2] | (e[3] << 16); o.z = e[4] | (e[5] << 16); o.w = e[6] | (e[7] << 16);
            *(LAS u32x4*)(VT + dvv * VTS + 32 * th + 8 * q4) = o; }
    }
    __syncthreads();
    const int dk = tid & 127, tg = tid >> 7;
    float bc[16];
    {
        float wv[16];
#pragma unroll
        for (int j = 0; j < 16; ++j) wv[j] = a.in[I_GWG2][j * 512 + h * 128 + dk];
        const float bias = a.in[I_GBG][h * 128 + dk];
        float run = 0.f;
#pragma unroll
        for (int i = 0; i < 16; ++i) { const LAS f32x4* gp = (const LAS f32x4*)(GLs + (16 * tg + i) * 16); float z = bias;
#pragma unroll
            for (int j4 = 0; j4 < 4; ++j4) { const f32x4 gq = gp[j4]; z += gq[0] * wv[4 * j4] + gq[1] * wv[4 * j4 + 1] + gq[2] * wv[4 * j4 + 2] + gq[3] * wv[4 * j4 + 3]; }
            run += log_sigmoid(z) * (1.f / 16.f); bc[i] = run; }
        GSUM[tg * 128 + dk] = run;
    }
    __syncthreads();
    float off = 0.f, blast = 0.f;
#pragma unroll
    for (int g = 0; g < 4; ++g) { const float s = GSUM[g * 128 + dk]; blast += s; if (g < tg) off += s; }
    const bf16_t* kp = P + (size_t)(16 * tg) * NPJ + 512 + h * 128 + dk;
    if (MODE == 0) {
        float kd[16];
#pragma unroll
        for (int i = 0; i < 16; ++i) { const float b = bc[i] + off; kd[i] = bf2f(kp[(size_t)i * NPJ]) * __expf(blast - b); }
        u32x4 o0, o1; o0.x = pk(kd[0], kd[1]); o0.y = pk(kd[2], kd[3]); o0.z = pk(kd[4], kd[5]); o0.w = pk(kd[6], kd[7]);
        o1.x = pk(kd[8], kd[9]); o1.y = pk(kd[10], kd[11]); o1.z = pk(kd[12], kd[13]); o1.w = pk(kd[14], kd[15]);
        *(LAS u32x4*)(KDT + dk * VTS + 16 * tg) = o0; *(LAS u32x4*)(KDT + dk * VTS + 16 * tg + 8) = o1;
        if (tg == 0) { const float d = __expf(blast); DECS[dk] = d; if (prompt) ((float*)(a.ws + WS_DEC))[(size_t)(cid * 4 + h) * 128 + dk] = d; }
    } else {
        const bf16_t* qp = P + (size_t)(16 * tg) * NPJ + h * 128 + dk;
#pragma unroll
        for (int i = 0; i < 16; ++i) { const float b = bc[i] + off; const int t = 16 * tg + i;
            const float qe = bf2f(qp[(size_t)i * NPJ]) * __expf(b) * 0.08838834764831845f, ke = bf2f(kp[(size_t)i * NPJ]) * __expf(-b);
            QE[t * QES + dk] = (bf16_t)f2bf(qe); KE[t * QES + dk] = (bf16_t)f2bf(ke); }
    }
    __syncthreads();
    if (MODE == 0) {
        bf16x8 vf[4];
#pragma unroll
        for (int ks = 0; ks < 4; ++ks) vf[ks] = *(const LAS bf16x8*)(VT + (32 * w + l31) * VTS + 16 * ks + 8 * hi);
        f32x16 acc[4];
#pragma unroll
        for (int d = 0; d < 4; ++d) acc[d] = f32x16{};
#pragma unroll
        for (int d = 0; d < 4; ++d)
#pragma unroll
            for (int ks = 0; ks < 4; ++ks) { const bf16x8 kf = *(const LAS bf16x8*)(KDT + (32 * d + l31) * VTS + 16 * ks + 8 * hi);
                acc[d] = prompt ? MFMA32(vf[ks], kf, acc[d]) : MFMA32(kf, vf[ks], acc[d]); }
        if (prompt) {
            float* dst = (float*)(a.ws + WS_DST) + ((size_t)(cid * 4 + h) * 256 + 32 * w) * 128;
#pragma unroll
            for (int d = 0; d < 4; ++d)
#pragma unroll
                for (int r = 0; r < 16; ++r) dst[(size_t)crow(r, hi) * 128 + 32 * d + l31] = acc[d][r];
        } else {
            const size_t base = ((size_t)((cid - 256) * 4 + h) * 128) * 256;
            float* outs = a.out + O_GSS;
#pragma unroll
            for (int d = 0; d < 4; ++d)
#pragma unroll
                for (int r = 0; r < 16; ++r) { const int dkk = 32 * d + crow(r, hi); const size_t idx = base + (size_t)dkk * 256 + 32 * w + l31; outs[idx] = state[idx] * DECS[dkk] + acc[d][r]; }
        }
    } else {
        f32x16 o[2]; o[0] = f32x16{}; o[1] = f32x16{};
#pragma unroll
        for (int tb = 0; tb < 2; ++tb)
#pragma unroll
            for (int ks = 0; ks < 8; ++ks) { const bf16x8 qa = *(const LAS bf16x8*)(QE + (32 * tb + l31) * QES + 16 * ks + 8 * hi); o[tb] = MFMA32(qa, sfr[ks], o[tb]); }
        if (w < 3) {
            const int tb = (w > 0) ? 1 : 0, sb = (w == 2) ? 1 : 0;
            f32x16 am = f32x16{};
#pragma unroll
            for (int ks = 0; ks < 8; ++ks) { const bf16x8 qa = *(const LAS bf16x8*)(QE + (32 * tb + l31) * QES + 16 * ks + 8 * hi), kb = *(const LAS bf16x8*)(KE + (32 * sb + l31) * QES + 16 * ks + 8 * hi);
                am = MFMA32(qa, kb, am); }
#pragma unroll
            for (int r = 0; r < 16; ++r) { const int tl = crow(r, hi); float v = am[r]; if (tb == sb && l31 > tl) v = 0.f; AL[(32 * tb + tl) * VTS + 32 * sb + l31] = (bf16_t)f2bf(v); }
        }
        __syncthreads();
#pragma unroll
        for (int tb = 0; tb < 2; ++tb)
#pragma unroll
            for (int ks = 0; ks < 4; ++ks) { if (tb == 0 && ks >= 2) continue;
                const bf16x8 aa = *(const LAS bf16x8*)(AL + (32 * tb + l31) * VTS + 16 * ks + 8 * hi), vb = *(const LAS bf16x8*)(VT + (32 * w + l31) * VTS + 16 * ks + 8 * hi);
                o[tb] = MFMA32(aa, vb, o[tb]); }
        __syncthreads();
        LAS float* OL = (LAS float*)(lds + OL_OFF);
#pragma unroll
        for (int tb = 0; tb < 2; ++tb)
#pragma unroll
            for (int r = 0; r < 16; ++r) OL[(32 * tb + crow(r, hi)) * OLS + 32 * w + l31] = o[tb][r];
        __syncthreads();
        const f32x4 ng = *(const f32x4*)(a.in[I_GNORM] + h * 256 + 4 * lane);
        bf16_t* OG = (bf16_t*)(a.ws + WS_OG);
#pragma unroll
        for (int i = 0; i < 8; ++i) { const int t = 8 * w + i; const f32x4 v = *(const LAS f32x4*)(OL + t * OLS + 4 * lane);
            const float rs = rsqrtf(wave_sum(dot4(v)) * (1.f / 256.f) + EPS);
            const u32x2 rr = *(const u32x2*)(P + (size_t)t * NPJ + 2048 + h * 256 + 4 * lane);
            float rv[4] = {bf2f(rr.x & 0xffffu), bf2f(rr.x >> 16), bf2f(rr.y & 0xffffu), bf2f(rr.y >> 16)}; float y[4];
#pragma unroll
            for (int j = 0; j < 4; ++j) y[j] = v[j] * rs * ng[j] * rv[j] * __builtin_amdgcn_rcpf(1.f + __expf(-rv[j]));
            u32x2 ov; ov.x = pk(y[0], y[1]); ov.y = pk(y[2], y[3]);
            *(u32x2*)(OG + (size_t)(row0 + t) * DM + h * 256 + 4 * lane) = ov; }
    }
    __syncthreads();
}

__device__ __forceinline__ void gla_scan(const Args& a, int vcu, int G) {
    const int gt = vcu * 512 + threadIdx.x, NT_ = G * 512;
    const float* DST = (const float*)(a.ws + WS_DST); const float* DEC = (const float*)(a.ws + WS_DEC); bf16_t* SP = (bf16_t*)(a.ws + WS_SPREV);
    for (int it = gt; it < 32 * 8192; it += NT_) {
        const int bh = it >> 13, e4 = it & 8191, dv = e4 >> 5, dk4 = (e4 & 31) * 4, b = bh >> 2, h = bh & 3;
        f32x4 S = (f32x4){0.f, 0.f, 0.f, 0.f};
#pragma unroll 8
        for (int c = 0; c < 32; ++c) {
            const size_t ch = (size_t)((b * 32 + c) * 4 + h); const size_t base = (ch * 256 + dv) * 128 + dk4;
            const f32x4 ds = *(const f32x4*)(DST + base), de = *(const f32x4*)(DEC + ch * 128 + dk4);
            u32x2 o; o.x = pk(S[0], S[1]); o.y = pk(S[2], S[3]); *(u32x2*)(SP + base) = o;
            S = S * de + ds;
        }
        float* og = a.out + O_GSP + ((size_t)bh * 128 + dk4) * 256 + dv;
#pragma unroll
        for (int i = 0; i < 4; ++i) og[(size_t)i * 256] = S[i];
    }
}

__device__ __forceinline__ void fox_cumsum(const Args& a, LAS unsigned char* lds, int vcu, int G) {
    const int tid = threadIdx.x, hh = tid & 15, seg = tid >> 4;
    LAS float* SEG = (LAS float*)lds;
    for (int it = vcu; it < 40; it += G) {
        const bool prompt = it < 8; const int b = prompt ? it : it - 8; const int L = prompt ? 64 : 66, LT = prompt ? 2048 : 2112;
        const float* src0 = prompt ? a.out + O_FLP + (size_t)b * 2048 * 16 : a.in[I_CLF] + (size_t)b * 2048 * 16;
        const float* src1 = a.out + O_FLS + (size_t)b * 64 * 16;
        float* dst = (float*)(a.ws + (prompt ? WS_CP : WS_CS)) + (size_t)(b * 16 + hh) * LT;
        float s = 0.f;
        for (int i = 0; i < L; ++i) { const int t = seg * L + i; s += (t < 2048) ? src0[(size_t)t * 16 + hh] : src1[(size_t)(t - 2048) * 16 + hh]; }
        SEG[seg * 16 + hh] = s;
        __syncthreads();
        float run = 0.f;
        for (int g = 0; g < seg; ++g) run += SEG[g * 16 + hh];
        for (int i = 0; i < L; ++i) { const int t = seg * L + i; run += (t < 2048) ? src0[(size_t)t * 16 + hh] : src1[(size_t)(t - 2048) * 16 + hh]; dst[t] = run; }
        __syncthreads();
    }
}

constexpr int AT_KS = 72, AT_VS = 68, AT_BUF = 18432, AT_VOFF = 9216, AT_COFF = 17920;
struct TileRegs { u32x4 k0, k1, v0, v1; float ck; };

template <bool SAMPLE> __device__ __forceinline__ void attn_load(TileRegs& R, const Args& a, int b, int h, int t, const float* cbase, int tid) {
    const int kvl = tid >> 3, ch = tid & 7, kp = tid >> 4, c4 = tid & 15;
    if (SAMPLE && t < 32) {
        const float* kptr = a.in[I_CK] + (((size_t)b * 2048 + 64 * t + kvl) * 16 + h) * 64 + 8 * ch;
        R.k0 = *(const u32x4*)kptr; R.k1 = *(const u32x4*)(kptr + 4);
        const float* vptr = a.in[I_CV] + (((size_t)b * 2048 + 64 * t + 2 * kp) * 16 + h) * 64 + 4 * c4;
        R.v0 = *(const u32x4*)vptr; R.v1 = *(const u32x4*)(vptr + 1024);
    } else {
        const size_t rowbase = SAMPLE ? (size_t)(MP + b * 64) : (size_t)(b * 2048 + 64 * t);
        const bf16_t* qkv = (const bf16_t*)(a.ws + WS_PROJ);
        R.k0 = *(const u32x4*)(qkv + (rowbase + kvl) * NPJ + 1024 + h * 64 + 8 * ch);
        const bf16_t* vptr = qkv + (rowbase + 2 * kp) * NPJ + 2048 + h * 64 + 4 * c4;
        const u32x2 x0 = *(const u32x2*)vptr, x1 = *(const u32x2*)(vptr + NPJ);
        R.v0.x = x0.x; R.v0.y = x0.y; R.v1.x = x1.x; R.v1.y = x1.y;
    }
    if (tid < 64) R.ck = cbase[64 * t + tid] * LOG2E;
}
__device__ __forceinline__ void attn_store(const TileRegs& R, LAS unsigned char* buf, bool f32src, int tid) {
    const int kvl = tid >> 3, ch = tid & 7, kp = tid >> 4, c4 = tid & 15;
    LAS unsigned* VT32 = (LAS unsigned*)(buf + AT_VOFF);
    if (f32src) {
        u32x4 o; o.x = pk(__uint_as_float(R.k0.x), __uint_as_float(R.k0.y)); o.y = pk(__uint_as_float(R.k0.z), __uint_as_float(R.k0.w));
        o.z = pk(__uint_as_float(R.k1.x), __uint_as_float(R.k1.y)); o.w = pk(__uint_as_float(R.k1.z), __uint_as_float(R.k1.w));
        *(LAS u32x4*)(buf + (kvl * AT_KS + 8 * ch) * 2) = o;
#pragma unroll
        for (int i = 0; i < 4; ++i) VT32[(4 * c4 + i) * (AT_VS / 2) + kp] = pk(__uint_as_float(R.v0[i]), __uint_as_float(R.v1[i]));
    } else {
        *(LAS u32x4*)(buf + (kvl * AT_KS + 8 * ch) * 2) = R.k0;
        VT32[(4 * c4 + 0) * (AT_VS / 2) + kp] = (R.v0.x & 0xffffu) | (R.v1.x << 16);
        VT32[(4 * c4 + 1) * (AT_VS / 2) + kp] = (R.v0.x >> 16) | (R.v1.x & 0xffff0000u);
        VT32[(4 * c4 + 2) * (AT_VS / 2) + kp] = (R.v0.y & 0xffffu) | (R.v1.y << 16);
        VT32[(4 * c4 + 3) * (AT_VS / 2) + kp] = (R.v0.y >> 16) | (R.v1.y & 0xffff0000u);
    }
    if (tid < 64) { const float c = -R.ck; const unsigned h1 = f2bf(c); const float r1 = c - bf2f(h1); const unsigned h2 = f2bf(r1); const unsigned h3 = f2bf(r1 - bf2f(h2));
        u32x2 o; o.x = h1 | (h2 << 16); o.y = h3; ((LAS u32x2*)(buf + AT_COFF))[tid] = o; }
}

template <bool QLDS> __device__ __forceinline__ void attn_tile(const LAS unsigned char* buf, const bf16x8 (&qf)[4], const LAS bf16x8* qlds, float cq2, int qpos, int kv0, bool diag, float& mrun, float& lrun, f32x16 (&ot)[2], int l31, int hi) {
    const LAS bf16_t* Ks = (const LAS bf16_t*)buf; const LAS bf16_t* VTs = (const LAS bf16_t*)(buf + AT_VOFF); const LAS u32x2* CKs = (const LAS u32x2*)(buf + AT_COFF);
    f32x16 p0, p1;
#pragma unroll
    for (int r = 0; r < 16; ++r) { p0[r] = cq2; p1[r] = cq2; }
    {
        const u32x2 b0 = CKs[l31], b1 = CKs[32 + l31];
        const unsigned msk = hi ? 0u : 0xffffffffu;
        u32x4 x0; x0.x = b0.x & msk; x0.y = b0.y & msk; x0.z = 0u; x0.w = 0u;
        u32x4 x1; x1.x = b1.x & msk; x1.y = b1.y & msk; x1.z = 0u; x1.w = 0u;
        u32x4 qx; qx.x = 0x3F803F80u & msk; qx.y = 0x00003F80u & msk; qx.z = 0u; qx.w = 0u;
        p0 = MFMA32(__builtin_bit_cast(bf16x8, x0), __builtin_bit_cast(bf16x8, qx), p0); p1 = MFMA32(__builtin_bit_cast(bf16x8, x1), __builtin_bit_cast(bf16x8, qx), p1);
    }
#pragma unroll
    for (int ks = 0; ks < 4; ++ks) { const bf16x8 k0 = *(const LAS bf16x8*)(Ks + l31 * AT_KS + 16 * ks + 8 * hi), k1 = *(const LAS bf16x8*)(Ks + (32 + l31) * AT_KS + 16 * ks + 8 * hi);
        const bf16x8 qq = QLDS ? qlds[ks * 64] : qf[ks];
        p0 = MFMA32(k0, qq, p0); p1 = MFMA32(k1, qq, p1); }
    __builtin_amdgcn_sched_barrier(0);
    if (diag) {
        int qp = qpos - kv0; asm volatile("" : "+v"(qp));
#pragma unroll
        for (int r = 0; r < 16; ++r) { const int kv = crow(r, hi); if (kv > qp) p0[r] = -INFINITY; if (kv + 32 > qp) p1[r] = -INFINITY; }
    }
    float rm = fmaxf(p0[0], p1[0]);
#pragma unroll
    for (int r = 1; r < 16; ++r) rm = fmaxf(rm, fmaxf(p0[r], p1[r]));
    rm = fmaxf(rm, __shfl_xor(rm, 32));
    if (__all(rm < mrun - 40.f)) return;
    const float mn = fmaxf(mrun, rm);
    if (__any(mn > mrun)) {
        const float alpha = __builtin_amdgcn_exp2f(mrun - mn);
        lrun *= alpha;
#pragma unroll
        for (int r = 0; r < 16; ++r) { ot[0][r] *= alpha; ot[1][r] *= alpha; }
        mrun = mn;
    }
    float rs = 0.f;
#pragma unroll
    for (int r = 0; r < 16; ++r) { p0[r] = __builtin_amdgcn_exp2f(p0[r] - mrun); p1[r] = __builtin_amdgcn_exp2f(p1[r] - mrun); rs += p0[r] + p1[r]; }
    lrun += rs;
    bf16x8 pf[4];
    { u32x4 x; x.x = pk(p0[0], p0[1]); x.y = pk(p0[2], p0[3]); x.z = pk(p0[4], p0[5]); x.w = pk(p0[6], p0[7]); pf[0] = __builtin_bit_cast(bf16x8, x);
      x.x = pk(p0[8], p0[9]); x.y = pk(p0[10], p0[11]); x.z = pk(p0[12], p0[13]); x.w = pk(p0[14], p0[15]); pf[1] = __builtin_bit_cast(bf16x8, x);
      x.x = pk(p1[0], p1[1]); x.y = pk(p1[2], p1[3]); x.z = pk(p1[4], p1[5]); x.w = pk(p1[6], p1[7]); pf[2] = __builtin_bit_cast(bf16x8, x);
      x.x = pk(p1[8], p1[9]); x.y = pk(p1[10], p1[11]); x.z = pk(p1[12], p1[13]); x.w = pk(p1[14], p1[15]); pf[3] = __builtin_bit_cast(bf16x8, x); }
    __builtin_amdgcn_sched_barrier(0);
#pragma unroll
    for (int db = 0; db < 2; ++db)
#pragma unroll
        for (int ks = 0; ks < 4; ++ks) { const LAS bf16_t* vp = VTs + (32 * db + l31) * AT_VS + 16 * ks + 4 * hi;
            const u32x2 lo = *(const LAS u32x2*)vp, hh2 = *(const LAS u32x2*)(vp + 8);
            u32x4 x; x.x = lo.x; x.y = lo.y; x.z = hh2.x; x.w = hh2.y;
            ot[db] = MFMA32(__builtin_bit_cast(bf16x8, x), pf[ks], ot[db]); }
}

__device__ __forceinline__ void attn_unit_prompt(const Args& a, LAS unsigned char* lds, int b, int h, int qb) {
    int tid_ = threadIdx.x; asm volatile("" : "+v"(tid_));
    const int tid = tid_, lane = tid & 63, w = __builtin_amdgcn_readfirstlane(tid >> 6), l31 = lane & 31, hi = lane >> 5;
    const int NT = 4 * (qb + 1);
    const int qpos = 256 * qb + 32 * w + l31;
    const size_t qrow = (size_t)(b * 2048 + qpos);
    const float* cbase = (const float*)(a.ws + WS_CP) + (size_t)(b * 16 + h) * 2048;
    const bf16_t* qkv = (const bf16_t*)(a.ws + WS_PROJ);
    bf16x8 qf[4];
#pragma unroll
    for (int ks = 0; ks < 4; ++ks) qf[ks] = *(const bf16x8*)(qkv + qrow * NPJ + h * 64 + 16 * ks + 8 * hi);
    const float cq2 = cbase[qpos] * LOG2E;
    const int qmax_w = 256 * qb + 32 * w + 31;
    TileRegs R0, R1, R2;
    attn_load<false>(R0, a, b, h, NT - 1, cbase, tid); attn_load<false>(R1, a, b, h, NT - 2, cbase, tid); attn_load<false>(R2, a, b, h, NT - 3, cbase, tid);
    attn_store(R0, lds, false, tid);
    attn_load<false>(R0, a, b, h, NT - 4, cbase, tid);
    __syncthreads();
    float mrun = -INFINITY, lrun = 0.f;
    f32x16 ot[2]; ot[0] = f32x16{}; ot[1] = f32x16{};
#define PSTEP(tt, RR) do { if ((tt) < NT) { const int ti_ = NT - 1 - (tt); if (64 * ti_ <= qmax_w) attn_tile<false>(lds + ((tt) & 1) * AT_BUF, qf, nullptr, cq2, qpos, 64 * ti_, ti_ >= 4 * qb, mrun, lrun, ot, l31, hi); \
        if ((tt) + 1 < NT) { attn_store(RR, lds + (((tt) + 1) & 1) * AT_BUF, false, tid); if ((tt) + 4 < NT) attn_load<false>(RR, a, b, h, NT - 5 - (tt), cbase, tid); } \
        __syncthreads(); } } while (0)
#pragma unroll 1
    for (int t = 0; t < NT; t += 3) { PSTEP(t, R1); PSTEP(t + 1, R2); PSTEP(t + 2, R0); }
#undef PSTEP
    lrun += __shfl_xor(lrun, 32);
    const float inv = 1.f / lrun;
    bf16_t* og = (bf16_t*)(a.ws + WS_OG) + qrow * DM + h * 64;
#pragma unroll
    for (int db = 0; db < 2; ++db)
#pragma unroll
        for (int j = 0; j < 4; ++j) { u32x2 o; o.x = pk(ot[db][4 * j] * inv, ot[db][4 * j + 1] * inv); o.y = pk(ot[db][4 * j + 2] * inv, ot[db][4 * j + 3] * inv);
            *(u32x2*)(og + 32 * db + 8 * j + 4 * hi) = o; }
}

__device__ __forceinline__ void attn_unit_sample(const Args& a, LAS unsigned char* lds, int b, int h) {
    int tid_ = threadIdx.x; asm volatile("" : "+v"(tid_));
    const int tid = tid_, lane = tid & 63, w = __builtin_amdgcn_readfirstlane(tid >> 6), l31 = lane & 31, hi = lane >> 5;
    const bool active = w < 2;
    const int qpos = 2048 + 32 * (w & 1) + l31;
    const size_t qrow = (size_t)(MP + b * 64 + 32 * (w & 1) + l31);
    const float* cbase = (const float*)(a.ws + WS_CS) + (size_t)(b * 16 + h) * 2112;
    const bf16_t* qkv = (const bf16_t*)(a.ws + WS_PROJ);
    bf16x8 qf[4];
#pragma unroll
    for (int ks = 0; ks < 4; ++ks) qf[ks] = *(const bf16x8*)(qkv + qrow * NPJ + h * 64 + 16 * ks + 8 * hi);
    const float cq2 = cbase[qpos] * LOG2E;
    TileRegs R0, R1, R2;
    attn_load<true>(R0, a, b, h, 32, cbase, tid); attn_load<true>(R1, a, b, h, 31, cbase, tid); attn_load<true>(R2, a, b, h, 30, cbase, tid);
    attn_store(R0, lds, false, tid);
    attn_load<true>(R0, a, b, h, 29, cbase, tid);
    __syncthreads();
    float mrun = -INFINITY, lrun = 0.f;
    f32x16 ot[2]; ot[0] = f32x16{}; ot[1] = f32x16{};
#define SSTEP(tt, RR) do { if (active) attn_tile<false>(lds + ((tt) & 1) * AT_BUF, qf, nullptr, cq2, qpos, 64 * (32 - (tt)), (tt) == 0, mrun, lrun, ot, l31, hi); \
        if ((tt) + 1 < 33) { attn_store(RR, lds + (((tt) + 1) & 1) * AT_BUF, true, tid); if ((tt) + 4 < 33) attn_load<true>(RR, a, b, h, 28 - (tt), cbase, tid); } \
        __syncthreads(); } while (0)
#pragma unroll 1
    for (int t = 0; t < 33; t += 3) { SSTEP(t, R1); SSTEP(t + 1, R2); SSTEP(t + 2, R0); }
#undef SSTEP
    if (active) {
        lrun += __shfl_xor(lrun, 32);
        const float inv = 1.f / lrun;
        bf16_t* og = (bf16_t*)(a.ws + WS_OG) + qrow * DM + h * 64;
#pragma unroll
        for (int db = 0; db < 2; ++db)
#pragma unroll
            for (int j = 0; j < 4; ++j) { u32x2 o; o.x = pk(ot[db][4 * j] * inv, ot[db][4 * j + 1] * inv); o.y = pk(ot[db][4 * j + 2] * inv, ot[db][4 * j + 3] * inv);
                *(u32x2*)(og + 32 * db + 8 * j + 4 * hi) = o; }
    }
}

__device__ __forceinline__ void fox_attention(const Args& a, LAS unsigned char* lds, int vcu, int G) {
#pragma unroll 1
    for (int pass = 0; pass < 2; ++pass) {
        if ((pass ^ (vcu & 1)) == 0) {
#ifdef ATT_DUP_PROMPT
          for (int rep2_ = 0; rep2_ < 2; ++rep2_)
#endif
            if (G == 256) {
                const int bh = vcu >> 1, s0 = 2 * (vcu & 1);
#pragma unroll 1
                for (int i = 0; i < 4; ++i) attn_unit_prompt(a, lds, bh >> 4, bh & 15, (i & 1) ? s0 + (i >> 1) : 7 - s0 - (i >> 1));
            } else {
#pragma unroll 1
                for (int u = vcu; u < 1024; u += G) attn_unit_prompt(a, lds, (u & 127) >> 4, u & 15, 7 - (u >> 7));
            }
        } else {
#pragma unroll 1
            for (int u = vcu; u < 512; u += G) attn_unit_sample(a, lds, u >> 4, u & 15);
        }
    }
}

#ifndef PH_MASK
#define PH_MASK 0x7fff
#endif
#define IN(k) (((PH_MASK >> (k)) & 1) && a.ph_lo <= (k) && (k) < a.ph_hi)
#define SEAM(k) do { if (IN(k) && IN((k) + 1)) { if ((k) == 0) cg::this_grid().sync(); else xcd_barrier(xbar); } } while (0)
#ifndef DUP_MASK
#define DUP_MASK 0
#endif
#define REP(k) _Pragma("unroll 1") for (int rep_ = 0; rep_ < ((((DUP_MASK) >> (k)) & 1) ? 2 : 1); ++rep_)
#define REPSYNC(k) do { if ((((DUP_MASK) >> (k)) & 1)) xcd_barrier(xbar); } while (0)
template <int L> __device__ __forceinline__ void common_gemms(const Args& a, LAS unsigned char* lds, int G, int bx, const XcdBarrier& xbar) {
    unsigned char* ws = a.ws;
    float* SS = (float*)(ws + WS_SS);
    bf16_t* XB = (bf16_t*)(ws + WS_XB); float* XR = (float*)(ws + WS_XR); bf16_t* OG = (bf16_t*)(ws + WS_OG); bf16_t* ACT = (bf16_t*)(ws + WS_ACT);
    constexpr int po = L ? 11 : 5;
    if (IN(po)) { pg8::Gemm g{OG, (const bf16_t*)(ws + (L ? WS_WFOUT : WS_WGOUT)), MT, DM, DM}; pg8::StaticOrder S; S.init(MT, DM, G, bx);
        EpiResid E{L ? XR : a.in[I_XP], L ? XR + (size_t)MP * DM : a.in[I_XS], XR, XB, SS + (L ? 3 : 1) * 32768};
        pg8::gemm_phase<EpiResid, pg8::StaticOrder, true, true>(lds, g, S, E); }
    SEAM(po);
    if (IN(po + 1)) REP(po + 1) { pg8::Gemm g{XB, (const bf16_t*)(ws + WS_WFFI + (size_t)L * 11 * MiB), MT, 2 * DFF, DM}; pg8::StaticOrder S; S.init(MT, 2 * DFF, G, bx);
        EpiSwiglu E{SS + (L ? 3 : 1) * 32768, ACT}; pg8::gemm_phase<EpiSwiglu, pg8::StaticOrder, true, true>(lds, g, S, E); REPSYNC(po + 1); }
    SEAM(po + 1);
    if (IN(po + 2)) { pg8::Gemm g{ACT, (const bf16_t*)(ws + WS_WFFD + (size_t)L * 6 * MiB), MT, DM, DFF}; pg8::StaticOrder S; S.init(MT, DM, G, bx);
        EpiResid E{XR, XR + (size_t)MP * DM, XR, XB, SS + (L ? 4 : 2) * 32768};
        pg8::gemm_phase<EpiResid, pg8::StaticOrder, true, true>(lds, g, S, E); }
    SEAM(po + 2);
}
constexpr int NPH = 15;
__global__ void __launch_bounds__(512, 2) fwd(Args a) {
    extern __shared__ __attribute__((aligned(16))) unsigned char lds_raw[];
    LAS unsigned char* lds = (LAS unsigned char*)lds_raw;
    const int G = gridDim.x, bx = blockIdx.x;
    const int vcu = (G % 8 == 0) ? (bx % 8) * (G / 8) + bx / 8 : bx;
    unsigned char* ws = a.ws;
    float* SS = (float*)(ws + WS_SS);
    bf16_t* XB = (bf16_t*)(ws + WS_XB); bf16_t* PROJ = (bf16_t*)(ws + WS_PROJ);

    volatile LAS unsigned* MISC = (volatile LAS unsigned*)(lds + 131072);
    if (threadIdx.x < 64) MISC[threadIdx.x] = 0u;
    __syncthreads();
    XcdBarrier xbar; xbar.bar = (unsigned*)ws; xbar.x = 0; xbar.st = nullptr;
    if (a.ph_hi - a.ph_lo > 1) xbar = xcd_barrier_post((unsigned*)ws, MISC + 8);
    if (IN(0)) REP(0) { p0_prologue(a, lds, vcu, G); REPSYNC(0); }
    SEAM(0);
    if (IN(1)) { pg8::Gemm g{XB, (const bf16_t*)(ws + WS_WGIN), MT, NPROJ, DM}; pg8::StaticOrder S; S.init(MT, NPROJ, G, bx);
        EpiGlaProj E{SS, PROJ, (float*)(ws + WS_GL)}; pg8::gemm_phase<EpiGlaProj, pg8::StaticOrder, true, true>(lds, g, S, E); }
    SEAM(1);
    if (IN(2)) REP(2) {
#pragma unroll 1
        for (int it = vcu; it < 1152; it += G) gla_item<0>(a, lds, it >> 2, it & 3);
        REPSYNC(2); }
    SEAM(2);
    if (IN(3)) REP(3) { gla_scan(a, vcu, G); REPSYNC(3); }
    SEAM(3);
    if (IN(4)) REP(4) {
#pragma unroll 1
        for (int it = vcu; it < 1152; it += G) gla_item<1>(a, lds, it >> 2, it & 3);
        REPSYNC(4); }
    SEAM(4);
    common_gemms<0>(a, lds, G, bx, xbar);
    if (IN(8)) { pg8::Gemm g{XB, (const bf16_t*)(ws + WS_WFIN), MT, NPROJ, DM}; pg8::StaticOrder S; S.init(MT, NPROJ, G, bx);
        EpiFoxProj E{SS + 2 * 32768, PROJ, a.out, a.in[I_FBF]}; pg8::gemm_phase<EpiFoxProj, pg8::StaticOrder, true, true>(lds, g, S, E); }
    SEAM(8);
    if (IN(9)) REP(9) { fox_cumsum(a, lds, vcu, G); REPSYNC(9); }
    SEAM(9);
    if (IN(10)) REP(10) { fox_attention(a, lds, vcu, G); REPSYNC(10); }
    SEAM(10);
    common_gemms<1>(a, lds, G, bx, xbar);
#ifdef EXTRA_SYNCS
    for (int i_ = 0; i_ < EXTRA_SYNCS; ++i_) xcd_barrier(xbar);
#endif
    if (IN(14)) p_final(a, vcu, G);
#undef IN
#undef SEAM
}

extern "C" void kernel_launch(void* const* d_in, const int* in_sizes, int n_in, void* d_out, int out_size, void* d_ws, size_t ws_size, hipStream_t stream) {
    static int grid = 0;
    if (grid == 0) {
        if (n_in != 19 || ws_size < WS_END || out_size != 62160896) { fprintf(stderr, "kernel_launch: unexpected problem shape (n_in %d, out %d, ws %zu)\n", n_in, out_size, ws_size); grid = -1; return; }
        if (hipFuncSetAttribute((const void*)fwd, hipFuncAttributeMaxDynamicSharedMemorySize, LDS_BYTES) != hipSuccess) { fprintf(stderr, "kernel_launch: hipFuncSetAttribute failed\n"); grid = -1; return; }
        int dev = 0, cus = 0, per_cu = 0;
        (void)hipGetDevice(&dev); (void)hipDeviceGetAttribute(&cus, hipDeviceAttributeMultiprocessorCount, dev);
        (void)hipOccupancyMaxActiveBlocksPerMultiprocessor(&per_cu, (const void*)fwd, 512, LDS_BYTES);
        (void)hipGetLastError();
        if (per_cu < 1) per_cu = 1;
        grid = cus * 1;
        if (grid <= 0) grid = 256;
    }
    if (grid < 0) return;
    (void)hipMemsetAsync((char*)d_ws + WS_CTL, 0, CTL_BYTES, stream);
    Args a{};
    for (int i = 0; i < 19; ++i) a.in[i] = (const float*)d_in[i];
    a.out = (float*)d_out; a.ws = (unsigned char*)d_ws;
#if MK_MULTI
    for (int ph = 0; ph < NPH; ++ph) { a.ph_lo = ph; a.ph_hi = ph + 1; hipLaunchKernelGGL(fwd, dim3(grid), dim3(512), LDS_BYTES, stream, a); }
#else
    a.ph_lo = 0; a.ph_hi = NPH;
    void* args[] = {&a};
    hipError_t e = hipLaunchCooperativeKernel((const void*)fwd, dim3(grid), dim3(512), args, LDS_BYTES, stream);
    if (e != hipSuccess) fprintf(stderr, "kernel_launch: cooperative launch failed: %s (grid %d)\n", hipGetErrorString(e), grid);
#endif
}
```

```cpp
#include <hip/hip_runtime.h>
#include <hip/hip_cooperative_groups.h>
#include <cstdio>
#include <cstdint>
#include <cmath>
namespace cg = cooperative_groups;
#define MK_MULTI 0
namespace pg8 {
#define PG8_LAS __attribute__((address_space(3)))
typedef unsigned short bf16_t;
typedef short bf16x8 __attribute__((ext_vector_type(8)));
typedef float f32x4 __attribute__((ext_vector_type(4)));
typedef unsigned u32x4 __attribute__((ext_vector_type(4)));
constexpr int BM = 256, BK = 64, HALF = 128, HTB = HALF * BK * 2  , STAGE_BYTES = 8 * HTB, NXCD = 8, WGM = 8;

__host__ __device__ __forceinline__ int lds_byte(int r, int c) { const int st = (r >> 4) * 2 + (c >> 5), rr = r & 15, cc = c & 31, ob = rr * 64 + cc * 2; return st * 1024 + (ob ^ (((ob >> 9) & 1) << 5)); }
__host__ __device__ __forceinline__ void stage_rc(int b, int& R, int& C) { const int st = b / 1024, sb = b % 1024, swz = sb ^ (((sb >> 9) & 1) << 5); R = (st >> 1) * 16 + swz / 64; C = (st & 1) * 32 + (swz % 64) / 2; }
__host__ __device__ __forceinline__ int perm32(int rho) { const int n = rho >> 4, i = rho & 15; return 8 * (i >> 2) + 4 * n + (i & 3); }

struct Unit { int pm, pn; };
struct Gemm { const bf16_t* A; const bf16_t* Bt; int M, N, K; };

struct StaticOrder {
    int nM, nN, nwg, G, c;
    __host__ __device__ void init(int M, int N, int G_, int c_) { nM = M / BM; nN = N / BM; nwg = nM * nN; G = G_; c = c_; }
    __host__ __device__ bool next(int i, Unit& u) const {
        const long L = (long)i * G + c; if (L >= nwg) return false;
        int wgid = (int)L; { const int q = nwg / NXCD, r = nwg % NXCD, xcd = wgid % NXCD, off = wgid / NXCD; wgid = (xcd < r ? xcd * (q + 1) : r * (q + 1) + (xcd - r) * q) + off; }
        const int nig = WGM * nN, gid = wgid / nig, fm = gid * WGM, gsz = (nM - fm) < WGM ? (nM - fm) : WGM;
        u.pm = fm + ((wgid % nig) % gsz); u.pn = (wgid % nig) / gsz; return true;
    }
    __device__ __forceinline__ void a_ready(const Unit&) const {}
    __device__ __forceinline__ void done(const Unit&) const {}
};

__device__ __forceinline__ unsigned cvt_pk_bf16(float lo, float hi) { unsigned r; asm volatile("v_cvt_pk_bf16_f32 %0, %1, %2" : "=v"(r) : "v"(lo), "v"(hi)); return r; }
template <class Epi, class Sched, bool ALIGN_EPI = false, bool SP2 = false>
__device__ __forceinline__ void gemm_phase(PG8_LAS unsigned char* lds, const Gemm g, const Sched& S, const Epi& E) {
    const int tid = threadIdx.x, wid = __builtin_amdgcn_readfirstlane(tid >> 6), lane = tid & 63, wr = wid >> 2, wc = wid & 3, fr = lane & 15, fq = lane >> 4;
    const int K = g.K, nt = K / BK;
    unsigned voffA[2], voffB[2];
#pragma unroll
    for (int i = 0; i < 2; ++i) { int R, C; stage_rc(tid * 16 + i * 8192, R, C); const int Rb = Epi::PERM ? ((R & ~31) + perm32(R & 31)) : R;
        voffA[i] = (unsigned)(R * K + C) * 2u; voffB[i] = (unsigned)(Rb * K + C) * 2u; }
    const size_t kstep = (size_t)(BK * 2);
    const size_t hstep = (size_t)HALF * K * 2;
    const size_t tstep = 2 * hstep;
    const unsigned ldsw = (unsigned)wid * 1024u;
    const int aoff = lds_byte(wr * 64 + fr, fq * 8), boff = lds_byte(wc * 32 + fr, fq * 8);
#define PG8_SA(b, h) (((b) * 2 + (h)) * HTB)
#define PG8_SB(b, h) ((4 + (b) * 2 + (h)) * HTB)
#define PG8_STAGE(bufoff, gbase, voff) do { _Pragma("unroll") for (int _i = 0; _i < 2; ++_i) \
        __builtin_amdgcn_global_load_lds((const unsigned*)((const char*)(gbase) + (voff)[_i]), (PG8_LAS unsigned*)(lds + (bufoff) + ldsw + _i * 8192), 16, 0, 0); } while (0)
#define PG8_LDA(dst, b, h) do { _Pragma("unroll") for (int m = 0; m < 4; ++m) _Pragma("unroll") for (int k = 0; k < 2; ++k) dst[m][k] = *(const PG8_LAS bf16x8*)(lds + PG8_SA(b, h) + aoff + m * 2048 + k * 1024); } while (0)
#define PG8_LDB(dst, b, h) do { _Pragma("unroll") for (int n = 0; n < 2; ++n) _Pragma("unroll") for (int k = 0; k < 2; ++k) dst[n][k] = *(const PG8_LAS bf16x8*)(lds + PG8_SB(b, h) + boff + n * 2048 + k * 1024); } while (0)
#define PG8_MMA(ai, bj, At, Bt) do { __builtin_amdgcn_s_setprio(1); _Pragma("unroll") for (int m = 0; m < 4; ++m) _Pragma("unroll") for (int n = 0; n < 2; ++n) _Pragma("unroll") for (int k = 0; k < 2; ++k) \
        acc[ai][bj][m][n] = __builtin_amdgcn_mfma_f32_16x16x32_bf16(Bt[n][k], At[m][k], acc[ai][bj][m][n], 0, 0, 0); __builtin_amdgcn_s_setprio(0); } while (0)
#define PG8_WAIT_V(n) asm volatile("s_waitcnt vmcnt(" #n ")" ::: "memory")
#define PG8_WAIT_L(n) asm volatile("s_waitcnt lgkmcnt(" #n ")" ::: "memory")
#define PG8_BAR __builtin_amdgcn_s_barrier()
#define PG8_SCHED __builtin_amdgcn_sched_barrier(0)
    Unit cur, nxt; int ui = 0;
    if (!S.next(0, cur)) return;
    f32x4 acc[2][2][4][2];
#pragma unroll
    for (int a = 0; a < 2; ++a)
#pragma unroll
        for (int b = 0; b < 2; ++b)
#pragma unroll
            for (int m = 0; m < 4; ++m)
#pragma unroll
                for (int n = 0; n < 2; ++n) acc[a][b][m][n] = (f32x4){0.f, 0.f, 0.f, 0.f};
    bf16x8 At[4][2], B0[2][2], B1[2][2];
    const char* cA = (const char*)g.A + (size_t)cur.pm * tstep; const char* cB = (const char*)g.Bt + (size_t)cur.pn * tstep;
    S.a_ready(cur);
    if constexpr (SP2) {
        PG8_STAGE(PG8_SB(0, 0), cB, voffB); PG8_STAGE(PG8_SB(0, 1), cB + hstep, voffB); PG8_STAGE(PG8_SA(0, 0), cA, voffA); PG8_STAGE(PG8_SA(0, 1), cA + hstep, voffA);
        if (wr == 1) PG8_BAR;
        PG8_WAIT_V(2); PG8_BAR;
        PG8_STAGE(PG8_SB(1, 0), cB + kstep, voffB); PG8_STAGE(PG8_SA(1, 0), cA + kstep, voffA); PG8_STAGE(PG8_SB(1, 1), cB + hstep + kstep, voffB);
        PG8_WAIT_V(6); PG8_BAR;
    } else {
        PG8_STAGE(PG8_SB(0, 0), cB, voffB); PG8_STAGE(PG8_SA(0, 0), cA, voffA); PG8_STAGE(PG8_SB(0, 1), cB + hstep, voffB); PG8_STAGE(PG8_SA(0, 1), cA + hstep, voffA);
        if (wr == 1) PG8_BAR;
        PG8_WAIT_V(4); PG8_BAR;
        PG8_STAGE(PG8_SB(1, 0), cB + kstep, voffB); PG8_STAGE(PG8_SA(1, 0), cA + kstep, voffA); PG8_STAGE(PG8_SB(1, 1), cB + hstep + kstep, voffB);
        PG8_WAIT_V(6); PG8_BAR;
    }
    for (;;) {
        const bool has_next = S.next(ui + 1, nxt);
        const char* nA = has_next ? (const char*)g.A + (size_t)nxt.pm * tstep : cA; const char* nB = has_next ? (const char*)g.Bt + (size_t)nxt.pn * tstep : cB;
        for (int t = 0; t < nt; t += 2) {
            const bool last = (t == nt - 2);
            const char* a1 = cA + (size_t)(t + 1) * kstep;
            const char* a2 = last ? nA : cA + (size_t)(t + 2) * kstep; const char* b2 = last ? nB : cB + (size_t)(t + 2) * kstep;
            const char* a3 = a2 + kstep; const char* b3 = b2 + kstep;
            if (last && has_next) S.a_ready(nxt);
            if constexpr (SP2) {
            PG8_LDB(B0, 0, 0); PG8_LDB(B1, 0, 1); PG8_SCHED; PG8_LDA(At, 0, 0); PG8_STAGE(PG8_SA(1, 1), a1 + hstep, voffA);
            PG8_WAIT_V(8); PG8_WAIT_L(0); PG8_BAR; PG8_MMA(0, 0, At, B0); PG8_MMA(0, 1, At, B1); PG8_BAR; PG8_SCHED;
            PG8_LDA(At, 0, 1); PG8_STAGE(PG8_SB(0, 0), b2, voffB); PG8_STAGE(PG8_SB(0, 1), b2 + hstep, voffB); PG8_STAGE(PG8_SA(0, 0), a2, voffA);
            PG8_WAIT_V(8); PG8_WAIT_L(0); PG8_BAR; PG8_MMA(1, 0, At, B0); PG8_MMA(1, 1, At, B1); PG8_BAR; PG8_SCHED;
            PG8_LDB(B0, 1, 0); PG8_LDB(B1, 1, 1); PG8_SCHED; PG8_LDA(At, 1, 0); PG8_STAGE(PG8_SA(0, 1), a2 + hstep, voffA);
            PG8_WAIT_V(8); PG8_WAIT_L(0); PG8_BAR; PG8_MMA(0, 0, At, B0); PG8_MMA(0, 1, At, B1); PG8_BAR; PG8_SCHED;
            PG8_LDA(At, 1, 1); PG8_STAGE(PG8_SB(1, 0), b3, voffB); PG8_STAGE(PG8_SB(1, 1), b3 + hstep, voffB); PG8_STAGE(PG8_SA(1, 0), a3, voffA);
            PG8_WAIT_V(8); PG8_WAIT_L(0); PG8_BAR; PG8_MMA(1, 0, At, B0); PG8_MMA(1, 1, At, B1); PG8_BAR; PG8_SCHED;
            } else {
            PG8_LDB(B0, 0, 0); PG8_SCHED; PG8_LDA(At, 0, 0); PG8_STAGE(PG8_SA(1, 1), a1 + hstep, voffA);
            PG8_WAIT_L(8); PG8_BAR; PG8_WAIT_L(0); PG8_MMA(0, 0, At, B0); PG8_BAR; PG8_SCHED;
            PG8_LDB(B1, 0, 1); PG8_STAGE(PG8_SB(0, 0), b2, voffB);
            PG8_BAR; PG8_WAIT_L(0); PG8_MMA(0, 1, At, B1); PG8_BAR;
            PG8_LDA(At, 0, 1); PG8_STAGE(PG8_SA(0, 0), a2, voffA);
            PG8_BAR; PG8_WAIT_L(0); PG8_MMA(1, 0, At, B0); PG8_BAR; PG8_SCHED;
            PG8_STAGE(PG8_SB(0, 1), b2 + hstep, voffB);
            PG8_WAIT_V(6); PG8_BAR; PG8_MMA(1, 1, At, B1); PG8_BAR;
            PG8_LDB(B0, 1, 0); PG8_SCHED; PG8_LDA(At, 1, 0); PG8_STAGE(PG8_SA(0, 1), a2 + hstep, voffA);
            PG8_WAIT_L(8); PG8_BAR; PG8_WAIT_L(0); PG8_MMA(0, 0, At, B0); PG8_BAR; PG8_SCHED;
            PG8_LDB(B1, 1, 1); PG8_STAGE(PG8_SB(1, 0), b3, voffB);
            PG8_BAR; PG8_WAIT_L(0); PG8_MMA(0, 1, At, B1); PG8_BAR;
            PG8_LDA(At, 1, 1); PG8_STAGE(PG8_SA(1, 0), a3, voffA);
            PG8_BAR; PG8_WAIT_L(0); PG8_MMA(1, 0, At, B0); PG8_BAR; PG8_SCHED;
            PG8_STAGE(PG8_SB(1, 1), b3 + hstep, voffB);
            PG8_WAIT_V(6); PG8_BAR; PG8_MMA(1, 1, At, B1); PG8_BAR;
            }
        }
        if constexpr (ALIGN_EPI) { if (wr == 0) PG8_BAR; }
        if constexpr (!Epi::AFTER_DRAIN) { E(acc, cur, wr, wc, fr, fq); S.done(cur); }
        if (!has_next) break;
#pragma unroll
        for (int a = 0; a < 2; ++a)
#pragma unroll
            for (int b = 0; b < 2; ++b)
#pragma unroll
                for (int m = 0; m < 4; ++m)
#pragma unroll
                    for (int n = 0; n < 2; ++n) acc[a][b][m][n] = (f32x4){0.f, 0.f, 0.f, 0.f};
        cur = nxt; cA = nA; cB = nB; ++ui;
        if constexpr (ALIGN_EPI) { if (wr == 1) PG8_BAR; }
    }
    PG8_WAIT_V(0);
    if constexpr (!ALIGN_EPI) { if (wr == 0) PG8_BAR; }
    PG8_BAR;
    if constexpr (Epi::AFTER_DRAIN) { E.fused(acc, cur, wr, wc, fr, fq, lds, wid, lane); S.done(cur); }
#undef PG8_SA
#undef PG8_SB
#undef PG8_STAGE
#undef PG8_LDA
#undef PG8_LDB
#undef PG8_MMA
#undef PG8_WAIT_V
#undef PG8_WAIT_L
#undef PG8_BAR
#undef PG8_SCHED
}
}

#define LAS __attribute__((address_space(3)))
typedef unsigned short bf16_t;
typedef short bf16x8 __attribute__((ext_vector_type(8)));
typedef float f32x4 __attribute__((ext_vector_type(4)));
typedef float f32x16 __attribute__((ext_vector_type(16)));
typedef unsigned u32x4 __attribute__((ext_vector_type(4)));
typedef unsigned u32x2 __attribute__((ext_vector_type(2)));

#ifndef MK_MULTI
#define MK_MULTI 0
#endif

constexpr int DM = 1024, MP = 16384, MS = 2048, MT = MP + MS;
constexpr int NPROJ = 3328, NPJ = 3072, DFF = 2816;
constexpr float EPS = 1e-6f;
constexpr float LOG2E = 1.4426950408889634f;
constexpr float QSCALE2 = 0.125f * LOG2E;
constexpr size_t O_Y = 0, O_GSP = 18874368, O_FKP = 19922944, O_FVP = 36700160, O_FLP = 53477376, O_GSS = 53739520, O_FKS = 57933824, O_FVS = 60030976, O_FLS = 62128128;
constexpr size_t MiB = 1u << 20;
constexpr size_t WS_CTL = 0, CTL_BYTES = 2 * MiB;
constexpr size_t WS_SS = 65536;
constexpr size_t WS_WGIN = 2 * MiB, WS_WFIN = 9 * MiB, WS_WGOUT = 16 * MiB, WS_WFOUT = 18 * MiB, WS_WFFI = 20 * MiB  , WS_WFFD = 42 * MiB  ;
constexpr size_t WS_XB = 54 * MiB, WS_XR = 90 * MiB, WS_PROJ = 162 * MiB, WS_GL = 270 * MiB, WS_DST = 272 * MiB, WS_DEC = 400 * MiB, WS_SPREV = 401 * MiB;
constexpr size_t WS_OG = 465 * MiB, WS_ACT = 501 * MiB, WS_CP = 600 * MiB, WS_CS = 601 * MiB, WS_END = 606 * MiB;
constexpr int LDS_BYTES = 135168;

struct Args {
    const float* in[19];
    float* out; unsigned char* ws;
    int ph_lo, ph_hi;
};
enum { I_XP = 0, I_XS, I_STATE, I_CK, I_CV, I_CLF, I_NMIX, I_GWIN, I_GWG2, I_GBG, I_GNORM, I_GWOUT, I_FWIN, I_FBF, I_FWOUT, I_NFFN, I_FFIN, I_FFDN, I_NFIN };

__device__ __forceinline__ float bf2f(unsigned u) { return __uint_as_float(u << 16); }
__device__ __forceinline__ unsigned f2bf(float f) { unsigned u = __float_as_uint(f); return (u + 0x7fffu + ((u >> 16) & 1u)) >> 16; }
__device__ __forceinline__ unsigned pk(float lo, float hi) { return pg8::cvt_pk_bf16(lo, hi); }
__device__ __forceinline__ float wave_sum(float v) {
#pragma unroll
    for (int o = 1; o < 64; o <<= 1) v += __shfl_xor(v, o);
    return v;
}
__device__ __forceinline__ float log_sigmoid(float z) { return fminf(z, 0.f) - __logf(1.f + __expf(-fabsf(z))); }
__device__ __forceinline__ int crow(int r, int hi) { return (r & 3) + 8 * (r >> 2) + 4 * hi; }
__device__ __forceinline__ float dot4(f32x4 v) { return (v[0] * v[0] + v[1] * v[1]) + (v[2] * v[2] + v[3] * v[3]); }
#define MFMA32(a, b, c) __builtin_amdgcn_mfma_f32_32x32x16_bf16((a), (b), (c), 0, 0, 0)

#define XB_TMO      128
#define XB_XCNT(j)  (256  + 64 * (j))
#define XB_XSUB(j)  (1280 + 64 * (j))
#define XB_XGEN(j)  (2304 + 64 * (j))
#define XB_TOP      3328
#define XB_TOPGEN   3392
#define XCD_BAR_WORDS 3456
#define XB_SPIN_CAP (1u << 18)

__device__ __forceinline__ unsigned xb_ld(unsigned* p)              { return __hip_atomic_load(p, __ATOMIC_RELAXED, __HIP_MEMORY_SCOPE_AGENT); }
__device__ __forceinline__ unsigned xb_add(unsigned* p, unsigned v) { return __hip_atomic_fetch_add(p, v, __ATOMIC_RELAXED, __HIP_MEMORY_SCOPE_AGENT); }
__device__ __forceinline__ unsigned xb_xcc_id() { return (unsigned)__builtin_amdgcn_s_getreg((3 << 11) | 20) & 0xFu; }
#define XB_SPIN(cond, bar) do { unsigned _sp = 0; while (cond) { __builtin_amdgcn_s_sleep(1); \
    if ((++_sp & 255u) == 0u) { if (xb_ld(&(bar)[XB_TMO])) break; if (_sp > XB_SPIN_CAP) { atomicAdd(&(bar)[XB_TMO], 1u); break; } } } } while (0)

struct XcdBarrier {
    unsigned* bar; unsigned x;
    volatile LAS unsigned* st;
};

__device__ __forceinline__ XcdBarrier xcd_barrier_post(unsigned* bar, volatile LAS unsigned* st) {
    XcdBarrier b; b.bar = bar; b.x = xb_xcc_id(); b.st = st;
    if (threadIdx.x == 0) (void)xb_add(&bar[XB_XCNT(b.x)], 1u);
    return b;
}
__device__ __forceinline__ void xcd_barrier_complete(unsigned* bar, unsigned x, unsigned& nloc, unsigned& nx) {
    const unsigned G = gridDim.x * gridDim.y * gridDim.z;
    unsigned sum, cnt, mine, sp = 0u;
    for (;;) {
        sum = 0u; cnt = 0u; mine = 0u;
#pragma unroll
        for (unsigned j = 0; j < 16; ++j) { const unsigned c = xb_ld(&bar[XB_XCNT(j)]); sum += c; cnt += (c > 0u) ? 1u : 0u; mine = (j == x) ? c : mine; }
        if (sum == G) break;
        __builtin_amdgcn_s_sleep(1);
        if ((++sp & 255u) == 0u) { if (xb_ld(&bar[XB_TMO])) break; if (sp > XB_SPIN_CAP) { atomicAdd(&bar[XB_TMO], 1u); break; } }
    }
    nloc = mine > 0u ? mine : 1u; nx = cnt > 0u ? cnt : 1u;
}

__device__ __forceinline__ void xcd_barrier(const XcdBarrier& b) {
    asm volatile("s_waitcnt vmcnt(0)" ::: "memory");
    __syncthreads();
    if (threadIdx.x == 0) {
        unsigned* bar = b.bar;
        __builtin_amdgcn_s_waitcnt(0);
        unsigned nloc = b.st[0], nx = b.st[1];
        if (nloc == 0u) { xcd_barrier_complete(bar, b.x, nloc, nx); b.st[0] = nloc; b.st[1] = nx; }
        const unsigned old = xb_add(&bar[XB_XSUB(b.x)], 1u);
        const unsigned gen = old / nloc;
        if (old + 1u == (gen + 1u) * nloc) {
            __builtin_amdgcn_fence(__ATOMIC_RELEASE, "agent");
            asm volatile("s_waitcnt vmcnt(0)" ::: "memory");
            const unsigned og = xb_add(&bar[XB_TOP], 1u);
            const unsigned tg = og / nx;
            if (og + 1u == (tg + 1u) * nx) xb_add(&bar[XB_TOPGEN], 1u);
            else XB_SPIN(xb_ld(&bar[XB_TOPGEN]) == tg, bar);
            __builtin_amdgcn_fence(__ATOMIC_ACQUIRE, "agent");
            xb_add(&bar[XB_XGEN(b.x)], 1u);
            asm volatile("s_waitcnt vmcnt(0)" ::: "memory");
        } else {
            XB_SPIN(xb_ld(&bar[XB_XGEN(b.x)]) == gen, bar);
            __builtin_amdgcn_fence(__ATOMIC_ACQUIRE, "agent");
            asm volatile("s_waitcnt vmcnt(0)" ::: "memory");
        }
    }
    __syncthreads();
}

__device__ __forceinline__ void tr_item(const float* __restrict__ W, int K, int N, int nsrc0, bf16_t* WT, int drow0, const float* __restrict__ gain, LAS float* scr, int k0, int lane) {
    const int n = nsrc0 + (lane & 31);
    float wv_[32];
    const float* wp_ = W + (size_t)(k0 + (lane >> 5)) * N + ((n < N) ? n : 0);
#pragma unroll
    for (int i = 0; i < 32; ++i) wv_[i] = wp_[(size_t)(2 * i) * N];
#pragma unroll
    for (int i = 0; i < 32; ++i) {
        const int kk = 2 * i + (lane >> 5);
        float v = (n < N) ? wv_[i] : 0.f;
        if (gain) v *= gain[k0 + kk];
        scr[kk * 33 + (lane & 31)] = v;
    }
    asm volatile("s_waitcnt lgkmcnt(0)" ::: "memory");
    const int c = lane & 7;
#pragma unroll
    for (int j = 0; j < 4; ++j) {
        const int nn = (lane >> 3) + 8 * j; const LAS float* s = scr + (8 * c) * 33 + nn;
        u32x4 o; o.x = pk(s[0 * 33], s[1 * 33]); o.y = pk(s[2 * 33], s[3 * 33]); o.z = pk(s[4 * 33], s[5 * 33]); o.w = pk(s[6 * 33], s[7 * 33]);
        *(u32x4*)(WT + (size_t)(drow0 + nn) * K + k0 + 8 * c) = o;
    }
    asm volatile("s_waitcnt lgkmcnt(0)" ::: "memory");
}

__device__ __forceinline__ void p0_prologue(const Args& a, LAS unsigned char* lds, int vcu, int G) {
    const int tid = threadIdx.x, lane = tid & 63, wave = tid >> 6;
    LAS float* scr = (LAS float*)(lds + wave * 16384);
    const int gw = vcu * 8 + wave, NGW = G * 8;
    unsigned char* ws = a.ws;
    constexpr int I_IN = 16 * 104, I_OUT = 16 * 32, I_FI = 16 * 176, I_FD = 44 * 32;
    constexpr int NITEMS = 2 * I_IN + 2 * I_OUT + 2 * I_FI + 2 * I_FD;
    for (int it = gw; it < NITEMS; it += NGW) {
        int r = it;
        if (r < I_IN) { const int kb = r / 104, nb = r % 104; tr_item(a.in[I_GWIN], 1024, 3088, 32 * nb, (bf16_t*)(ws + WS_WGIN), 32 * nb, a.in[I_NMIX], scr, 64 * kb, lane); continue; } r -= I_IN;
        if (r < I_IN) { const int kb = r / 104, nb = r % 104; tr_item(a.in[I_FWIN], 1024, 3088, 32 * nb, (bf16_t*)(ws + WS_WFIN), 32 * nb, a.in[I_NMIX] + 1024, scr, 64 * kb, lane); continue; } r -= I_IN;
        if (r < I_OUT) { const int kb = r / 32, nb = r % 32; tr_item(a.in[I_GWOUT], 1024, 1024, 32 * nb, (bf16_t*)(ws + WS_WGOUT), 32 * nb, nullptr, scr, 64 * kb, lane); continue; } r -= I_OUT;
        if (r < I_OUT) { const int kb = r / 32, nb = r % 32; tr_item(a.in[I_FWOUT], 1024, 1024, 32 * nb, (bf16_t*)(ws + WS_WFOUT), 32 * nb, nullptr, scr, 64 * kb, lane); continue; } r -= I_OUT;
        if (r < 2 * I_FI) { const int li = r / I_FI; r -= li * I_FI; const int kb = r / 176, nb = r % 176, ns = 32 * nb, bj = ns / DFF, j = ns % DFF, drow = 256 * (j / 128) + 128 * bj + (j % 128);
            tr_item(a.in[I_FFIN] + (size_t)li * 1024 * 5632, 1024, 5632, ns, (bf16_t*)(ws + WS_WFFI + (size_t)li * 11 * MiB), drow, a.in[I_NFFN] + li * 1024, scr, 64 * kb, lane); continue; } r -= 2 * I_FI;
        { const int li = r / I_FD; r -= li * I_FD; const int kb = r / 32, nb = r % 32;
            tr_item(a.in[I_FFDN] + (size_t)li * DFF * 1024, DFF, 1024, 32 * nb, (bf16_t*)(ws + WS_WFFD + (size_t)li * 6 * MiB), 32 * nb, nullptr, scr, 64 * kb, lane); }
    }
    float* ss0 = (float*)(ws + WS_SS);
    bf16_t* XB = (bf16_t*)(ws + WS_XB);
    for (int m0 = gw; m0 < MT; m0 += 3 * NGW) {
        f32x4 v[3][4];
#pragma unroll
        for (int q = 0; q < 3; ++q) { const int m = m0 + q * NGW; if (m < MT) { const float* xr = (m < MP) ? a.in[I_XP] + (size_t)m * DM : a.in[I_XS] + (size_t)(m - MP) * DM;
#pragma unroll
            for (int j = 0; j < 4; ++j) v[q][j] = ((const f32x4*)xr)[lane + 64 * j]; } }
#pragma unroll
        for (int q = 0; q < 3; ++q) { const int m = m0 + q * NGW; if (m < MT) { float s = 0.f;
#pragma unroll
            for (int j = 0; j < 4; ++j) s += dot4(v[q][j]);
            s = wave_sum(s);
            if (lane == 0) ss0[m] = s;
#pragma unroll
            for (int j = 0; j < 4; ++j) { u32x2 o; o.x = pk(v[q][j][0], v[q][j][1]); o.y = pk(v[q][j][2], v[q][j][3]); ((u32x2*)(XB + (size_t)m * DM))[lane + 64 * j] = o; } } }
    }
}

__device__ __forceinline__ void p_final(const Args& a, int vcu, int G) {
    const int tid = threadIdx.x, lane = tid & 63, wave = tid >> 6;
    const int gw = vcu * 8 + wave, NGW = G * 8;
    const float* ss = (const float*)(a.ws + WS_SS + 4 * 131072);
    const float* XR = (const float*)(a.ws + WS_XR);
    const float* g = a.in[I_NFIN];
    f32x4 gv[4];
#pragma unroll
    for (int j = 0; j < 4; ++j) gv[j] = ((const f32x4*)g)[lane + 64 * j];
    for (int m0 = gw; m0 < MT; m0 += 3 * NGW) {
        f32x4 v[3][4]; float rs[3];
#pragma unroll
        for (int q = 0; q < 3; ++q) { const int m = m0 + q * NGW; if (m < MT) { rs[q] = rsqrtf(ss[m] * (1.f / DM) + EPS);
#pragma unroll
            for (int j = 0; j < 4; ++j) v[q][j] = ((const f32x4*)(XR + (size_t)m * DM))[lane + 64 * j]; } }
#pragma unroll
        for (int q = 0; q < 3; ++q) { const int m = m0 + q * NGW; if (m < MT) {
#pragma unroll
            for (int j = 0; j < 4; ++j) ((f32x4*)(a.out + O_Y + (size_t)m * DM))[lane + 64 * j] = v[q][j] * rs[q] * gv[j]; } }
    }
}

struct EpiGlaProj {
    static constexpr bool PERM = true, AFTER_DRAIN = false;
    const float* ss; bf16_t* proj; float* gl;
    __device__ __forceinline__ void operator()(const pg8::f32x4 (&acc)[2][2][4][2], const pg8::Unit& u, int wr, int wc, int fr, int fq) const {
        const int row0 = u.pm * 256 + wr * 64 + fr;
#pragma unroll
        for (int ai = 0; ai < 2; ++ai)
#pragma unroll
            for (int m = 0; m < 4; ++m) {
                const int row = row0 + ai * 128 + m * 16; const float rs = rsqrtf(ss[row] * (1.f / DM) + EPS);
                if (u.pn < 12) {
#pragma unroll
                    for (int bj = 0; bj < 2; ++bj) { const f32x4 v0 = acc[ai][bj][m][0] * rs, v1 = acc[ai][bj][m][1] * rs;
                        u32x4 w; w.x = pk(v0[0], v0[1]); w.y = pk(v0[2], v0[3]); w.z = pk(v1[0], v1[1]); w.w = pk(v1[2], v1[3]);
                        *(u32x4*)(proj + (size_t)row * NPJ + u.pn * 256 + bj * 128 + wc * 32 + 8 * fq) = w; }
                } else if (wc == 0 && fq < 2) {
#pragma unroll
                    for (int n = 0; n < 2; ++n) *(f32x4*)(gl + (size_t)row * 16 + 8 * fq + 4 * n) = acc[ai][0][m][n] * rs;
                }
            }
    }
};
struct EpiResid {
    static constexpr bool PERM = true, AFTER_DRAIN = false;
    const float* xin_p; const float* xin_s; float* xout; bf16_t* xb; float* ssout;
    __device__ __forceinline__ void operator()(const pg8::f32x4 (&acc)[2][2][4][2], const pg8::Unit& u, int wr, int wc, int fr, int fq) const {
        const int row0 = u.pm * 256 + wr * 64 + fr;
#pragma unroll
        for (int ai = 0; ai < 2; ++ai)
#pragma unroll
            for (int m = 0; m < 4; ++m) {
                const int row = row0 + ai * 128 + m * 16;
                const float* xi = (row < MP) ? xin_p + (size_t)row * DM : xin_s + (size_t)(row - MP) * DM;
                float sq = 0.f;
#pragma unroll
                for (int bj = 0; bj < 2; ++bj) { const int col = u.pn * 256 + bj * 128 + wc * 32 + 8 * fq;
                    const f32x4 a0 = *(const f32x4*)(xi + col) + acc[ai][bj][m][0], a1 = *(const f32x4*)(xi + col + 4) + acc[ai][bj][m][1];
                    *(f32x4*)(xout + (size_t)row * DM + col) = a0; *(f32x4*)(xout + (size_t)row * DM + col + 4) = a1;
                    u32x4 w; w.x = pk(a0[0], a0[1]); w.y = pk(a0[2], a0[3]); w.z = pk(a1[0], a1[1]); w.w = pk(a1[2], a1[3]);
                    *(u32x4*)(xb + (size_t)row * DM + col) = w;
                    sq += dot4(a0) + dot4(a1); }
                sq += __shfl_xor(sq, 16); sq += __shfl_xor(sq, 32);
                if (fq == 0) atomicAdd(ssout + row, sq);
            }
    }
};
struct EpiSwiglu {
    static constexpr bool PERM = true, AFTER_DRAIN = false;
    const float* ss; bf16_t* act;
    __device__ __forceinline__ void operator()(const pg8::f32x4 (&acc)[2][2][4][2], const pg8::Unit& u, int wr, int wc, int fr, int fq) const {
        const int row0 = u.pm * 256 + wr * 64 + fr;
#pragma unroll
        for (int ai = 0; ai < 2; ++ai)
#pragma unroll
            for (int m = 0; m < 4; ++m) {
                const int row = row0 + ai * 128 + m * 16; const float rs = rsqrtf(ss[row] * (1.f / DM) + EPS);
                float y[8];
#pragma unroll
                for (int n = 0; n < 2; ++n)
#pragma unroll
                    for (int i = 0; i < 4; ++i) { const float g = acc[ai][0][m][n][i] * rs, up = acc[ai][1][m][n][i] * rs; y[4 * n + i] = g * up * __builtin_amdgcn_rcpf(1.f + __expf(-g)); }
                u32x4 w; w.x = pk(y[0], y[1]); w.y = pk(y[2], y[3]); w.z = pk(y[4], y[5]); w.w = pk(y[6], y[7]);
                *(u32x4*)(act + (size_t)row * DFF + u.pn * 128 + wc * 32 + 8 * fq) = w;
            }
    }
};
struct EpiFoxProj {
    static constexpr bool PERM = true, AFTER_DRAIN = false;
    const float* ss; bf16_t* qkv; float* out; const float* bf;
    __device__ __forceinline__ void operator()(const pg8::f32x4 (&acc)[2][2][4][2], const pg8::Unit& u, int wr, int wc, int fr, int fq) const {
        const int row0 = u.pm * 256 + wr * 64 + fr;
        const int sect = u.pn >> 2;
#pragma unroll
        for (int ai = 0; ai < 2; ++ai)
#pragma unroll
            for (int m = 0; m < 4; ++m) {
                const int row = row0 + ai * 128 + m * 16; const float rs = rsqrtf(ss[row] * (1.f / DM) + EPS);
                if (u.pn < 12) {
                    const float sc = (sect == 0) ? rs * QSCALE2 : rs;
                    float* fdst = nullptr;
                    if (sect == 1) fdst = (row < MP) ? out + O_FKP + (size_t)row * DM : out + O_FKS + (size_t)(row - MP) * DM;
                    if (sect == 2) fdst = (row < MP) ? out + O_FVP + (size_t)row * DM : out + O_FVS + (size_t)(row - MP) * DM;
#pragma unroll
                    for (int bj = 0; bj < 2; ++bj) { const f32x4 v0 = acc[ai][bj][m][0] * sc, v1 = acc[ai][bj][m][1] * sc;
                        u32x4 w; w.x = pk(v0[0], v0[1]); w.y = pk(v0[2], v0[3]); w.z = pk(v1[0], v1[1]); w.w = pk(v1[2], v1[3]);
                        const int cl = bj * 128 + wc * 32 + 8 * fq;
                        *(u32x4*)(qkv + (size_t)row * NPJ + u.pn * 256 + cl) = w;
                        if (sect > 0) { float* d = fdst + (u.pn & 3) * 256 + cl; *(f32x4*)d = v0; *(f32x4*)(d + 4) = v1; } }
                } else if (wc == 0 && fq < 2) {
                    float* d = (row < MP) ? out + O_FLP + (size_t)row * 16 : out + O_FLS + (size_t)(row - MP) * 16;
#pragma unroll
                    for (int n = 0; n < 2; ++n) { const f32x4 v = acc[ai][0][m][n] * rs; f32x4 o;
#pragma unroll
                        for (int i = 0; i < 4; ++i) o[i] = log_sigmoid(v[i] + bf[8 * fq + 4 * n + i]);
                        *(f32x4*)(d + 8 * fq + 4 * n) = o; }
                }
            }
    }
};

constexpr int GL_OFF = 0, GSUM_OFF = 4096, DECS_OFF = 6144, QE_OFF = 8192, KE_OFF = 25600, VT_OFF = 43008, AL_OFF = 79872, KDT_OFF = 8192, OL_OFF = 8192;
constexpr int QES = 136, VTS = 72, OLS = 260;

template <int MODE> __device__ __forceinline__ void gla_item(const Args& a, LAS unsigned char* lds, int cid, int h) {
    const int tid = threadIdx.x, lane = tid & 63, w = tid >> 6, l31 = lane & 31, hi = lane >> 5;
    const int row0 = cid * 64;
    const bool prompt = cid < 256;
    LAS float* GLs = (LAS float*)(lds + GL_OFF); LAS float* GSUM = (LAS float*)(lds + GSUM_OFF); LAS float* DECS = (LAS float*)(lds + DECS_OFF);
    LAS bf16_t* QE = (LAS bf16_t*)(lds + QE_OFF); LAS bf16_t* KE = (LAS bf16_t*)(lds + KE_OFF); LAS bf16_t* VT = (LAS bf16_t*)(lds + VT_OFF);
    LAS bf16_t* AL = (LAS bf16_t*)(lds + AL_OFF); LAS bf16_t* KDT = (LAS bf16_t*)(lds + KDT_OFF);
    const bf16_t* P = (const bf16_t*)(a.ws + WS_PROJ) + (size_t)row0 * NPJ;
    const float* GL = (const float*)(a.ws + WS_GL);
    const float* state = a.in[I_STATE];

    bf16x8 sfr[8];
    if (MODE == 1) {
        if (prompt) {
            const bf16_t* sp = (const bf16_t*)(a.ws + WS_SPREV) + ((size_t)(cid * 4 + h) * 256 + 32 * w + l31) * 128 + 8 * hi;
#pragma unroll
            for (int ks = 0; ks < 8; ++ks) sfr[ks] = *(const bf16x8*)(sp + 16 * ks);
        } else {
            const float* s0 = state + ((size_t)((cid - 256) * 4 + h) * 128) * 256 + 32 * w + l31;
#pragma unroll
            for (int ks = 0; ks < 8; ++ks) { float f[8];
#pragma unroll
                for (int j = 0; j < 8; ++j) f[j] = s0[(size_t)(16 * ks + 8 * hi + j) * 256];
                u32x4 o; o.x = pk(f[0], f[1]); o.y = pk(f[2], f[3]); o.z = pk(f[4], f[5]); o.w = pk(f[6], f[7]); sfr[ks] = __builtin_bit_cast(bf16x8, o); }
        }
    }
    unsigned kraw[16], qraw[16];
    {
        const int dk_ = tid & 127, tg_ = tid >> 7;
        const bf16_t* kp_ = P + (size_t)(16 * tg_) * NPJ + 512 + h * 128 + dk_;
#pragma unroll
        for (int i = 0; i < 16; ++i) kraw[i] = kp_[(size_t)i * NPJ];
        if (MODE == 1) { const bf16_t* qp_ = P + (size_t)(16 * tg_) * NPJ + h * 128 + dk_;
#pragma unroll
            for (int i = 0; i < 16; ++i) qraw[i] = qp_[(size_t)i * NPJ]; }
    }
    if (tid < 256) ((LAS f32x4*)GLs)[tid] = *(const f32x4*)(GL + (size_t)(row0 + (tid >> 2)) * 16 + (tid & 3) * 4);
    {
        const int dvv = tid & 255, th = tid >> 8; const bf16_t* vp = P + (size_t)(32 * th) * NPJ + 1024 + h * 256 + dvv;
#pragma unroll
        for (int q4 = 0; q4 < 4; ++q4) { unsigned e[8];
#pragma unroll
            for (int i = 0; i < 8; ++i) e[i] = vp[(size_t)(8 * q4 + i) * NPJ];
            u32x4 o; o.x = e[0] | (e[1] << 16); o.y = e[2] | (e[3] << 16); o.z = e[4] | (e[5] << 16); o.w = e[6] | (e[7] << 16);
            *(LAS u32x4*)(VT + dvv * VTS + 32 * th + 8 * q4) = o; }
    }
    __syncthreads();
    const int dk = tid & 127, tg = tid >> 7;
    float bc[16];
    {
        float wv[16];
#pragma unroll
        for (int j = 0; j < 16; ++j) wv[j] = a.in[I_GWG2][j * 512 + h * 128 + dk];
        const float bias = a.in[I_GBG][h * 128 + dk];
        float run = 0.f;
#pragma unroll
        for (int i = 0; i < 16; ++i) { const LAS f32x4* gp = (const LAS f32x4*)(GLs + (16 * tg + i) * 16); float z = bias;
#pragma unroll
            for (int j4 = 0; j4 < 4; ++j4) { const f32x4 gq = gp[j4]; z += gq[0] * wv[4 * j4] + gq[1] * wv[4 * j4 + 1] + gq[2] * wv[4 * j4 + 2] + gq[3] * wv[4 * j4 + 3]; }
            run += log_sigmoid(z) * (1.f / 16.f); bc[i] = run; }
        GSUM[tg * 128 + dk] = run;
    }
    __syncthreads();
    float off = 0.f, blast = 0.f;
#pragma unroll
    for (int g = 0; g < 4; ++g) { const float s = GSUM[g * 128 + dk]; blast += s; if (g < tg) off += s; }
    if (MODE == 0) {
        float kd[16];
#pragma unroll
        for (int i = 0; i < 16; ++i) { const float b = bc[i] + off; kd[i] = bf2f(kraw[i]) * __expf(blast - b); }
        u32x4 o0, o1; o0.x = pk(kd[0], kd[1]); o0.y = pk(kd[2], kd[3]); o0.z = pk(kd[4], kd[5]); o0.w = pk(kd[6], kd[7]);
        o1.x = pk(kd[8], kd[9]); o1.y = pk(kd[10], kd[11]); o1.z = pk(kd[12], kd[13]); o1.w = pk(kd[14], kd[15]);
        *(LAS u32x4*)(KDT + dk * VTS + 16 * tg) = o0; *(LAS u32x4*)(KDT + dk * VTS + 16 * tg + 8) = o1;
        if (tg == 0) { const float d = __expf(blast); DECS[dk] = d; if (prompt) ((float*)(a.ws + WS_DEC))[(size_t)(cid * 4 + h) * 128 + dk] = d; }
    } else {
#pragma unroll
        for (int i = 0; i < 16; ++i) { const float b = bc[i] + off; const int t = 16 * tg + i;
            const float qe = bf2f(qraw[i]) * __expf(b) * 0.08838834764831845f, ke = bf2f(kraw[i]) * __expf(-b);
            QE[t * QES + dk] = (bf16_t)f2bf(qe); KE[t * QES + dk] = (bf16_t)f2bf(ke); }
    }
    __syncthreads();
    if (MODE == 0) {
        bf16x8 vf[4];
#pragma unroll
        for (int ks = 0; ks < 4; ++ks) vf[ks] = *(const LAS bf16x8*)(VT + (32 * w + l31) * VTS + 16 * ks + 8 * hi);
        f32x16 acc[4];
#pragma unroll
        for (int d = 0; d < 4; ++d) acc[d] = f32x16{};
#pragma unroll
        for (int d = 0; d < 4; ++d)
#pragma unroll
            for (int ks = 0; ks < 4; ++ks) { const bf16x8 kf = *(const LAS bf16x8*)(KDT + (32 * d + l31) * VTS + 16 * ks + 8 * hi);
                acc[d] = prompt ? MFMA32(vf[ks], kf, acc[d]) : MFMA32(kf, vf[ks], acc[d]); }
        if (prompt) {
            float* dst = (float*)(a.ws + WS_DST) + ((size_t)(cid * 4 + h) * 256 + 32 * w) * 128;
#pragma unroll
            for (int d = 0; d < 4; ++d)
#pragma unroll
                for (int r = 0; r < 16; ++r) dst[(size_t)crow(r, hi) * 128 + 32 * d + l31] = acc[d][r];
        } else {
            const size_t base = ((size_t)((cid - 256) * 4 + h) * 128) * 256;
            float* outs = a.out + O_GSS;
#pragma unroll
            for (int d = 0; d < 4; ++d)
#pragma unroll
                for (int r = 0; r < 16; ++r) { const int dkk = 32 * d + crow(r, hi); const size_t idx = base + (size_t)dkk * 256 + 32 * w + l31; outs[idx] = state[idx] * DECS[dkk] + acc[d][r]; }
        }
    } else {
        u32x2 rraw[8];
#pragma unroll
        for (int i = 0; i < 8; ++i) rraw[i] = *(const u32x2*)(P + (size_t)(8 * w + i) * NPJ + 2048 + h * 256 + 4 * lane);
        f32x16 o[2]; o[0] = f32x16{}; o[1] = f32x16{};
#pragma unroll
        for (int tb = 0; tb < 2; ++tb)
#pragma unroll
            for (int ks = 0; ks < 8; ++ks) { const bf16x8 qa = *(const LAS bf16x8*)(QE + (32 * tb + l31) * QES + 16 * ks + 8 * hi); o[tb] = MFMA32(qa, sfr[ks], o[tb]); }
        if (w < 3) {
            const int tb = (w > 0) ? 1 : 0, sb = (w == 2) ? 1 : 0;
            f32x16 am = f32x16{};
#pragma unroll
            for (int ks = 0; ks < 8; ++ks) { const bf16x8 qa = *(const LAS bf16x8*)(QE + (32 * tb + l31) * QES + 16 * ks + 8 * hi), kb = *(const LAS bf16x8*)(KE + (32 * sb + l31) * QES + 16 * ks + 8 * hi);
                am = MFMA32(qa, kb, am); }
#pragma unroll
            for (int r = 0; r < 16; ++r) { const int tl = crow(r, hi); float v = am[r]; if (tb == sb && l31 > tl) v = 0.f; AL[(32 * tb + tl) * VTS + 32 * sb + l31] = (bf16_t)f2bf(v); }
        }
        __syncthreads();
#pragma unroll
        for (int tb = 0; tb < 2; ++tb)
#pragma unroll
            for (int ks = 0; ks < 4; ++ks) { if (tb == 0 && ks >= 2) continue;
                const bf16x8 aa = *(const LAS bf16x8*)(AL + (32 * tb + l31) * VTS + 16 * ks + 8 * hi), vb = *(const LAS bf16x8*)(VT + (32 * w + l31) * VTS + 16 * ks + 8 * hi);
                o[tb] = MFMA32(aa, vb, o[tb]); }
        __syncthreads();
        LAS float* OL = (LAS float*)(lds + OL_OFF);
#pragma unroll
        for (int tb = 0; tb < 2; ++tb)
#pragma unroll
            for (int r = 0; r < 16; ++r) OL[(32 * tb + crow(r, hi)) * OLS + 32 * w + l31] = o[tb][r];
        __syncthreads();
        const f32x4 ng = *(const f32x4*)(a.in[I_GNORM] + h * 256 + 4 * lane);
        bf16_t* OG = (bf16_t*)(a.ws + WS_OG);
#pragma unroll
        for (int i = 0; i < 8; ++i) { const int t = 8 * w + i; const f32x4 v = *(const LAS f32x4*)(OL + t * OLS + 4 * lane);
            const float rs = rsqrtf(wave_sum(dot4(v)) * (1.f / 256.f) + EPS);
            const u32x2 rr = rraw[i];
            float rv[4] = {bf2f(rr.x & 0xffffu), bf2f(rr.x >> 16), bf2f(rr.y & 0xffffu), bf2f(rr.y >> 16)}; float y[4];
#pragma unroll
            for (int j = 0; j < 4; ++j) y[j] = v[j] * rs * ng[j] * rv[j] * __builtin_amdgcn_rcpf(1.f + __expf(-rv[j]));
            u32x2 ov; ov.x = pk(y[0], y[1]); ov.y = pk(y[2], y[3]);
            *(u32x2*)(OG + (size_t)(row0 + t) * DM + h * 256 + 4 * lane) = ov; }
    }
    __syncthreads();
}

__device__ __forceinline__ void gla_scan(const Args& a, int vcu, int G) {
    const int gt = vcu * 512 + threadIdx.x, NT_ = G * 512;
    const float* DST = (const float*)(a.ws + WS_DST); const float* DEC = (const float*)(a.ws + WS_DEC); bf16_t* SP = (bf16_t*)(a.ws + WS_SPREV);
    for (int it = gt; it < 32 * 8192; it += NT_) {
        const int bh = it >> 13, e4 = it & 8191, dv = e4 >> 5, dk4 = (e4 & 31) * 4, b = bh >> 2, h = bh & 3;
        f32x4 S = (f32x4){0.f, 0.f, 0.f, 0.f};
#pragma unroll 8
        for (int c = 0; c < 32; ++c) {
            const size_t ch = (size_t)((b * 32 + c) * 4 + h); const size_t base = (ch * 256 + dv) * 128 + dk4;
            const f32x4 ds = *(const f32x4*)(DST + base), de = *(const f32x4*)(DEC + ch * 128 + dk4);
            u32x2 o; o.x = pk(S[0], S[1]); o.y = pk(S[2], S[3]); *(u32x2*)(SP + base) = o;
            S = S * de + ds;
        }
        float* og = a.out + O_GSP + ((size_t)bh * 128 + dk4) * 256 + dv;
#pragma unroll
        for (int i = 0; i < 4; ++i) og[(size_t)i * 256] = S[i];
    }
}

template <int L, int C> __device__ __forceinline__ void cumsum_item(const float* src0, const float* src1, float* dst, LAS float* SEG, int hh, int seg) {
    float s = 0.f;
#pragma unroll 1
    for (int c0 = 0; c0 < L; c0 += C) { float v[C];
#pragma unroll
        for (int i = 0; i < C; ++i) { const int t = seg * L + c0 + i; v[i] = (t < 2048) ? src0[(unsigned)(t * 16 + hh)] : src1[(unsigned)((t - 2048) * 16 + hh)]; }
#pragma unroll
        for (int i = 0; i < C; ++i) s += v[i]; }
    SEG[seg * 16 + hh] = s;
    __syncthreads();
    float run = 0.f;
    for (int g = 0; g < seg; ++g) run += SEG[g * 16 + hh];
#pragma unroll 1
    for (int c0 = 0; c0 < L; c0 += C) { float v[C];
#pragma unroll
        for (int i = 0; i < C; ++i) { const int t = seg * L + c0 + i; v[i] = (t < 2048) ? src0[(unsigned)(t * 16 + hh)] : src1[(unsigned)((t - 2048) * 16 + hh)]; }
#pragma unroll
        for (int i = 0; i < C; ++i) { run += v[i]; dst[seg * L + c0 + i] = run; } }
    __syncthreads();
}
__device__ __forceinline__ void fox_cumsum(const Args& a, LAS unsigned char* lds, int vcu, int G) {
    const int tid = threadIdx.x, hh = tid & 15, seg = tid >> 4;
    LAS float* SEG = (LAS float*)lds;
    for (int it = vcu; it < 40; it += G) {
        const bool prompt = it < 8; const int b = prompt ? it : it - 8;
        const float* src0 = prompt ? a.out + O_FLP + (size_t)b * 2048 * 16 : a.in[I_CLF] + (size_t)b * 2048 * 16;
        const float* src1 = a.out + O_FLS + (size_t)b * 64 * 16;
        if (prompt) cumsum_item<64, 32>(src0, src1, (float*)(a.ws + WS_CP) + (size_t)(b * 16 + hh) * 2048, SEG, hh, seg);
        else cumsum_item<66, 22>(src0, src1, (float*)(a.ws + WS_CS) + (size_t)(b * 16 + hh) * 2112, SEG, hh, seg);
    }
}

constexpr int AT_KS = 72, AT_VS = 68, AT_BUF = 18432, AT_VOFF = 9216, AT_COFF = 17920;
struct TileRegs { u32x4 k0, k1, v0, v1; float ck; };

template <bool SAMPLE> __device__ __forceinline__ void attn_load(TileRegs& R, const Args& a, int b, int h, int t, const float* cbase, int tid) {
    const int kvl = tid >> 3, ch = tid & 7, kp = tid >> 4, c4 = tid & 15;
    if (SAMPLE && t < 32) {
        const float* kptr = a.in[I_CK] + (((size_t)b * 2048 + 64 * t + kvl) * 16 + h) * 64 + 8 * ch;
        R.k0 = *(const u32x4*)kptr; R.k1 = *(const u32x4*)(kptr + 4);
        const float* vptr = a.in[I_CV] + (((size_t)b * 2048 + 64 * t + 2 * kp) * 16 + h) * 64 + 4 * c4;
        R.v0 = *(const u32x4*)vptr; R.v1 = *(const u32x4*)(vptr + 1024);
    } else {
        const size_t rowbase = SAMPLE ? (size_t)(MP + b * 64) : (size_t)(b * 2048 + 64 * t);
        const bf16_t* qkv = (const bf16_t*)(a.ws + WS_PROJ);
        R.k0 = *(const u32x4*)(qkv + (rowbase + kvl) * NPJ + 1024 + h * 64 + 8 * ch);
        const bf16_t* vptr = qkv + (rowbase + 2 * kp) * NPJ + 2048 + h * 64 + 4 * c4;
        const u32x2 x0 = *(const u32x2*)vptr, x1 = *(const u32x2*)(vptr + NPJ);
        R.v0.x = x0.x; R.v0.y = x0.y; R.v1.x = x1.x; R.v1.y = x1.y;
    }
    if (tid < 64) R.ck = cbase[64 * t + tid] * LOG2E;
}
__device__ __forceinline__ void attn_store(const TileRegs& R, LAS unsigned char* buf, bool f32src, int tid) {
    const int kvl = tid >> 3, ch = tid & 7, kp = tid >> 4, c4 = tid & 15;
    LAS unsigned* VT32 = (LAS unsigned*)(buf + AT_VOFF);
    if (f32src) {
        u32x4 o; o.x = pk(__uint_as_float(R.k0.x), __uint_as_float(R.k0.y)); o.y = pk(__uint_as_float(R.k0.z), __uint_as_float(R.k0.w));
        o.z = pk(__uint_as_float(R.k1.x), __uint_as_float(R.k1.y)); o.w = pk(__uint_as_float(R.k1.z), __uint_as_float(R.k1.w));
        *(LAS u32x4*)(buf + (kvl * AT_KS + 8 * ch) * 2) = o;
#pragma unroll
        for (int i = 0; i < 4; ++i) VT32[(4 * c4 + i) * (AT_VS / 2) + kp] = pk(__uint_as_float(R.v0[i]), __uint_as_float(R.v1[i]));
    } else {
        *(LAS u32x4*)(buf + (kvl * AT_KS + 8 * ch) * 2) = R.k0;
        VT32[(4 * c4 + 0) * (AT_VS / 2) + kp] = (R.v0.x & 0xffffu) | (R.v1.x << 16);
        VT32[(4 * c4 + 1) * (AT_VS / 2) + kp] = (R.v0.x >> 16) | (R.v1.x & 0xffff0000u);
        VT32[(4 * c4 + 2) * (AT_VS / 2) + kp] = (R.v0.y & 0xffffu) | (R.v1.y << 16);
        VT32[(4 * c4 + 3) * (AT_VS / 2) + kp] = (R.v0.y >> 16) | (R.v1.y & 0xffff0000u);
    }
    if (tid < 64) { const float c = -R.ck; const unsigned h1 = f2bf(c); const float r1 = c - bf2f(h1); const unsigned h2 = f2bf(r1); const unsigned h3 = f2bf(r1 - bf2f(h2));
        u32x2 o; o.x = h1 | (h2 << 16); o.y = h3; ((LAS u32x2*)(buf + AT_COFF))[tid] = o; }
}

template <bool QLDS> __device__ __forceinline__ void attn_tile(const LAS unsigned char* buf, const bf16x8 (&qf)[4], const LAS bf16x8* qlds, float cq2, int qpos, int kv0, bool diag, float& mrun, float& lrun, f32x16 (&ot)[2], int l31, int hi) {
    const LAS bf16_t* Ks = (const LAS bf16_t*)buf; const LAS bf16_t* VTs = (const LAS bf16_t*)(buf + AT_VOFF); const LAS u32x2* CKs = (const LAS u32x2*)(buf + AT_COFF);
    f32x16 p0, p1;
#pragma unroll
    for (int r = 0; r < 16; ++r) { p0[r] = cq2; p1[r] = cq2; }
    {
        const u32x2 b0 = CKs[l31], b1 = CKs[32 + l31];
        const unsigned msk = hi ? 0u : 0xffffffffu;
        u32x4 x0; x0.x = b0.x & msk; x0.y = b0.y & msk; x0.z = 0u; x0.w = 0u;
        u32x4 x1; x1.x = b1.x & msk; x1.y = b1.y & msk; x1.z = 0u; x1.w = 0u;
        u32x4 qx; qx.x = 0x3F803F80u & msk; qx.y = 0x00003F80u & msk; qx.z = 0u; qx.w = 0u;
        p0 = MFMA32(__builtin_bit_cast(bf16x8, x0), __builtin_bit_cast(bf16x8, qx), p0); p1 = MFMA32(__builtin_bit_cast(bf16x8, x1), __builtin_bit_cast(bf16x8, qx), p1);
    }
#pragma unroll
    for (int ks = 0; ks < 4; ++ks) { const bf16x8 k0 = *(const LAS bf16x8*)(Ks + l31 * AT_KS + 16 * ks + 8 * hi), k1 = *(const LAS bf16x8*)(Ks + (32 + l31) * AT_KS + 16 * ks + 8 * hi);
        const bf16x8 qq = QLDS ? qlds[ks * 64] : qf[ks];
        p0 = MFMA32(k0, qq, p0); p1 = MFMA32(k1, qq, p1); }
    __builtin_amdgcn_sched_barrier(0);
    if (diag) {
        int qp = qpos - kv0; asm volatile("" : "+v"(qp));
#pragma unroll
        for (int r = 0; r < 16; ++r) { const int kv = crow(r, hi); if (kv > qp) p0[r] = -INFINITY; if (kv + 32 > qp) p1[r] = -INFINITY; }
    }
    float rm = fmaxf(p0[0], p1[0]);
#pragma unroll
    for (int r = 1; r < 16; ++r) rm = fmaxf(rm, fmaxf(p0[r], p1[r]));
    rm = fmaxf(rm, __shfl_xor(rm, 32));
    if (__all(rm < mrun - 40.f)) return;
    const float mn = fmaxf(mrun, rm);
    if (__any(mn > mrun)) {
        const float alpha = __builtin_amdgcn_exp2f(mrun - mn);
        lrun *= alpha;
#pragma unroll
        for (int r = 0; r < 16; ++r) { ot[0][r] *= alpha; ot[1][r] *= alpha; }
        mrun = mn;
    }
    float rs = 0.f;
#pragma unroll
    for (int r = 0; r < 16; ++r) { p0[r] = __builtin_amdgcn_exp2f(p0[r] - mrun); p1[r] = __builtin_amdgcn_exp2f(p1[r] - mrun); rs += p0[r] + p1[r]; }
    lrun += rs;
    bf16x8 pf[4];
    { u32x4 x; x.x = pk(p0[0], p0[1]); x.y = pk(p0[2], p0[3]); x.z = pk(p0[4], p0[5]); x.w = pk(p0[6], p0[7]); pf[0] = __builtin_bit_cast(bf16x8, x);
      x.x = pk(p0[8], p0[9]); x.y = pk(p0[10], p0[11]); x.z = pk(p0[12], p0[13]); x.w = pk(p0[14], p0[15]); pf[1] = __builtin_bit_cast(bf16x8, x);
      x.x = pk(p1[0], p1[1]); x.y = pk(p1[2], p1[3]); x.z = pk(p1[4], p1[5]); x.w = pk(p1[6], p1[7]); pf[2] = __builtin_bit_cast(bf16x8, x);
      x.x = pk(p1[8], p1[9]); x.y = pk(p1[10], p1[11]); x.z = pk(p1[12], p1[13]); x.w = pk(p1[14], p1[15]); pf[3] = __builtin_bit_cast(bf16x8, x); }
    __builtin_amdgcn_sched_barrier(0);
#pragma unroll
    for (int db = 0; db < 2; ++db)
#pragma unroll
        for (int ks = 0; ks < 4; ++ks) { const LAS bf16_t* vp = VTs + (32 * db + l31) * AT_VS + 16 * ks + 4 * hi;
            const u32x2 lo = *(const LAS u32x2*)vp, hh2 = *(const LAS u32x2*)(vp + 8);
            u32x4 x; x.x = lo.x; x.y = lo.y; x.z = hh2.x; x.w = hh2.y;
            ot[db] = MFMA32(__builtin_bit_cast(bf16x8, x), pf[ks], ot[db]); }
}

__device__ __forceinline__ void attn_unit_prompt(const Args& a, LAS unsigned char* lds, int b, int h, int qb) {
    int tid_ = threadIdx.x; asm volatile("" : "+v"(tid_));
    const int tid = tid_, lane = tid & 63, w = __builtin_amdgcn_readfirstlane(tid >> 6), l31 = lane & 31, hi = lane >> 5;
    const int NT = 4 * (qb + 1);
    const int qpos = 256 * qb + 32 * w + l31;
    const size_t qrow = (size_t)(b * 2048 + qpos);
    const float* cbase = (const float*)(a.ws + WS_CP) + (size_t)(b * 16 + h) * 2048;
    const bf16_t* qkv = (const bf16_t*)(a.ws + WS_PROJ);
    bf16x8 qf[4];
#pragma unroll
    for (int ks = 0; ks < 4; ++ks) qf[ks] = *(const bf16x8*)(qkv + qrow * NPJ + h * 64 + 16 * ks + 8 * hi);
    const float cq2 = cbase[qpos] * LOG2E;
    const int qmax_w = 256 * qb + 32 * w + 31;
    TileRegs R0, R1, R2;
    attn_load<false>(R0, a, b, h, NT - 1, cbase, tid); attn_load<false>(R1, a, b, h, NT - 2, cbase, tid); attn_load<false>(R2, a, b, h, NT - 3, cbase, tid);
    attn_store(R0, lds, false, tid);
    attn_load<false>(R0, a, b, h, NT - 4, cbase, tid);
    __syncthreads();
    float mrun = -INFINITY, lrun = 0.f;
    f32x16 ot[2]; ot[0] = f32x16{}; ot[1] = f32x16{};
#define PSTEP(tt, RR) do { if ((tt) < NT) { const int ti_ = NT - 1 - (tt); if (64 * ti_ <= qmax_w) attn_tile<false>(lds + ((tt) & 1) * AT_BUF, qf, nullptr, cq2, qpos, 64 * ti_, ti_ >= 4 * qb, mrun, lrun, ot, l31, hi); \
        if ((tt) + 1 < NT) { attn_store(RR, lds + (((tt) + 1) & 1) * AT_BUF, false, tid); if ((tt) + 4 < NT) attn_load<false>(RR, a, b, h, NT - 5 - (tt), cbase, tid); } \
        __syncthreads(); } } while (0)
#pragma unroll 1
    for (int t = 0; t < NT; t += 3) { PSTEP(t, R1); PSTEP(t + 1, R2); PSTEP(t + 2, R0); }
#undef PSTEP
    lrun += __shfl_xor(lrun, 32);
    const float inv = 1.f / lrun;
    bf16_t* og = (bf16_t*)(a.ws + WS_OG) + qrow * DM + h * 64;
#pragma unroll
    for (int db = 0; db < 2; ++db)
#pragma unroll
        for (int j = 0; j < 4; ++j) { u32x2 o; o.x = pk(ot[db][4 * j] * inv, ot[db][4 * j + 1] * inv); o.y = pk(ot[db][4 * j + 2] * inv, ot[db][4 * j + 3] * inv);
            *(u32x2*)(og + 32 * db + 8 * j + 4 * hi) = o; }
}

__device__ __forceinline__ void attn_unit_sample(const Args& a, LAS unsigned char* lds, int b, int h) {
    int tid_ = threadIdx.x; asm volatile("" : "+v"(tid_));
    const int tid = tid_, lane = tid & 63, w = __builtin_amdgcn_readfirstlane(tid >> 6), l31 = lane & 31, hi = lane >> 5;
    const bool active = w < 2;
    const int qpos = 2048 + 32 * (w & 1) + l31;
    const size_t qrow = (size_t)(MP + b * 64 + 32 * (w & 1) + l31);
    const float* cbase = (const float*)(a.ws + WS_CS) + (size_t)(b * 16 + h) * 2112;
    const bf16_t* qkv = (const bf16_t*)(a.ws + WS_PROJ);
    bf16x8 qf[4];
#pragma unroll
    for (int ks = 0; ks < 4; ++ks) qf[ks] = *(const bf16x8*)(qkv + qrow * NPJ + h * 64 + 16 * ks + 8 * hi);
    const float cq2 = cbase[qpos] * LOG2E;
    TileRegs R0, R1, R2;
    attn_load<true>(R0, a, b, h, 32, cbase, tid); attn_load<true>(R1, a, b, h, 31, cbase, tid); attn_load<true>(R2, a, b, h, 30, cbase, tid);
    attn_store(R0, lds, false, tid);
    attn_load<true>(R0, a, b, h, 29, cbase, tid);
    __syncthreads();
    float mrun = -INFINITY, lrun = 0.f;
    f32x16 ot[2]; ot[0] = f32x16{}; ot[1] = f32x16{};
#define SSTEP(tt, RR) do { if (active) attn_tile<false>(lds + ((tt) & 1) * AT_BUF, qf, nullptr, cq2, qpos, 64 * (32 - (tt)), (tt) == 0, mrun, lrun, ot, l31, hi); \
        if ((tt) + 1 < 33) { attn_store(RR, lds + (((tt) + 1) & 1) * AT_BUF, true, tid); if ((tt) + 4 < 33) attn_load<true>(RR, a, b, h, 28 - (tt), cbase, tid); } \
        __syncthreads(); } while (0)
#pragma unroll 1
    for (int t = 0; t < 33; t += 3) { SSTEP(t, R1); SSTEP(t + 1, R2); SSTEP(t + 2, R0); }
#undef SSTEP
    if (active) {
        lrun += __shfl_xor(lrun, 32);
        const float inv = 1.f / lrun;
        bf16_t* og = (bf16_t*)(a.ws + WS_OG) + qrow * DM + h * 64;
#pragma unroll
        for (int db = 0; db < 2; ++db)
#pragma unroll
            for (int j = 0; j < 4; ++j) { u32x2 o; o.x = pk(ot[db][4 * j] * inv, ot[db][4 * j + 1] * inv); o.y = pk(ot[db][4 * j + 2] * inv, ot[db][4 * j + 3] * inv);
                *(u32x2*)(og + 32 * db + 8 * j + 4 * hi) = o; }
    }
}

__device__ __forceinline__ void fox_attention(const Args& a, LAS unsigned char* lds, int vcu, int G) {
#pragma unroll 1
    for (int pass = 0; pass < 2; ++pass) {
        if ((pass ^ (vcu & 1)) == 0) {
#ifdef ATT_DUP_PROMPT
          for (int rep2_ = 0; rep2_ < 2; ++rep2_)
#endif
            if (G == 256) {
                const int bh = vcu >> 1, s0 = 2 * (vcu & 1);
#pragma unroll 1
                for (int i = 0; i < 4; ++i) attn_unit_prompt(a, lds, bh >> 4, bh & 15, (i & 1) ? s0 + (i >> 1) : 7 - s0 - (i >> 1));
            } else {
#pragma unroll 1
                for (int u = vcu; u < 1024; u += G) attn_unit_prompt(a, lds, (u & 127) >> 4, u & 15, 7 - (u >> 7));
            }
        } else {
#pragma unroll 1
            for (int u = vcu; u < 512; u += G) attn_unit_sample(a, lds, u >> 4, u & 15);
        }
    }
}

#ifndef PH_MASK
#define PH_MASK 0x7fff
#endif
#define IN(k) (((PH_MASK >> (k)) & 1) && a.ph_lo <= (k) && (k) < a.ph_hi)
#define SEAM(k) do { if (IN(k) && IN((k) + 1)) { if ((k) == 0) cg::this_grid().sync(); else xcd_barrier(xbar); } } while (0)
#ifndef DUP_MASK
#define DUP_MASK 0
#endif
#define REP(k) _Pragma("unroll 1") for (int rep_ = 0; rep_ < ((((DUP_MASK) >> (k)) & 1) ? 2 : 1); ++rep_)
#define REPSYNC(k) do { if ((((DUP_MASK) >> (k)) & 1)) xcd_barrier(xbar); } while (0)
template <int L> __device__ __forceinline__ void common_gemms(const Args& a, LAS unsigned char* lds, int G, int bx, const XcdBarrier& xbar) {
    unsigned char* ws = a.ws;
    float* SS = (float*)(ws + WS_SS);
    bf16_t* XB = (bf16_t*)(ws + WS_XB); float* XR = (float*)(ws + WS_XR); bf16_t* OG = (bf16_t*)(ws + WS_OG); bf16_t* ACT = (bf16_t*)(ws + WS_ACT);
    constexpr int po = L ? 11 : 5;
    if (IN(po)) { pg8::Gemm g{OG, (const bf16_t*)(ws + (L ? WS_WFOUT : WS_WGOUT)), MT, DM, DM}; pg8::StaticOrder S; S.init(MT, DM, G, bx);
        EpiResid E{L ? XR : a.in[I_XP], L ? XR + (size_t)MP * DM : a.in[I_XS], XR, XB, SS + (L ? 3 : 1) * 32768};
        pg8::gemm_phase<EpiResid, pg8::StaticOrder, true, true>(lds, g, S, E); }
    SEAM(po);
    if (IN(po + 1)) REP(po + 1) { pg8::Gemm g{XB, (const bf16_t*)(ws + WS_WFFI + (size_t)L * 11 * MiB), MT, 2 * DFF, DM}; pg8::StaticOrder S; S.init(MT, 2 * DFF, G, bx);
        EpiSwiglu E{SS + (L ? 3 : 1) * 32768, ACT}; pg8::gemm_phase<EpiSwiglu, pg8::StaticOrder, true, true>(lds, g, S, E); REPSYNC(po + 1); }
    SEAM(po + 1);
    if (IN(po + 2)) { pg8::Gemm g{ACT, (const bf16_t*)(ws + WS_WFFD + (size_t)L * 6 * MiB), MT, DM, DFF}; pg8::StaticOrder S; S.init(MT, DM, G, bx);
        EpiResid E{XR, XR + (size_t)MP * DM, XR, XB, SS + (L ? 4 : 2) * 32768};
        pg8::gemm_phase<EpiResid, pg8::StaticOrder, true, true>(lds, g, S, E); }
    SEAM(po + 2);
}
constexpr int NPH = 15;
__global__ void __launch_bounds__(512, 2) fwd(Args a) {
    extern __shared__ __attribute__((aligned(16))) unsigned char lds_raw[];
    LAS unsigned char* lds = (LAS unsigned char*)lds_raw;
    const int G = gridDim.x, bx = blockIdx.x;
    const int vcu = (G % 8 == 0) ? (bx % 8) * (G / 8) + bx / 8 : bx;
    unsigned char* ws = a.ws;
    float* SS = (float*)(ws + WS_SS);
    bf16_t* XB = (bf16_t*)(ws + WS_XB); bf16_t* PROJ = (bf16_t*)(ws + WS_PROJ);

    volatile LAS unsigned* MISC = (volatile LAS unsigned*)(lds + 131072);
    if (threadIdx.x < 64) MISC[threadIdx.x] = 0u;
    __syncthreads();
    XcdBarrier xbar; xbar.bar = (unsigned*)ws; xbar.x = 0; xbar.st = nullptr;
    if (a.ph_hi - a.ph_lo > 1) xbar = xcd_barrier_post((unsigned*)ws, MISC + 8);
    if (IN(0)) REP(0) { p0_prologue(a, lds, vcu, G); REPSYNC(0); }
    SEAM(0);
    if (IN(1)) { pg8::Gemm g{XB, (const bf16_t*)(ws + WS_WGIN), MT, NPROJ, DM}; pg8::StaticOrder S; S.init(MT, NPROJ, G, bx);
        EpiGlaProj E{SS, PROJ, (float*)(ws + WS_GL)}; pg8::gemm_phase<EpiGlaProj, pg8::StaticOrder, true, true>(lds, g, S, E); }
    SEAM(1);
    if (IN(2)) REP(2) {
#pragma unroll 1
        for (int it = vcu; it < 1152; it += G) gla_item<0>(a, lds, it >> 2, it & 3);
        REPSYNC(2); }
    SEAM(2);
    if (IN(3)) REP(3) { gla_scan(a, vcu, G); REPSYNC(3); }
    SEAM(3);
    if (IN(4)) REP(4) {
#pragma unroll 1
        for (int it = vcu; it < 1152; it += G) gla_item<1>(a, lds, it >> 2, it & 3);
        REPSYNC(4); }
    SEAM(4);
    common_gemms<0>(a, lds, G, bx, xbar);
    if (IN(8)) { pg8::Gemm g{XB, (const bf16_t*)(ws + WS_WFIN), MT, NPROJ, DM}; pg8::StaticOrder S; S.init(MT, NPROJ, G, bx);
        EpiFoxProj E{SS + 2 * 32768, PROJ, a.out, a.in[I_FBF]}; pg8::gemm_phase<EpiFoxProj, pg8::StaticOrder, true, true>(lds, g, S, E); }
    SEAM(8);
    if (IN(9)) REP(9) { fox_cumsum(a, lds, vcu, G); REPSYNC(9); }
    SEAM(9);
    if (IN(10)) REP(10) { fox_attention(a, lds, vcu, G); REPSYNC(10); }
    SEAM(10);
    common_gemms<1>(a, lds, G, bx, xbar);
#ifdef EXTRA_SYNCS
    for (int i_ = 0; i_ < EXTRA_SYNCS; ++i_) xcd_barrier(xbar);
#endif
    if (IN(14)) p_final(a, vcu, G);
#undef IN
#undef SEAM
}

extern "C" void kernel_launch(void* const* d_in, const int* in_sizes, int n_in, void* d_out, int out_size, void* d_ws, size_t ws_size, hipStream_t stream) {
    static int grid = 0;
    if (grid == 0) {
        if (n_in != 19 || ws_size < WS_END || out_size != 62160896) { fprintf(stderr, "kernel_launch: unexpected problem shape (n_in %d, out %d, ws %zu)\n", n_in, out_size, ws_size); grid = -1; return; }
        if (hipFuncSetAttribute((const void*)fwd, hipFuncAttributeMaxDynamicSharedMemorySize, LDS_BYTES) != hipSuccess) { fprintf(stderr, "kernel_launch: hipFuncSetAttribute failed\n"); grid = -1; return; }
        int dev = 0, cus = 0, per_cu = 0;
        (void)hipGetDevice(&dev); (void)hipDeviceGetAttribute(&cus, hipDeviceAttributeMultiprocessorCount, dev);
        (void)hipOccupancyMaxActiveBlocksPerMultiprocessor(&per_cu, (const void*)fwd, 512, LDS_BYTES);
        (void)hipGetLastError();
        if (per_cu < 1) per_cu = 1;
        grid = cus * 1;
        if (grid <= 0) grid = 256;
    }
    if (grid < 0) return;
    (void)hipMemsetAsync((char*)d_ws + WS_CTL, 0, CTL_BYTES, stream);
    Args a{};
    for (int i = 0; i < 19; ++i) a.in[i] = (const float*)d_in[i];
    a.out = (float*)d_out; a.ws = (unsigned char*)d_ws;
#if MK_MULTI
    for (int ph = 0; ph < NPH; ++ph) { a.ph_lo = ph; a.ph_hi = ph + 1; hipLaunchKernelGGL(fwd, dim3(grid), dim3(512), LDS_BYTES, stream, a); }
#else
    a.ph_lo = 0; a.ph_hi = NPH;
    void* args[] = {&a};
    hipError_t e = hipLaunchCooperativeKernel((const void*)fwd, dim3(grid), dim3(512), args, LDS_BYTES, stream);
    if (e != hipSuccess) fprintf(stderr, "kernel_launch: cooperative launch failed: %s (grid %d)\n", hipGetErrorString(e), grid);
#endif
}
```

```cpp
#include <hip/hip_runtime.h>
#include <hip/hip_cooperative_groups.h>
#include <cstdio>
#include <cstdint>
#include <cmath>
namespace cg = cooperative_groups;
#define MK_MULTI 0
namespace pg8 {
#define PG8_LAS __attribute__((address_space(3)))
typedef unsigned short bf16_t;
typedef short bf16x8 __attribute__((ext_vector_type(8)));
typedef float f32x4 __attribute__((ext_vector_type(4)));
typedef unsigned u32x4 __attribute__((ext_vector_type(4)));
constexpr int BM = 256, BK = 64, HALF = 128, HTB = HALF * BK * 2  , STAGE_BYTES = 8 * HTB, NXCD = 8, WGM = 8;

__host__ __device__ __forceinline__ int lds_byte(int r, int c) { const int st = (r >> 4) * 2 + (c >> 5), rr = r & 15, cc = c & 31, ob = rr * 64 + cc * 2; return st * 1024 + (ob ^ (((ob >> 9) & 1) << 5)); }
__host__ __device__ __forceinline__ void stage_rc(int b, int& R, int& C) { const int st = b / 1024, sb = b % 1024, swz = sb ^ (((sb >> 9) & 1) << 5); R = (st >> 1) * 16 + swz / 64; C = (st & 1) * 32 + (swz % 64) / 2; }
__host__ __device__ __forceinline__ int perm32(int rho) { const int n = rho >> 4, i = rho & 15; return 8 * (i >> 2) + 4 * n + (i & 3); }

struct Unit { int pm, pn; };
struct Gemm { const bf16_t* A; const bf16_t* Bt; int M, N, K; };

struct StaticOrder {
    int nM, nN, nwg, G, c;
    __host__ __device__ void init(int M, int N, int G_, int c_) { nM = M / BM; nN = N / BM; nwg = nM * nN; G = G_; c = c_; }
    __host__ __device__ bool next(int i, Unit& u) const {
        const long L = (long)i * G + c; if (L >= nwg) return false;
        int wgid = (int)L; { const int q = nwg / NXCD, r = nwg % NXCD, xcd = wgid % NXCD, off = wgid / NXCD; wgid = (xcd < r ? xcd * (q + 1) : r * (q + 1) + (xcd - r) * q) + off; }
        const int nig = WGM * nN, gid = wgid / nig, fm = gid * WGM, gsz = (nM - fm) < WGM ? (nM - fm) : WGM;
        u.pm = fm + ((wgid % nig) % gsz); u.pn = (wgid % nig) / gsz; return true;
    }
    __device__ __forceinline__ void a_ready(const Unit&) const {}
    __device__ __forceinline__ void done(const Unit&) const {}
};

__device__ __forceinline__ unsigned cvt_pk_bf16(float lo, float hi) { unsigned r; asm volatile("v_cvt_pk_bf16_f32 %0, %1, %2" : "=v"(r) : "v"(lo), "v"(hi)); return r; }
template <class Epi, class Sched, bool ALIGN_EPI = false, bool SP2 = false>
__device__ __forceinline__ void gemm_phase(PG8_LAS unsigned char* lds, const Gemm g, const Sched& S, const Epi& E) {
    const int tid = threadIdx.x, wid = __builtin_amdgcn_readfirstlane(tid >> 6), lane = tid & 63, wr = wid >> 2, wc = wid & 3, fr = lane & 15, fq = lane >> 4;
    const int K = g.K, nt = K / BK;
    unsigned voffA[2], voffB[2];
#pragma unroll
    for (int i = 0; i < 2; ++i) { int R, C; stage_rc(tid * 16 + i * 8192, R, C); const int Rb = Epi::PERM ? ((R & ~31) + perm32(R & 31)) : R;
        voffA[i] = (unsigned)(R * K + C) * 2u; voffB[i] = (unsigned)(Rb * K + C) * 2u; }
    const size_t kstep = (size_t)(BK * 2);
    const size_t hstep = (size_t)HALF * K * 2;
    const size_t tstep = 2 * hstep;
    const unsigned ldsw = (unsigned)wid * 1024u;
    const int aoff = lds_byte(wr * 64 + fr, fq * 8), boff = lds_byte(wc * 32 + fr, fq * 8);
#define PG8_SA(b, h) (((b) * 2 + (h)) * HTB)
#define PG8_SB(b, h) ((4 + (b) * 2 + (h)) * HTB)
#define PG8_STAGE(bufoff, gbase, voff) do { _Pragma("unroll") for (int _i = 0; _i < 2; ++_i) \
        __builtin_amdgcn_global_load_lds((const unsigned*)((const char*)(gbase) + (voff)[_i]), (PG8_LAS unsigned*)(lds + (bufoff) + ldsw + _i * 8192), 16, 0, 0); } while (0)
#define PG8_LDA(dst, b, h) do { _Pragma("unroll") for (int m = 0; m < 4; ++m) _Pragma("unroll") for (int k = 0; k < 2; ++k) dst[m][k] = *(const PG8_LAS bf16x8*)(lds + PG8_SA(b, h) + aoff + m * 2048 + k * 1024); } while (0)
#define PG8_LDB(dst, b, h) do { _Pragma("unroll") for (int n = 0; n < 2; ++n) _Pragma("unroll") for (int k = 0; k < 2; ++k) dst[n][k] = *(const PG8_LAS bf16x8*)(lds + PG8_SB(b, h) + boff + n * 2048 + k * 1024); } while (0)
#define PG8_MMA(ai, bj, At, Bt) do { __builtin_amdgcn_s_setprio(1); _Pragma("unroll") for (int m = 0; m < 4; ++m) _Pragma("unroll") for (int n = 0; n < 2; ++n) _Pragma("unroll") for (int k = 0; k < 2; ++k) \
        acc[ai][bj][m][n] = __builtin_amdgcn_mfma_f32_16x16x32_bf16(Bt[n][k], At[m][k], acc[ai][bj][m][n], 0, 0, 0); __builtin_amdgcn_s_setprio(0); } while (0)
#define PG8_WAIT_V(n) asm volatile("s_waitcnt vmcnt(" #n ")" ::: "memory")
#define PG8_WAIT_L(n) asm volatile("s_waitcnt lgkmcnt(" #n ")" ::: "memory")
#define PG8_BAR __builtin_amdgcn_s_barrier()
#define PG8_SCHED __builtin_amdgcn_sched_barrier(0)
    Unit cur, nxt; int ui = 0;
    if (!S.next(0, cur)) return;
    f32x4 acc[2][2][4][2];
#pragma unroll
    for (int a = 0; a < 2; ++a)
#pragma unroll
        for (int b = 0; b < 2; ++b)
#pragma unroll
            for (int m = 0; m < 4; ++m)
#pragma unroll
                for (int n = 0; n < 2; ++n) acc[a][b][m][n] = (f32x4){0.f, 0.f, 0.f, 0.f};
    bf16x8 At[4][2], B0[2][2], B1[2][2];
    const char* cA = (const char*)g.A + (size_t)cur.pm * tstep; const char* cB = (const char*)g.Bt + (size_t)cur.pn * tstep;
    S.a_ready(cur);
    if constexpr (SP2) {
        PG8_STAGE(PG8_SB(0, 0), cB, voffB); PG8_STAGE(PG8_SB(0, 1), cB + hstep, voffB); PG8_STAGE(PG8_SA(0, 0), cA, voffA); PG8_STAGE(PG8_SA(0, 1), cA + hstep, voffA);
        if (wr == 1) PG8_BAR;
        PG8_WAIT_V(2); PG8_BAR;
        PG8_STAGE(PG8_SB(1, 0), cB + kstep, voffB); PG8_STAGE(PG8_SA(1, 0), cA + kstep, voffA); PG8_STAGE(PG8_SB(1, 1), cB + hstep + kstep, voffB);
        PG8_WAIT_V(6); PG8_BAR;
    } else {
        PG8_STAGE(PG8_SB(0, 0), cB, voffB); PG8_STAGE(PG8_SA(0, 0), cA, voffA); PG8_STAGE(PG8_SB(0, 1), cB + hstep, voffB); PG8_STAGE(PG8_SA(0, 1), cA + hstep, voffA);
        if (wr == 1) PG8_BAR;
        PG8_WAIT_V(4); PG8_BAR;
        PG8_STAGE(PG8_SB(1, 0), cB + kstep, voffB); PG8_STAGE(PG8_SA(1, 0), cA + kstep, voffA); PG8_STAGE(PG8_SB(1, 1), cB + hstep + kstep, voffB);
        PG8_WAIT_V(6); PG8_BAR;
    }
    for (;;) {
        const bool has_next = S.next(ui + 1, nxt);
        const char* nA = has_next ? (const char*)g.A + (size_t)nxt.pm * tstep : cA; const char* nB = has_next ? (const char*)g.Bt + (size_t)nxt.pn * tstep : cB;
        for (int t = 0; t < nt; t += 2) {
            const bool last = (t == nt - 2);
            const char* a1 = cA + (size_t)(t + 1) * kstep;
            const char* a2 = last ? nA : cA + (size_t)(t + 2) * kstep; const char* b2 = last ? nB : cB + (size_t)(t + 2) * kstep;
            const char* a3 = a2 + kstep; const char* b3 = b2 + kstep;
            if (last && has_next) S.a_ready(nxt);
            if constexpr (SP2) {
            PG8_LDB(B0, 0, 0); PG8_LDB(B1, 0, 1); PG8_SCHED; PG8_LDA(At, 0, 0); PG8_STAGE(PG8_SA(1, 1), a1 + hstep, voffA);
            PG8_WAIT_V(8); PG8_WAIT_L(0); PG8_BAR; PG8_MMA(0, 0, At, B0); PG8_MMA(0, 1, At, B1); PG8_BAR; PG8_SCHED;
            PG8_LDA(At, 0, 1); PG8_STAGE(PG8_SB(0, 0), b2, voffB); PG8_STAGE(PG8_SB(0, 1), b2 + hstep, voffB); PG8_STAGE(PG8_SA(0, 0), a2, voffA);
            PG8_WAIT_V(8); PG8_WAIT_L(0); PG8_BAR; PG8_MMA(1, 0, At, B0); PG8_MMA(1, 1, At, B1); PG8_BAR; PG8_SCHED;
            PG8_LDB(B0, 1, 0); PG8_LDB(B1, 1, 1); PG8_SCHED; PG8_LDA(At, 1, 0); PG8_STAGE(PG8_SA(0, 1), a2 + hstep, voffA);
            PG8_WAIT_V(8); PG8_WAIT_L(0); PG8_BAR; PG8_MMA(0, 0, At, B0); PG8_MMA(0, 1, At, B1); PG8_BAR; PG8_SCHED;
            PG8_LDA(At, 1, 1); PG8_STAGE(PG8_SB(1, 0), b3, voffB); PG8_STAGE(PG8_SB(1, 1), b3 + hstep, voffB); PG8_STAGE(PG8_SA(1, 0), a3, voffA);
            PG8_WAIT_V(8); PG8_WAIT_L(0); PG8_BAR; PG8_MMA(1, 0, At, B0); PG8_MMA(1, 1, At, B1); PG8_BAR; PG8_SCHED;
            } else {
            PG8_LDB(B0, 0, 0); PG8_SCHED; PG8_LDA(At, 0, 0); PG8_STAGE(PG8_SA(1, 1), a1 + hstep, voffA);
            PG8_WAIT_L(8); PG8_BAR; PG8_WAIT_L(0); PG8_MMA(0, 0, At, B0); PG8_BAR; PG8_SCHED;
            PG8_LDB(B1, 0, 1); PG8_STAGE(PG8_SB(0, 0), b2, voffB);
            PG8_BAR; PG8_WAIT_L(0); PG8_MMA(0, 1, At, B1); PG8_BAR;
            PG8_LDA(At, 0, 1); PG8_STAGE(PG8_SA(0, 0), a2, voffA);
            PG8_BAR; PG8_WAIT_L(0); PG8_MMA(1, 0, At, B0); PG8_BAR; PG8_SCHED;
            PG8_STAGE(PG8_SB(0, 1), b2 + hstep, voffB);
            PG8_WAIT_V(6); PG8_BAR; PG8_MMA(1, 1, At, B1); PG8_BAR;
            PG8_LDB(B0, 1, 0); PG8_SCHED; PG8_LDA(At, 1, 0); PG8_STAGE(PG8_SA(0, 1), a2 + hstep, voffA);
            PG8_WAIT_L(8); PG8_BAR; PG8_WAIT_L(0); PG8_MMA(0, 0, At, B0); PG8_BAR; PG8_SCHED;
            PG8_LDB(B1, 1, 1); PG8_STAGE(PG8_SB(1, 0), b3, voffB);
            PG8_BAR; PG8_WAIT_L(0); PG8_MMA(0, 1, At, B1); PG8_BAR;
            PG8_LDA(At, 1, 1); PG8_STAGE(PG8_SA(1, 0), a3, voffA);
            PG8_BAR; PG8_WAIT_L(0); PG8_MMA(1, 0, At, B0); PG8_BAR; PG8_SCHED;
            PG8_STAGE(PG8_SB(1, 1), b3 + hstep, voffB);
            PG8_WAIT_V(6); PG8_BAR; PG8_MMA(1, 1, At, B1); PG8_BAR;
            }
        }
        if constexpr (ALIGN_EPI) { if (wr == 0) PG8_BAR; }
        if constexpr (!Epi::AFTER_DRAIN) { E(acc, cur, wr, wc, fr, fq); S.done(cur); }
        if (!has_next) break;
#pragma unroll
        for (int a = 0; a < 2; ++a)
#pragma unroll
            for (int b = 0; b < 2; ++b)
#pragma unroll
                for (int m = 0; m < 4; ++m)
#pragma unroll
                    for (int n = 0; n < 2; ++n) acc[a][b][m][n] = (f32x4){0.f, 0.f, 0.f, 0.f};
        cur = nxt; cA = nA; cB = nB; ++ui;
        if constexpr (ALIGN_EPI) { if (wr == 1) PG8_BAR; }
    }
    PG8_WAIT_V(0);
    if constexpr (!ALIGN_EPI) { if (wr == 0) PG8_BAR; }
    PG8_BAR;
    if constexpr (Epi::AFTER_DRAIN) { E.fused(acc, cur, wr, wc, fr, fq, lds, wid, lane); S.done(cur); }
#undef PG8_SA
#undef PG8_SB
#undef PG8_STAGE
#undef PG8_LDA
#undef PG8_LDB
#undef PG8_MMA
#undef PG8_WAIT_V
#undef PG8_WAIT_L
#undef PG8_BAR
#undef PG8_SCHED
}
}

#define LAS __attribute__((address_space(3)))
typedef unsigned short bf16_t;
typedef short bf16x8 __attribute__((ext_vector_type(8)));
typedef float f32x4 __attribute__((ext_vector_type(4)));
typedef float f32x16 __attribute__((ext_vector_type(16)));
typedef unsigned u32x4 __attribute__((ext_vector_type(4)));
typedef unsigned u32x2 __attribute__((ext_vector_type(2)));

#ifndef MK_MULTI
#define MK_MULTI 0
#endif

constexpr int DM = 1024, MP = 16384, MS = 2048, MT = MP + MS;
constexpr int NPROJ = 3328, NPJ = 3072, DFF = 2816;
constexpr float EPS = 1e-6f;
constexpr float LOG2E = 1.4426950408889634f;
constexpr float QSCALE2 = 0.125f * LOG2E;
constexpr size_t O_Y = 0, O_GSP = 18874368, O_FKP = 19922944, O_FVP = 36700160, O_FLP = 53477376, O_GSS = 53739520, O_FKS = 57933824, O_FVS = 60030976, O_FLS = 62128128;
constexpr size_t MiB = 1u << 20;
constexpr size_t WS_CTL = 0, CTL_BYTES = 2 * MiB;
constexpr size_t WS_SS = 65536;
constexpr size_t WS_WGIN = 2 * MiB, WS_WFIN = 9 * MiB, WS_WGOUT = 16 * MiB, WS_WFOUT = 18 * MiB, WS_WFFI = 20 * MiB  , WS_WFFD = 42 * MiB  ;
constexpr size_t WS_XB = 54 * MiB, WS_XR = 90 * MiB, WS_PROJ = 162 * MiB, WS_GL = 270 * MiB, WS_DST = 272 * MiB, WS_DEC = 400 * MiB, WS_SPREV = 401 * MiB;
constexpr size_t WS_OG = 465 * MiB, WS_ACT = 501 * MiB, WS_CP = 600 * MiB, WS_CS = 601 * MiB, WS_END = 606 * MiB;
constexpr int LDS_BYTES = 135168;

struct Args {
    const float* in[19];
    float* out; unsigned char* ws;
    int ph_lo, ph_hi;
};
enum { I_XP = 0, I_XS, I_STATE, I_CK, I_CV, I_CLF, I_NMIX, I_GWIN, I_GWG2, I_GBG, I_GNORM, I_GWOUT, I_FWIN, I_FBF, I_FWOUT, I_NFFN, I_FFIN, I_FFDN, I_NFIN };

__device__ __forceinline__ float bf2f(unsigned u) { return __uint_as_float(u << 16); }
__device__ __forceinline__ unsigned f2bf(float f) { unsigned u = __float_as_uint(f); return (u + 0x7fffu + ((u >> 16) & 1u)) >> 16; }
__device__ __forceinline__ unsigned pk(float lo, float hi) { return pg8::cvt_pk_bf16(lo, hi); }
__device__ __forceinline__ float wave_sum(float v) {
#pragma unroll
    for (int o = 1; o < 64; o <<= 1) v += __shfl_xor(v, o);
    return v;
}
__device__ __forceinline__ float log_sigmoid(float z) { return fminf(z, 0.f) - __logf(1.f + __expf(-fabsf(z))); }
__device__ __forceinline__ int crow(int r, int hi) { return (r & 3) + 8 * (r >> 2) + 4 * hi; }
__device__ __forceinline__ float dot4(f32x4 v) { return (v[0] * v[0] + v[1] * v[1]) + (v[2] * v[2] + v[3] * v[3]); }
#define MFMA32(a, b, c) __builtin_amdgcn_mfma_f32_32x32x16_bf16((a), (b), (c), 0, 0, 0)

#define XB_TMO      128
#define XB_XCNT(j)  (256  + 64 * (j))
#define XB_XSUB(j)  (1280 + 64 * (j))
#define XB_XGEN(j)  (2304 + 64 * (j))
#define XB_TOP      3328
#define XB_TOPGEN   3392
#define XCD_BAR_WORDS 3456
#define XB_SPIN_CAP (1u << 18)

__device__ __forceinline__ unsigned xb_ld(unsigned* p)              { return __hip_atomic_load(p, __ATOMIC_RELAXED, __HIP_MEMORY_SCOPE_AGENT); }
__device__ __forceinline__ unsigned xb_add(unsigned* p, unsigned v) { return __hip_atomic_fetch_add(p, v, __ATOMIC_RELAXED, __HIP_MEMORY_SCOPE_AGENT); }
__device__ __forceinline__ unsigned xb_xcc_id() { return (unsigned)__builtin_amdgcn_s_getreg((3 << 11) | 20) & 0xFu; }
#define XB_SPIN(cond, bar) do { unsigned _sp = 0; while (cond) { __builtin_amdgcn_s_sleep(1); \
    if ((++_sp & 255u) == 0u) { if (xb_ld(&(bar)[XB_TMO])) break; if (_sp > XB_SPIN_CAP) { atomicAdd(&(bar)[XB_TMO], 1u); break; } } } } while (0)

struct XcdBarrier {
    unsigned* bar; unsigned x;
    volatile LAS unsigned* st;
};

__device__ __forceinline__ XcdBarrier xcd_barrier_post(unsigned* bar, volatile LAS unsigned* st) {
    XcdBarrier b; b.bar = bar; b.x = xb_xcc_id(); b.st = st;
    if (threadIdx.x == 0) (void)xb_add(&bar[XB_XCNT(b.x)], 1u);
    return b;
}
__device__ __forceinline__ void xcd_barrier_complete(unsigned* bar, unsigned x, unsigned& nloc, unsigned& nx) {
    const unsigned G = gridDim.x * gridDim.y * gridDim.z;
    unsigned sum, cnt, mine, sp = 0u;
    for (;;) {
        sum = 0u; cnt = 0u; mine = 0u;
#pragma unroll
        for (unsigned j = 0; j < 16; ++j) { const unsigned c = xb_ld(&bar[XB_XCNT(j)]); sum += c; cnt += (c > 0u) ? 1u : 0u; mine = (j == x) ? c : mine; }
        if (sum == G) break;
        __builtin_amdgcn_s_sleep(1);
        if ((++sp & 255u) == 0u) { if (xb_ld(&bar[XB_TMO])) break; if (sp > XB_SPIN_CAP) { atomicAdd(&bar[XB_TMO], 1u); break; } }
    }
    nloc = mine > 0u ? mine : 1u; nx = cnt > 0u ? cnt : 1u;
}

__device__ __forceinline__ void xcd_barrier(const XcdBarrier& b) {
    asm volatile("s_waitcnt vmcnt(0)" ::: "memory");
    __syncthreads();
    if (threadIdx.x == 0) {
        unsigned* bar = b.bar;
        __builtin_amdgcn_s_waitcnt(0);
        unsigned nloc = b.st[0], nx = b.st[1];
        if (nloc == 0u) { xcd_barrier_complete(bar, b.x, nloc, nx); b.st[0] = nloc; b.st[1] = nx; }
        const unsigned old = xb_add(&bar[XB_XSUB(b.x)], 1u);
        const unsigned gen = old / nloc;
        if (old + 1u == (gen + 1u) * nloc) {
            __builtin_amdgcn_fence(__ATOMIC_RELEASE, "agent");
            asm volatile("s_waitcnt vmcnt(0)" ::: "memory");
            const unsigned og = xb_add(&bar[XB_TOP], 1u);
            const unsigned tg = og / nx;
            if (og + 1u == (tg + 1u) * nx) xb_add(&bar[XB_TOPGEN], 1u);
            else XB_SPIN(xb_ld(&bar[XB_TOPGEN]) == tg, bar);
            __builtin_amdgcn_fence(__ATOMIC_ACQUIRE, "agent");
            xb_add(&bar[XB_XGEN(b.x)], 1u);
            asm volatile("s_waitcnt vmcnt(0)" ::: "memory");
        } else {
            XB_SPIN(xb_ld(&bar[XB_XGEN(b.x)]) == gen, bar);
            __builtin_amdgcn_fence(__ATOMIC_ACQUIRE, "agent");
            asm volatile("s_waitcnt vmcnt(0)" ::: "memory");
        }
    }
    __syncthreads();
}

__device__ __forceinline__ void tr_item(const float* __restrict__ W, int K, int N, int nsrc0, bf16_t* WT, int drow0, const float* __restrict__ gain, LAS float* scr, int k0, int lane) {
    const int n = nsrc0 + (lane & 31);
    float wv_[32];
    const float* wp_ = W + (size_t)(k0 + (lane >> 5)) * N + ((n < N) ? n : 0);
#pragma unroll
    for (int i = 0; i < 32; ++i) wv_[i] = wp_[(size_t)(2 * i) * N];
#pragma unroll
    for (int i = 0; i < 32; ++i) {
        const int kk = 2 * i + (lane >> 5);
        float v = (n < N) ? wv_[i] : 0.f;
        if (gain) v *= gain[k0 + kk];
        scr[kk * 33 + (lane & 31)] = v;
    }
    asm volatile("s_waitcnt lgkmcnt(0)" ::: "memory");
    const int c = lane & 7;
#pragma unroll
    for (int j = 0; j < 4; ++j) {
        const int nn = (lane >> 3) + 8 * j; const LAS float* s = scr + (8 * c) * 33 + nn;
        u32x4 o; o.x = pk(s[0 * 33], s[1 * 33]); o.y = pk(s[2 * 33], s[3 * 33]); o.z = pk(s[4 * 33], s[5 * 33]); o.w = pk(s[6 * 33], s[7 * 33]);
        *(u32x4*)(WT + (size_t)(drow0 + nn) * K + k0 + 8 * c) = o;
    }
    asm volatile("s_waitcnt lgkmcnt(0)" ::: "memory");
}

__device__ __forceinline__ void p0_prologue(const Args& a, LAS unsigned char* lds, int vcu, int G) {
    const int tid = threadIdx.x, lane = tid & 63, wave = tid >> 6;
    LAS float* scr = (LAS float*)(lds + wave * 16384);
    const int gw = vcu * 8 + wave, NGW = G * 8;
    unsigned char* ws = a.ws;
    constexpr int I_IN = 16 * 104, I_OUT = 16 * 32, I_FI = 16 * 176, I_FD = 44 * 32;
    constexpr int NITEMS = 2 * I_IN + 2 * I_OUT + 2 * I_FI + 2 * I_FD;
    for (int it = gw; it < NITEMS; it += NGW) {
        int r = it;
        if (r < I_IN) { const int kb = r / 104, nb = r % 104; tr_item(a.in[I_GWIN], 1024, 3088, 32 * nb, (bf16_t*)(ws + WS_WGIN), 32 * nb, a.in[I_NMIX], scr, 64 * kb, lane); continue; } r -= I_IN;
        if (r < I_IN) { const int kb = r / 104, nb = r % 104; tr_item(a.in[I_FWIN], 1024, 3088, 32 * nb, (bf16_t*)(ws + WS_WFIN), 32 * nb, a.in[I_NMIX] + 1024, scr, 64 * kb, lane); continue; } r -= I_IN;
        if (r < I_OUT) { const int kb = r / 32, nb = r % 32; tr_item(a.in[I_GWOUT], 1024, 1024, 32 * nb, (bf16_t*)(ws + WS_WGOUT), 32 * nb, nullptr, scr, 64 * kb, lane); continue; } r -= I_OUT;
        if (r < I_OUT) { const int kb = r / 32, nb = r % 32; tr_item(a.in[I_FWOUT], 1024, 1024, 32 * nb, (bf16_t*)(ws + WS_WFOUT), 32 * nb, nullptr, scr, 64 * kb, lane); continue; } r -= I_OUT;
        if (r < 2 * I_FI) { const int li = r / I_FI; r -= li * I_FI; const int kb = r / 176, nb = r % 176, ns = 32 * nb, bj = ns / DFF, j = ns % DFF, drow = 256 * (j / 128) + 128 * bj + (j % 128);
            tr_item(a.in[I_FFIN] + (size_t)li * 1024 * 5632, 1024, 5632, ns, (bf16_t*)(ws + WS_WFFI + (size_t)li * 11 * MiB), drow, a.in[I_NFFN] + li * 1024, scr, 64 * kb, lane); continue; } r -= 2 * I_FI;
        { const int li = r / I_FD; r -= li * I_FD; const int kb = r / 32, nb = r % 32;
            tr_item(a.in[I_FFDN] + (size_t)li * DFF * 1024, DFF, 1024, 32 * nb, (bf16_t*)(ws + WS_WFFD + (size_t)li * 6 * MiB), 32 * nb, nullptr, scr, 64 * kb, lane); }
    }
    float* ss0 = (float*)(ws + WS_SS);
    bf16_t* XB = (bf16_t*)(ws + WS_XB);
    for (int m0 = gw; m0 < MT; m0 += 3 * NGW) {
        f32x4 v[3][4];
#pragma unroll
        for (int q = 0; q < 3; ++q) { const int m = m0 + q * NGW; if (m < MT) { const float* xr = (m < MP) ? a.in[I_XP] + (size_t)m * DM : a.in[I_XS] + (size_t)(m - MP) * DM;
#pragma unroll
            for (int j = 0; j < 4; ++j) v[q][j] = ((const f32x4*)xr)[lane + 64 * j]; } }
#pragma unroll
        for (int q = 0; q < 3; ++q) { const int m = m0 + q * NGW; if (m < MT) { float s = 0.f;
#pragma unroll
            for (int j = 0; j < 4; ++j) s += dot4(v[q][j]);
            s = wave_sum(s);
            if (lane == 0) ss0[m] = s;
#pragma unroll
            for (int j = 0; j < 4; ++j) { u32x2 o; o.x = pk(v[q][j][0], v[q][j][1]); o.y = pk(v[q][j][2], v[q][j][3]); ((u32x2*)(XB + (size_t)m * DM))[lane + 64 * j] = o; } } }
    }
}

__device__ __forceinline__ void p_final(const Args& a, int vcu, int G) {
    const int tid = threadIdx.x, lane = tid & 63, wave = tid >> 6;
    const int gw = vcu * 8 + wave, NGW = G * 8;
    const float* ss = (const float*)(a.ws + WS_SS + 4 * 131072);
    const float* XR = (const float*)(a.ws + WS_XR);
    const float* g = a.in[I_NFIN];
    f32x4 gv[4];
#pragma unroll
    for (int j = 0; j < 4; ++j) gv[j] = ((const f32x4*)g)[lane + 64 * j];
    for (int m0 = gw; m0 < MT; m0 += 3 * NGW) {
        f32x4 v[3][4]; float rs[3];
#pragma unroll
        for (int q = 0; q < 3; ++q) { const int m = m0 + q * NGW; if (m < MT) { rs[q] = rsqrtf(ss[m] * (1.f / DM) + EPS);
#pragma unroll
            for (int j = 0; j < 4; ++j) v[q][j] = ((const f32x4*)(XR + (size_t)m * DM))[lane + 64 * j]; } }
#pragma unroll
        for (int q = 0; q < 3; ++q) { const int m = m0 + q * NGW; if (m < MT) {
#pragma unroll
            for (int j = 0; j < 4; ++j) ((f32x4*)(a.out + O_Y + (size_t)m * DM))[lane + 64 * j] = v[q][j] * rs[q] * gv[j]; } }
    }
}

struct EpiGlaProj {
    static constexpr bool PERM = true, AFTER_DRAIN = false;
    const float* ss; bf16_t* proj; float* gl;
    __device__ __forceinline__ void operator()(const pg8::f32x4 (&acc)[2][2][4][2], const pg8::Unit& u, int wr, int wc, int fr, int fq) const {
        const int row0 = u.pm * 256 + wr * 64 + fr;
#pragma unroll
        for (int ai = 0; ai < 2; ++ai)
#pragma unroll
            for (int m = 0; m < 4; ++m) {
                const int row = row0 + ai * 128 + m * 16; const float rs = rsqrtf(ss[row] * (1.f / DM) + EPS);
                if (u.pn < 12) {
#pragma unroll
                    for (int bj = 0; bj < 2; ++bj) { const f32x4 v0 = acc[ai][bj][m][0] * rs, v1 = acc[ai][bj][m][1] * rs;
                        u32x4 w; w.x = pk(v0[0], v0[1]); w.y = pk(v0[2], v0[3]); w.z = pk(v1[0], v1[1]); w.w = pk(v1[2], v1[3]);
                        *(u32x4*)(proj + (size_t)row * NPJ + u.pn * 256 + bj * 128 + wc * 32 + 8 * fq) = w; }
                } else if (wc == 0 && fq < 2) {
#pragma unroll
                    for (int n = 0; n < 2; ++n) *(f32x4*)(gl + (size_t)row * 16 + 8 * fq + 4 * n) = acc[ai][0][m][n] * rs;
                }
            }
    }
};
struct EpiResid {
    static constexpr bool PERM = true, AFTER_DRAIN = false;
    const float* xin_p; const float* xin_s; float* xout; bf16_t* xb; float* ssout;
    __device__ __forceinline__ void operator()(const pg8::f32x4 (&acc)[2][2][4][2], const pg8::Unit& u, int wr, int wc, int fr, int fq) const {
        const int row0 = u.pm * 256 + wr * 64 + fr;
#pragma unroll
        for (int ai = 0; ai < 2; ++ai)
#pragma unroll
            for (int m = 0; m < 4; ++m) {
                const int row = row0 + ai * 128 + m * 16;
                const float* xi = (row < MP) ? xin_p + (size_t)row * DM : xin_s + (size_t)(row - MP) * DM;
                float sq = 0.f;
#pragma unroll
                for (int bj = 0; bj < 2; ++bj) { const int col = u.pn * 256 + bj * 128 + wc * 32 + 8 * fq;
                    const f32x4 a0 = *(const f32x4*)(xi + col) + acc[ai][bj][m][0], a1 = *(const f32x4*)(xi + col + 4) + acc[ai][bj][m][1];
                    *(f32x4*)(xout + (size_t)row * DM + col) = a0; *(f32x4*)(xout + (size_t)row * DM + col + 4) = a1;
                    u32x4 w; w.x = pk(a0[0], a0[1]); w.y = pk(a0[2], a0[3]); w.z = pk(a1[0], a1[1]); w.w = pk(a1[2], a1[3]);
                    *(u32x4*)(xb + (size_t)row * DM + col) = w;
                    sq += dot4(a0) + dot4(a1); }
                sq += __shfl_xor(sq, 16); sq += __shfl_xor(sq, 32);
                if (fq == 0) atomicAdd(ssout + row, sq);
            }
    }
};
struct EpiSwiglu {
    static constexpr bool PERM = true, AFTER_DRAIN = false;
    const float* ss; bf16_t* act;
    __device__ __forceinline__ void operator()(const pg8::f32x4 (&acc)[2][2][4][2], const pg8::Unit& u, int wr, int wc, int fr, int fq) const {
        const int row0 = u.pm * 256 + wr * 64 + fr;
#pragma unroll
        for (int ai = 0; ai < 2; ++ai)
#pragma unroll
            for (int m = 0; m < 4; ++m) {
                const int row = row0 + ai * 128 + m * 16; const float rs = rsqrtf(ss[row] * (1.f / DM) + EPS);
                float y[8];
#pragma unroll
                for (int n = 0; n < 2; ++n)
#pragma unroll
                    for (int i = 0; i < 4; ++i) { const float g = acc[ai][0][m][n][i] * rs, up = acc[ai][1][m][n][i] * rs; y[4 * n + i] = g * up * __builtin_amdgcn_rcpf(1.f + __expf(-g)); }
                u32x4 w; w.x = pk(y[0], y[1]); w.y = pk(y[2], y[3]); w.z = pk(y[4], y[5]); w.w = pk(y[6], y[7]);
                *(u32x4*)(act + (size_t)row * DFF + u.pn * 128 + wc * 32 + 8 * fq) = w;
            }
    }
};
struct EpiFoxProj {
    static constexpr bool PERM = true, AFTER_DRAIN = false;
    const float* ss; bf16_t* qkv; float* out; const float* bf;
    __device__ __forceinline__ void operator()(const pg8::f32x4 (&acc)[2][2][4][2], const pg8::Unit& u, int wr, int wc, int fr, int fq) const {
        const int row0 = u.pm * 256 + wr * 64 + fr;
        const int sect = u.pn >> 2;
#pragma unroll
        for (int ai = 0; ai < 2; ++ai)
#pragma unroll
            for (int m = 0; m < 4; ++m) {
                const int row = row0 + ai * 128 + m * 16; const float rs = rsqrtf(ss[row] * (1.f / DM) + EPS);
                if (u.pn < 12) {
                    const float sc = (sect == 0) ? rs * QSCALE2 : rs;
                    float* fdst = nullptr;
                    if (sect == 1) fdst = (row < MP) ? out + O_FKP + (size_t)row * DM : out + O_FKS + (size_t)(row - MP) * DM;
                    if (sect == 2) fdst = (row < MP) ? out + O_FVP + (size_t)row * DM : out + O_FVS + (size_t)(row - MP) * DM;
#pragma unroll
                    for (int bj = 0; bj < 2; ++bj) { const f32x4 v0 = acc[ai][bj][m][0] * sc, v1 = acc[ai][bj][m][1] * sc;
                        u32x4 w; w.x = pk(v0[0], v0[1]); w.y = pk(v0[2], v0[3]); w.z = pk(v1[0], v1[1]); w.w = pk(v1[2], v1[3]);
                        const int cl = bj * 128 + wc * 32 + 8 * fq;
                        *(u32x4*)(qkv + (size_t)row * NPJ + u.pn * 256 + cl) = w;
                        if (sect > 0) { float* d = fdst + (u.pn & 3) * 256 + cl; *(f32x4*)d = v0; *(f32x4*)(d + 4) = v1; } }
                } else if (wc == 0 && fq < 2) {
                    float* d = (row < MP) ? out + O_FLP + (size_t)row * 16 : out + O_FLS + (size_t)(row - MP) * 16;
#pragma unroll
                    for (int n = 0; n < 2; ++n) { const f32x4 v = acc[ai][0][m][n] * rs; f32x4 o;
#pragma unroll
                        for (int i = 0; i < 4; ++i) o[i] = log_sigmoid(v[i] + bf[8 * fq + 4 * n + i]);
                        *(f32x4*)(d + 8 * fq + 4 * n) = o; }
                }
            }
    }
};

constexpr int GL_OFF = 0, GSUM_OFF = 4096, DECS_OFF = 6144, QE_OFF = 8192, KE_OFF = 25600, VT_OFF = 43008, AL_OFF = 79872, KDT_OFF = 8192, OL_OFF = 8192;
constexpr int QES = 136, VTS = 72, OLS = 260;

template <int MODE> __device__ __forceinline__ void gla_item(const Args& a, LAS unsigned char* lds, int cid, int h) {
    const int tid = threadIdx.x, lane = tid & 63, w = tid >> 6, l31 = lane & 31, hi = lane >> 5;
    const int row0 = cid * 64;
    const bool prompt = cid < 256;
    LAS float* GLs = (LAS float*)(lds + GL_OFF); LAS float* GSUM = (LAS float*)(lds + GSUM_OFF); LAS float* DECS = (LAS float*)(lds + DECS_OFF);
    LAS bf16_t* QE = (LAS bf16_t*)(lds + QE_OFF); LAS bf16_t* KE = (LAS bf16_t*)(lds + KE_OFF); LAS bf16_t* VT = (LAS bf16_t*)(lds + VT_OFF);
    LAS bf16_t* AL = (LAS bf16_t*)(lds + AL_OFF); LAS bf16_t* KDT = (LAS bf16_t*)(lds + KDT_OFF);
    const bf16_t* P = (const bf16_t*)(a.ws + WS_PROJ) + (size_t)row0 * NPJ;
    const float* GL = (const float*)(a.ws + WS_GL);
    const float* state = a.in[I_STATE];

    bf16x8 sfr[8];
    if (MODE == 1) {
        if (prompt) {
            const bf16_t* sp = (const bf16_t*)(a.ws + WS_SPREV) + ((size_t)(cid * 4 + h) * 256 + 32 * w + l31) * 128 + 8 * hi;
#pragma unroll
            for (int ks = 0; ks < 8; ++ks) sfr[ks] = *(const bf16x8*)(sp + 16 * ks);
        } else {
            const float* s0 = state + ((size_t)((cid - 256) * 4 + h) * 128) * 256 + 32 * w + l31;
#pragma unroll
            for (int ks = 0; ks < 8; ++ks) { float f[8];
#pragma unroll
                for (int j = 0; j < 8; ++j) f[j] = s0[(size_t)(16 * ks + 8 * hi + j) * 256];
                u32x4 o; o.x = pk(f[0], f[1]); o.y = pk(f[2], f[3]); o.z = pk(f[4], f[5]); o.w = pk(f[6], f[7]); sfr[ks] = __builtin_bit_cast(bf16x8, o); }
        }
    }
    unsigned kraw[16], qraw[16];
    {
        const int dk_ = tid & 127, tg_ = tid >> 7;
        const bf16_t* kp_ = P + (size_t)(16 * tg_) * NPJ + 512 + h * 128 + dk_;
#pragma unroll
        for (int i = 0; i < 16; ++i) kraw[i] = kp_[(size_t)i * NPJ];
        if (MODE == 1) { const bf16_t* qp_ = P + (size_t)(16 * tg_) * NPJ + h * 128 + dk_;
#pragma unroll
            for (int i = 0; i < 16; ++i) qraw[i] = qp_[(size_t)i * NPJ]; }
    }
    float wv[16];
#pragma unroll
    for (int j = 0; j < 16; ++j) wv[j] = a.in[I_GWG2][j * 512 + h * 128 + (tid & 127)];
    const float bias = a.in[I_GBG][h * 128 + (tid & 127)];
    if (tid < 256) ((LAS f32x4*)GLs)[tid] = *(const f32x4*)(GL + (size_t)(row0 + (tid >> 2)) * 16 + (tid & 3) * 4);
    {
        const int dvv = tid & 255, th = tid >> 8; const bf16_t* vp = P + (size_t)(32 * th) * NPJ + 1024 + h * 256 + dvv;
#pragma unroll
        for (int q4 = 0; q4 < 4; ++q4) { unsigned e[8];
#pragma unroll
            for (int i = 0; i < 8; ++i) e[i] = vp[(size_t)(8 * q4 + i) * NPJ];
            u32x4 o; o.x = e[0] | (e[1] << 16); o.y = e[2] | (e[3] << 16); o.z = e[4] | (e[5] << 16); o.w = e[6] | (e[7] << 16);
            *(LAS u32x4*)(VT + dvv * VTS + 32 * th + 8 * q4) = o; }
    }
    __syncthreads();
    const int dk = tid & 127, tg = tid >> 7;
    float bc[16];
    {
        float run = 0.f;
#pragma unroll
        for (int i = 0; i < 16; ++i) { const LAS f32x4* gp = (const LAS f32x4*)(GLs + (16 * tg + i) * 16); float z = bias;
#pragma unroll
            for (int j4 = 0; j4 < 4; ++j4) { const f32x4 gq = gp[j4]; z += gq[0] * wv[4 * j4] + gq[1] * wv[4 * j4 + 1] + gq[2] * wv[4 * j4 + 2] + gq[3] * wv[4 * j4 + 3]; }
            run += log_sigmoid(z) * (1.f / 16.f); bc[i] = run; }
        GSUM[tg * 128 + dk] = run;
    }
    __syncthreads();
    float off = 0.f, blast = 0.f;
#pragma unroll
    for (int g = 0; g < 4; ++g) { const float s = GSUM[g * 128 + dk]; blast += s; if (g < tg) off += s; }
    if (MODE == 0) {
        float kd[16];
#pragma unroll
        for (int i = 0; i < 16; ++i) { const float b = bc[i] + off; kd[i] = bf2f(kraw[i]) * __expf(blast - b); }
        u32x4 o0, o1; o0.x = pk(kd[0], kd[1]); o0.y = pk(kd[2], kd[3]); o0.z = pk(kd[4], kd[5]); o0.w = pk(kd[6], kd[7]);
        o1.x = pk(kd[8], kd[9]); o1.y = pk(kd[10], kd[11]); o1.z = pk(kd[12], kd[13]); o1.w = pk(kd[14], kd[15]);
        *(LAS u32x4*)(KDT + dk * VTS + 16 * tg) = o0; *(LAS u32x4*)(KDT + dk * VTS + 16 * tg + 8) = o1;
        if (tg == 0) { const float d = __expf(blast); DECS[dk] = d; if (prompt) ((float*)(a.ws + WS_DEC))[(size_t)(cid * 4 + h) * 128 + dk] = d; }
    } else {
#pragma unroll
        for (int i = 0; i < 16; ++i) { const float b = bc[i] + off; const int t = 16 * tg + i;
            const float qe = bf2f(qraw[i]) * __expf(b) * 0.08838834764831845f, ke = bf2f(kraw[i]) * __expf(-b);
            QE[t * QES + dk] = (bf16_t)f2bf(qe); KE[t * QES + dk] = (bf16_t)f2bf(ke); }
    }
    __syncthreads();
    if (MODE == 0) {
        bf16x8 vf[4];
#pragma unroll
        for (int ks = 0; ks < 4; ++ks) vf[ks] = *(const LAS bf16x8*)(VT + (32 * w + l31) * VTS + 16 * ks + 8 * hi);
        f32x16 acc[4];
#pragma unroll
        for (int d = 0; d < 4; ++d) acc[d] = f32x16{};
#pragma unroll
        for (int d = 0; d < 4; ++d)
#pragma unroll
            for (int ks = 0; ks < 4; ++ks) { const bf16x8 kf = *(const LAS bf16x8*)(KDT + (32 * d + l31) * VTS + 16 * ks + 8 * hi);
                acc[d] = prompt ? MFMA32(vf[ks], kf, acc[d]) : MFMA32(kf, vf[ks], acc[d]); }
        if (prompt) {
            bf16_t* dst = (bf16_t*)(a.ws + WS_DST) + ((size_t)(cid * 4 + h) * 256 + 32 * w) * 128;
#pragma unroll
            for (int d = 0; d < 4; ++d)
#pragma unroll
                for (int r = 0; r < 16; ++r) dst[(size_t)crow(r, hi) * 128 + 32 * d + l31] = (bf16_t)f2bf(acc[d][r]);
        } else {
            const size_t base = ((size_t)((cid - 256) * 4 + h) * 128) * 256;
            float* outs = a.out + O_GSS;
#pragma unroll
            for (int d = 0; d < 4; ++d)
#pragma unroll
                for (int r = 0; r < 16; ++r) { const int dkk = 32 * d + crow(r, hi); const size_t idx = base + (size_t)dkk * 256 + 32 * w + l31; outs[idx] = state[idx] * DECS[dkk] + acc[d][r]; }
        }
    } else {
        u32x2 rraw[8];
#pragma unroll
        for (int i = 0; i < 8; ++i) rraw[i] = *(const u32x2*)(P + (size_t)(8 * w + i) * NPJ + 2048 + h * 256 + 4 * lane);
        f32x16 o[2]; o[0] = f32x16{}; o[1] = f32x16{};
#pragma unroll
        for (int tb = 0; tb < 2; ++tb)
#pragma unroll
            for (int ks = 0; ks < 8; ++ks) { const bf16x8 qa = *(const LAS bf16x8*)(QE + (32 * tb + l31) * QES + 16 * ks + 8 * hi); o[tb] = MFMA32(qa, sfr[ks], o[tb]); }
        if (w < 3) {
            const int tb = (w > 0) ? 1 : 0, sb = (w == 2) ? 1 : 0;
            f32x16 am = f32x16{};
#pragma unroll
            for (int ks = 0; ks < 8; ++ks) { const bf16x8 qa = *(const LAS bf16x8*)(QE + (32 * tb + l31) * QES + 16 * ks + 8 * hi), kb = *(const LAS bf16x8*)(KE + (32 * sb + l31) * QES + 16 * ks + 8 * hi);
                am = MFMA32(qa, kb, am); }
#pragma unroll
            for (int r = 0; r < 16; ++r) { const int tl = crow(r, hi); float v = am[r]; if (tb == sb && l31 > tl) v = 0.f; AL[(32 * tb + tl) * VTS + 32 * sb + l31] = (bf16_t)f2bf(v); }
        }
        __syncthreads();
#pragma unroll
        for (int tb = 0; tb < 2; ++tb)
#pragma unroll
            for (int ks = 0; ks < 4; ++ks) { if (tb == 0 && ks >= 2) continue;
                const bf16x8 aa = *(const LAS bf16x8*)(AL + (32 * tb + l31) * VTS + 16 * ks + 8 * hi), vb = *(const LAS bf16x8*)(VT + (32 * w + l31) * VTS + 16 * ks + 8 * hi);
                o[tb] = MFMA32(aa, vb, o[tb]); }
        __syncthreads();
        LAS float* OL = (LAS float*)(lds + OL_OFF);
#pragma unroll
        for (int tb = 0; tb < 2; ++tb)
#pragma unroll
            for (int r = 0; r < 16; ++r) OL[(32 * tb + crow(r, hi)) * OLS + 32 * w + l31] = o[tb][r];
        __syncthreads();
        const f32x4 ng = *(const f32x4*)(a.in[I_GNORM] + h * 256 + 4 * lane);
        bf16_t* OG = (bf16_t*)(a.ws + WS_OG);
#pragma unroll
        for (int i = 0; i < 8; ++i) { const int t = 8 * w + i; const f32x4 v = *(const LAS f32x4*)(OL + t * OLS + 4 * lane);
            const float rs = rsqrtf(wave_sum(dot4(v)) * (1.f / 256.f) + EPS);
            const u32x2 rr = rraw[i];
            float rv[4] = {bf2f(rr.x & 0xffffu), bf2f(rr.x >> 16), bf2f(rr.y & 0xffffu), bf2f(rr.y >> 16)}; float y[4];
#pragma unroll
            for (int j = 0; j < 4; ++j) y[j] = v[j] * rs * ng[j] * rv[j] * __builtin_amdgcn_rcpf(1.f + __expf(-rv[j]));
            u32x2 ov; ov.x = pk(y[0], y[1]); ov.y = pk(y[2], y[3]);
            *(u32x2*)(OG + (size_t)(row0 + t) * DM + h * 256 + 4 * lane) = ov; }
    }
    __syncthreads();
}

__device__ __forceinline__ void gla_scan(const Args& a, int vcu, int G) {
    const int gt = vcu * 512 + threadIdx.x, NT_ = G * 512;
    const bf16_t* DST = (const bf16_t*)(a.ws + WS_DST); const float* DEC = (const float*)(a.ws + WS_DEC); bf16_t* SP = (bf16_t*)(a.ws + WS_SPREV);
    for (int it0 = gt; it0 < 32 * 8192; it0 += 2 * NT_) {
        const int it1 = it0 + NT_; const bool two = it1 < 32 * 8192;
        const int bhA = it0 >> 13, eA = it0 & 8191, dvA = eA >> 5, dkA = (eA & 31) * 4;
        const int itB = two ? it1 : it0; const int bhB = itB >> 13, eB = itB & 8191, dvB = eB >> 5, dkB = (eB & 31) * 4;
        f32x4 SA = (f32x4){0.f, 0.f, 0.f, 0.f}, SB = SA;
#pragma unroll 8
        for (int c = 0; c < 32; ++c) {
            const size_t chA = (size_t)(((bhA >> 2) * 32 + c) * 4 + (bhA & 3)), chB = (size_t)(((bhB >> 2) * 32 + c) * 4 + (bhB & 3));
            const size_t baseA = (chA * 256 + dvA) * 128 + dkA, baseB = (chB * 256 + dvB) * 128 + dkB;
            const u32x2 rA = *(const u32x2*)(DST + baseA), rB = *(const u32x2*)(DST + baseB);
            const f32x4 deA = *(const f32x4*)(DEC + chA * 128 + dkA), deB = *(const f32x4*)(DEC + chB * 128 + dkB);
            const f32x4 dsA = (f32x4){bf2f(rA.x & 0xffffu), bf2f(rA.x >> 16), bf2f(rA.y & 0xffffu), bf2f(rA.y >> 16)};
            const f32x4 dsB = (f32x4){bf2f(rB.x & 0xffffu), bf2f(rB.x >> 16), bf2f(rB.y & 0xffffu), bf2f(rB.y >> 16)};
            u32x2 o; o.x = pk(SA[0], SA[1]); o.y = pk(SA[2], SA[3]); *(u32x2*)(SP + baseA) = o;
            if (two) { o.x = pk(SB[0], SB[1]); o.y = pk(SB[2], SB[3]); *(u32x2*)(SP + baseB) = o; }
            SA = SA * deA + dsA; SB = SB * deB + dsB;
        }
        float* ogA = a.out + O_GSP + ((size_t)bhA * 128 + dkA) * 256 + dvA;
#pragma unroll
        for (int i = 0; i < 4; ++i) ogA[(size_t)i * 256] = SA[i];
        if (two) { float* ogB = a.out + O_GSP + ((size_t)bhB * 128 + dkB) * 256 + dvB;
#pragma unroll
            for (int i = 0; i < 4; ++i) ogB[(size_t)i * 256] = SB[i]; }
    }
}

template <int L, int C> __device__ __forceinline__ void cumsum_item(const float* src0, const float* src1, float* dst, LAS float* SEG, int hh, int seg) {
    float s = 0.f;
#pragma unroll 1
    for (int c0 = 0; c0 < L; c0 += C) { float v[C];
#pragma unroll
        for (int i = 0; i < C; ++i) { const int t = seg * L + c0 + i; v[i] = (t < 2048) ? src0[(unsigned)(t * 16 + hh)] : src1[(unsigned)((t - 2048) * 16 + hh)]; }
#pragma unroll
        for (int i = 0; i < C; ++i) s += v[i]; }
    SEG[seg * 16 + hh] = s;
    __syncthreads();
    float run = 0.f;
    for (int g = 0; g < seg; ++g) run += SEG[g * 16 + hh];
#pragma unroll 1
    for (int c0 = 0; c0 < L; c0 += C) { float v[C];
#pragma unroll
        for (int i = 0; i < C; ++i) { const int t = seg * L + c0 + i; v[i] = (t < 2048) ? src0[(unsigned)(t * 16 + hh)] : src1[(unsigned)((t - 2048) * 16 + hh)]; }
#pragma unroll
        for (int i = 0; i < C; ++i) { run += v[i]; dst[seg * L + c0 + i] = run; } }
    __syncthreads();
}
__device__ __forceinline__ void fox_cumsum(const Args& a, LAS unsigned char* lds, int vcu, int G) {
    const int tid = threadIdx.x, hh = tid & 15, seg = tid >> 4;
    LAS float* SEG = (LAS float*)lds;
    for (int it = vcu; it < 40; it += G) {
        const bool prompt = it < 8; const int b = prompt ? it : it - 8;
        const float* src0 = prompt ? a.out + O_FLP + (size_t)b * 2048 * 16 : a.in[I_CLF] + (size_t)b * 2048 * 16;
        const float* src1 = a.out + O_FLS + (size_t)b * 64 * 16;
        if (prompt) cumsum_item<64, 32>(src0, src1, (float*)(a.ws + WS_CP) + (size_t)(b * 16 + hh) * 2048, SEG, hh, seg);
        else cumsum_item<66, 22>(src0, src1, (float*)(a.ws + WS_CS) + (size_t)(b * 16 + hh) * 2112, SEG, hh, seg);
    }
}

constexpr int AT_KS = 72, AT_VS = 68, AT_BUF = 18432, AT_VOFF = 9216, AT_COFF = 17920;
struct TileRegs { u32x4 k0, k1, v0, v1; float ck; };

template <bool SAMPLE> __device__ __forceinline__ void attn_load(TileRegs& R, const Args& a, int b, int h, int t, const float* cbase, int tid) {
    const int kvl = tid >> 3, ch = tid & 7, kp = tid >> 4, c4 = tid & 15;
    if (SAMPLE && t < 32) {
        const float* kptr = a.in[I_CK] + (((size_t)b * 2048 + 64 * t + kvl) * 16 + h) * 64 + 8 * ch;
        R.k0 = *(const u32x4*)kptr; R.k1 = *(const u32x4*)(kptr + 4);
        const float* vptr = a.in[I_CV] + (((size_t)b * 2048 + 64 * t + 2 * kp) * 16 + h) * 64 + 4 * c4;
        R.v0 = *(const u32x4*)vptr; R.v1 = *(const u32x4*)(vptr + 1024);
    } else {
        const size_t rowbase = SAMPLE ? (size_t)(MP + b * 64) : (size_t)(b * 2048 + 64 * t);
        const bf16_t* qkv = (const bf16_t*)(a.ws + WS_PROJ);
        R.k0 = *(const u32x4*)(qkv + (rowbase + kvl) * NPJ + 1024 + h * 64 + 8 * ch);
        const bf16_t* vptr = qkv + (rowbase + 2 * kp) * NPJ + 2048 + h * 64 + 4 * c4;
        const u32x2 x0 = *(const u32x2*)vptr, x1 = *(const u32x2*)(vptr + NPJ);
        R.v0.x = x0.x; R.v0.y = x0.y; R.v1.x = x1.x; R.v1.y = x1.y;
    }
    if (tid < 64) R.ck = cbase[64 * t + tid] * LOG2E;
}
__device__ __forceinline__ void attn_store(const TileRegs& R, LAS unsigned char* buf, bool f32src, int tid) {
    const int kvl = tid >> 3, ch = tid & 7, kp = tid >> 4, c4 = tid & 15;
    LAS unsigned* VT32 = (LAS unsigned*)(buf + AT_VOFF);
    if (f32src) {
        u32x4 o; o.x = pk(__uint_as_float(R.k0.x), __uint_as_float(R.k0.y)); o.y = pk(__uint_as_float(R.k0.z), __uint_as_float(R.k0.w));
        o.z = pk(__uint_as_float(R.k1.x), __uint_as_float(R.k1.y)); o.w = pk(__uint_as_float(R.k1.z), __uint_as_float(R.k1.w));
        *(LAS u32x4*)(buf + (kvl * AT_KS + 8 * ch) * 2) = o;
#pragma unroll
        for (int i = 0; i < 4; ++i) VT32[(4 * c4 + i) * (AT_VS / 2) + kp] = pk(__uint_as_float(R.v0[i]), __uint_as_float(R.v1[i]));
    } else {
        *(LAS u32x4*)(buf + (kvl * AT_KS + 8 * ch) * 2) = R.k0;
        VT32[(4 * c4 + 0) * (AT_VS / 2) + kp] = (R.v0.x & 0xffffu) | (R.v1.x << 16);
        VT32[(4 * c4 + 1) * (AT_VS / 2) + kp] = (R.v0.x >> 16) | (R.v1.x & 0xffff0000u);
        VT32[(4 * c4 + 2) * (AT_VS / 2) + kp] = (R.v0.y & 0xffffu) | (R.v1.y << 16);
        VT32[(4 * c4 + 3) * (AT_VS / 2) + kp] = (R.v0.y >> 16) | (R.v1.y & 0xffff0000u);
    }
    if (tid < 64) { const float c = -R.ck; const unsigned h1 = f2bf(c); const float r1 = c - bf2f(h1); const unsigned h2 = f2bf(r1); const unsigned h3 = f2bf(r1 - bf2f(h2));
        u32x2 o; o.x = h1 | (h2 << 16); o.y = h3; ((LAS u32x2*)(buf + AT_COFF))[tid] = o; }
}

template <bool QLDS> __device__ __forceinline__ void attn_tile(const LAS unsigned char* buf, const bf16x8 (&qf)[4], const LAS bf16x8* qlds, float cq2, int qpos, int kv0, bool diag, float& mrun, float& lrun, f32x16 (&ot)[2], int l31, int hi) {
    const LAS bf16_t* Ks = (const LAS bf16_t*)buf; const LAS bf16_t* VTs = (const LAS bf16_t*)(buf + AT_VOFF); const LAS u32x2* CKs = (const LAS u32x2*)(buf + AT_COFF);
    f32x16 p0, p1;
#pragma unroll
    for (int r = 0; r < 16; ++r) { p0[r] = cq2; p1[r] = cq2; }
    {
        const u32x2 b0 = CKs[l31], b1 = CKs[32 + l31];
        const unsigned msk = hi ? 0u : 0xffffffffu;
        u32x4 x0; x0.x = b0.x & msk; x0.y = b0.y & msk; x0.z = 0u; x0.w = 0u;
        u32x4 x1; x1.x = b1.x & msk; x1.y = b1.y & msk; x1.z = 0u; x1.w = 0u;
        u32x4 qx; qx.x = 0x3F803F80u & msk; qx.y = 0x00003F80u & msk; qx.z = 0u; qx.w = 0u;
        p0 = MFMA32(__builtin_bit_cast(bf16x8, x0), __builtin_bit_cast(bf16x8, qx), p0); p1 = MFMA32(__builtin_bit_cast(bf16x8, x1), __builtin_bit_cast(bf16x8, qx), p1);
    }
#pragma unroll
    for (int ks = 0; ks < 4; ++ks) { const bf16x8 k0 = *(const LAS bf16x8*)(Ks + l31 * AT_KS + 16 * ks + 8 * hi), k1 = *(const LAS bf16x8*)(Ks + (32 + l31) * AT_KS + 16 * ks + 8 * hi);
        const bf16x8 qq = QLDS ? qlds[ks * 64] : qf[ks];
        p0 = MFMA32(k0, qq, p0); p1 = MFMA32(k1, qq, p1); }
    __builtin_amdgcn_sched_barrier(0);
    if (diag) {
        int qp = qpos - kv0; asm volatile("" : "+v"(qp));
#pragma unroll
        for (int r = 0; r < 16; ++r) { const int kv = crow(r, hi); if (kv > qp) p0[r] = -INFINITY; if (kv + 32 > qp) p1[r] = -INFINITY; }
    }
    float rm = fmaxf(p0[0], p1[0]);
#pragma unroll
    for (int r = 1; r < 16; ++r) rm = fmaxf(rm, fmaxf(p0[r], p1[r]));
    rm = fmaxf(rm, __shfl_xor(rm, 32));
    if (__all(rm < mrun - 40.f)) return;
    const float mn = fmaxf(mrun, rm);
    if (__any(mn > mrun)) {
        const float alpha = __builtin_amdgcn_exp2f(mrun - mn);
        lrun *= alpha;
#pragma unroll
        for (int r = 0; r < 16; ++r) { ot[0][r] *= alpha; ot[1][r] *= alpha; }
        mrun = mn;
    }
    float rs = 0.f;
#pragma unroll
    for (int r = 0; r < 16; ++r) { p0[r] = __builtin_amdgcn_exp2f(p0[r] - mrun); p1[r] = __builtin_amdgcn_exp2f(p1[r] - mrun); rs += p0[r] + p1[r]; }
    lrun += rs;
    bf16x8 pf[4];
    { u32x4 x; x.x = pk(p0[0], p0[1]); x.y = pk(p0[2], p0[3]); x.z = pk(p0[4], p0[5]); x.w = pk(p0[6], p0[7]); pf[0] = __builtin_bit_cast(bf16x8, x);
      x.x = pk(p0[8], p0[9]); x.y = pk(p0[10], p0[11]); x.z = pk(p0[12], p0[13]); x.w = pk(p0[14], p0[15]); pf[1] = __builtin_bit_cast(bf16x8, x);
      x.x = pk(p1[0], p1[1]); x.y = pk(p1[2], p1[3]); x.z = pk(p1[4], p1[5]); x.w = pk(p1[6], p1[7]); pf[2] = __builtin_bit_cast(bf16x8, x);
      x.x = pk(p1[8], p1[9]); x.y = pk(p1[10], p1[11]); x.z = pk(p1[12], p1[13]); x.w = pk(p1[14], p1[15]); pf[3] = __builtin_bit_cast(bf16x8, x); }
    __builtin_amdgcn_sched_barrier(0);
#pragma unroll
    for (int db = 0; db < 2; ++db)
#pragma unroll
        for (int ks = 0; ks < 4; ++ks) { const LAS bf16_t* vp = VTs + (32 * db + l31) * AT_VS + 16 * ks + 4 * hi;
            const u32x2 lo = *(const LAS u32x2*)vp, hh2 = *(const LAS u32x2*)(vp + 8);
            u32x4 x; x.x = lo.x; x.y = lo.y; x.z = hh2.x; x.w = hh2.y;
            ot[db] = MFMA32(__builtin_bit_cast(bf16x8, x), pf[ks], ot[db]); }
}

__device__ __forceinline__ void attn_unit_prompt(const Args& a, LAS unsigned char* lds, int b, int h, int qb) {
    int tid_ = threadIdx.x; asm volatile("" : "+v"(tid_));
    const int tid = tid_, lane = tid & 63, w = __builtin_amdgcn_readfirstlane(tid >> 6), l31 = lane & 31, hi = lane >> 5;
    const int NT = 4 * (qb + 1);
    const int qpos = 256 * qb + 32 * w + l31;
    const size_t qrow = (size_t)(b * 2048 + qpos);
    const float* cbase = (const float*)(a.ws + WS_CP) + (size_t)(b * 16 + h) * 2048;
    const bf16_t* qkv = (const bf16_t*)(a.ws + WS_PROJ);
    bf16x8 qf[4];
#pragma unroll
    for (int ks = 0; ks < 4; ++ks) qf[ks] = *(const bf16x8*)(qkv + qrow * NPJ + h * 64 + 16 * ks + 8 * hi);
    const float cq2 = cbase[qpos] * LOG2E;
    const int qmax_w = 256 * qb + 32 * w + 31;
    TileRegs R0, R1, R2;
    attn_load<false>(R0, a, b, h, NT - 1, cbase, tid); attn_load<false>(R1, a, b, h, NT - 2, cbase, tid); attn_load<false>(R2, a, b, h, NT - 3, cbase, tid);
    attn_store(R0, lds, false, tid);
    attn_load<false>(R0, a, b, h, NT - 4, cbase, tid);
    __syncthreads();
    float mrun = -INFINITY, lrun = 0.f;
    f32x16 ot[2]; ot[0] = f32x16{}; ot[1] = f32x16{};
#define PSTEP(tt, RR) do { if ((tt) < NT) { const int ti_ = NT - 1 - (tt); if (64 * ti_ <= qmax_w) attn_tile<false>(lds + ((tt) & 1) * AT_BUF, qf, nullptr, cq2, qpos, 64 * ti_, ti_ >= 4 * qb, mrun, lrun, ot, l31, hi); \
        if ((tt) + 1 < NT) { attn_store(RR, lds + (((tt) + 1) & 1) * AT_BUF, false, tid); if ((tt) + 4 < NT) attn_load<false>(RR, a, b, h, NT - 5 - (tt), cbase, tid); } \
        __syncthreads(); } } while (0)
#pragma unroll 1
    for (int t = 0; t < NT; t += 3) { PSTEP(t, R1); PSTEP(t + 1, R2); PSTEP(t + 2, R0); }
#undef PSTEP
    lrun += __shfl_xor(lrun, 32);
    const float inv = 1.f / lrun;
    bf16_t* og = (bf16_t*)(a.ws + WS_OG) + qrow * DM + h * 64;
#pragma unroll
    for (int db = 0; db < 2; ++db)
#pragma unroll
        for (int j = 0; j < 4; ++j) { u32x2 o; o.x = pk(ot[db][4 * j] * inv, ot[db][4 * j + 1] * inv); o.y = pk(ot[db][4 * j + 2] * inv, ot[db][4 * j + 3] * inv);
            *(u32x2*)(og + 32 * db + 8 * j + 4 * hi) = o; }
}

__device__ __forceinline__ void attn_unit_sample(const Args& a, LAS unsigned char* lds, int b, int h) {
    int tid_ = threadIdx.x; asm volatile("" : "+v"(tid_));
    const int tid = tid_, lane = tid & 63, w = __builtin_amdgcn_readfirstlane(tid >> 6), l31 = lane & 31, hi = lane >> 5;
    const bool active = w < 2;
    const int qpos = 2048 + 32 * (w & 1) + l31;
    const size_t qrow = (size_t)(MP + b * 64 + 32 * (w & 1) + l31);
    const float* cbase = (const float*)(a.ws + WS_CS) + (size_t)(b * 16 + h) * 2112;
    const bf16_t* qkv = (const bf16_t*)(a.ws + WS_PROJ);
    bf16x8 qf[4];
#pragma unroll
    for (int ks = 0; ks < 4; ++ks) qf[ks] = *(const bf16x8*)(qkv + qrow * NPJ + h * 64 + 16 * ks + 8 * hi);
    const float cq2 = cbase[qpos] * LOG2E;
    TileRegs R0, R1, R2;
    attn_load<true>(R0, a, b, h, 32, cbase, tid); attn_load<true>(R1, a, b, h, 31, cbase, tid); attn_load<true>(R2, a, b, h, 30, cbase, tid);
    attn_store(R0, lds, false, tid);
    attn_load<true>(R0, a, b, h, 29, cbase, tid);
    __syncthreads();
    float mrun = -INFINITY, lrun = 0.f;
    f32x16 ot[2]; ot[0] = f32x16{}; ot[1] = f32x16{};
#define SSTEP(tt, RR) do { if (active) attn_tile<false>(lds + ((tt) & 1) * AT_BUF, qf, nullptr, cq2, qpos, 64 * (32 - (tt)), (tt) == 0, mrun, lrun, ot, l31, hi); \
        if ((tt) + 1 < 33) { attn_store(RR, lds + (((tt) + 1) & 1) * AT_BUF, true, tid); if ((tt) + 4 < 33) attn_load<true>(RR, a, b, h, 28 - (tt), cbase, tid); } \
        __syncthreads(); } while (0)
#pragma unroll 1
    for (int t = 0; t < 33; t += 3) { SSTEP(t, R1); SSTEP(t + 1, R2); SSTEP(t + 2, R0); }
#undef SSTEP
    if (active) {
        lrun += __shfl_xor(lrun, 32);
        const float inv = 1.f / lrun;
        bf16_t* og = (bf16_t*)(a.ws + WS_OG) + qrow * DM + h * 64;
#pragma unroll
        for (int db = 0; db < 2; ++db)
#pragma unroll
            for (int j = 0; j < 4; ++j) { u32x2 o; o.x = pk(ot[db][4 * j] * inv, ot[db][4 * j + 1] * inv); o.y = pk(ot[db][4 * j + 2] * inv, ot[db][4 * j + 3] * inv);
                *(u32x2*)(og + 32 * db + 8 * j + 4 * hi) = o; }
    }
}

__device__ __forceinline__ void fox_attention(const Args& a, LAS unsigned char* lds, int vcu, int G) {
#pragma unroll 1
    for (int pass = 0; pass < 2; ++pass) {
        if ((pass ^ (vcu & 1)) == 0) {
#ifdef ATT_DUP_PROMPT
          for (int rep2_ = 0; rep2_ < 2; ++rep2_)
#endif
            if (G == 256) {
                const int bh = vcu >> 1, s0 = 2 * (vcu & 1);
#pragma unroll 1
                for (int i = 0; i < 4; ++i) attn_unit_prompt(a, lds, bh >> 4, bh & 15, (i & 1) ? s0 + (i >> 1) : 7 - s0 - (i >> 1));
            } else {
#pragma unroll 1
                for (int u = vcu; u < 1024; u += G) attn_unit_prompt(a, lds, (u & 127) >> 4, u & 15, 7 - (u >> 7));
            }
        } else {
#pragma unroll 1
            for (int u = vcu; u < 512; u += G) attn_unit_sample(a, lds, u >> 4, u & 15);
        }
    }
}

#ifndef PH_MASK
#define PH_MASK 0x7fff
#endif
#define IN(k) (((PH_MASK >> (k)) & 1) && a.ph_lo <= (k) && (k) < a.ph_hi)
#define SEAM(k) do { if (IN(k) && IN((k) + 1)) { if ((k) == 0) cg::this_grid().sync(); else xcd_barrier(xbar); } } while (0)
#ifndef DUP_MASK
#define DUP_MASK 0
#endif
#define REP(k) _Pragma("unroll 1") for (int rep_ = 0; rep_ < ((((DUP_MASK) >> (k)) & 1) ? 2 : 1); ++rep_)
#define REPSYNC(k) do { if ((((DUP_MASK) >> (k)) & 1)) xcd_barrier(xbar); } while (0)
template <int L> __device__ __forceinline__ void common_gemms(const Args& a, LAS unsigned char* lds, int G, int bx, const XcdBarrier& xbar) {
    unsigned char* ws = a.ws;
    float* SS = (float*)(ws + WS_SS);
    bf16_t* XB = (bf16_t*)(ws + WS_XB); float* XR = (float*)(ws + WS_XR); bf16_t* OG = (bf16_t*)(ws + WS_OG); bf16_t* ACT = (bf16_t*)(ws + WS_ACT);
    constexpr int po = L ? 11 : 5;
    if (IN(po)) { pg8::Gemm g{OG, (const bf16_t*)(ws + (L ? WS_WFOUT : WS_WGOUT)), MT, DM, DM}; pg8::StaticOrder S; S.init(MT, DM, G, bx);
        EpiResid E{L ? XR : a.in[I_XP], L ? XR + (size_t)MP * DM : a.in[I_XS], XR, XB, SS + (L ? 3 : 1) * 32768};
        pg8::gemm_phase<EpiResid, pg8::StaticOrder, true, true>(lds, g, S, E); }
    SEAM(po);
    if (IN(po + 1)) REP(po + 1) { pg8::Gemm g{XB, (const bf16_t*)(ws + WS_WFFI + (size_t)L * 11 * MiB), MT, 2 * DFF, DM}; pg8::StaticOrder S; S.init(MT, 2 * DFF, G, bx);
        EpiSwiglu E{SS + (L ? 3 : 1) * 32768, ACT}; pg8::gemm_phase<EpiSwiglu, pg8::StaticOrder, true, true>(lds, g, S, E); REPSYNC(po + 1); }
    SEAM(po + 1);
    if (IN(po + 2)) { pg8::Gemm g{ACT, (const bf16_t*)(ws + WS_WFFD + (size_t)L * 6 * MiB), MT, DM, DFF}; pg8::StaticOrder S; S.init(MT, DM, G, bx);
        EpiResid E{XR, XR + (size_t)MP * DM, XR, XB, SS + (L ? 4 : 2) * 32768};
        pg8::gemm_phase<EpiResid, pg8::StaticOrder, true, true>(lds, g, S, E); }
    SEAM(po + 2);
}
constexpr int NPH = 15;
__global__ void __launch_bounds__(512, 2) fwd(Args a) {
    extern __shared__ __attribute__((aligned(16))) unsigned char lds_raw[];
    LAS unsigned char* lds = (LAS unsigned char*)lds_raw;
    const int G = gridDim.x, bx = blockIdx.x;
    const int vcu = (G % 8 == 0) ? (bx % 8) * (G / 8) + bx / 8 : bx;
    unsigned char* ws = a.ws;
    float* SS = (float*)(ws + WS_SS);
    bf16_t* XB = (bf16_t*)(ws + WS_XB); bf16_t* PROJ = (bf16_t*)(ws + WS_PROJ);

    volatile LAS unsigned* MISC = (volatile LAS unsigned*)(lds + 131072);
    if (threadIdx.x < 64) MISC[threadIdx.x] = 0u;
    __syncthreads();
    XcdBarrier xbar; xbar.bar = (unsigned*)ws; xbar.x = 0; xbar.st = nullptr;
    if (a.ph_hi - a.ph_lo > 1) xbar = xcd_barrier_post((unsigned*)ws, MISC + 8);
    if (IN(0)) REP(0) { p0_prologue(a, lds, vcu, G); REPSYNC(0); }
    SEAM(0);
    if (IN(1)) { pg8::Gemm g{XB, (const bf16_t*)(ws + WS_WGIN), MT, NPROJ, DM}; pg8::StaticOrder S; S.init(MT, NPROJ, G, bx);
        EpiGlaProj E{SS, PROJ, (float*)(ws + WS_GL)}; pg8::gemm_phase<EpiGlaProj, pg8::StaticOrder, true, true>(lds, g, S, E); }
    SEAM(1);
    if (IN(2)) REP(2) {
#pragma unroll 1
        for (int it = vcu; it < 1152; it += G) gla_item<0>(a, lds, it >> 2, it & 3);
        REPSYNC(2); }
    SEAM(2);
    if (IN(3)) REP(3) { gla_scan(a, vcu, G); REPSYNC(3); }
    SEAM(3);
    if (IN(4)) REP(4) {
#pragma unroll 1
        for (int it = vcu; it < 1152; it += G) gla_item<1>(a, lds, it >> 2, it & 3);
        REPSYNC(4); }
    SEAM(4);
    common_gemms<0>(a, lds, G, bx, xbar);
    if (IN(8)) { pg8::Gemm g{XB, (const bf16_t*)(ws + WS_WFIN), MT, NPROJ, DM}; pg8::StaticOrder S; S.init(MT, NPROJ, G, bx);
        EpiFoxProj E{SS + 2 * 32768, PROJ, a.out, a.in[I_FBF]}; pg8::gemm_phase<EpiFoxProj, pg8::StaticOrder, true, true>(lds, g, S, E); }
    SEAM(8);
    if (IN(9)) REP(9) { fox_cumsum(a, lds, vcu, G); REPSYNC(9); }
    SEAM(9);
    if (IN(10)) REP(10) { fox_attention(a, lds, vcu, G); REPSYNC(10); }
    SEAM(10);
    common_gemms<1>(a, lds, G, bx, xbar);
#ifdef EXTRA_SYNCS
    for (int i_ = 0; i_ < EXTRA_SYNCS; ++i_) xcd_barrier(xbar);
#endif
    if (IN(14)) p_final(a, vcu, G);
#undef IN
#undef SEAM
}

extern "C" void kernel_launch(void* const* d_in, const int* in_sizes, int n_in, void* d_out, int out_size, void* d_ws, size_t ws_size, hipStream_t stream) {
    static int grid = 0;
    if (grid == 0) {
        if (n_in != 19 || ws_size < WS_END || out_size != 62160896) { fprintf(stderr, "kernel_launch: unexpected problem shape (n_in %d, out %d, ws %zu)\n", n_in, out_size, ws_size); grid = -1; return; }
        if (hipFuncSetAttribute((const void*)fwd, hipFuncAttributeMaxDynamicSharedMemorySize, LDS_BYTES) != hipSuccess) { fprintf(stderr, "kernel_launch: hipFuncSetAttribute failed\n"); grid = -1; return; }
        int dev = 0, cus = 0, per_cu = 0;
        (void)hipGetDevice(&dev); (void)hipDeviceGetAttribute(&cus, hipDeviceAttributeMultiprocessorCount, dev);
        (void)hipOccupancyMaxActiveBlocksPerMultiprocessor(&per_cu, (const void*)fwd, 512, LDS_BYTES);
        (void)hipGetLastError();
        if (per_cu < 1) per_cu = 1;
        grid = cus * 1;
        if (grid <= 0) grid = 256;
    }
    if (grid < 0) return;
    (void)hipMemsetAsync((char*)d_ws + WS_CTL, 0, CTL_BYTES, stream);
    Args a{};
    for (int i = 0; i < 19; ++i) a.in[i] = (const float*)d_in[i];
    a.out = (float*)d_out; a.ws = (unsigned char*)d_ws;
#if MK_MULTI
    for (int ph = 0; ph < NPH; ++ph) { a.ph_lo = ph; a.ph_hi = ph + 1; hipLaunchKernelGGL(fwd, dim3(grid), dim3(512), LDS_BYTES, stream, a); }
#else
    a.ph_lo = 0; a.ph_hi = NPH;
    void* args[] = {&a};
    hipError_t e = hipLaunchCooperativeKernel((const void*)fwd, dim3(grid), dim3(512), args, LDS_BYTES, stream);
    if (e != hipSuccess) fprintf(stderr, "kernel_launch: cooperative launch failed: %s (grid %d)\n", hipGetErrorString(e), grid);
#endif
}
```

```cpp
#include <hip/hip_runtime.h>
#include <hip/hip_cooperative_groups.h>
#include <cstdio>
#include <cstdint>
#include <cmath>
namespace cg = cooperative_groups;
#define MK_MULTI 0
namespace pg8 {
#define PG8_LAS __attribute__((address_space(3)))
typedef unsigned short bf16_t;
typedef short bf16x8 __attribute__((ext_vector_type(8)));
typedef float f32x4 __attribute__((ext_vector_type(4)));
typedef unsigned u32x4 __attribute__((ext_vector_type(4)));
constexpr int BM = 256, BK = 64, HALF = 128, HTB = HALF * BK * 2  , STAGE_BYTES = 8 * HTB, NXCD = 8, WGM = 8;

__host__ __device__ __forceinline__ int lds_byte(int r, int c) { const int st = (r >> 4) * 2 + (c >> 5), rr = r & 15, cc = c & 31, ob = rr * 64 + cc * 2; return st * 1024 + (ob ^ (((ob >> 9) & 1) << 5)); }
__host__ __device__ __forceinline__ void stage_rc(int b, int& R, int& C) { const int st = b / 1024, sb = b % 1024, swz = sb ^ (((sb >> 9) & 1) << 5); R = (st >> 1) * 16 + swz / 64; C = (st & 1) * 32 + (swz % 64) / 2; }
__host__ __device__ __forceinline__ int perm32(int rho) { const int n = rho >> 4, i = rho & 15; return 8 * (i >> 2) + 4 * n + (i & 3); }

struct Unit { int pm, pn; };
struct Gemm { const bf16_t* A; const bf16_t* Bt; int M, N, K; };

struct StaticOrder {
    int nM, nN, nwg, G, c;
    __host__ __device__ void init(int M, int N, int G_, int c_) { nM = M / BM; nN = N / BM; nwg = nM * nN; G = G_; c = c_; }
    __host__ __device__ bool next(int i, Unit& u) const {
        const long L = (long)i * G + c; if (L >= nwg) return false;
        int wgid = (int)L; { const int q = nwg / NXCD, r = nwg % NXCD, xcd = wgid % NXCD, off = wgid / NXCD; wgid = (xcd < r ? xcd * (q + 1) : r * (q + 1) + (xcd - r) * q) + off; }
        const int nig = WGM * nN, gid = wgid / nig, fm = gid * WGM, gsz = (nM - fm) < WGM ? (nM - fm) : WGM;
        u.pm = fm + ((wgid % nig) % gsz); u.pn = (wgid % nig) / gsz; return true;
    }
    __device__ __forceinline__ void a_ready(const Unit&) const {}
    __device__ __forceinline__ void done(const Unit&) const {}
};

__device__ __forceinline__ unsigned cvt_pk_bf16(float lo, float hi) { unsigned r; asm volatile("v_cvt_pk_bf16_f32 %0, %1, %2" : "=v"(r) : "v"(lo), "v"(hi)); return r; }
template <class Epi, class Sched, bool ALIGN_EPI = false, bool SP2 = false>
__device__ __forceinline__ void gemm_phase(PG8_LAS unsigned char* lds, const Gemm g, const Sched& S, const Epi& E) {
    const int tid = threadIdx.x, wid = __builtin_amdgcn_readfirstlane(tid >> 6), lane = tid & 63, wr = wid >> 2, wc = wid & 3, fr = lane & 15, fq = lane >> 4;
    const int K = g.K, nt = K / BK;
    unsigned voffA[2], voffB[2];
#pragma unroll
    for (int i = 0; i < 2; ++i) { int R, C; stage_rc(tid * 16 + i * 8192, R, C); const int Rb = Epi::PERM ? ((R & ~31) + perm32(R & 31)) : R;
        voffA[i] = (unsigned)(R * K + C) * 2u; voffB[i] = (unsigned)(Rb * K + C) * 2u; }
    const size_t kstep = (size_t)(BK * 2);
    const size_t hstep = (size_t)HALF * K * 2;
    const size_t tstep = 2 * hstep;
    const unsigned ldsw = (unsigned)wid * 1024u;
    const int aoff = lds_byte(wr * 64 + fr, fq * 8), boff = lds_byte(wc * 32 + fr, fq * 8);
#define PG8_SA(b, h) (((b) * 2 + (h)) * HTB)
#define PG8_SB(b, h) ((4 + (b) * 2 + (h)) * HTB)
#define PG8_STAGE(bufoff, gbase, voff) do { _Pragma("unroll") for (int _i = 0; _i < 2; ++_i) \
        __builtin_amdgcn_global_load_lds((const unsigned*)((const char*)(gbase) + (voff)[_i]), (PG8_LAS unsigned*)(lds + (bufoff) + ldsw + _i * 8192), 16, 0, 0); } while (0)
#define PG8_LDA(dst, b, h) do { _Pragma("unroll") for (int m = 0; m < 4; ++m) _Pragma("unroll") for (int k = 0; k < 2; ++k) dst[m][k] = *(const PG8_LAS bf16x8*)(lds + PG8_SA(b, h) + aoff + m * 2048 + k * 1024); } while (0)
#define PG8_LDB(dst, b, h) do { _Pragma("unroll") for (int n = 0; n < 2; ++n) _Pragma("unroll") for (int k = 0; k < 2; ++k) dst[n][k] = *(const PG8_LAS bf16x8*)(lds + PG8_SB(b, h) + boff + n * 2048 + k * 1024); } while (0)
#define PG8_MMA(ai, bj, At, Bt) do { __builtin_amdgcn_s_setprio(1); _Pragma("unroll") for (int m = 0; m < 4; ++m) _Pragma("unroll") for (int n = 0; n < 2; ++n) _Pragma("unroll") for (int k = 0; k < 2; ++k) \
        acc[ai][bj][m][n] = __builtin_amdgcn_mfma_f32_16x16x32_bf16(Bt[n][k], At[m][k], acc[ai][bj][m][n], 0, 0, 0); __builtin_amdgcn_s_setprio(0); } while (0)
#define PG8_WAIT_V(n) asm volatile("s_waitcnt vmcnt(" #n ")" ::: "memory")
#define PG8_WAIT_L(n) asm volatile("s_waitcnt lgkmcnt(" #n ")" ::: "memory")
#define PG8_BAR __builtin_amdgcn_s_barrier()
#define PG8_SCHED __builtin_amdgcn_sched_barrier(0)
    Unit cur, nxt; int ui = 0;
    if (!S.next(0, cur)) return;
    f32x4 acc[2][2][4][2];
#pragma unroll
    for (int a = 0; a < 2; ++a)
#pragma unroll
        for (int b = 0; b < 2; ++b)
#pragma unroll
            for (int m = 0; m < 4; ++m)
#pragma unroll
                for (int n = 0; n < 2; ++n) acc[a][b][m][n] = (f32x4){0.f, 0.f, 0.f, 0.f};
    bf16x8 At[4][2], B0[2][2], B1[2][2];
    const char* cA = (const char*)g.A + (size_t)cur.pm * tstep; const char* cB = (const char*)g.Bt + (size_t)cur.pn * tstep;
    S.a_ready(cur);
    if constexpr (SP2) {
        PG8_STAGE(PG8_SB(0, 0), cB, voffB); PG8_STAGE(PG8_SB(0, 1), cB + hstep, voffB); PG8_STAGE(PG8_SA(0, 0), cA, voffA); PG8_STAGE(PG8_SA(0, 1), cA + hstep, voffA);
        if (wr == 1) PG8_BAR;
        PG8_WAIT_V(2); PG8_BAR;
        PG8_STAGE(PG8_SB(1, 0), cB + kstep, voffB); PG8_STAGE(PG8_SA(1, 0), cA + kstep, voffA); PG8_STAGE(PG8_SB(1, 1), cB + hstep + kstep, voffB);
        PG8_WAIT_V(6); PG8_BAR;
    } else {
        PG8_STAGE(PG8_SB(0, 0), cB, voffB); PG8_STAGE(PG8_SA(0, 0), cA, voffA); PG8_STAGE(PG8_SB(0, 1), cB + hstep, voffB); PG8_STAGE(PG8_SA(0, 1), cA + hstep, voffA);
        if (wr == 1) PG8_BAR;
        PG8_WAIT_V(4); PG8_BAR;
        PG8_STAGE(PG8_SB(1, 0), cB + kstep, voffB); PG8_STAGE(PG8_SA(1, 0), cA + kstep, voffA); PG8_STAGE(PG8_SB(1, 1), cB + hstep + kstep, voffB);
        PG8_WAIT_V(6); PG8_BAR;
    }
    for (;;) {
        const bool has_next = S.next(ui + 1, nxt);
        const char* nA = has_next ? (const char*)g.A + (size_t)nxt.pm * tstep : cA; const char* nB = has_next ? (const char*)g.Bt + (size_t)nxt.pn * tstep : cB;
        for (int t = 0; t < nt; t += 2) {
            const bool last = (t == nt - 2);
            const char* a1 = cA + (size_t)(t + 1) * kstep;
            const char* a2 = last ? nA : cA + (size_t)(t + 2) * kstep; const char* b2 = last ? nB : cB + (size_t)(t + 2) * kstep;
            const char* a3 = a2 + kstep; const char* b3 = b2 + kstep;
            if (last && has_next) S.a_ready(nxt);
            if constexpr (SP2) {
            PG8_LDB(B0, 0, 0); PG8_LDB(B1, 0, 1); PG8_SCHED; PG8_LDA(At, 0, 0); PG8_STAGE(PG8_SA(1, 1), a1 + hstep, voffA);
            PG8_WAIT_V(8); PG8_WAIT_L(0); PG8_BAR; PG8_MMA(0, 0, At, B0); PG8_MMA(0, 1, At, B1); PG8_BAR; PG8_SCHED;
            PG8_LDA(At, 0, 1); PG8_STAGE(PG8_SB(0, 0), b2, voffB); PG8_STAGE(PG8_SB(0, 1), b2 + hstep, voffB); PG8_STAGE(PG8_SA(0, 0), a2, voffA);
            PG8_WAIT_V(8); PG8_WAIT_L(0); PG8_BAR; PG8_MMA(1, 0, At, B0); PG8_MMA(1, 1, At, B1); PG8_BAR; PG8_SCHED;
            PG8_LDB(B0, 1, 0); PG8_LDB(B1, 1, 1); PG8_SCHED; PG8_LDA(At, 1, 0); PG8_STAGE(PG8_SA(0, 1), a2 + hstep, voffA);
            PG8_WAIT_V(8); PG8_WAIT_L(0); PG8_BAR; PG8_MMA(0, 0, At, B0); PG8_MMA(0, 1, At, B1); PG8_BAR; PG8_SCHED;
            PG8_LDA(At, 1, 1); PG8_STAGE(PG8_SB(1, 0), b3, voffB); PG8_STAGE(PG8_SB(1, 1), b3 + hstep, voffB); PG8_STAGE(PG8_SA(1, 0), a3, voffA);
            PG8_WAIT_V(8); PG8_WAIT_L(0); PG8_BAR; PG8_MMA(1, 0, At, B0); PG8_MMA(1, 1, At, B1); PG8_BAR; PG8_SCHED;
            } else {
            PG8_LDB(B0, 0, 0); PG8_SCHED; PG8_LDA(At, 0, 0); PG8_STAGE(PG8_SA(1, 1), a1 + hstep, voffA);
            PG8_WAIT_L(8); PG8_BAR; PG8_WAIT_L(0); PG8_MMA(0, 0, At, B0); PG8_BAR; PG8_SCHED;
            PG8_LDB(B1, 0, 1); PG8_STAGE(PG8_SB(0, 0), b2, voffB);
            PG8_BAR; PG8_WAIT_L(0); PG8_MMA(0, 1, At, B1); PG8_BAR;
            PG8_LDA(At, 0, 1); PG8_STAGE(PG8_SA(0, 0), a2, voffA);
            PG8_BAR; PG8_WAIT_L(0); PG8_MMA(1, 0, At, B0); PG8_BAR; PG8_SCHED;
            PG8_STAGE(PG8_SB(0, 1), b2 + hstep, voffB);
            PG8_WAIT_V(6); PG8_BAR; PG8_MMA(1, 1, At, B1); PG8_BAR;
            PG8_LDB(B0, 1, 0); PG8_SCHED; PG8_LDA(At, 1, 0); PG8_STAGE(PG8_SA(0, 1), a2 + hstep, voffA);
            PG8_WAIT_L(8); PG8_BAR; PG8_WAIT_L(0); PG8_MMA(0, 0, At, B0); PG8_BAR; PG8_SCHED;
            PG8_LDB(B1, 1, 1); PG8_STAGE(PG8_SB(1, 0), b3, voffB);
            PG8_BAR; PG8_WAIT_L(0); PG8_MMA(0, 1, At, B1); PG8_BAR;
            PG8_LDA(At, 1, 1); PG8_STAGE(PG8_SA(1, 0), a3, voffA);
            PG8_BAR; PG8_WAIT_L(0); PG8_MMA(1, 0, At, B0); PG8_BAR; PG8_SCHED;
            PG8_STAGE(PG8_SB(1, 1), b3 + hstep, voffB);
            PG8_WAIT_V(6); PG8_BAR; PG8_MMA(1, 1, At, B1); PG8_BAR;
            }
        }
        if constexpr (ALIGN_EPI) { if (wr == 0) PG8_BAR; }
        if constexpr (!Epi::AFTER_DRAIN) { E(acc, cur, wr, wc, fr, fq); S.done(cur); }
        if (!has_next) break;
#pragma unroll
        for (int a = 0; a < 2; ++a)
#pragma unroll
            for (int b = 0; b < 2; ++b)
#pragma unroll
                for (int m = 0; m < 4; ++m)
#pragma unroll
                    for (int n = 0; n < 2; ++n) acc[a][b][m][n] = (f32x4){0.f, 0.f, 0.f, 0.f};
        cur = nxt; cA = nA; cB = nB; ++ui;
        if constexpr (ALIGN_EPI) { if (wr == 1) PG8_BAR; }
    }
    PG8_WAIT_V(0);
    if constexpr (!ALIGN_EPI) { if (wr == 0) PG8_BAR; }
    PG8_BAR;
    if constexpr (Epi::AFTER_DRAIN) { E.fused(acc, cur, wr, wc, fr, fq, lds, wid, lane); S.done(cur); }
#undef PG8_SA
#undef PG8_SB
#undef PG8_STAGE
#undef PG8_LDA
#undef PG8_LDB
#undef PG8_MMA
#undef PG8_WAIT_V
#undef PG8_WAIT_L
#undef PG8_BAR
#undef PG8_SCHED
}
}

#define LAS __attribute__((address_space(3)))
typedef unsigned short bf16_t;
typedef short bf16x8 __attribute__((ext_vector_type(8)));
typedef float f32x4 __attribute__((ext_vector_type(4)));
typedef float f32x16 __attribute__((ext_vector_type(16)));
typedef unsigned u32x4 __attribute__((ext_vector_type(4)));
typedef unsigned u32x2 __attribute__((ext_vector_type(2)));

#ifndef MK_MULTI
#define MK_MULTI 0
#endif

constexpr int DM = 1024, MP = 16384, MS = 2048, MT = MP + MS;
constexpr int NPROJ = 3328, NPJ = 3072, DFF = 2816;
constexpr float EPS = 1e-6f;
constexpr float LOG2E = 1.4426950408889634f;
constexpr float QSCALE2 = 0.125f * LOG2E;
constexpr size_t O_Y = 0, O_GSP = 18874368, O_FKP = 19922944, O_FVP = 36700160, O_FLP = 53477376, O_GSS = 53739520, O_FKS = 57933824, O_FVS = 60030976, O_FLS = 62128128;
constexpr size_t MiB = 1u << 20;
constexpr size_t WS_CTL = 0, CTL_BYTES = 2 * MiB;
constexpr size_t WS_SS = 65536;
constexpr size_t WS_WGIN = 2 * MiB, WS_WFIN = 9 * MiB, WS_WGOUT = 16 * MiB, WS_WFOUT = 18 * MiB, WS_WFFI = 20 * MiB  , WS_WFFD = 42 * MiB  ;
constexpr size_t WS_XB = 54 * MiB, WS_XR = 90 * MiB, WS_PROJ = 162 * MiB, WS_GL = 270 * MiB, WS_DST = 272 * MiB, WS_DEC = 400 * MiB, WS_SPREV = 401 * MiB;
constexpr size_t WS_OG = 465 * MiB, WS_ACT = 501 * MiB, WS_CP = 600 * MiB, WS_CS = 601 * MiB, WS_END = 606 * MiB;
constexpr int LDS_BYTES = 135168;

struct Args {
    const float* in[19];
    float* out; unsigned char* ws;
    int ph_lo, ph_hi;
};
enum { I_XP = 0, I_XS, I_STATE, I_CK, I_CV, I_CLF, I_NMIX, I_GWIN, I_GWG2, I_GBG, I_GNORM, I_GWOUT, I_FWIN, I_FBF, I_FWOUT, I_NFFN, I_FFIN, I_FFDN, I_NFIN };

__device__ __forceinline__ float bf2f(unsigned u) { return __uint_as_float(u << 16); }
__device__ __forceinline__ unsigned f2bf(float f) { unsigned u = __float_as_uint(f); return (u + 0x7fffu + ((u >> 16) & 1u)) >> 16; }
__device__ __forceinline__ unsigned pk(float lo, float hi) { return pg8::cvt_pk_bf16(lo, hi); }
__device__ __forceinline__ float wave_sum(float v) {
#pragma unroll
    for (int o = 1; o < 64; o <<= 1) v += __shfl_xor(v, o);
    return v;
}
__device__ __forceinline__ float log_sigmoid(float z) { return fminf(z, 0.f) - __logf(1.f + __expf(-fabsf(z))); }
__device__ __forceinline__ int crow(int r, int hi) { return (r & 3) + 8 * (r >> 2) + 4 * hi; }
__device__ __forceinline__ float dot4(f32x4 v) { return (v[0] * v[0] + v[1] * v[1]) + (v[2] * v[2] + v[3] * v[3]); }
#define MFMA32(a, b, c) __builtin_amdgcn_mfma_f32_32x32x16_bf16((a), (b), (c), 0, 0, 0)

#define XB_TMO      128
#define XB_XCNT(j)  (256  + 64 * (j))
#define XB_XSUB(j)  (1280 + 64 * (j))
#define XB_XGEN(j)  (2304 + 64 * (j))
#define XB_TOP      3328
#define XB_TOPGEN   3392
#define XCD_BAR_WORDS 3456
#define XB_SPIN_CAP (1u << 18)

__device__ __forceinline__ unsigned xb_ld(unsigned* p)              { return __hip_atomic_load(p, __ATOMIC_RELAXED, __HIP_MEMORY_SCOPE_AGENT); }
__device__ __forceinline__ unsigned xb_add(unsigned* p, unsigned v) { return __hip_atomic_fetch_add(p, v, __ATOMIC_RELAXED, __HIP_MEMORY_SCOPE_AGENT); }
__device__ __forceinline__ unsigned xb_xcc_id() { return (unsigned)__builtin_amdgcn_s_getreg((3 << 11) | 20) & 0xFu; }
#define XB_SPIN(cond, bar) do { unsigned _sp = 0; while (cond) { __builtin_amdgcn_s_sleep(1); \
    if ((++_sp & 255u) == 0u) { if (xb_ld(&(bar)[XB_TMO])) break; if (_sp > XB_SPIN_CAP) { atomicAdd(&(bar)[XB_TMO], 1u); break; } } } } while (0)

struct XcdBarrier {
    unsigned* bar; unsigned x;
    volatile LAS unsigned* st;
};

__device__ __forceinline__ XcdBarrier xcd_barrier_post(unsigned* bar, volatile LAS unsigned* st) {
    XcdBarrier b; b.bar = bar; b.x = xb_xcc_id(); b.st = st;
    if (threadIdx.x == 0) (void)xb_add(&bar[XB_XCNT(b.x)], 1u);
    return b;
}
__device__ __forceinline__ void xcd_barrier_complete(unsigned* bar, unsigned x, unsigned& nloc, unsigned& nx) {
    const unsigned G = gridDim.x * gridDim.y * gridDim.z;
    unsigned sum, cnt, mine, sp = 0u;
    for (;;) {
        sum = 0u; cnt = 0u; mine = 0u;
#pragma unroll
        for (unsigned j = 0; j < 16; ++j) { const unsigned c = xb_ld(&bar[XB_XCNT(j)]); sum += c; cnt += (c > 0u) ? 1u : 0u; mine = (j == x) ? c : mine; }
        if (sum == G) break;
        __builtin_amdgcn_s_sleep(1);
        if ((++sp & 255u) == 0u) { if (xb_ld(&bar[XB_TMO])) break; if (sp > XB_SPIN_CAP) { atomicAdd(&bar[XB_TMO], 1u); break; } }
    }
    nloc = mine > 0u ? mine : 1u; nx = cnt > 0u ? cnt : 1u;
}

__device__ __forceinline__ void xcd_barrier(const XcdBarrier& b) {
    asm volatile("s_waitcnt vmcnt(0)" ::: "memory");
    __syncthreads();
    if (threadIdx.x == 0) {
        unsigned* bar = b.bar;
        __builtin_amdgcn_s_waitcnt(0);
        unsigned nloc = b.st[0], nx = b.st[1];
        if (nloc == 0u) { xcd_barrier_complete(bar, b.x, nloc, nx); b.st[0] = nloc; b.st[1] = nx; }
        const unsigned old = xb_add(&bar[XB_XSUB(b.x)], 1u);
        const unsigned gen = old / nloc;
        if (old + 1u == (gen + 1u) * nloc) {
            __builtin_amdgcn_fence(__ATOMIC_RELEASE, "agent");
            asm volatile("s_waitcnt vmcnt(0)" ::: "memory");
            const unsigned og = xb_add(&bar[XB_TOP], 1u);
            const unsigned tg = og / nx;
            if (og + 1u == (tg + 1u) * nx) xb_add(&bar[XB_TOPGEN], 1u);
            else XB_SPIN(xb_ld(&bar[XB_TOPGEN]) == tg, bar);
            __builtin_amdgcn_fence(__ATOMIC_ACQUIRE, "agent");
            xb_add(&bar[XB_XGEN(b.x)], 1u);
            asm volatile("s_waitcnt vmcnt(0)" ::: "memory");
        } else {
            XB_SPIN(xb_ld(&bar[XB_XGEN(b.x)]) == gen, bar);
            __builtin_amdgcn_fence(__ATOMIC_ACQUIRE, "agent");
            asm volatile("s_waitcnt vmcnt(0)" ::: "memory");
        }
    }
    __syncthreads();
}

__device__ __forceinline__ void tr_item(const float* __restrict__ W, int K, int N, int nsrc0, bf16_t* WT, int drow0, const float* __restrict__ gain, LAS float* scr, int k0, int lane) {
    const int n = nsrc0 + (lane & 31);
    float wv_[32];
    const float* wp_ = W + (size_t)(k0 + (lane >> 5)) * N + ((n < N) ? n : 0);
#pragma unroll
    for (int i = 0; i < 32; ++i) wv_[i] = wp_[(size_t)(2 * i) * N];
#pragma unroll
    for (int i = 0; i < 32; ++i) {
        const int kk = 2 * i + (lane >> 5);
        float v = (n < N) ? wv_[i] : 0.f;
        if (gain) v *= gain[k0 + kk];
        scr[kk * 33 + (lane & 31)] = v;
    }
    asm volatile("s_waitcnt lgkmcnt(0)" ::: "memory");
    const int c = lane & 7;
#pragma unroll
    for (int j = 0; j < 4; ++j) {
        const int nn = (lane >> 3) + 8 * j; const LAS float* s = scr + (8 * c) * 33 + nn;
        u32x4 o; o.x = pk(s[0 * 33], s[1 * 33]); o.y = pk(s[2 * 33], s[3 * 33]); o.z = pk(s[4 * 33], s[5 * 33]); o.w = pk(s[6 * 33], s[7 * 33]);
        *(u32x4*)(WT + (size_t)(drow0 + nn) * K + k0 + 8 * c) = o;
    }
    asm volatile("s_waitcnt lgkmcnt(0)" ::: "memory");
}

__device__ __forceinline__ void convert_weights(const Args& a, LAS unsigned char* lds, int sel, int gw, int NGW) {
    const int tid = threadIdx.x, lane = tid & 63, wave = tid >> 6;
    LAS float* scr = (LAS float*)(lds + wave * 16384);
    unsigned char* ws = a.ws;
    constexpr int I_IN = 16 * 104, I_OUT = 16 * 32, I_FI = 16 * 176, I_FD = 44 * 32;
    constexpr int NITEMS = I_IN + I_OUT + I_FI + I_FD;
    for (int it = gw; it < NITEMS; it += NGW) {
        int r = it;
        if (r < I_IN) { const int kb = r / 104, nb = r % 104; tr_item(a.in[sel ? I_FWIN : I_GWIN], 1024, 3088, 32 * nb, (bf16_t*)(ws + (sel ? WS_WFIN : WS_WGIN)), 32 * nb, a.in[I_NMIX] + sel * 1024, scr, 64 * kb, lane); continue; } r -= I_IN;
        if (r < I_OUT) { const int kb = r / 32, nb = r % 32; tr_item(a.in[sel ? I_FWOUT : I_GWOUT], 1024, 1024, 32 * nb, (bf16_t*)(ws + (sel ? WS_WFOUT : WS_WGOUT)), 32 * nb, nullptr, scr, 64 * kb, lane); continue; } r -= I_OUT;
        if (r < I_FI) { const int kb = r / 176, nb = r % 176, ns = 32 * nb, bj = ns / DFF, j = ns % DFF, drow = 256 * (j / 128) + 128 * bj + (j % 128);
            tr_item(a.in[I_FFIN] + (size_t)sel * 1024 * 5632, 1024, 5632, ns, (bf16_t*)(ws + WS_WFFI + (size_t)sel * 11 * MiB), drow, a.in[I_NFFN] + sel * 1024, scr, 64 * kb, lane); continue; } r -= I_FI;
        { const int kb = r / 32, nb = r % 32;
            tr_item(a.in[I_FFDN] + (size_t)sel * DFF * 1024, DFF, 1024, 32 * nb, (bf16_t*)(ws + WS_WFFD + (size_t)sel * 6 * MiB), 32 * nb, nullptr, scr, 64 * kb, lane); }
    }
}
__device__ __forceinline__ void p0_prologue(const Args& a, LAS unsigned char* lds, int vcu, int G) {
    const int tid = threadIdx.x, lane = tid & 63, wave = tid >> 6;
    const int gw = vcu * 8 + wave, NGW = G * 8;
    unsigned char* ws = a.ws;
    convert_weights(a, lds, 0, gw, NGW);
    if (G != 256 || MK_MULTI) convert_weights(a, lds, 1, gw, NGW);
    float* ss0 = (float*)(ws + WS_SS);
    bf16_t* XB = (bf16_t*)(ws + WS_XB);
    for (int m0 = gw; m0 < MT; m0 += 3 * NGW) {
        f32x4 v[3][4];
#pragma unroll
        for (int q = 0; q < 3; ++q) { const int m = m0 + q * NGW; if (m < MT) { const float* xr = (m < MP) ? a.in[I_XP] + (size_t)m * DM : a.in[I_XS] + (size_t)(m - MP) * DM;
#pragma unroll
            for (int j = 0; j < 4; ++j) v[q][j] = ((const f32x4*)xr)[lane + 64 * j]; } }
#pragma unroll
        for (int q = 0; q < 3; ++q) { const int m = m0 + q * NGW; if (m < MT) { float s = 0.f;
#pragma unroll
            for (int j = 0; j < 4; ++j) s += dot4(v[q][j]);
            s = wave_sum(s);
            if (lane == 0) ss0[m] = s;
#pragma unroll
            for (int j = 0; j < 4; ++j) { u32x2 o; o.x = pk(v[q][j][0], v[q][j][1]); o.y = pk(v[q][j][2], v[q][j][3]); ((u32x2*)(XB + (size_t)m * DM))[lane + 64 * j] = o; } } }
    }
}

__device__ __forceinline__ void p_final(const Args& a, int vcu, int G) {
    const int tid = threadIdx.x, lane = tid & 63, wave = tid >> 6;
    const int gw = vcu * 8 + wave, NGW = G * 8;
    const float* ss = (const float*)(a.ws + WS_SS + 4 * 131072);
    const float* XR = (const float*)(a.ws + WS_XR);
    const float* g = a.in[I_NFIN];
    f32x4 gv[4];
#pragma unroll
    for (int j = 0; j < 4; ++j) gv[j] = ((const f32x4*)g)[lane + 64 * j];
    for (int m0 = gw; m0 < MT; m0 += 3 * NGW) {
        f32x4 v[3][4]; float rs[3];
#pragma unroll
        for (int q = 0; q < 3; ++q) { const int m = m0 + q * NGW; if (m < MT) { rs[q] = rsqrtf(ss[m] * (1.f / DM) + EPS);
#pragma unroll
            for (int j = 0; j < 4; ++j) v[q][j] = ((const f32x4*)(XR + (size_t)m * DM))[lane + 64 * j]; } }
#pragma unroll
        for (int q = 0; q < 3; ++q) { const int m = m0 + q * NGW; if (m < MT) {
#pragma unroll
            for (int j = 0; j < 4; ++j) ((f32x4*)(a.out + O_Y + (size_t)m * DM))[lane + 64 * j] = v[q][j] * rs[q] * gv[j]; } }
    }
}

struct EpiGlaProj {
    static constexpr bool PERM = true, AFTER_DRAIN = false;
    const float* ss; bf16_t* proj; float* gl;
    __device__ __forceinline__ void operator()(const pg8::f32x4 (&acc)[2][2][4][2], const pg8::Unit& u, int wr, int wc, int fr, int fq) const {
        const int row0 = u.pm * 256 + wr * 64 + fr;
#pragma unroll
        for (int ai = 0; ai < 2; ++ai)
#pragma unroll
            for (int m = 0; m < 4; ++m) {
                const int row = row0 + ai * 128 + m * 16; const float rs = rsqrtf(ss[row] * (1.f / DM) + EPS);
                if (u.pn < 12) {
#pragma unroll
                    for (int bj = 0; bj < 2; ++bj) { const f32x4 v0 = acc[ai][bj][m][0] * rs, v1 = acc[ai][bj][m][1] * rs;
                        u32x4 w; w.x = pk(v0[0], v0[1]); w.y = pk(v0[2], v0[3]); w.z = pk(v1[0], v1[1]); w.w = pk(v1[2], v1[3]);
                        *(u32x4*)(proj + (size_t)row * NPJ + u.pn * 256 + bj * 128 + wc * 32 + 8 * fq) = w; }
                } else if (wc == 0 && fq < 2) {
#pragma unroll
                    for (int n = 0; n < 2; ++n) *(f32x4*)(gl + (size_t)row * 16 + 8 * fq + 4 * n) = acc[ai][0][m][n] * rs;
                }
            }
    }
};
struct EpiResid {
    static constexpr bool PERM = true, AFTER_DRAIN = false;
    const float* xin_p; const float* xin_s; float* xout; bf16_t* xb; float* ssout;
    __device__ __forceinline__ void operator()(const pg8::f32x4 (&acc)[2][2][4][2], const pg8::Unit& u, int wr, int wc, int fr, int fq) const {
        const int row0 = u.pm * 256 + wr * 64 + fr;
#pragma unroll
        for (int ai = 0; ai < 2; ++ai)
#pragma unroll
            for (int m = 0; m < 4; ++m) {
                const int row = row0 + ai * 128 + m * 16;
                const float* xi = (row < MP) ? xin_p + (size_t)row * DM : xin_s + (size_t)(row - MP) * DM;
                float sq = 0.f;
#pragma unroll
                for (int bj = 0; bj < 2; ++bj) { const int col = u.pn * 256 + bj * 128 + wc * 32 + 8 * fq;
                    const f32x4 a0 = *(const f32x4*)(xi + col) + acc[ai][bj][m][0], a1 = *(const f32x4*)(xi + col + 4) + acc[ai][bj][m][1];
                    *(f32x4*)(xout + (size_t)row * DM + col) = a0; *(f32x4*)(xout + (size_t)row * DM + col + 4) = a1;
                    u32x4 w; w.x = pk(a0[0], a0[1]); w.y = pk(a0[2], a0[3]); w.z = pk(a1[0], a1[1]); w.w = pk(a1[2], a1[3]);
                    *(u32x4*)(xb + (size_t)row * DM + col) = w;
                    sq += dot4(a0) + dot4(a1); }
                sq += __shfl_xor(sq, 16); sq += __shfl_xor(sq, 32);
                if (fq == 0) atomicAdd(ssout + row, sq);
            }
    }
};
struct EpiSwiglu {
    static constexpr bool PERM = true, AFTER_DRAIN = false;
    const float* ss; bf16_t* act;
    __device__ __forceinline__ void operator()(const pg8::f32x4 (&acc)[2][2][4][2], const pg8::Unit& u, int wr, int wc, int fr, int fq) const {
        const int row0 = u.pm * 256 + wr * 64 + fr;
#pragma unroll
        for (int ai = 0; ai < 2; ++ai)
#pragma unroll
            for (int m = 0; m < 4; ++m) {
                const int row = row0 + ai * 128 + m * 16; const float rs = rsqrtf(ss[row] * (1.f / DM) + EPS);
                float y[8];
#pragma unroll
                for (int n = 0; n < 2; ++n)
#pragma unroll
                    for (int i = 0; i < 4; ++i) { const float g = acc[ai][0][m][n][i] * rs, up = acc[ai][1][m][n][i] * rs; y[4 * n + i] = g * up * __builtin_amdgcn_rcpf(1.f + __expf(-g)); }
                u32x4 w; w.x = pk(y[0], y[1]); w.y = pk(y[2], y[3]); w.z = pk(y[4], y[5]); w.w = pk(y[6], y[7]);
                *(u32x4*)(act + (size_t)row * DFF + u.pn * 128 + wc * 32 + 8 * fq) = w;
            }
    }
};
struct EpiFoxProj {
    static constexpr bool PERM = true, AFTER_DRAIN = false;
    const float* ss; bf16_t* qkv; float* out; const float* bf;
    __device__ __forceinline__ void operator()(const pg8::f32x4 (&acc)[2][2][4][2], const pg8::Unit& u, int wr, int wc, int fr, int fq) const {
        const int row0 = u.pm * 256 + wr * 64 + fr;
        const int sect = u.pn >> 2;
#pragma unroll
        for (int ai = 0; ai < 2; ++ai)
#pragma unroll
            for (int m = 0; m < 4; ++m) {
                const int row = row0 + ai * 128 + m * 16; const float rs = rsqrtf(ss[row] * (1.f / DM) + EPS);
                if (u.pn < 12) {
                    const float sc = (sect == 0) ? rs * QSCALE2 : rs;
                    float* fdst = nullptr;
                    if (sect == 1) fdst = (row < MP) ? out + O_FKP + (size_t)row * DM : out + O_FKS + (size_t)(row - MP) * DM;
                    if (sect == 2) fdst = (row < MP) ? out + O_FVP + (size_t)row * DM : out + O_FVS + (size_t)(row - MP) * DM;
#pragma unroll
                    for (int bj = 0; bj < 2; ++bj) { const f32x4 v0 = acc[ai][bj][m][0] * sc, v1 = acc[ai][bj][m][1] * sc;
                        u32x4 w; w.x = pk(v0[0], v0[1]); w.y = pk(v0[2], v0[3]); w.z = pk(v1[0], v1[1]); w.w = pk(v1[2], v1[3]);
                        const int cl = bj * 128 + wc * 32 + 8 * fq;
                        *(u32x4*)(qkv + (size_t)row * NPJ + u.pn * 256 + cl) = w;
                        if (sect > 0) { float* d = fdst + (u.pn & 3) * 256 + cl; *(f32x4*)d = v0; *(f32x4*)(d + 4) = v1; } }
                } else if (wc == 0 && fq < 2) {
                    float* d = (row < MP) ? out + O_FLP + (size_t)row * 16 : out + O_FLS + (size_t)(row - MP) * 16;
#pragma unroll
                    for (int n = 0; n < 2; ++n) { const f32x4 v = acc[ai][0][m][n] * rs; f32x4 o;
#pragma unroll
                        for (int i = 0; i < 4; ++i) o[i] = log_sigmoid(v[i] + bf[8 * fq + 4 * n + i]);
                        *(f32x4*)(d + 8 * fq + 4 * n) = o; }
                }
            }
    }
};

constexpr int GL_OFF = 0, GSUM_OFF = 4096, DECS_OFF = 6144, QE_OFF = 8192, KE_OFF = 25600, VT_OFF = 43008, AL_OFF = 79872, KDT_OFF = 8192, OL_OFF = 8192;
constexpr int QES = 136, VTS = 72, OLS = 260;

template <int MODE> __device__ __forceinline__ void gla_item(const Args& a, LAS unsigned char* lds, int cid, int h) {
    const int tid = threadIdx.x, lane = tid & 63, w = tid >> 6, l31 = lane & 31, hi = lane >> 5;
    const int row0 = cid * 64;
    const bool prompt = cid < 256;
    LAS float* GLs = (LAS float*)(lds + GL_OFF); LAS float* GSUM = (LAS float*)(lds + GSUM_OFF); LAS float* DECS = (LAS float*)(lds + DECS_OFF);
    LAS bf16_t* QE = (LAS bf16_t*)(lds + QE_OFF); LAS bf16_t* KE = (LAS bf16_t*)(lds + KE_OFF); LAS bf16_t* VT = (LAS bf16_t*)(lds + VT_OFF);
    LAS bf16_t* AL = (LAS bf16_t*)(lds + AL_OFF); LAS bf16_t* KDT = (LAS bf16_t*)(lds + KDT_OFF);
    const bf16_t* P = (const bf16_t*)(a.ws + WS_PROJ) + (size_t)row0 * NPJ;
    const float* GL = (const float*)(a.ws + WS_GL);
    const float* state = a.in[I_STATE];

    bf16x8 sfr[8];
    if (MODE == 1) {
        if (prompt) {
            const bf16_t* sp = (const bf16_t*)(a.ws + WS_SPREV) + ((size_t)(cid * 4 + h) * 256 + 32 * w + l31) * 128 + 8 * hi;
#pragma unroll
            for (int ks = 0; ks < 8; ++ks) sfr[ks] = *(const bf16x8*)(sp + 16 * ks);
        } else {
            const float* s0 = state + ((size_t)((cid - 256) * 4 + h) * 128) * 256 + 32 * w + l31;
#pragma unroll
            for (int ks = 0; ks < 8; ++ks) { float f[8];
#pragma unroll
                for (int j = 0; j < 8; ++j) f[j] = s0[(size_t)(16 * ks + 8 * hi + j) * 256];
                u32x4 o; o.x = pk(f[0], f[1]); o.y = pk(f[2], f[3]); o.z = pk(f[4], f[5]); o.w = pk(f[6], f[7]); sfr[ks] = __builtin_bit_cast(bf16x8, o); }
        }
    }
    unsigned kraw[16], qraw[16];
    {
        const int dk_ = tid & 127, tg_ = tid >> 7;
        const bf16_t* kp_ = P + (size_t)(16 * tg_) * NPJ + 512 + h * 128 + dk_;
#pragma unroll
        for (int i = 0; i < 16; ++i) kraw[i] = kp_[(size_t)i * NPJ];
        if (MODE == 1) { const bf16_t* qp_ = P + (size_t)(16 * tg_) * NPJ + h * 128 + dk_;
#pragma unroll
            for (int i = 0; i < 16; ++i) qraw[i] = qp_[(size_t)i * NPJ]; }
    }
    float wv[16];
#pragma unroll
    for (int j = 0; j < 16; ++j) wv[j] = a.in[I_GWG2][j * 512 + h * 128 + (tid & 127)];
    const float bias = a.in[I_GBG][h * 128 + (tid & 127)];
    if (tid < 256) ((LAS f32x4*)GLs)[tid] = *(const f32x4*)(GL + (size_t)(row0 + (tid >> 2)) * 16 + (tid & 3) * 4);
    {
        const int dvv = tid & 255, th = tid >> 8; const bf16_t* vp = P + (size_t)(32 * th) * NPJ + 1024 + h * 256 + dvv;
#pragma unroll
        for (int q4 = 0; q4 < 4; ++q4) { unsigned e[8];
#pragma unroll
            for (int i = 0; i < 8; ++i) e[i] = vp[(size_t)(8 * q4 + i) * NPJ];
            u32x4 o; o.x = e[0] | (e[1] << 16); o.y = e[2] | (e[3] << 16); o.z = e[4] | (e[5] << 16); o.w = e[6] | (e[7] << 16);
            *(LAS u32x4*)(VT + dvv * VTS + 32 * th + 8 * q4) = o; }
    }
    __syncthreads();
    const int dk = tid & 127, tg = tid >> 7;
    float bc[16];
    {
        float run = 0.f;
#pragma unroll
        for (int i = 0; i < 16; ++i) { const LAS f32x4* gp = (const LAS f32x4*)(GLs + (16 * tg + i) * 16); float z = bias;
#pragma unroll
            for (int j4 = 0; j4 < 4; ++j4) { const f32x4 gq = gp[j4]; z += gq[0] * wv[4 * j4] + gq[1] * wv[4 * j4 + 1] + gq[2] * wv[4 * j4 + 2] + gq[3] * wv[4 * j4 + 3]; }
            run += log_sigmoid(z) * (1.f / 16.f); bc[i] = run; }
        GSUM[tg * 128 + dk] = run;
    }
    __syncthreads();
    float off = 0.f, blast = 0.f;
#pragma unroll
    for (int g = 0; g < 4; ++g) { const float s = GSUM[g * 128 + dk]; blast += s; if (g < tg) off += s; }
    if (MODE == 0) {
        float kd[16];
#pragma unroll
        for (int i = 0; i < 16; ++i) { const float b = bc[i] + off; kd[i] = bf2f(kraw[i]) * __expf(blast - b); }
        u32x4 o0, o1; o0.x = pk(kd[0], kd[1]); o0.y = pk(kd[2], kd[3]); o0.z = pk(kd[4], kd[5]); o0.w = pk(kd[6], kd[7]);
        o1.x = pk(kd[8], kd[9]); o1.y = pk(kd[10], kd[11]); o1.z = pk(kd[12], kd[13]); o1.w = pk(kd[14], kd[15]);
        *(LAS u32x4*)(KDT + dk * VTS + 16 * tg) = o0; *(LAS u32x4*)(KDT + dk * VTS + 16 * tg + 8) = o1;
        if (tg == 0) { const float d = __expf(blast); DECS[dk] = d; if (prompt) ((float*)(a.ws + WS_DEC))[(size_t)(cid * 4 + h) * 128 + dk] = d; }
    } else {
#pragma unroll
        for (int i = 0; i < 16; ++i) { const float b = bc[i] + off; const int t = 16 * tg + i;
            const float qe = bf2f(qraw[i]) * __expf(b) * 0.08838834764831845f, ke = bf2f(kraw[i]) * __expf(-b);
            QE[t * QES + dk] = (bf16_t)f2bf(qe); KE[t * QES + dk] = (bf16_t)f2bf(ke); }
    }
    __syncthreads();
    if (MODE == 0) {
        bf16x8 vf[4];
#pragma unroll
        for (int ks = 0; ks < 4; ++ks) vf[ks] = *(const LAS bf16x8*)(VT + (32 * w + l31) * VTS + 16 * ks + 8 * hi);
        f32x16 acc[4];
#pragma unroll
        for (int d = 0; d < 4; ++d) acc[d] = f32x16{};
#pragma unroll
        for (int d = 0; d < 4; ++d)
#pragma unroll
            for (int ks = 0; ks < 4; ++ks) { const bf16x8 kf = *(const LAS bf16x8*)(KDT + (32 * d + l31) * VTS + 16 * ks + 8 * hi);
                acc[d] = prompt ? MFMA32(vf[ks], kf, acc[d]) : MFMA32(kf, vf[ks], acc[d]); }
        if (prompt) {
            bf16_t* dst = (bf16_t*)(a.ws + WS_DST) + ((size_t)(cid * 4 + h) * 256 + 32 * w) * 128;
#pragma unroll
            for (int d = 0; d < 4; ++d)
#pragma unroll
                for (int r = 0; r < 16; ++r) dst[(size_t)crow(r, hi) * 128 + 32 * d + l31] = (bf16_t)f2bf(acc[d][r]);
        } else {
            const size_t base = ((size_t)((cid - 256) * 4 + h) * 128) * 256;
            float* outs = a.out + O_GSS;
#pragma unroll
            for (int d = 0; d < 4; ++d)
#pragma unroll
                for (int r = 0; r < 16; ++r) { const int dkk = 32 * d + crow(r, hi); const size_t idx = base + (size_t)dkk * 256 + 32 * w + l31; outs[idx] = state[idx] * DECS[dkk] + acc[d][r]; }
        }
    } else {
        u32x2 rraw[8];
#pragma unroll
        for (int i = 0; i < 8; ++i) rraw[i] = *(const u32x2*)(P + (size_t)(8 * w + i) * NPJ + 2048 + h * 256 + 4 * lane);
        f32x16 o[2]; o[0] = f32x16{}; o[1] = f32x16{};
#pragma unroll
        for (int tb = 0; tb < 2; ++tb)
#pragma unroll
            for (int ks = 0; ks < 8; ++ks) { const bf16x8 qa = *(const LAS bf16x8*)(QE + (32 * tb + l31) * QES + 16 * ks + 8 * hi); o[tb] = MFMA32(qa, sfr[ks], o[tb]); }
        if (w < 3) {
            const int tb = (w > 0) ? 1 : 0, sb = (w == 2) ? 1 : 0;
            f32x16 am = f32x16{};
#pragma unroll
            for (int ks = 0; ks < 8; ++ks) { const bf16x8 qa = *(const LAS bf16x8*)(QE + (32 * tb + l31) * QES + 16 * ks + 8 * hi), kb = *(const LAS bf16x8*)(KE + (32 * sb + l31) * QES + 16 * ks + 8 * hi);
                am = MFMA32(qa, kb, am); }
#pragma unroll
            for (int r = 0; r < 16; ++r) { const int tl = crow(r, hi); float v = am[r]; if (tb == sb && l31 > tl) v = 0.f; AL[(32 * tb + tl) * VTS + 32 * sb + l31] = (bf16_t)f2bf(v); }
        }
        __syncthreads();
#pragma unroll
        for (int tb = 0; tb < 2; ++tb)
#pragma unroll
            for (int ks = 0; ks < 4; ++ks) { if (tb == 0 && ks >= 2) continue;
                const bf16x8 aa = *(const LAS bf16x8*)(AL + (32 * tb + l31) * VTS + 16 * ks + 8 * hi), vb = *(const LAS bf16x8*)(VT + (32 * w + l31) * VTS + 16 * ks + 8 * hi);
                o[tb] = MFMA32(aa, vb, o[tb]); }
        __syncthreads();
        LAS float* OL = (LAS float*)(lds + OL_OFF);
#pragma unroll
        for (int tb = 0; tb < 2; ++tb)
#pragma unroll
            for (int r = 0; r < 16; ++r) OL[(32 * tb + crow(r, hi)) * OLS + 32 * w + l31] = o[tb][r];
        __syncthreads();
        const f32x4 ng = *(const f32x4*)(a.in[I_GNORM] + h * 256 + 4 * lane);
        bf16_t* OG = (bf16_t*)(a.ws + WS_OG);
#pragma unroll
        for (int i = 0; i < 8; ++i) { const int t = 8 * w + i; const f32x4 v = *(const LAS f32x4*)(OL + t * OLS + 4 * lane);
            const float rs = rsqrtf(wave_sum(dot4(v)) * (1.f / 256.f) + EPS);
            const u32x2 rr = rraw[i];
            float rv[4] = {bf2f(rr.x & 0xffffu), bf2f(rr.x >> 16), bf2f(rr.y & 0xffffu), bf2f(rr.y >> 16)}; float y[4];
#pragma unroll
            for (int j = 0; j < 4; ++j) y[j] = v[j] * rs * ng[j] * rv[j] * __builtin_amdgcn_rcpf(1.f + __expf(-rv[j]));
            u32x2 ov; ov.x = pk(y[0], y[1]); ov.y = pk(y[2], y[3]);
            *(u32x2*)(OG + (size_t)(row0 + t) * DM + h * 256 + 4 * lane) = ov; }
    }
    __syncthreads();
}

__device__ __forceinline__ void gla_scan(const Args& a, int vcu, int G) {
    const int gt = vcu * 512 + threadIdx.x, NT_ = G * 512;
    const bf16_t* DST = (const bf16_t*)(a.ws + WS_DST); const float* DEC = (const float*)(a.ws + WS_DEC); bf16_t* SP = (bf16_t*)(a.ws + WS_SPREV);
    for (int it0 = gt; it0 < 32 * 8192; it0 += 2 * NT_) {
        const int it1 = it0 + NT_; const bool two = it1 < 32 * 8192;
        const int bhA = it0 >> 13, eA = it0 & 8191, dvA = eA >> 5, dkA = (eA & 31) * 4;
        const int itB = two ? it1 : it0; const int bhB = itB >> 13, eB = itB & 8191, dvB = eB >> 5, dkB = (eB & 31) * 4;
        f32x4 SA = (f32x4){0.f, 0.f, 0.f, 0.f}, SB = SA;
#pragma unroll 8
        for (int c = 0; c < 32; ++c) {
            const size_t chA = (size_t)(((bhA >> 2) * 32 + c) * 4 + (bhA & 3)), chB = (size_t)(((bhB >> 2) * 32 + c) * 4 + (bhB & 3));
            const size_t baseA = (chA * 256 + dvA) * 128 + dkA, baseB = (chB * 256 + dvB) * 128 + dkB;
            const u32x2 rA = *(const u32x2*)(DST + baseA), rB = *(const u32x2*)(DST + baseB);
            const f32x4 deA = *(const f32x4*)(DEC + chA * 128 + dkA), deB = *(const f32x4*)(DEC + chB * 128 + dkB);
            const f32x4 dsA = (f32x4){bf2f(rA.x & 0xffffu), bf2f(rA.x >> 16), bf2f(rA.y & 0xffffu), bf2f(rA.y >> 16)};
            const f32x4 dsB = (f32x4){bf2f(rB.x & 0xffffu), bf2f(rB.x >> 16), bf2f(rB.y & 0xffffu), bf2f(rB.y >> 16)};
            u32x2 o; o.x = pk(SA[0], SA[1]); o.y = pk(SA[2], SA[3]); *(u32x2*)(SP + baseA) = o;
            if (two) { o.x = pk(SB[0], SB[1]); o.y = pk(SB[2], SB[3]); *(u32x2*)(SP + baseB) = o; }
            SA = SA * deA + dsA; SB = SB * deB + dsB;
        }
        float* ogA = a.out + O_GSP + ((size_t)bhA * 128 + dkA) * 256 + dvA;
#pragma unroll
        for (int i = 0; i < 4; ++i) ogA[(size_t)i * 256] = SA[i];
        if (two) { float* ogB = a.out + O_GSP + ((size_t)bhB * 128 + dkB) * 256 + dvB;
#pragma unroll
            for (int i = 0; i < 4; ++i) ogB[(size_t)i * 256] = SB[i]; }
    }
}

template <int L, int C> __device__ __forceinline__ void cumsum_item(const float* src0, const float* src1, float* dst, LAS float* SEG, int hh, int seg) {
    float s = 0.f;
#pragma unroll 1
    for (int c0 = 0; c0 < L; c0 += C) { float v[C];
#pragma unroll
        for (int i = 0; i < C; ++i) { const int t = seg * L + c0 + i; v[i] = (t < 2048) ? src0[(unsigned)(t * 16 + hh)] : src1[(unsigned)((t - 2048) * 16 + hh)]; }
#pragma unroll
        for (int i = 0; i < C; ++i) s += v[i]; }
    SEG[seg * 16 + hh] = s;
    __syncthreads();
    float run = 0.f;
    for (int g = 0; g < seg; ++g) run += SEG[g * 16 + hh];
#pragma unroll 1
    for (int c0 = 0; c0 < L; c0 += C) { float v[C];
#pragma unroll
        for (int i = 0; i < C; ++i) { const int t = seg * L + c0 + i; v[i] = (t < 2048) ? src0[(unsigned)(t * 16 + hh)] : src1[(unsigned)((t - 2048) * 16 + hh)]; }
#pragma unroll
        for (int i = 0; i < C; ++i) { run += v[i]; dst[seg * L + c0 + i] = run; } }
    __syncthreads();
}
__device__ __forceinline__ void fox_cumsum(const Args& a, LAS unsigned char* lds, int vcu, int G) {
    const int tid = threadIdx.x, hh = tid & 15, seg = tid >> 4;
    LAS float* SEG = (LAS float*)lds;
    for (int it = vcu; it < 40; it += G) {
        const bool prompt = it < 8; const int b = prompt ? it : it - 8;
        const float* src0 = prompt ? a.out + O_FLP + (size_t)b * 2048 * 16 : a.in[I_CLF] + (size_t)b * 2048 * 16;
        const float* src1 = a.out + O_FLS + (size_t)b * 64 * 16;
        if (prompt) cumsum_item<64, 32>(src0, src1, (float*)(a.ws + WS_CP) + (size_t)(b * 16 + hh) * 2048, SEG, hh, seg);
        else cumsum_item<66, 22>(src0, src1, (float*)(a.ws + WS_CS) + (size_t)(b * 16 + hh) * 2112, SEG, hh, seg);
    }
}

constexpr int AT_KS = 72, AT_VS = 68, AT_BUF = 18432, AT_VOFF = 9216, AT_COFF = 17920;
struct TileRegs { u32x4 k0, k1, v0, v1; float ck; };

template <bool SAMPLE> __device__ __forceinline__ void attn_load(TileRegs& R, const Args& a, int b, int h, int t, const float* cbase, int tid) {
    const int kvl = tid >> 3, ch = tid & 7, kp = tid >> 4, c4 = tid & 15;
    if (SAMPLE && t < 32) {
        const float* kptr = a.in[I_CK] + (((size_t)b * 2048 + 64 * t + kvl) * 16 + h) * 64 + 8 * ch;
        R.k0 = *(const u32x4*)kptr; R.k1 = *(const u32x4*)(kptr + 4);
        const float* vptr = a.in[I_CV] + (((size_t)b * 2048 + 64 * t + 2 * kp) * 16 + h) * 64 + 4 * c4;
        R.v0 = *(const u32x4*)vptr; R.v1 = *(const u32x4*)(vptr + 1024);
    } else {
        const size_t rowbase = SAMPLE ? (size_t)(MP + b * 64) : (size_t)(b * 2048 + 64 * t);
        const bf16_t* qkv = (const bf16_t*)(a.ws + WS_PROJ);
        R.k0 = *(const u32x4*)(qkv + (rowbase + kvl) * NPJ + 1024 + h * 64 + 8 * ch);
        const bf16_t* vptr = qkv + (rowbase + 2 * kp) * NPJ + 2048 + h * 64 + 4 * c4;
        const u32x2 x0 = *(const u32x2*)vptr, x1 = *(const u32x2*)(vptr + NPJ);
        R.v0.x = x0.x; R.v0.y = x0.y; R.v1.x = x1.x; R.v1.y = x1.y;
    }
    R.ck = cbase[64 * t + (tid & 63)];
}
__device__ __forceinline__ void attn_store(const TileRegs& R, LAS unsigned char* buf, bool f32src, int tid) {
    const int kvl = tid >> 3, ch = tid & 7, kp = tid >> 4, c4 = tid & 15;
    LAS unsigned* VT32 = (LAS unsigned*)(buf + AT_VOFF);
    if (f32src) {
        u32x4 o; o.x = pk(__uint_as_float(R.k0.x), __uint_as_float(R.k0.y)); o.y = pk(__uint_as_float(R.k0.z), __uint_as_float(R.k0.w));
        o.z = pk(__uint_as_float(R.k1.x), __uint_as_float(R.k1.y)); o.w = pk(__uint_as_float(R.k1.z), __uint_as_float(R.k1.w));
        *(LAS u32x4*)(buf + (kvl * AT_KS + 8 * ch) * 2) = o;
#pragma unroll
        for (int i = 0; i < 4; ++i) VT32[(4 * c4 + i) * (AT_VS / 2) + kp] = pk(__uint_as_float(R.v0[i]), __uint_as_float(R.v1[i]));
    } else {
        *(LAS u32x4*)(buf + (kvl * AT_KS + 8 * ch) * 2) = R.k0;
        VT32[(4 * c4 + 0) * (AT_VS / 2) + kp] = (R.v0.x & 0xffffu) | (R.v1.x << 16);
        VT32[(4 * c4 + 1) * (AT_VS / 2) + kp] = (R.v0.x >> 16) | (R.v1.x & 0xffff0000u);
        VT32[(4 * c4 + 2) * (AT_VS / 2) + kp] = (R.v0.y & 0xffffu) | (R.v1.y << 16);
        VT32[(4 * c4 + 3) * (AT_VS / 2) + kp] = (R.v0.y >> 16) | (R.v1.y & 0xffff0000u);
    }
    if (tid < 64) { const float c = -R.ck * LOG2E; const unsigned h1 = f2bf(c); const float r1 = c - bf2f(h1); const unsigned h2 = f2bf(r1); const unsigned h3 = f2bf(r1 - bf2f(h2));
        u32x2 o; o.x = h1 | (h2 << 16); o.y = h3; ((LAS u32x2*)(buf + AT_COFF))[tid] = o; }
}

template <bool QLDS> __device__ __forceinline__ void attn_tile(const LAS unsigned char* buf, const bf16x8 (&qf)[4], const LAS bf16x8* qlds, float cq2, int qpos, int kv0, bool diag, float& mrun, float& lrun, f32x16 (&ot)[2], int l31, int hi) {
    const LAS bf16_t* Ks = (const LAS bf16_t*)buf; const LAS bf16_t* VTs = (const LAS bf16_t*)(buf + AT_VOFF); const LAS u32x2* CKs = (const LAS u32x2*)(buf + AT_COFF);
    f32x16 p0, p1;
#pragma unroll
    for (int r = 0; r < 16; ++r) { p0[r] = cq2; p1[r] = cq2; }
    {
        const u32x2 b0 = CKs[l31], b1 = CKs[32 + l31];
        const unsigned msk = hi ? 0u : 0xffffffffu;
        u32x4 x0; x0.x = b0.x & msk; x0.y = b0.y & msk; x0.z = 0u; x0.w = 0u;
        u32x4 x1; x1.x = b1.x & msk; x1.y = b1.y & msk; x1.z = 0u; x1.w = 0u;
        u32x4 qx; qx.x = 0x3F803F80u & msk; qx.y = 0x00003F80u & msk; qx.z = 0u; qx.w = 0u;
        p0 = MFMA32(__builtin_bit_cast(bf16x8, x0), __builtin_bit_cast(bf16x8, qx), p0); p1 = MFMA32(__builtin_bit_cast(bf16x8, x1), __builtin_bit_cast(bf16x8, qx), p1);
    }
#pragma unroll
    for (int ks = 0; ks < 4; ++ks) { const bf16x8 k0 = *(const LAS bf16x8*)(Ks + l31 * AT_KS + 16 * ks + 8 * hi), k1 = *(const LAS bf16x8*)(Ks + (32 + l31) * AT_KS + 16 * ks + 8 * hi);
        const bf16x8 qq = QLDS ? qlds[ks * 64] : qf[ks];
        p0 = MFMA32(k0, qq, p0); p1 = MFMA32(k1, qq, p1); }
    __builtin_amdgcn_sched_barrier(0);
    if (diag) {
        int qp = qpos - kv0; asm volatile("" : "+v"(qp));
#pragma unroll
        for (int r = 0; r < 16; ++r) { const int kv = crow(r, hi); if (kv > qp) p0[r] = -INFINITY; if (kv + 32 > qp) p1[r] = -INFINITY; }
    }
    float rm = fmaxf(p0[0], p1[0]);
#pragma unroll
    for (int r = 1; r < 16; ++r) rm = fmaxf(rm, fmaxf(p0[r], p1[r]));
    rm = fmaxf(rm, __shfl_xor(rm, 32));
    if (__all(rm < mrun - 40.f)) return;
    const float mn = fmaxf(mrun, rm);
    if (__any(mn > mrun)) {
        const float alpha = __builtin_amdgcn_exp2f(mrun - mn);
        lrun *= alpha;
#pragma unroll
        for (int r = 0; r < 16; ++r) { ot[0][r] *= alpha; ot[1][r] *= alpha; }
        mrun = mn;
    }
    float rs = 0.f;
#pragma unroll
    for (int r = 0; r < 16; ++r) { p0[r] = __builtin_amdgcn_exp2f(p0[r] - mrun); p1[r] = __builtin_amdgcn_exp2f(p1[r] - mrun); rs += p0[r] + p1[r]; }
    lrun += rs;
    bf16x8 pf[4];
    { u32x4 x; x.x = pk(p0[0], p0[1]); x.y = pk(p0[2], p0[3]); x.z = pk(p0[4], p0[5]); x.w = pk(p0[6], p0[7]); pf[0] = __builtin_bit_cast(bf16x8, x);
      x.x = pk(p0[8], p0[9]); x.y = pk(p0[10], p0[11]); x.z = pk(p0[12], p0[13]); x.w = pk(p0[14], p0[15]); pf[1] = __builtin_bit_cast(bf16x8, x);
      x.x = pk(p1[0], p1[1]); x.y = pk(p1[2], p1[3]); x.z = pk(p1[4], p1[5]); x.w = pk(p1[6], p1[7]); pf[2] = __builtin_bit_cast(bf16x8, x);
      x.x = pk(p1[8], p1[9]); x.y = pk(p1[10], p1[11]); x.z = pk(p1[12], p1[13]); x.w = pk(p1[14], p1[15]); pf[3] = __builtin_bit_cast(bf16x8, x); }
    __builtin_amdgcn_sched_barrier(0);
#pragma unroll
    for (int db = 0; db < 2; ++db)
#pragma unroll
        for (int ks = 0; ks < 4; ++ks) { const LAS bf16_t* vp = VTs + (32 * db + l31) * AT_VS + 16 * ks + 4 * hi;
            const u32x2 lo = *(const LAS u32x2*)vp, hh2 = *(const LAS u32x2*)(vp + 8);
            u32x4 x; x.x = lo.x; x.y = lo.y; x.z = hh2.x; x.w = hh2.y;
            ot[db] = MFMA32(__builtin_bit_cast(bf16x8, x), pf[ks], ot[db]); }
}

__device__ __forceinline__ void gld16(u32x4& d, const void* p) { asm volatile("global_load_dwordx4 %0, %1, off" : "=v"(d) : "v"(p)); }
__device__ __forceinline__ void gld8(u32x2& d, const void* p) { asm volatile("global_load_dwordx2 %0, %1, off" : "=v"(d) : "v"(p)); }
__device__ __forceinline__ void gld4(float& d, const void* p) { asm volatile("global_load_dword %0, %1, off" : "=v"(d) : "v"(p)); }
struct PRegs { u32x4 k; u32x2 v0, v1; float ck; };
__device__ __forceinline__ void pload_a(PRegs& R, const Args& a, int b, int h, int t, const float* cbase, int tid) {
    const int kvl = tid >> 3, ch = tid & 7, kp = tid >> 4, c4 = tid & 15;
    const size_t rowbase = (size_t)(b * 2048 + 64 * t);
    const bf16_t* qkv = (const bf16_t*)(a.ws + WS_PROJ);
    gld16(R.k, qkv + (rowbase + kvl) * NPJ + 1024 + h * 64 + 8 * ch);
    const bf16_t* vptr = qkv + (rowbase + 2 * kp) * NPJ + 2048 + h * 64 + 4 * c4;
    gld8(R.v0, vptr); gld8(R.v1, vptr + NPJ);
    gld4(R.ck, cbase + 64 * t + (tid & 63));
}
#define WAIT_P(N, R) asm volatile("s_waitcnt vmcnt(" #N ")" : "+v"(R.k), "+v"(R.v0), "+v"(R.v1), "+v"(R.ck))
__device__ __forceinline__ void pstore(const PRegs& R, LAS unsigned char* buf, int tid) {
    const int kvl = tid >> 3, ch = tid & 7, kp = tid >> 4, c4 = tid & 15;
    LAS unsigned* VT32 = (LAS unsigned*)(buf + AT_VOFF);
    *(LAS u32x4*)(buf + (kvl * AT_KS + 8 * ch) * 2) = R.k;
    VT32[(4 * c4 + 0) * (AT_VS / 2) + kp] = (R.v0.x & 0xffffu) | (R.v1.x << 16);
    VT32[(4 * c4 + 1) * (AT_VS / 2) + kp] = (R.v0.x >> 16) | (R.v1.x & 0xffff0000u);
    VT32[(4 * c4 + 2) * (AT_VS / 2) + kp] = (R.v0.y & 0xffffu) | (R.v1.y << 16);
    VT32[(4 * c4 + 3) * (AT_VS / 2) + kp] = (R.v0.y >> 16) | (R.v1.y & 0xffff0000u);
    if (tid < 64) { const float c = -R.ck * LOG2E; const unsigned h1 = f2bf(c); const float r1 = c - bf2f(h1); const unsigned h2 = f2bf(r1); const unsigned h3 = f2bf(r1 - bf2f(h2));
        u32x2 o; o.x = h1 | (h2 << 16); o.y = h3; ((LAS u32x2*)(buf + AT_COFF))[tid] = o; }
}
__device__ __forceinline__ void attn_unit_prompt(const Args& a, LAS unsigned char* lds, int b, int h, int qb) {
    int tid_ = threadIdx.x; asm volatile("" : "+v"(tid_));
    const int tid = tid_, lane = tid & 63, w = __builtin_amdgcn_readfirstlane(tid >> 6), l31 = lane & 31, hi = lane >> 5;
    const int NT = 4 * (qb + 1);
    const int qpos = 256 * qb + 32 * w + l31;
    const size_t qrow = (size_t)(b * 2048 + qpos);
    const float* cbase = (const float*)(a.ws + WS_CP) + (size_t)(b * 16 + h) * 2048;
    const bf16_t* qkv = (const bf16_t*)(a.ws + WS_PROJ);
    bf16x8 qf[4];
#pragma unroll
    for (int ks = 0; ks < 4; ++ks) qf[ks] = *(const bf16x8*)(qkv + qrow * NPJ + h * 64 + 16 * ks + 8 * hi);
    const float cq2 = cbase[qpos] * LOG2E;
    const int qmax_w = 256 * qb + 32 * w + 31;
    PRegs R0, R1, R2;
    pload_a(R0, a, b, h, NT - 1, cbase, tid); pload_a(R1, a, b, h, NT - 2, cbase, tid); pload_a(R2, a, b, h, NT - 3, cbase, tid);
    WAIT_P(8, R0); pstore(R0, lds, tid);
    pload_a(R0, a, b, h, NT - 4, cbase, tid);
    __syncthreads();
    float mrun = -INFINITY, lrun = 0.f;
    f32x16 ot[2]; ot[0] = f32x16{}; ot[1] = f32x16{};
#define PSTEP(tt, RR) do { if ((tt) < NT) { const int ti_ = NT - 1 - (tt); if (64 * ti_ <= qmax_w) attn_tile<false>(lds + ((tt) & 1) * AT_BUF, qf, nullptr, cq2, qpos, 64 * ti_, ti_ >= 4 * qb, mrun, lrun, ot, l31, hi); \
        { WAIT_P(8, RR); pstore(RR, lds + (((tt) + 1) & 1) * AT_BUF, tid); pload_a(RR, a, b, h, (NT - 5 - (tt)) > 0 ? NT - 5 - (tt) : 0, cbase, tid); } \
        __syncthreads(); } } while (0)
#pragma unroll 1
    for (int t = 0; t < NT; t += 3) { PSTEP(t, R1); PSTEP(t + 1, R2); PSTEP(t + 2, R0); }
#undef PSTEP
    WAIT_P(0, R0); WAIT_P(0, R1); WAIT_P(0, R2);
    lrun += __shfl_xor(lrun, 32);
    const float inv = 1.f / lrun;
    bf16_t* og = (bf16_t*)(a.ws + WS_OG) + qrow * DM + h * 64;
#pragma unroll
    for (int db = 0; db < 2; ++db)
#pragma unroll
        for (int j = 0; j < 4; ++j) { u32x2 o; o.x = pk(ot[db][4 * j] * inv, ot[db][4 * j + 1] * inv); o.y = pk(ot[db][4 * j + 2] * inv, ot[db][4 * j + 3] * inv);
            *(u32x2*)(og + 32 * db + 8 * j + 4 * hi) = o; }
}

struct TileRegs2 { u32x4 k[4], v[4]; float ck; };
__device__ __forceinline__ void sload2(TileRegs2& R, const Args& a, int b, int h, int t, const float* cbase, int st) {
#pragma unroll
    for (int q = 0; q < 2; ++q) {
        const int item = st + 256 * q, kvl = item >> 3, ch = item & 7, kp = item >> 4, c4 = item & 15;
        if (t < 32) {
            const float* kptr = a.in[I_CK] + (((size_t)b * 2048 + 64 * t + kvl) * 16 + h) * 64 + 8 * ch;
            R.k[2 * q] = *(const u32x4*)kptr; R.k[2 * q + 1] = *(const u32x4*)(kptr + 4);
            const float* vptr = a.in[I_CV] + (((size_t)b * 2048 + 64 * t + 2 * kp) * 16 + h) * 64 + 4 * c4;
            R.v[2 * q] = *(const u32x4*)vptr; R.v[2 * q + 1] = *(const u32x4*)(vptr + 1024);
        } else {
            const size_t rowbase = (size_t)(MP + b * 64);
            const bf16_t* qkv = (const bf16_t*)(a.ws + WS_PROJ);
            R.k[2 * q] = *(const u32x4*)(qkv + (rowbase + kvl) * NPJ + 1024 + h * 64 + 8 * ch);
            const bf16_t* vptr = qkv + (rowbase + 2 * kp) * NPJ + 2048 + h * 64 + 4 * c4;
            const u32x2 x0 = *(const u32x2*)vptr, x1 = *(const u32x2*)(vptr + NPJ);
            R.v[2 * q].x = x0.x; R.v[2 * q].y = x0.y; R.v[2 * q + 1].x = x1.x; R.v[2 * q + 1].y = x1.y;
        }
    }
    R.ck = cbase[64 * t + (st & 63)];
}
__device__ __forceinline__ void sload2a(TileRegs2& R, const Args& a, int b, int h, int t, const float* cbase, int st) {
#pragma unroll
    for (int q = 0; q < 2; ++q) {
        const int item = st + 256 * q, kvl = item >> 3, ch = item & 7, kp = item >> 4, c4 = item & 15;
        const float* kptr = a.in[I_CK] + (((size_t)b * 2048 + 64 * t + kvl) * 16 + h) * 64 + 8 * ch;
        gld16(R.k[2 * q], kptr); gld16(R.k[2 * q + 1], kptr + 4);
        const float* vptr = a.in[I_CV] + (((size_t)b * 2048 + 64 * t + 2 * kp) * 16 + h) * 64 + 4 * c4;
        gld16(R.v[2 * q], vptr); gld16(R.v[2 * q + 1], vptr + 1024);
    }
    gld4(R.ck, cbase + 64 * t + (st & 63));
}
#define WAIT_R2(N, R) asm volatile("s_waitcnt vmcnt(" #N ")" : "+v"(R.k[0]), "+v"(R.k[1]), "+v"(R.k[2]), "+v"(R.k[3]), "+v"(R.v[0]), "+v"(R.v[1]), "+v"(R.v[2]), "+v"(R.v[3]), "+v"(R.ck))
__device__ __forceinline__ void sstore2(const TileRegs2& R, LAS unsigned char* buf, bool f32src, int st) {
    LAS unsigned* VT32 = (LAS unsigned*)(buf + AT_VOFF);
#pragma unroll
    for (int q = 0; q < 2; ++q) {
        const int item = st + 256 * q, kvl = item >> 3, ch = item & 7, kp = item >> 4, c4 = item & 15;
        if (f32src) {
            const u32x4 k0 = R.k[2 * q], k1 = R.k[2 * q + 1];
            u32x4 o; o.x = pk(__uint_as_float(k0.x), __uint_as_float(k0.y)); o.y = pk(__uint_as_float(k0.z), __uint_as_float(k0.w));
            o.z = pk(__uint_as_float(k1.x), __uint_as_float(k1.y)); o.w = pk(__uint_as_float(k1.z), __uint_as_float(k1.w));
            *(LAS u32x4*)(buf + (kvl * AT_KS + 8 * ch) * 2) = o;
#pragma unroll
            for (int i = 0; i < 4; ++i) VT32[(4 * c4 + i) * (AT_VS / 2) + kp] = pk(__uint_as_float(R.v[2 * q][i]), __uint_as_float(R.v[2 * q + 1][i]));
        } else {
            *(LAS u32x4*)(buf + (kvl * AT_KS + 8 * ch) * 2) = R.k[2 * q];
            const u32x4 v0 = R.v[2 * q], v1 = R.v[2 * q + 1];
            VT32[(4 * c4 + 0) * (AT_VS / 2) + kp] = (v0.x & 0xffffu) | (v1.x << 16);
            VT32[(4 * c4 + 1) * (AT_VS / 2) + kp] = (v0.x >> 16) | (v1.x & 0xffff0000u);
            VT32[(4 * c4 + 2) * (AT_VS / 2) + kp] = (v0.y & 0xffffu) | (v1.y << 16);
            VT32[(4 * c4 + 3) * (AT_VS / 2) + kp] = (v0.y >> 16) | (v1.y & 0xffff0000u);
        }
    }
    if (st < 64) { const float c = -R.ck * LOG2E; const unsigned h1 = f2bf(c); const float r1 = c - bf2f(h1); const unsigned h2 = f2bf(r1); const unsigned h3 = f2bf(r1 - bf2f(h2));
        u32x2 o; o.x = h1 | (h2 << 16); o.y = h3; ((LAS u32x2*)(buf + AT_COFF))[st] = o; }
}
__device__ __forceinline__ void attn_unit_sample(const Args& a, LAS unsigned char* lds, int b, int h) {
    int tid_ = threadIdx.x; asm volatile("" : "+v"(tid_));
    const int tid = tid_, lane = tid & 63, w = __builtin_amdgcn_readfirstlane(tid >> 6), l31 = lane & 31, hi = lane >> 5;
    const bool active = w < 2, stager = (w >= 2 && w < 6);
    const int st = tid - 128;
    const int qpos = 2048 + 32 * (w & 1) + l31;
    const size_t qrow = (size_t)(MP + b * 64 + 32 * (w & 1) + l31);
    const float* cbase = (const float*)(a.ws + WS_CS) + (size_t)(b * 16 + h) * 2112;
    const bf16_t* qkv = (const bf16_t*)(a.ws + WS_PROJ);
    bf16x8 qf[4];
#pragma unroll
    for (int ks = 0; ks < 4; ++ks) qf[ks] = *(const bf16x8*)(qkv + qrow * NPJ + h * 64 + 16 * ks + 8 * hi);
    const float cq2 = cbase[qpos] * LOG2E;
    TileRegs2 R0, R1, R2;
    if (stager) { sload2(R0, a, b, h, 32, cbase, st); sload2a(R1, a, b, h, 31, cbase, st); sload2a(R2, a, b, h, 30, cbase, st);
        sstore2(R0, lds, false, st);
        sload2a(R0, a, b, h, 29, cbase, st); }
    __syncthreads();
    float mrun = -INFINITY, lrun = 0.f;
    f32x16 ot[2]; ot[0] = f32x16{}; ot[1] = f32x16{};
#define SSTEP(tt, RR) do { if (active) attn_tile<false>(lds + ((tt) & 1) * AT_BUF, qf, nullptr, cq2, qpos, 64 * (32 - (tt)), (tt) == 0, mrun, lrun, ot, l31, hi); \
        if (stager) { WAIT_R2(18, RR); sstore2(RR, lds + (((tt) + 1) & 1) * AT_BUF, true, st); sload2a(RR, a, b, h, (28 - (tt)) > 0 ? 28 - (tt) : 0, cbase, st); } \
        __syncthreads(); } while (0)
#pragma unroll 1
    for (int t = 0; t < 33; t += 3) { SSTEP(t, R1); SSTEP(t + 1, R2); SSTEP(t + 2, R0); }
#undef SSTEP
    if (stager) { WAIT_R2(0, R0); WAIT_R2(0, R1); WAIT_R2(0, R2); }
    if (active) {
        lrun += __shfl_xor(lrun, 32);
        const float inv = 1.f / lrun;
        bf16_t* og = (bf16_t*)(a.ws + WS_OG) + qrow * DM + h * 64;
#pragma unroll
        for (int db = 0; db < 2; ++db)
#pragma unroll
            for (int j = 0; j < 4; ++j) { u32x2 o; o.x = pk(ot[db][4 * j] * inv, ot[db][4 * j + 1] * inv); o.y = pk(ot[db][4 * j + 2] * inv, ot[db][4 * j + 3] * inv);
                *(u32x2*)(og + 32 * db + 8 * j + 4 * hi) = o; }
    }
}

__device__ __forceinline__ void fox_attention(const Args& a, LAS unsigned char* lds, int vcu, int G) {
#pragma unroll 1
    for (int pass = 0; pass < 2; ++pass) {
        if ((pass ^ (vcu & 1)) == 0) {
#ifdef ATT_DUP_PROMPT
          for (int rep2_ = 0; rep2_ < 2; ++rep2_)
#endif
            if (G == 256) {
                const int bh = vcu >> 1, s0 = 2 * (vcu & 1);
#pragma unroll 1
                for (int i = 0; i < 4; ++i) attn_unit_prompt(a, lds, bh >> 4, bh & 15, (i & 1) ? s0 + (i >> 1) : 7 - s0 - (i >> 1));
            } else {
#pragma unroll 1
                for (int u = vcu; u < 1024; u += G) attn_unit_prompt(a, lds, (u & 127) >> 4, u & 15, 7 - (u >> 7));
            }
        } else {
#pragma unroll 1
            for (int u = vcu; u < 512; u += G) attn_unit_sample(a, lds, u >> 4, u & 15);
        }
    }
}

#ifndef PH_MASK
#define PH_MASK 0x7fff
#endif
#define IN(k) (((PH_MASK >> (k)) & 1) && a.ph_lo <= (k) && (k) < a.ph_hi)
#define SEAM(k) do { if (IN(k) && IN((k) + 1)) { if ((k) == 0) cg::this_grid().sync(); else xcd_barrier(xbar); } } while (0)
#ifndef DUP_MASK
#define DUP_MASK 0
#endif
#define REP(k) _Pragma("unroll 1") for (int rep_ = 0; rep_ < ((((DUP_MASK) >> (k)) & 1) ? 2 : 1); ++rep_)
#define REPSYNC(k) do { if ((((DUP_MASK) >> (k)) & 1)) xcd_barrier(xbar); } while (0)
template <int L> __device__ __forceinline__ void common_gemms(const Args& a, LAS unsigned char* lds, int G, int bx, const XcdBarrier& xbar) {
    unsigned char* ws = a.ws;
    float* SS = (float*)(ws + WS_SS);
    bf16_t* XB = (bf16_t*)(ws + WS_XB); float* XR = (float*)(ws + WS_XR); bf16_t* OG = (bf16_t*)(ws + WS_OG); bf16_t* ACT = (bf16_t*)(ws + WS_ACT);
    constexpr int po = L ? 11 : 5;
    if (IN(po)) { pg8::Gemm g{OG, (const bf16_t*)(ws + (L ? WS_WFOUT : WS_WGOUT)), MT, DM, DM}; pg8::StaticOrder S; S.init(MT, DM, G, bx);
        EpiResid E{L ? XR : a.in[I_XP], L ? XR + (size_t)MP * DM : a.in[I_XS], XR, XB, SS + (L ? 3 : 1) * 32768};
        pg8::gemm_phase<EpiResid, pg8::StaticOrder, true, true>(lds, g, S, E);
        if (L == 0 && G == 256 && !MK_MULTI && bx >= 32) convert_weights(a, lds, 1, (bx - 32) * 8 + (int)(threadIdx.x >> 6), 224 * 8); }
    SEAM(po);
    if (IN(po + 1)) REP(po + 1) { pg8::Gemm g{XB, (const bf16_t*)(ws + WS_WFFI + (size_t)L * 11 * MiB), MT, 2 * DFF, DM}; pg8::StaticOrder S; S.init(MT, 2 * DFF, G, bx);
        EpiSwiglu E{SS + (L ? 3 : 1) * 32768, ACT}; pg8::gemm_phase<EpiSwiglu, pg8::StaticOrder, true, true>(lds, g, S, E); REPSYNC(po + 1); }
    SEAM(po + 1);
    if (IN(po + 2)) { pg8::Gemm g{ACT, (const bf16_t*)(ws + WS_WFFD + (size_t)L * 6 * MiB), MT, DM, DFF}; pg8::StaticOrder S; S.init(MT, DM, G, bx);
        EpiResid E{XR, XR + (size_t)MP * DM, XR, XB, SS + (L ? 4 : 2) * 32768};
        pg8::gemm_phase<EpiResid, pg8::StaticOrder, true, true>(lds, g, S, E); }
    SEAM(po + 2);
}
constexpr int NPH = 15;
__global__ void __launch_bounds__(512, 2) fwd(Args a) {
    extern __shared__ __attribute__((aligned(16))) unsigned char lds_raw[];
    LAS unsigned char* lds = (LAS unsigned char*)lds_raw;
    const int G = gridDim.x, bx = blockIdx.x;
    const int vcu = (G % 8 == 0) ? (bx % 8) * (G / 8) + bx / 8 : bx;
    unsigned char* ws = a.ws;
    float* SS = (float*)(ws + WS_SS);
    bf16_t* XB = (bf16_t*)(ws + WS_XB); bf16_t* PROJ = (bf16_t*)(ws + WS_PROJ);

    volatile LAS unsigned* MISC = (volatile LAS unsigned*)(lds + 131072);
    if (threadIdx.x < 64) MISC[threadIdx.x] = 0u;
    __syncthreads();
    XcdBarrier xbar; xbar.bar = (unsigned*)ws; xbar.x = 0; xbar.st = nullptr;
    if (a.ph_hi - a.ph_lo > 1) xbar = xcd_barrier_post((unsigned*)ws, MISC + 8);
    if (IN(0)) REP(0) { p0_prologue(a, lds, vcu, G); REPSYNC(0); }
    SEAM(0);
    if (IN(1)) { pg8::Gemm g{XB, (const bf16_t*)(ws + WS_WGIN), MT, NPROJ, DM}; pg8::StaticOrder S; S.init(MT, NPROJ, G, bx);
        EpiGlaProj E{SS, PROJ, (float*)(ws + WS_GL)}; pg8::gemm_phase<EpiGlaProj, pg8::StaticOrder, true, true>(lds, g, S, E); }
    SEAM(1);
    if (IN(2)) REP(2) {
#pragma unroll 1
        for (int it = vcu; it < 1152; it += G) gla_item<0>(a, lds, it >> 2, it & 3);
        REPSYNC(2); }
    SEAM(2);
    if (IN(3)) REP(3) { gla_scan(a, vcu, G); REPSYNC(3); }
    SEAM(3);
    if (IN(4)) REP(4) {
#pragma unroll 1
        for (int it = vcu; it < 1152; it += G) gla_item<1>(a, lds, it >> 2, it & 3);
        REPSYNC(4); }
    SEAM(4);
    common_gemms<0>(a, lds, G, bx, xbar);
    if (IN(8)) { pg8::Gemm g{XB, (const bf16_t*)(ws + WS_WFIN), MT, NPROJ, DM}; pg8::StaticOrder S; S.init(MT, NPROJ, G, bx);
        EpiFoxProj E{SS + 2 * 32768, PROJ, a.out, a.in[I_FBF]}; pg8::gemm_phase<EpiFoxProj, pg8::StaticOrder, true, true>(lds, g, S, E); }
    SEAM(8);
    if (IN(9)) REP(9) { fox_cumsum(a, lds, vcu, G); REPSYNC(9); }
    SEAM(9);
    if (IN(10)) REP(10) { fox_attention(a, lds, vcu, G); REPSYNC(10); }
    SEAM(10);
    common_gemms<1>(a, lds, G, bx, xbar);
#ifdef EXTRA_SYNCS
    for (int i_ = 0; i_ < EXTRA_SYNCS; ++i_) xcd_barrier(xbar);
#endif
    if (IN(14)) p_final(a, vcu, G);
#undef IN
#undef SEAM
}

extern "C" void kernel_launch(void* const* d_in, const int* in_sizes, int n_in, void* d_out, int out_size, void* d_ws, size_t ws_size, hipStream_t stream) {
    static int grid = 0;
    if (grid == 0) {
        if (n_in != 19 || ws_size < WS_END || out_size != 62160896) { fprintf(stderr, "kernel_launch: unexpected problem shape (n_in %d, out %d, ws %zu)\n", n_in, out_size, ws_size); grid = -1; return; }
        if (hipFuncSetAttribute((const void*)fwd, hipFuncAttributeMaxDynamicSharedMemorySize, LDS_BYTES) != hipSuccess) { fprintf(stderr, "kernel_launch: hipFuncSetAttribute failed\n"); grid = -1; return; }
        int dev = 0, cus = 0, per_cu = 0;
        (void)hipGetDevice(&dev); (void)hipDeviceGetAttribute(&cus, hipDeviceAttributeMultiprocessorCount, dev);
        (void)hipOccupancyMaxActiveBlocksPerMultiprocessor(&per_cu, (const void*)fwd, 512, LDS_BYTES);
        (void)hipGetLastError();
        if (per_cu < 1) per_cu = 1;
        grid = cus * 1;
        if (grid <= 0) grid = 256;
    }
    if (grid < 0) return;
    (void)hipMemsetAsync((char*)d_ws + WS_CTL, 0, CTL_BYTES, stream);
    Args a{};
    for (int i = 0; i < 19; ++i) a.in[i] = (const float*)d_in[i];
    a.out = (float*)d_out; a.ws = (unsigned char*)d_ws;
#if MK_MULTI
    for (int ph = 0; ph < NPH; ++ph) { a.ph_lo = ph; a.ph_hi = ph + 1; hipLaunchKernelGGL(fwd, dim3(grid), dim3(512), LDS_BYTES, stream, a); }
#else
    a.ph_lo = 0; a.ph_hi = NPH;
    void* args[] = {&a};
    hipError_t e = hipLaunchCooperativeKernel((const void*)fwd, dim3(grid), dim3(512), args, LDS_BYTES, stream);
    if (e != hipSuccess) fprintf(stderr, "kernel_launch: cooperative launch failed: %s (grid %d)\n", hipGetErrorString(e), grid);
#endif
}
```

```cpp
#include <hip/hip_runtime.h>
#include <hip/hip_cooperative_groups.h>
#include <cstdio>
#include <cstdint>
#include <cmath>
namespace cg = cooperative_groups;
#define MK_MULTI 0
namespace pg8 {
#define PG8_LAS __attribute__((address_space(3)))
typedef unsigned short bf16_t;
typedef short bf16x8 __attribute__((ext_vector_type(8)));
typedef float f32x4 __attribute__((ext_vector_type(4)));
typedef unsigned u32x4 __attribute__((ext_vector_type(4)));
constexpr int BM = 256, BK = 64, HALF = 128, HTB = HALF * BK * 2  , STAGE_BYTES = 8 * HTB, NXCD = 8, WGM = 8;

__host__ __device__ __forceinline__ int lds_byte(int r, int c) { const int st = (r >> 4) * 2 + (c >> 5), rr = r & 15, cc = c & 31, ob = rr * 64 + cc * 2; return st * 1024 + (ob ^ (((ob >> 9) & 1) << 5)); }
__host__ __device__ __forceinline__ void stage_rc(int b, int& R, int& C) { const int st = b / 1024, sb = b % 1024, swz = sb ^ (((sb >> 9) & 1) << 5); R = (st >> 1) * 16 + swz / 64; C = (st & 1) * 32 + (swz % 64) / 2; }
__host__ __device__ __forceinline__ int perm32(int rho) { const int n = rho >> 4, i = rho & 15; return 8 * (i >> 2) + 4 * n + (i & 3); }

struct Unit { int pm, pn; };
struct Gemm { const bf16_t* A; const bf16_t* Bt; int M, N, K; };

struct StaticOrder {
    int nM, nN, nwg, G, c;
    __host__ __device__ void init(int M, int N, int G_, int c_) { nM = M / BM; nN = N / BM; nwg = nM * nN; G = G_; c = c_; }
    __host__ __device__ bool next(int i, Unit& u) const {
        const long L = (long)i * G + c; if (L >= nwg) return false;
        int wgid = (int)L; { const int q = nwg / NXCD, r = nwg % NXCD, xcd = wgid % NXCD, off = wgid / NXCD; wgid = (xcd < r ? xcd * (q + 1) : r * (q + 1) + (xcd - r) * q) + off; }
        const int nig = WGM * nN, gid = wgid / nig, fm = gid * WGM, gsz = (nM - fm) < WGM ? (nM - fm) : WGM;
        u.pm = fm + ((wgid % nig) % gsz); u.pn = (wgid % nig) / gsz; return true;
    }
    __device__ __forceinline__ void a_ready(const Unit&) const {}
    __device__ __forceinline__ void done(const Unit&) const {}
};

__device__ __forceinline__ unsigned cvt_pk_bf16(float lo, float hi) { unsigned r; asm volatile("v_cvt_pk_bf16_f32 %0, %1, %2" : "=v"(r) : "v"(lo), "v"(hi)); return r; }
template <class Epi, class Sched, bool ALIGN_EPI = false, bool SP2 = false>
__device__ __forceinline__ void gemm_phase(PG8_LAS unsigned char* lds, const Gemm g, const Sched& S, const Epi& E) {
    const int tid = threadIdx.x, wid = __builtin_amdgcn_readfirstlane(tid >> 6), lane = tid & 63, wr = wid >> 2, wc = wid & 3, fr = lane & 15, fq = lane >> 4;
    const int K = g.K, nt = K / BK;
    unsigned voffA[2], voffB[2];
#pragma unroll
    for (int i = 0; i < 2; ++i) { int R, C; stage_rc(tid * 16 + i * 8192, R, C); const int Rb = Epi::PERM ? ((R & ~31) + perm32(R & 31)) : R;
        voffA[i] = (unsigned)(R * K + C) * 2u; voffB[i] = (unsigned)(Rb * K + C) * 2u; }
    const size_t kstep = (size_t)(BK * 2);
    const size_t hstep = (size_t)HALF * K * 2;
    const size_t tstep = 2 * hstep;
    const unsigned ldsw = (unsigned)wid * 1024u;
    const int aoff = lds_byte(wr * 64 + fr, fq * 8), boff = lds_byte(wc * 32 + fr, fq * 8);
#define PG8_SA(b, h) (((b) * 2 + (h)) * HTB)
#define PG8_SB(b, h) ((4 + (b) * 2 + (h)) * HTB)
#define PG8_STAGE(bufoff, gbase, voff) do { _Pragma("unroll") for (int _i = 0; _i < 2; ++_i) \
        __builtin_amdgcn_global_load_lds((const unsigned*)((const char*)(gbase) + (voff)[_i]), (PG8_LAS unsigned*)(lds + (bufoff) + ldsw + _i * 8192), 16, 0, 0); } while (0)
#define PG8_LDA(dst, b, h) do { _Pragma("unroll") for (int m = 0; m < 4; ++m) _Pragma("unroll") for (int k = 0; k < 2; ++k) dst[m][k] = *(const PG8_LAS bf16x8*)(lds + PG8_SA(b, h) + aoff + m * 2048 + k * 1024); } while (0)
#define PG8_LDB(dst, b, h) do { _Pragma("unroll") for (int n = 0; n < 2; ++n) _Pragma("unroll") for (int k = 0; k < 2; ++k) dst[n][k] = *(const PG8_LAS bf16x8*)(lds + PG8_SB(b, h) + boff + n * 2048 + k * 1024); } while (0)
#define PG8_MMA(ai, bj, At, Bt) do { __builtin_amdgcn_s_setprio(1); _Pragma("unroll") for (int m = 0; m < 4; ++m) _Pragma("unroll") for (int n = 0; n < 2; ++n) _Pragma("unroll") for (int k = 0; k < 2; ++k) \
        acc[ai][bj][m][n] = __builtin_amdgcn_mfma_f32_16x16x32_bf16(Bt[n][k], At[m][k], acc[ai][bj][m][n], 0, 0, 0); __builtin_amdgcn_s_setprio(0); } while (0)
#define PG8_WAIT_V(n) asm volatile("s_waitcnt vmcnt(" #n ")" ::: "memory")
#define PG8_WAIT_L(n) asm volatile("s_waitcnt lgkmcnt(" #n ")" ::: "memory")
#define PG8_BAR __builtin_amdgcn_s_barrier()
#define PG8_SCHED __builtin_amdgcn_sched_barrier(0)
    Unit cur, nxt; int ui = 0;
    if (!S.next(0, cur)) return;
    f32x4 acc[2][2][4][2];
#pragma unroll
    for (int a = 0; a < 2; ++a)
#pragma unroll
        for (int b = 0; b < 2; ++b)
#pragma unroll
            for (int m = 0; m < 4; ++m)
#pragma unroll
                for (int n = 0; n < 2; ++n) acc[a][b][m][n] = (f32x4){0.f, 0.f, 0.f, 0.f};
    bf16x8 At[4][2], B0[2][2], B1[2][2];
    const char* cA = (const char*)g.A + (size_t)cur.pm * tstep; const char* cB = (const char*)g.Bt + (size_t)cur.pn * tstep;
    S.a_ready(cur);
    if constexpr (SP2) {
        PG8_STAGE(PG8_SB(0, 0), cB, voffB); PG8_STAGE(PG8_SB(0, 1), cB + hstep, voffB); PG8_STAGE(PG8_SA(0, 0), cA, voffA); PG8_STAGE(PG8_SA(0, 1), cA + hstep, voffA);
        if (wr == 1) PG8_BAR;
        PG8_WAIT_V(2); PG8_BAR;
        PG8_STAGE(PG8_SB(1, 0), cB + kstep, voffB); PG8_STAGE(PG8_SA(1, 0), cA + kstep, voffA); PG8_STAGE(PG8_SB(1, 1), cB + hstep + kstep, voffB);
        PG8_WAIT_V(6); PG8_BAR;
    } else {
        PG8_STAGE(PG8_SB(0, 0), cB, voffB); PG8_STAGE(PG8_SA(0, 0), cA, voffA); PG8_STAGE(PG8_SB(0, 1), cB + hstep, voffB); PG8_STAGE(PG8_SA(0, 1), cA + hstep, voffA);
        if (wr == 1) PG8_BAR;
        PG8_WAIT_V(4); PG8_BAR;
        PG8_STAGE(PG8_SB(1, 0), cB + kstep, voffB); PG8_STAGE(PG8_SA(1, 0), cA + kstep, voffA); PG8_STAGE(PG8_SB(1, 1), cB + hstep + kstep, voffB);
        PG8_WAIT_V(6); PG8_BAR;
    }
    for (;;) {
        const bool has_next = S.next(ui + 1, nxt);
        const char* nA = has_next ? (const char*)g.A + (size_t)nxt.pm * tstep : cA; const char* nB = has_next ? (const char*)g.Bt + (size_t)nxt.pn * tstep : cB;
        for (int t = 0; t < nt; t += 2) {
            const bool last = (t == nt - 2);
            const char* a1 = cA + (size_t)(t + 1) * kstep;
            const char* a2 = last ? nA : cA + (size_t)(t + 2) * kstep; const char* b2 = last ? nB : cB + (size_t)(t + 2) * kstep;
            const char* a3 = a2 + kstep; const char* b3 = b2 + kstep;
            if (last && has_next) S.a_ready(nxt);
            if constexpr (SP2) {
            PG8_LDB(B0, 0, 0); PG8_LDB(B1, 0, 1); PG8_SCHED; PG8_LDA(At, 0, 0); PG8_STAGE(PG8_SA(1, 1), a1 + hstep, voffA);
            PG8_WAIT_V(8); PG8_WAIT_L(0); PG8_BAR; PG8_MMA(0, 0, At, B0); PG8_MMA(0, 1, At, B1); PG8_BAR; PG8_SCHED;
            PG8_LDA(At, 0, 1); PG8_STAGE(PG8_SB(0, 0), b2, voffB); PG8_STAGE(PG8_SB(0, 1), b2 + hstep, voffB); PG8_STAGE(PG8_SA(0, 0), a2, voffA);
            PG8_WAIT_V(8); PG8_WAIT_L(0); PG8_BAR; PG8_MMA(1, 0, At, B0); PG8_MMA(1, 1, At, B1); PG8_BAR; PG8_SCHED;
            PG8_LDB(B0, 1, 0); PG8_LDB(B1, 1, 1); PG8_SCHED; PG8_LDA(At, 1, 0); PG8_STAGE(PG8_SA(0, 1), a2 + hstep, voffA);
            PG8_WAIT_V(8); PG8_WAIT_L(0); PG8_BAR; PG8_MMA(0, 0, At, B0); PG8_MMA(0, 1, At, B1); PG8_BAR; PG8_SCHED;
            PG8_LDA(At, 1, 1); PG8_STAGE(PG8_SB(1, 0), b3, voffB); PG8_STAGE(PG8_SB(1, 1), b3 + hstep, voffB); PG8_STAGE(PG8_SA(1, 0), a3, voffA);
            PG8_WAIT_V(8); PG8_WAIT_L(0); PG8_BAR; PG8_MMA(1, 0, At, B0); PG8_MMA(1, 1, At, B1); PG8_BAR; PG8_SCHED;
            } else {
            PG8_LDB(B0, 0, 0); PG8_SCHED; PG8_LDA(At, 0, 0); PG8_STAGE(PG8_SA(1, 1), a1 + hstep, voffA);
            PG8_WAIT_L(8); PG8_BAR; PG8_WAIT_L(0); PG8_MMA(0, 0, At, B0); PG8_BAR; PG8_SCHED;
            PG8_LDB(B1, 0, 1); PG8_STAGE(PG8_SB(0, 0), b2, voffB);
            PG8_BAR; PG8_WAIT_L(0); PG8_MMA(0, 1, At, B1); PG8_BAR;
            PG8_LDA(At, 0, 1); PG8_STAGE(PG8_SA(0, 0), a2, voffA);
            PG8_BAR; PG8_WAIT_L(0); PG8_MMA(1, 0, At, B0); PG8_BAR; PG8_SCHED;
            PG8_STAGE(PG8_SB(0, 1), b2 + hstep, voffB);
            PG8_WAIT_V(6); PG8_BAR; PG8_MMA(1, 1, At, B1); PG8_BAR;
            PG8_LDB(B0, 1, 0); PG8_SCHED; PG8_LDA(At, 1, 0); PG8_STAGE(PG8_SA(0, 1), a2 + hstep, voffA);
            PG8_WAIT_L(8); PG8_BAR; PG8_WAIT_L(0); PG8_MMA(0, 0, At, B0); PG8_BAR; PG8_SCHED;
            PG8_LDB(B1, 1, 1); PG8_STAGE(PG8_SB(1, 0), b3, voffB);
            PG8_BAR; PG8_WAIT_L(0); PG8_MMA(0, 1, At, B1); PG8_BAR;
            PG8_LDA(At, 1, 1); PG8_STAGE(PG8_SA(1, 0), a3, voffA);
            PG8_BAR; PG8_WAIT_L(0); PG8_MMA(1, 0, At, B0); PG8_BAR; PG8_SCHED;
            PG8_STAGE(PG8_SB(1, 1), b3 + hstep, voffB);
            PG8_WAIT_V(6); PG8_BAR; PG8_MMA(1, 1, At, B1); PG8_BAR;
            }
        }
        if constexpr (ALIGN_EPI) { if (wr == 0) PG8_BAR; }
        if constexpr (!Epi::AFTER_DRAIN) { E(acc, cur, wr, wc, fr, fq); S.done(cur); }
        if (!has_next) break;
#pragma unroll
        for (int a = 0; a < 2; ++a)
#pragma unroll
            for (int b = 0; b < 2; ++b)
#pragma unroll
                for (int m = 0; m < 4; ++m)
#pragma unroll
                    for (int n = 0; n < 2; ++n) acc[a][b][m][n] = (f32x4){0.f, 0.f, 0.f, 0.f};
        cur = nxt; cA = nA; cB = nB; ++ui;
        if constexpr (ALIGN_EPI) { if (wr == 1) PG8_BAR; }
    }
    PG8_WAIT_V(0);
    if constexpr (!ALIGN_EPI) { if (wr == 0) PG8_BAR; }
    PG8_BAR;
    if constexpr (Epi::AFTER_DRAIN) { E.fused(acc, cur, wr, wc, fr, fq, lds, wid, lane); S.done(cur); }
#undef PG8_SA
#undef PG8_SB
#undef PG8_STAGE
#undef PG8_LDA
#undef PG8_LDB
#undef PG8_MMA
#undef PG8_WAIT_V
#undef PG8_WAIT_L
#undef PG8_BAR
#undef PG8_SCHED
}
}

#define LAS __attribute__((address_space(3)))
typedef unsigned short bf16_t;
typedef short bf16x8 __attribute__((ext_vector_type(8)));
typedef float f32x4 __attribute__((ext_vector_type(4)));
typedef float f32x16 __attribute__((ext_vector_type(16)));
typedef unsigned u32x4 __attribute__((ext_vector_type(4)));
typedef unsigned u32x2 __attribute__((ext_vector_type(2)));

#ifndef MK_MULTI
#define MK_MULTI 0
#endif

constexpr int DM = 1024, MP = 16384, MS = 2048, MT = MP + MS;
constexpr int NPROJ = 3328, NPJ = 3072, DFF = 2816;
constexpr float EPS = 1e-6f;
constexpr float LOG2E = 1.4426950408889634f;
constexpr float QSCALE2 = 0.125f * LOG2E;
constexpr size_t O_Y = 0, O_GSP = 18874368, O_FKP = 19922944, O_FVP = 36700160, O_FLP = 53477376, O_GSS = 53739520, O_FKS = 57933824, O_FVS = 60030976, O_FLS = 62128128;
constexpr size_t MiB = 1u << 20;
constexpr size_t WS_CTL = 0, CTL_BYTES = 2 * MiB;
constexpr size_t WS_SS = 65536;
constexpr size_t WS_WGIN = 2 * MiB, WS_WFIN = 9 * MiB, WS_WGOUT = 16 * MiB, WS_WFOUT = 18 * MiB, WS_WFFI = 20 * MiB  , WS_WFFD = 42 * MiB  ;
constexpr size_t WS_XB = 54 * MiB, WS_XR = 90 * MiB, WS_PROJ = 162 * MiB, WS_GL = 270 * MiB, WS_DST = 272 * MiB, WS_DEC = 400 * MiB, WS_SPREV = 401 * MiB;
constexpr size_t WS_OG = 465 * MiB, WS_ACT = 501 * MiB, WS_CP = 600 * MiB, WS_CS = 601 * MiB, WS_END = 606 * MiB;
constexpr int LDS_BYTES = 135168;

struct Args {
    const float* in[19];
    float* out; unsigned char* ws;
    int ph_lo, ph_hi;
};
enum { I_XP = 0, I_XS, I_STATE, I_CK, I_CV, I_CLF, I_NMIX, I_GWIN, I_GWG2, I_GBG, I_GNORM, I_GWOUT, I_FWIN, I_FBF, I_FWOUT, I_NFFN, I_FFIN, I_FFDN, I_NFIN };

__device__ __forceinline__ float bf2f(unsigned u) { return __uint_as_float(u << 16); }
__device__ __forceinline__ unsigned f2bf(float f) { unsigned u = __float_as_uint(f); return (u + 0x7fffu + ((u >> 16) & 1u)) >> 16; }
__device__ __forceinline__ unsigned pk(float lo, float hi) { return pg8::cvt_pk_bf16(lo, hi); }
__device__ __forceinline__ float wave_sum(float v) {
#pragma unroll
    for (int o = 1; o < 64; o <<= 1) v += __shfl_xor(v, o);
    return v;
}
__device__ __forceinline__ float log_sigmoid(float z) { return fminf(z, 0.f) - __logf(1.f + __expf(-fabsf(z))); }
__device__ __forceinline__ int crow(int r, int hi) { return (r & 3) + 8 * (r >> 2) + 4 * hi; }
__device__ __forceinline__ float dot4(f32x4 v) { return (v[0] * v[0] + v[1] * v[1]) + (v[2] * v[2] + v[3] * v[3]); }
#define MFMA32(a, b, c) __builtin_amdgcn_mfma_f32_32x32x16_bf16((a), (b), (c), 0, 0, 0)

#define XB_TMO      128
#define XB_XCNT(j)  (256  + 64 * (j))
#define XB_XSUB(j)  (1280 + 64 * (j))
#define XB_XGEN(j)  (2304 + 64 * (j))
#define XB_TOP      3328
#define XB_TOPGEN   3392
#define XCD_BAR_WORDS 3456
#define XB_SPIN_CAP (1u << 18)

__device__ __forceinline__ unsigned xb_ld(unsigned* p)              { return __hip_atomic_load(p, __ATOMIC_RELAXED, __HIP_MEMORY_SCOPE_AGENT); }
__device__ __forceinline__ unsigned xb_add(unsigned* p, unsigned v) { return __hip_atomic_fetch_add(p, v, __ATOMIC_RELAXED, __HIP_MEMORY_SCOPE_AGENT); }
__device__ __forceinline__ unsigned xb_xcc_id() { return (unsigned)__builtin_amdgcn_s_getreg((3 << 11) | 20) & 0xFu; }
#define XB_SPIN(cond, bar) do { unsigned _sp = 0; while (cond) { __builtin_amdgcn_s_sleep(1); \
    if ((++_sp & 255u) == 0u) { if (xb_ld(&(bar)[XB_TMO])) break; if (_sp > XB_SPIN_CAP) { atomicAdd(&(bar)[XB_TMO], 1u); break; } } } } while (0)

struct XcdBarrier {
    unsigned* bar; unsigned x;
    volatile LAS unsigned* st;
};

__device__ __forceinline__ XcdBarrier xcd_barrier_post(unsigned* bar, volatile LAS unsigned* st) {
    XcdBarrier b; b.bar = bar; b.x = xb_xcc_id(); b.st = st;
    if (threadIdx.x == 0) (void)xb_add(&bar[XB_XCNT(b.x)], 1u);
    return b;
}
__device__ __forceinline__ void xcd_barrier_complete(unsigned* bar, unsigned x, unsigned& nloc, unsigned& nx) {
    const unsigned G = gridDim.x * gridDim.y * gridDim.z;
    unsigned sum, cnt, mine, sp = 0u;
    for (;;) {
        sum = 0u; cnt = 0u; mine = 0u;
#pragma unroll
        for (unsigned j = 0; j < 16; ++j) { const unsigned c = xb_ld(&bar[XB_XCNT(j)]); sum += c; cnt += (c > 0u) ? 1u : 0u; mine = (j == x) ? c : mine; }
        if (sum == G) break;
        __builtin_amdgcn_s_sleep(1);
        if ((++sp & 255u) == 0u) { if (xb_ld(&bar[XB_TMO])) break; if (sp > XB_SPIN_CAP) { atomicAdd(&bar[XB_TMO], 1u); break; } }
    }
    nloc = mine > 0u ? mine : 1u; nx = cnt > 0u ? cnt : 1u;
}

__device__ __forceinline__ void xcd_barrier(const XcdBarrier& b) {
    asm volatile("s_waitcnt vmcnt(0)" ::: "memory");
    __syncthreads();
    if (threadIdx.x == 0) {
        unsigned* bar = b.bar;
        __builtin_amdgcn_s_waitcnt(0);
        unsigned nloc = b.st[0], nx = b.st[1];
        if (nloc == 0u) { xcd_barrier_complete(bar, b.x, nloc, nx); b.st[0] = nloc; b.st[1] = nx; }
        const unsigned old = xb_add(&bar[XB_XSUB(b.x)], 1u);
        const unsigned gen = old / nloc;
        if (old + 1u == (gen + 1u) * nloc) {
            __builtin_amdgcn_fence(__ATOMIC_RELEASE, "agent");
            asm volatile("s_waitcnt vmcnt(0)" ::: "memory");
            const unsigned og = xb_add(&bar[XB_TOP], 1u);
            const unsigned tg = og / nx;
            if (og + 1u == (tg + 1u) * nx) xb_add(&bar[XB_TOPGEN], 1u);
            else XB_SPIN(xb_ld(&bar[XB_TOPGEN]) == tg, bar);
            __builtin_amdgcn_fence(__ATOMIC_ACQUIRE, "agent");
            xb_add(&bar[XB_XGEN(b.x)], 1u);
            asm volatile("s_waitcnt vmcnt(0)" ::: "memory");
        } else {
            XB_SPIN(xb_ld(&bar[XB_XGEN(b.x)]) == gen, bar);
            __builtin_amdgcn_fence(__ATOMIC_ACQUIRE, "agent");
            asm volatile("s_waitcnt vmcnt(0)" ::: "memory");
        }
    }
    __syncthreads();
}

__device__ __forceinline__ void tr_item(const float* __restrict__ W, int K, int N, int nsrc0, bf16_t* WT, int drow0, const float* __restrict__ gain, LAS float* scr, int k0, int lane) {
    const int n = nsrc0 + (lane & 31);
    float wv_[32];
    const float* wp_ = W + (size_t)(k0 + (lane >> 5)) * N + ((n < N) ? n : 0);
#pragma unroll
    for (int i = 0; i < 32; ++i) wv_[i] = wp_[(size_t)(2 * i) * N];
#pragma unroll
    for (int i = 0; i < 32; ++i) {
        const int kk = 2 * i + (lane >> 5);
        float v = (n < N) ? wv_[i] : 0.f;
        if (gain) v *= gain[k0 + kk];
        scr[kk * 33 + (lane & 31)] = v;
    }
    asm volatile("s_waitcnt lgkmcnt(0)" ::: "memory");
    const int c = lane & 7;
#pragma unroll
    for (int j = 0; j < 4; ++j) {
        const int nn = (lane >> 3) + 8 * j; const LAS float* s = scr + (8 * c) * 33 + nn;
        u32x4 o; o.x = pk(s[0 * 33], s[1 * 33]); o.y = pk(s[2 * 33], s[3 * 33]); o.z = pk(s[4 * 33], s[5 * 33]); o.w = pk(s[6 * 33], s[7 * 33]);
        *(u32x4*)(WT + (size_t)(drow0 + nn) * K + k0 + 8 * c) = o;
    }
    asm volatile("s_waitcnt lgkmcnt(0)" ::: "memory");
}

__device__ __forceinline__ void convert_weights(const Args& a, LAS unsigned char* lds, int sel, int gw, int NGW) {
    const int tid = threadIdx.x, lane = tid & 63, wave = tid >> 6;
    LAS float* scr = (LAS float*)(lds + wave * 16384);
    unsigned char* ws = a.ws;
    constexpr int I_IN = 16 * 104, I_OUT = 16 * 32, I_FI = 16 * 176, I_FD = 44 * 32;
    constexpr int NITEMS = I_IN + I_OUT + I_FI + I_FD;
    for (int it = gw; it < NITEMS; it += NGW) {
        int r = it;
        if (r < I_IN) { const int kb = r / 104, nb = r % 104; tr_item(a.in[sel ? I_FWIN : I_GWIN], 1024, 3088, 32 * nb, (bf16_t*)(ws + (sel ? WS_WFIN : WS_WGIN)), 32 * nb, a.in[I_NMIX] + sel * 1024, scr, 64 * kb, lane); continue; } r -= I_IN;
        if (r < I_OUT) { const int kb = r / 32, nb = r % 32; tr_item(a.in[sel ? I_FWOUT : I_GWOUT], 1024, 1024, 32 * nb, (bf16_t*)(ws + (sel ? WS_WFOUT : WS_WGOUT)), 32 * nb, nullptr, scr, 64 * kb, lane); continue; } r -= I_OUT;
        if (r < I_FI) { const int kb = r / 176, nb = r % 176, ns = 32 * nb, bj = ns / DFF, j = ns % DFF, drow = 256 * (j / 128) + 128 * bj + (j % 128);
            tr_item(a.in[I_FFIN] + (size_t)sel * 1024 * 5632, 1024, 5632, ns, (bf16_t*)(ws + WS_WFFI + (size_t)sel * 11 * MiB), drow, a.in[I_NFFN] + sel * 1024, scr, 64 * kb, lane); continue; } r -= I_FI;
        { const int kb = r / 32, nb = r % 32;
            tr_item(a.in[I_FFDN] + (size_t)sel * DFF * 1024, DFF, 1024, 32 * nb, (bf16_t*)(ws + WS_WFFD + (size_t)sel * 6 * MiB), 32 * nb, nullptr, scr, 64 * kb, lane); }
    }
}
__device__ __forceinline__ void p0_prologue(const Args& a, LAS unsigned char* lds, int vcu, int G) {
    const int tid = threadIdx.x, lane = tid & 63, wave = tid >> 6;
    const int gw = vcu * 8 + wave, NGW = G * 8;
    unsigned char* ws = a.ws;
    convert_weights(a, lds, 0, gw, NGW);
    if (G != 256 || MK_MULTI) convert_weights(a, lds, 1, gw, NGW);
    float* ss0 = (float*)(ws + WS_SS);
    bf16_t* XB = (bf16_t*)(ws + WS_XB);
    for (int m0 = gw; m0 < MT; m0 += 3 * NGW) {
        f32x4 v[3][4];
#pragma unroll
        for (int q = 0; q < 3; ++q) { const int m = m0 + q * NGW; if (m < MT) { const float* xr = (m < MP) ? a.in[I_XP] + (size_t)m * DM : a.in[I_XS] + (size_t)(m - MP) * DM;
#pragma unroll
            for (int j = 0; j < 4; ++j) v[q][j] = ((const f32x4*)xr)[lane + 64 * j]; } }
#pragma unroll
        for (int q = 0; q < 3; ++q) { const int m = m0 + q * NGW; if (m < MT) { float s = 0.f;
#pragma unroll
            for (int j = 0; j < 4; ++j) s += dot4(v[q][j]);
            s = wave_sum(s);
            if (lane == 0) ss0[m] = s;
#pragma unroll
            for (int j = 0; j < 4; ++j) { u32x2 o; o.x = pk(v[q][j][0], v[q][j][1]); o.y = pk(v[q][j][2], v[q][j][3]); ((u32x2*)(XB + (size_t)m * DM))[lane + 64 * j] = o; } } }
    }
}

__device__ __forceinline__ void p_final(const Args& a, int vcu, int G) {
    const int tid = threadIdx.x, lane = tid & 63, wave = tid >> 6;
    const int gw = vcu * 8 + wave, NGW = G * 8;
    const float* ss = (const float*)(a.ws + WS_SS + 4 * 131072);
    const float* XR = (const float*)(a.ws + WS_XR);
    const float* g = a.in[I_NFIN];
    f32x4 gv[4];
#pragma unroll
    for (int j = 0; j < 4; ++j) gv[j] = ((const f32x4*)g)[lane + 64 * j];
    for (int m0 = gw; m0 < MT; m0 += 3 * NGW) {
        f32x4 v[3][4]; float rs[3];
#pragma unroll
        for (int q = 0; q < 3; ++q) { const int m = m0 + q * NGW; if (m < MT) { rs[q] = rsqrtf(ss[m] * (1.f / DM) + EPS);
#pragma unroll
            for (int j = 0; j < 4; ++j) v[q][j] = ((const f32x4*)(XR + (size_t)m * DM))[lane + 64 * j]; } }
#pragma unroll
        for (int q = 0; q < 3; ++q) { const int m = m0 + q * NGW; if (m < MT) {
#pragma unroll
            for (int j = 0; j < 4; ++j) ((f32x4*)(a.out + O_Y + (size_t)m * DM))[lane + 64 * j] = v[q][j] * rs[q] * gv[j]; } }
    }
}

struct EpiGlaProj {
    static constexpr bool PERM = true, AFTER_DRAIN = false;
    const float* ss; bf16_t* proj; float* gl;
    __device__ __forceinline__ void operator()(const pg8::f32x4 (&acc)[2][2][4][2], const pg8::Unit& u, int wr, int wc, int fr, int fq) const {
        const int row0 = u.pm * 256 + wr * 64 + fr;
#pragma unroll
        for (int ai = 0; ai < 2; ++ai)
#pragma unroll
            for (int m = 0; m < 4; ++m) {
                const int row = row0 + ai * 128 + m * 16; const float rs = rsqrtf(ss[row] * (1.f / DM) + EPS);
                if (u.pn < 12) {
#pragma unroll
                    for (int bj = 0; bj < 2; ++bj) { const f32x4 v0 = acc[ai][bj][m][0] * rs, v1 = acc[ai][bj][m][1] * rs;
                        u32x4 w; w.x = pk(v0[0], v0[1]); w.y = pk(v0[2], v0[3]); w.z = pk(v1[0], v1[1]); w.w = pk(v1[2], v1[3]);
                        *(u32x4*)(proj + (size_t)row * NPJ + u.pn * 256 + bj * 128 + wc * 32 + 8 * fq) = w; }
                } else if (wc == 0 && fq < 2) {
#pragma unroll
                    for (int n = 0; n < 2; ++n) *(f32x4*)(gl + (size_t)row * 16 + 8 * fq + 4 * n) = acc[ai][0][m][n] * rs;
                }
            }
    }
};
struct EpiResid {
    static constexpr bool PERM = true, AFTER_DRAIN = false;
    const float* xin_p; const float* xin_s; float* xout; bf16_t* xb; float* ssout;
    __device__ __forceinline__ void operator()(const pg8::f32x4 (&acc)[2][2][4][2], const pg8::Unit& u, int wr, int wc, int fr, int fq) const {
        const int row0 = u.pm * 256 + wr * 64 + fr;
#pragma unroll
        for (int ai = 0; ai < 2; ++ai)
#pragma unroll
            for (int m = 0; m < 4; ++m) {
                const int row = row0 + ai * 128 + m * 16;
                const float* xi = (row < MP) ? xin_p + (size_t)row * DM : xin_s + (size_t)(row - MP) * DM;
                float sq = 0.f;
#pragma unroll
                for (int bj = 0; bj < 2; ++bj) { const int col = u.pn * 256 + bj * 128 + wc * 32 + 8 * fq;
                    const f32x4 a0 = *(const f32x4*)(xi + col) + acc[ai][bj][m][0], a1 = *(const f32x4*)(xi + col + 4) + acc[ai][bj][m][1];
                    *(f32x4*)(xout + (size_t)row * DM + col) = a0; *(f32x4*)(xout + (size_t)row * DM + col + 4) = a1;
                    u32x4 w; w.x = pk(a0[0], a0[1]); w.y = pk(a0[2], a0[3]); w.z = pk(a1[0], a1[1]); w.w = pk(a1[2], a1[3]);
                    *(u32x4*)(xb + (size_t)row * DM + col) = w;
                    sq += dot4(a0) + dot4(a1); }
                sq += __shfl_xor(sq, 16); sq += __shfl_xor(sq, 32);
                if (fq == 0) atomicAdd(ssout + row, sq);
            }
    }
};
struct EpiSwiglu {
    static constexpr bool PERM = true, AFTER_DRAIN = false;
    const float* ss; bf16_t* act;
    __device__ __forceinline__ void operator()(const pg8::f32x4 (&acc)[2][2][4][2], const pg8::Unit& u, int wr, int wc, int fr, int fq) const {
        const int row0 = u.pm * 256 + wr * 64 + fr;
#pragma unroll
        for (int ai = 0; ai < 2; ++ai)
#pragma unroll
            for (int m = 0; m < 4; ++m) {
                const int row = row0 + ai * 128 + m * 16; const float rs = rsqrtf(ss[row] * (1.f / DM) + EPS);
                float y[8];
#pragma unroll
                for (int n = 0; n < 2; ++n)
#pragma unroll
                    for (int i = 0; i < 4; ++i) { const float g = acc[ai][0][m][n][i] * rs, up = acc[ai][1][m][n][i] * rs; y[4 * n + i] = g * up * __builtin_amdgcn_rcpf(1.f + __expf(-g)); }
                u32x4 w; w.x = pk(y[0], y[1]); w.y = pk(y[2], y[3]); w.z = pk(y[4], y[5]); w.w = pk(y[6], y[7]);
                *(u32x4*)(act + (size_t)row * DFF + u.pn * 128 + wc * 32 + 8 * fq) = w;
            }
    }
};
struct EpiFoxProj {
    static constexpr bool PERM = true, AFTER_DRAIN = false;
    const float* ss; bf16_t* qkv; float* out; const float* bf;
    __device__ __forceinline__ void operator()(const pg8::f32x4 (&acc)[2][2][4][2], const pg8::Unit& u, int wr, int wc, int fr, int fq) const {
        const int row0 = u.pm * 256 + wr * 64 + fr;
        const int sect = u.pn >> 2;
#pragma unroll
        for (int ai = 0; ai < 2; ++ai)
#pragma unroll
            for (int m = 0; m < 4; ++m) {
                const int row = row0 + ai * 128 + m * 16; const float rs = rsqrtf(ss[row] * (1.f / DM) + EPS);
                if (u.pn < 12) {
                    const float sc = (sect == 0) ? rs * QSCALE2 : rs;
                    float* fdst = nullptr;
                    if (sect == 1) fdst = (row < MP) ? out + O_FKP + (size_t)row * DM : out + O_FKS + (size_t)(row - MP) * DM;
                    if (sect == 2) fdst = (row < MP) ? out + O_FVP + (size_t)row * DM : out + O_FVS + (size_t)(row - MP) * DM;
#pragma unroll
                    for (int bj = 0; bj < 2; ++bj) { const f32x4 v0 = acc[ai][bj][m][0] * sc, v1 = acc[ai][bj][m][1] * sc;
                        u32x4 w; w.x = pk(v0[0], v0[1]); w.y = pk(v0[2], v0[3]); w.z = pk(v1[0], v1[1]); w.w = pk(v1[2], v1[3]);
                        const int cl = bj * 128 + wc * 32 + 8 * fq;
                        *(u32x4*)(qkv + (size_t)row * NPJ + u.pn * 256 + cl) = w;
                        if (sect > 0) { float* d = fdst + (u.pn & 3) * 256 + cl; *(f32x4*)d = v0; *(f32x4*)(d + 4) = v1; } }
                } else if (wc == 0 && fq < 2) {
                    float* d = (row < MP) ? out + O_FLP + (size_t)row * 16 : out + O_FLS + (size_t)(row - MP) * 16;
#pragma unroll
                    for (int n = 0; n < 2; ++n) { const f32x4 v = acc[ai][0][m][n] * rs; f32x4 o;
#pragma unroll
                        for (int i = 0; i < 4; ++i) o[i] = log_sigmoid(v[i] + bf[8 * fq + 4 * n + i]);
                        *(f32x4*)(d + 8 * fq + 4 * n) = o; }
                }
            }
    }
};

constexpr int GL_OFF = 0, GSUM_OFF = 4096, DECS_OFF = 6144, QE_OFF = 8192, KE_OFF = 25600, VT_OFF = 43008, AL_OFF = 79872, KDT_OFF = 8192, OL_OFF = 8192;
constexpr int QES = 136, VTS = 72, OLS = 260;

struct GlaPre { unsigned v[32]; f32x4 gl; };
__device__ __forceinline__ void gla_prefetch(GlaPre& pf, const Args& a, int cid, int h) {
    const int tid = threadIdx.x, dvv = tid & 255, th = tid >> 8, row0 = cid * 64;
    const bf16_t* vp = (const bf16_t*)(a.ws + WS_PROJ) + (size_t)(row0 + 32 * th) * NPJ + 1024 + h * 256 + dvv;
#pragma unroll
    for (int i = 0; i < 32; ++i) pf.v[i] = vp[(size_t)i * NPJ];
    pf.gl = *(const f32x4*)((const float*)(a.ws + WS_GL) + (size_t)(row0 + ((tid & 255) >> 2)) * 16 + (tid & 3) * 4);
}
template <int MODE> __device__ __forceinline__ void gla_item(const Args& a, LAS unsigned char* lds, int cid, int h, GlaPre& pf, int next) {
    const int tid = threadIdx.x, lane = tid & 63, w = tid >> 6, l31 = lane & 31, hi = lane >> 5;
    const int row0 = cid * 64;
    const bool prompt = cid < 256;
    LAS float* GLs = (LAS float*)(lds + GL_OFF); LAS float* GSUM = (LAS float*)(lds + GSUM_OFF); LAS float* DECS = (LAS float*)(lds + DECS_OFF);
    LAS bf16_t* QE = (LAS bf16_t*)(lds + QE_OFF); LAS bf16_t* KE = (LAS bf16_t*)(lds + KE_OFF); LAS bf16_t* VT = (LAS bf16_t*)(lds + VT_OFF);
    LAS bf16_t* AL = (LAS bf16_t*)(lds + AL_OFF); LAS bf16_t* KDT = (LAS bf16_t*)(lds + KDT_OFF);
    const bf16_t* P = (const bf16_t*)(a.ws + WS_PROJ) + (size_t)row0 * NPJ;
    const float* GL = (const float*)(a.ws + WS_GL);
    const float* state = a.in[I_STATE];

    bf16x8 sfr[8];
    if (MODE == 1) {
        if (prompt) {
            const bf16_t* sp = (const bf16_t*)(a.ws + WS_SPREV) + ((size_t)(cid * 4 + h) * 256 + 32 * w + l31) * 128 + 8 * hi;
#pragma unroll
            for (int ks = 0; ks < 8; ++ks) sfr[ks] = *(const bf16x8*)(sp + 16 * ks);
        } else {
            const float* s0 = state + ((size_t)((cid - 256) * 4 + h) * 128) * 256 + 32 * w + l31;
#pragma unroll
            for (int ks = 0; ks < 8; ++ks) { float f[8];
#pragma unroll
                for (int j = 0; j < 8; ++j) f[j] = s0[(size_t)(16 * ks + 8 * hi + j) * 256];
                u32x4 o; o.x = pk(f[0], f[1]); o.y = pk(f[2], f[3]); o.z = pk(f[4], f[5]); o.w = pk(f[6], f[7]); sfr[ks] = __builtin_bit_cast(bf16x8, o); }
        }
    }
    unsigned kraw[16], qraw[16];
    {
        const int dk_ = tid & 127, tg_ = tid >> 7;
        const bf16_t* kp_ = P + (size_t)(16 * tg_) * NPJ + 512 + h * 128 + dk_;
#pragma unroll
        for (int i = 0; i < 16; ++i) kraw[i] = kp_[(size_t)i * NPJ];
        if (MODE == 1) { const bf16_t* qp_ = P + (size_t)(16 * tg_) * NPJ + h * 128 + dk_;
#pragma unroll
            for (int i = 0; i < 16; ++i) qraw[i] = qp_[(size_t)i * NPJ]; }
    }
    float wv[16];
#pragma unroll
    for (int j = 0; j < 16; ++j) wv[j] = a.in[I_GWG2][j * 512 + h * 128 + (tid & 127)];
    const float bias = a.in[I_GBG][h * 128 + (tid & 127)];
    if (tid < 256) ((LAS f32x4*)GLs)[tid] = pf.gl;
    {
        const int dvv = tid & 255, th = tid >> 8;
#pragma unroll
        for (int q4 = 0; q4 < 4; ++q4) { u32x4 o; o.x = pf.v[8 * q4] | (pf.v[8 * q4 + 1] << 16); o.y = pf.v[8 * q4 + 2] | (pf.v[8 * q4 + 3] << 16);
            o.z = pf.v[8 * q4 + 4] | (pf.v[8 * q4 + 5] << 16); o.w = pf.v[8 * q4 + 6] | (pf.v[8 * q4 + 7] << 16);
            *(LAS u32x4*)(VT + dvv * VTS + 32 * th + 8 * q4) = o; }
    }
    if (next >= 0) gla_prefetch(pf, a, next >> 2, next & 3);
    __syncthreads();
    const int dk = tid & 127, tg = tid >> 7;
    float bc[16];
    {
        float run = 0.f;
#pragma unroll
        for (int i = 0; i < 16; ++i) { const LAS f32x4* gp = (const LAS f32x4*)(GLs + (16 * tg + i) * 16); float z = bias;
#pragma unroll
            for (int j4 = 0; j4 < 4; ++j4) { const f32x4 gq = gp[j4]; z += gq[0] * wv[4 * j4] + gq[1] * wv[4 * j4 + 1] + gq[2] * wv[4 * j4 + 2] + gq[3] * wv[4 * j4 + 3]; }
            run += log_sigmoid(z) * (1.f / 16.f); bc[i] = run; }
        GSUM[tg * 128 + dk] = run;
    }
    __syncthreads();
    float off = 0.f, blast = 0.f;
#pragma unroll
    for (int g = 0; g < 4; ++g) { const float s = GSUM[g * 128 + dk]; blast += s; if (g < tg) off += s; }
    if (MODE == 0) {
        float kd[16];
#pragma unroll
        for (int i = 0; i < 16; ++i) { const float b = bc[i] + off; kd[i] = bf2f(kraw[i]) * __expf(blast - b); }
        u32x4 o0, o1; o0.x = pk(kd[0], kd[1]); o0.y = pk(kd[2], kd[3]); o0.z = pk(kd[4], kd[5]); o0.w = pk(kd[6], kd[7]);
        o1.x = pk(kd[8], kd[9]); o1.y = pk(kd[10], kd[11]); o1.z = pk(kd[12], kd[13]); o1.w = pk(kd[14], kd[15]);
        *(LAS u32x4*)(KDT + dk * VTS + 16 * tg) = o0; *(LAS u32x4*)(KDT + dk * VTS + 16 * tg + 8) = o1;
        if (tg == 0) { const float d = __expf(blast); DECS[dk] = d; if (prompt) ((float*)(a.ws + WS_DEC))[(size_t)(cid * 4 + h) * 128 + dk] = d; }
    } else {
#pragma unroll
        for (int i = 0; i < 16; ++i) { const float b = bc[i] + off; const int t = 16 * tg + i;
            const float qe = bf2f(qraw[i]) * __expf(b) * 0.08838834764831845f, ke = bf2f(kraw[i]) * __expf(-b);
            QE[t * QES + dk] = (bf16_t)f2bf(qe); KE[t * QES + dk] = (bf16_t)f2bf(ke); }
    }
    __syncthreads();
    if (MODE == 0) {
        bf16x8 vf[4];
#pragma unroll
        for (int ks = 0; ks < 4; ++ks) vf[ks] = *(const LAS bf16x8*)(VT + (32 * w + l31) * VTS + 16 * ks + 8 * hi);
        f32x16 acc[4];
#pragma unroll
        for (int d = 0; d < 4; ++d) acc[d] = f32x16{};
#pragma unroll
        for (int d = 0; d < 4; ++d)
#pragma unroll
            for (int ks = 0; ks < 4; ++ks) { const bf16x8 kf = *(const LAS bf16x8*)(KDT + (32 * d + l31) * VTS + 16 * ks + 8 * hi);
                acc[d] = prompt ? MFMA32(vf[ks], kf, acc[d]) : MFMA32(kf, vf[ks], acc[d]); }
        if (prompt) {
            bf16_t* dst = (bf16_t*)(a.ws + WS_DST) + ((size_t)(cid * 4 + h) * 256 + 32 * w) * 128;
#pragma unroll
            for (int d = 0; d < 4; ++d)
#pragma unroll
                for (int r = 0; r < 16; ++r) dst[(size_t)crow(r, hi) * 128 + 32 * d + l31] = (bf16_t)f2bf(acc[d][r]);
        } else {
            const size_t base = ((size_t)((cid - 256) * 4 + h) * 128) * 256;
            float* outs = a.out + O_GSS;
#pragma unroll
            for (int d = 0; d < 4; ++d)
#pragma unroll
                for (int r = 0; r < 16; ++r) { const int dkk = 32 * d + crow(r, hi); const size_t idx = base + (size_t)dkk * 256 + 32 * w + l31; outs[idx] = state[idx] * DECS[dkk] + acc[d][r]; }
        }
    } else {
        u32x2 rraw[8];
#pragma unroll
        for (int i = 0; i < 8; ++i) rraw[i] = *(const u32x2*)(P + (size_t)(8 * w + i) * NPJ + 2048 + h * 256 + 4 * lane);
        f32x16 o[2]; o[0] = f32x16{}; o[1] = f32x16{};
#pragma unroll
        for (int tb = 0; tb < 2; ++tb)
#pragma unroll
            for (int ks = 0; ks < 8; ++ks) { const bf16x8 qa = *(const LAS bf16x8*)(QE + (32 * tb + l31) * QES + 16 * ks + 8 * hi); o[tb] = MFMA32(qa, sfr[ks], o[tb]); }
        if (w < 3) {
            const int tb = (w > 0) ? 1 : 0, sb = (w == 2) ? 1 : 0;
            f32x16 am = f32x16{};
#pragma unroll
            for (int ks = 0; ks < 8; ++ks) { const bf16x8 qa = *(const LAS bf16x8*)(QE + (32 * tb + l31) * QES + 16 * ks + 8 * hi), kb = *(const LAS bf16x8*)(KE + (32 * sb + l31) * QES + 16 * ks + 8 * hi);
                am = MFMA32(qa, kb, am); }
#pragma unroll
            for (int r = 0; r < 16; ++r) { const int tl = crow(r, hi); float v = am[r]; if (tb == sb && l31 > tl) v = 0.f; AL[(32 * tb + tl) * VTS + 32 * sb + l31] = (bf16_t)f2bf(v); }
        }
        __syncthreads();
#pragma unroll
        for (int tb = 0; tb < 2; ++tb)
#pragma unroll
            for (int ks = 0; ks < 4; ++ks) { if (tb == 0 && ks >= 2) continue;
                const bf16x8 aa = *(const LAS bf16x8*)(AL + (32 * tb + l31) * VTS + 16 * ks + 8 * hi), vb = *(const LAS bf16x8*)(VT + (32 * w + l31) * VTS + 16 * ks + 8 * hi);
                o[tb] = MFMA32(aa, vb, o[tb]); }
        __syncthreads();
        LAS float* OL = (LAS float*)(lds + OL_OFF);
#pragma unroll
        for (int tb = 0; tb < 2; ++tb)
#pragma unroll
            for (int r = 0; r < 16; ++r) OL[(32 * tb + crow(r, hi)) * OLS + 32 * w + l31] = o[tb][r];
        __syncthreads();
        const f32x4 ng = *(const f32x4*)(a.in[I_GNORM] + h * 256 + 4 * lane);
        bf16_t* OG = (bf16_t*)(a.ws + WS_OG);
#pragma unroll
        for (int i = 0; i < 8; ++i) { const int t = 8 * w + i; const f32x4 v = *(const LAS f32x4*)(OL + t * OLS + 4 * lane);
            const float rs = rsqrtf(wave_sum(dot4(v)) * (1.f / 256.f) + EPS);
            const u32x2 rr = rraw[i];
            float rv[4] = {bf2f(rr.x & 0xffffu), bf2f(rr.x >> 16), bf2f(rr.y & 0xffffu), bf2f(rr.y >> 16)}; float y[4];
#pragma unroll
            for (int j = 0; j < 4; ++j) y[j] = v[j] * rs * ng[j] * rv[j] * __builtin_amdgcn_rcpf(1.f + __expf(-rv[j]));
            u32x2 ov; ov.x = pk(y[0], y[1]); ov.y = pk(y[2], y[3]);
            *(u32x2*)(OG + (size_t)(row0 + t) * DM + h * 256 + 4 * lane) = ov; }
    }
    __syncthreads();
}

__device__ __forceinline__ void gla_scan(const Args& a, int vcu, int G) {
    const int gt = vcu * 512 + threadIdx.x, NT_ = G * 512;
    const bf16_t* DST = (const bf16_t*)(a.ws + WS_DST); const float* DEC = (const float*)(a.ws + WS_DEC); bf16_t* SP = (bf16_t*)(a.ws + WS_SPREV);
    for (int it0 = gt; it0 < 32 * 8192; it0 += 2 * NT_) {
        const int it1 = it0 + NT_; const bool two = it1 < 32 * 8192;
        const int bhA = it0 >> 13, eA = it0 & 8191, dvA = eA >> 5, dkA = (eA & 31) * 4;
        const int itB = two ? it1 : it0; const int bhB = itB >> 13, eB = itB & 8191, dvB = eB >> 5, dkB = (eB & 31) * 4;
        f32x4 SA = (f32x4){0.f, 0.f, 0.f, 0.f}, SB = SA;
#pragma unroll 8
        for (int c = 0; c < 32; ++c) {
            const size_t chA = (size_t)(((bhA >> 2) * 32 + c) * 4 + (bhA & 3)), chB = (size_t)(((bhB >> 2) * 32 + c) * 4 + (bhB & 3));
            const size_t baseA = (chA * 256 + dvA) * 128 + dkA, baseB = (chB * 256 + dvB) * 128 + dkB;
            const u32x2 rA = *(const u32x2*)(DST + baseA), rB = *(const u32x2*)(DST + baseB);
            const f32x4 deA = *(const f32x4*)(DEC + chA * 128 + dkA), deB = *(const f32x4*)(DEC + chB * 128 + dkB);
            const f32x4 dsA = (f32x4){bf2f(rA.x & 0xffffu), bf2f(rA.x >> 16), bf2f(rA.y & 0xffffu), bf2f(rA.y >> 16)};
            const f32x4 dsB = (f32x4){bf2f(rB.x & 0xffffu), bf2f(rB.x >> 16), bf2f(rB.y & 0xffffu), bf2f(rB.y >> 16)};
            u32x2 o; o.x = pk(SA[0], SA[1]); o.y = pk(SA[2], SA[3]); *(u32x2*)(SP + baseA) = o;
            if (two) { o.x = pk(SB[0], SB[1]); o.y = pk(SB[2], SB[3]); *(u32x2*)(SP + baseB) = o; }
            SA = SA * deA + dsA; SB = SB * deB + dsB;
        }
        float* ogA = a.out + O_GSP + ((size_t)bhA * 128 + dkA) * 256 + dvA;
#pragma unroll
        for (int i = 0; i < 4; ++i) ogA[(size_t)i * 256] = SA[i];
        if (two) { float* ogB = a.out + O_GSP + ((size_t)bhB * 128 + dkB) * 256 + dvB;
#pragma unroll
            for (int i = 0; i < 4; ++i) ogB[(size_t)i * 256] = SB[i]; }
    }
}

template <int L, int C> __device__ __forceinline__ void cumsum_item(const float* src0, const float* src1, float* dst, LAS float* SEG, int hh, int seg) {
    float s = 0.f;
#pragma unroll 1
    for (int c0 = 0; c0 < L; c0 += C) { float v[C];
#pragma unroll
        for (int i = 0; i < C; ++i) { const int t = seg * L + c0 + i; v[i] = (t < 2048) ? src0[(unsigned)(t * 16 + hh)] : src1[(unsigned)((t - 2048) * 16 + hh)]; }
#pragma unroll
        for (int i = 0; i < C; ++i) s += v[i]; }
    SEG[seg * 16 + hh] = s;
    __syncthreads();
    float run = 0.f;
    for (int g = 0; g < seg; ++g) run += SEG[g * 16 + hh];
#pragma unroll 1
    for (int c0 = 0; c0 < L; c0 += C) { float v[C];
#pragma unroll
        for (int i = 0; i < C; ++i) { const int t = seg * L + c0 + i; v[i] = (t < 2048) ? src0[(unsigned)(t * 16 + hh)] : src1[(unsigned)((t - 2048) * 16 + hh)]; }
#pragma unroll
        for (int i = 0; i < C; ++i) { run += v[i]; dst[seg * L + c0 + i] = run; } }
    __syncthreads();
}
__device__ __forceinline__ void fox_cumsum(const Args& a, LAS unsigned char* lds, int vcu, int G) {
    const int tid = threadIdx.x, hh = tid & 15, seg = tid >> 4;
    LAS float* SEG = (LAS float*)lds;
    for (int it = vcu; it < 40; it += G) {
        const bool prompt = it < 8; const int b = prompt ? it : it - 8;
        const float* src0 = prompt ? a.out + O_FLP + (size_t)b * 2048 * 16 : a.in[I_CLF] + (size_t)b * 2048 * 16;
        const float* src1 = a.out + O_FLS + (size_t)b * 64 * 16;
        if (prompt) cumsum_item<64, 32>(src0, src1, (float*)(a.ws + WS_CP) + (size_t)(b * 16 + hh) * 2048, SEG, hh, seg);
        else cumsum_item<66, 22>(src0, src1, (float*)(a.ws + WS_CS) + (size_t)(b * 16 + hh) * 2112, SEG, hh, seg);
    }
}

constexpr int AT_KS = 72, AT_VS = 68, AT_BUF = 18432, AT_VOFF = 9216, AT_COFF = 17920;
struct TileRegs { u32x4 k0, k1, v0, v1; float ck; };

template <bool SAMPLE> __device__ __forceinline__ void attn_load(TileRegs& R, const Args& a, int b, int h, int t, const float* cbase, int tid) {
    const int kvl = tid >> 3, ch = tid & 7, kp = tid >> 4, c4 = tid & 15;
    if (SAMPLE && t < 32) {
        const float* kptr = a.in[I_CK] + (((size_t)b * 2048 + 64 * t + kvl) * 16 + h) * 64 + 8 * ch;
        R.k0 = *(const u32x4*)kptr; R.k1 = *(const u32x4*)(kptr + 4);
        const float* vptr = a.in[I_CV] + (((size_t)b * 2048 + 64 * t + 2 * kp) * 16 + h) * 64 + 4 * c4;
        R.v0 = *(const u32x4*)vptr; R.v1 = *(const u32x4*)(vptr + 1024);
    } else {
        const size_t rowbase = SAMPLE ? (size_t)(MP + b * 64) : (size_t)(b * 2048 + 64 * t);
        const bf16_t* qkv = (const bf16_t*)(a.ws + WS_PROJ);
        R.k0 = *(const u32x4*)(qkv + (rowbase + kvl) * NPJ + 1024 + h * 64 + 8 * ch);
        const bf16_t* vptr = qkv + (rowbase + 2 * kp) * NPJ + 2048 + h * 64 + 4 * c4;
        const u32x2 x0 = *(const u32x2*)vptr, x1 = *(const u32x2*)(vptr + NPJ);
        R.v0.x = x0.x; R.v0.y = x0.y; R.v1.x = x1.x; R.v1.y = x1.y;
    }
    R.ck = cbase[64 * t + (tid & 63)];
}
__device__ __forceinline__ void attn_store(const TileRegs& R, LAS unsigned char* buf, bool f32src, int tid) {
    const int kvl = tid >> 3, ch = tid & 7, kp = tid >> 4, c4 = tid & 15;
    LAS unsigned* VT32 = (LAS unsigned*)(buf + AT_VOFF);
    if (f32src) {
        u32x4 o; o.x = pk(__uint_as_float(R.k0.x), __uint_as_float(R.k0.y)); o.y = pk(__uint_as_float(R.k0.z), __uint_as_float(R.k0.w));
        o.z = pk(__uint_as_float(R.k1.x), __uint_as_float(R.k1.y)); o.w = pk(__uint_as_float(R.k1.z), __uint_as_float(R.k1.w));
        *(LAS u32x4*)(buf + (kvl * AT_KS + 8 * ch) * 2) = o;
#pragma unroll
        for (int i = 0; i < 4; ++i) VT32[(4 * c4 + i) * (AT_VS / 2) + kp] = pk(__uint_as_float(R.v0[i]), __uint_as_float(R.v1[i]));
    } else {
        *(LAS u32x4*)(buf + (kvl * AT_KS + 8 * ch) * 2) = R.k0;
        VT32[(4 * c4 + 0) * (AT_VS / 2) + kp] = (R.v0.x & 0xffffu) | (R.v1.x << 16);
        VT32[(4 * c4 + 1) * (AT_VS / 2) + kp] = (R.v0.x >> 16) | (R.v1.x & 0xffff0000u);
        VT32[(4 * c4 + 2) * (AT_VS / 2) + kp] = (R.v0.y & 0xffffu) | (R.v1.y << 16);
        VT32[(4 * c4 + 3) * (AT_VS / 2) + kp] = (R.v0.y >> 16) | (R.v1.y & 0xffff0000u);
    }
    if (tid < 64) { const float c = -R.ck * LOG2E; const unsigned h1 = f2bf(c); const float r1 = c - bf2f(h1); const unsigned h2 = f2bf(r1); const unsigned h3 = f2bf(r1 - bf2f(h2));
        u32x2 o; o.x = h1 | (h2 << 16); o.y = h3; ((LAS u32x2*)(buf + AT_COFF))[tid] = o; }
}

template <bool QLDS> __device__ __forceinline__ void attn_tile(const LAS unsigned char* buf, const bf16x8 (&qf)[4], const LAS bf16x8* qlds, float cq2, int qpos, int kv0, bool diag, float& mrun, float& lrun, f32x16 (&ot)[2], int l31, int hi) {
    const LAS bf16_t* Ks = (const LAS bf16_t*)buf; const LAS bf16_t* VTs = (const LAS bf16_t*)(buf + AT_VOFF); const LAS u32x2* CKs = (const LAS u32x2*)(buf + AT_COFF);
    f32x16 p0, p1;
#pragma unroll
    for (int r = 0; r < 16; ++r) { p0[r] = cq2; p1[r] = cq2; }
    {
        const u32x2 b0 = CKs[l31], b1 = CKs[32 + l31];
        const unsigned msk = hi ? 0u : 0xffffffffu;
        u32x4 x0; x0.x = b0.x & msk; x0.y = b0.y & msk; x0.z = 0u; x0.w = 0u;
        u32x4 x1; x1.x = b1.x & msk; x1.y = b1.y & msk; x1.z = 0u; x1.w = 0u;
        u32x4 qx; qx.x = 0x3F803F80u & msk; qx.y = 0x00003F80u & msk; qx.z = 0u; qx.w = 0u;
        p0 = MFMA32(__builtin_bit_cast(bf16x8, x0), __builtin_bit_cast(bf16x8, qx), p0); p1 = MFMA32(__builtin_bit_cast(bf16x8, x1), __builtin_bit_cast(bf16x8, qx), p1);
    }
#pragma unroll
    for (int ks = 0; ks < 4; ++ks) { const bf16x8 k0 = *(const LAS bf16x8*)(Ks + l31 * AT_KS + 16 * ks + 8 * hi), k1 = *(const LAS bf16x8*)(Ks + (32 + l31) * AT_KS + 16 * ks + 8 * hi);
        const bf16x8 qq = QLDS ? qlds[ks * 64] : qf[ks];
        p0 = MFMA32(k0, qq, p0); p1 = MFMA32(k1, qq, p1); }
    __builtin_amdgcn_sched_barrier(0);
    if (diag) {
        int qp = qpos - kv0; asm volatile("" : "+v"(qp));
#pragma unroll
        for (int r = 0; r < 16; ++r) { const int kv = crow(r, hi); if (kv > qp) p0[r] = -INFINITY; if (kv + 32 > qp) p1[r] = -INFINITY; }
    }
    float rm = fmaxf(p0[0], p1[0]);
#pragma unroll
    for (int r = 1; r < 16; ++r) rm = fmaxf(rm, fmaxf(p0[r], p1[r]));
    rm = fmaxf(rm, __shfl_xor(rm, 32));
    if (__all(rm < mrun - 40.f)) return;
    const float mn = fmaxf(mrun, rm);
    if (__any(mn > mrun)) {
        const float alpha = __builtin_amdgcn_exp2f(mrun - mn);
        lrun *= alpha;
#pragma unroll
        for (int r = 0; r < 16; ++r) { ot[0][r] *= alpha; ot[1][r] *= alpha; }
        mrun = mn;
    }
    float rs = 0.f;
#pragma unroll
    for (int r = 0; r < 16; ++r) { p0[r] = __builtin_amdgcn_exp2f(p0[r] - mrun); p1[r] = __builtin_amdgcn_exp2f(p1[r] - mrun); rs += p0[r] + p1[r]; }
    lrun += rs;
    bf16x8 pf[4];
    { u32x4 x; x.x = pk(p0[0], p0[1]); x.y = pk(p0[2], p0[3]); x.z = pk(p0[4], p0[5]); x.w = pk(p0[6], p0[7]); pf[0] = __builtin_bit_cast(bf16x8, x);
      x.x = pk(p0[8], p0[9]); x.y = pk(p0[10], p0[11]); x.z = pk(p0[12], p0[13]); x.w = pk(p0[14], p0[15]); pf[1] = __builtin_bit_cast(bf16x8, x);
      x.x = pk(p1[0], p1[1]); x.y = pk(p1[2], p1[3]); x.z = pk(p1[4], p1[5]); x.w = pk(p1[6], p1[7]); pf[2] = __builtin_bit_cast(bf16x8, x);
      x.x = pk(p1[8], p1[9]); x.y = pk(p1[10], p1[11]); x.z = pk(p1[12], p1[13]); x.w = pk(p1[14], p1[15]); pf[3] = __builtin_bit_cast(bf16x8, x); }
    __builtin_amdgcn_sched_barrier(0);
#pragma unroll
    for (int db = 0; db < 2; ++db)
#pragma unroll
        for (int ks = 0; ks < 4; ++ks) { const LAS bf16_t* vp = VTs + (32 * db + l31) * AT_VS + 16 * ks + 4 * hi;
            const u32x2 lo = *(const LAS u32x2*)vp, hh2 = *(const LAS u32x2*)(vp + 8);
            u32x4 x; x.x = lo.x; x.y = lo.y; x.z = hh2.x; x.w = hh2.y;
            ot[db] = MFMA32(__builtin_bit_cast(bf16x8, x), pf[ks], ot[db]); }
}

__device__ __forceinline__ void gld16(u32x4& d, const void* p) { asm volatile("global_load_dwordx4 %0, %1, off" : "=v"(d) : "v"(p)); }
__device__ __forceinline__ void gld8(u32x2& d, const void* p) { asm volatile("global_load_dwordx2 %0, %1, off" : "=v"(d) : "v"(p)); }
__device__ __forceinline__ void gld4(float& d, const void* p) { asm volatile("global_load_dword %0, %1, off" : "=v"(d) : "v"(p)); }
struct PRegs { u32x4 k; u32x2 v0, v1; float ck; };
__device__ __forceinline__ void pload_a(PRegs& R, const Args& a, int b, int h, int t, const float* cbase, int tid) {
    const int kvl = tid >> 3, ch = tid & 7, kp = tid >> 4, c4 = tid & 15;
    const size_t rowbase = (size_t)(b * 2048 + 64 * t);
    const bf16_t* qkv = (const bf16_t*)(a.ws + WS_PROJ);
    gld16(R.k, qkv + (rowbase + kvl) * NPJ + 1024 + h * 64 + 8 * ch);
    const bf16_t* vptr = qkv + (rowbase + 2 * kp) * NPJ + 2048 + h * 64 + 4 * c4;
    gld8(R.v0, vptr); gld8(R.v1, vptr + NPJ);
    gld4(R.ck, cbase + 64 * t + (tid & 63));
}
#define WAIT_P(N, R) asm volatile("s_waitcnt vmcnt(" #N ")" : "+v"(R.k), "+v"(R.v0), "+v"(R.v1), "+v"(R.ck))
__device__ __forceinline__ void pstore(const PRegs& R, LAS unsigned char* buf, int tid) {
    const int kvl = tid >> 3, ch = tid & 7, kp = tid >> 4, c4 = tid & 15;
    LAS unsigned* VT32 = (LAS unsigned*)(buf + AT_VOFF);
    *(LAS u32x4*)(buf + (kvl * AT_KS + 8 * ch) * 2) = R.k;
    VT32[(4 * c4 + 0) * (AT_VS / 2) + kp] = (R.v0.x & 0xffffu) | (R.v1.x << 16);
    VT32[(4 * c4 + 1) * (AT_VS / 2) + kp] = (R.v0.x >> 16) | (R.v1.x & 0xffff0000u);
    VT32[(4 * c4 + 2) * (AT_VS / 2) + kp] = (R.v0.y & 0xffffu) | (R.v1.y << 16);
    VT32[(4 * c4 + 3) * (AT_VS / 2) + kp] = (R.v0.y >> 16) | (R.v1.y & 0xffff0000u);
    if (tid < 64) { const float c = -R.ck * LOG2E; const unsigned h1 = f2bf(c); const float r1 = c - bf2f(h1); const unsigned h2 = f2bf(r1); const unsigned h3 = f2bf(r1 - bf2f(h2));
        u32x2 o; o.x = h1 | (h2 << 16); o.y = h3; ((LAS u32x2*)(buf + AT_COFF))[tid] = o; }
}
__device__ __forceinline__ void attn_unit_prompt(const Args& a, LAS unsigned char* lds, int b, int h, int qb) {
    int tid_ = threadIdx.x; asm volatile("" : "+v"(tid_));
    const int tid = tid_, lane = tid & 63, w = __builtin_amdgcn_readfirstlane(tid >> 6), l31 = lane & 31, hi = lane >> 5;
    const int NT = 4 * (qb + 1);
    const int qpos = 256 * qb + 32 * w + l31;
    const size_t qrow = (size_t)(b * 2048 + qpos);
    const float* cbase = (const float*)(a.ws + WS_CP) + (size_t)(b * 16 + h) * 2048;
    const bf16_t* qkv = (const bf16_t*)(a.ws + WS_PROJ);
    bf16x8 qf[4];
#pragma unroll
    for (int ks = 0; ks < 4; ++ks) qf[ks] = *(const bf16x8*)(qkv + qrow * NPJ + h * 64 + 16 * ks + 8 * hi);
    const float cq2 = cbase[qpos] * LOG2E;
    const int qmax_w = 256 * qb + 32 * w + 31;
    PRegs R0, R1, R2;
    pload_a(R0, a, b, h, NT - 1, cbase, tid); pload_a(R1, a, b, h, NT - 2, cbase, tid); pload_a(R2, a, b, h, NT - 3, cbase, tid);
    WAIT_P(8, R0); pstore(R0, lds, tid);
    pload_a(R0, a, b, h, NT - 4, cbase, tid);
    __syncthreads();
    float mrun = -INFINITY, lrun = 0.f;
    f32x16 ot[2]; ot[0] = f32x16{}; ot[1] = f32x16{};
#define PSTEP(tt, RR) do { if ((tt) < NT) { const int ti_ = NT - 1 - (tt); if (64 * ti_ <= qmax_w) attn_tile<false>(lds + ((tt) & 1) * AT_BUF, qf, nullptr, cq2, qpos, 64 * ti_, ti_ >= 4 * qb, mrun, lrun, ot, l31, hi); \
        { WAIT_P(8, RR); pstore(RR, lds + (((tt) + 1) & 1) * AT_BUF, tid); pload_a(RR, a, b, h, (NT - 5 - (tt)) > 0 ? NT - 5 - (tt) : 0, cbase, tid); } \
        __syncthreads(); } } while (0)
#pragma unroll 1
    for (int t = 0; t < NT; t += 3) { PSTEP(t, R1); PSTEP(t + 1, R2); PSTEP(t + 2, R0); }
#undef PSTEP
    WAIT_P(0, R0); WAIT_P(0, R1); WAIT_P(0, R2);
    lrun += __shfl_xor(lrun, 32);
    const float inv = 1.f / lrun;
    bf16_t* og = (bf16_t*)(a.ws + WS_OG) + qrow * DM + h * 64;
#pragma unroll
    for (int db = 0; db < 2; ++db)
#pragma unroll
        for (int j = 0; j < 4; ++j) { u32x2 o; o.x = pk(ot[db][4 * j] * inv, ot[db][4 * j + 1] * inv); o.y = pk(ot[db][4 * j + 2] * inv, ot[db][4 * j + 3] * inv);
            *(u32x2*)(og + 32 * db + 8 * j + 4 * hi) = o; }
}

struct TileRegs2 { u32x4 k[4], v[4]; float ck; };
__device__ __forceinline__ void sload2(TileRegs2& R, const Args& a, int b, int h, int t, const float* cbase, int st) {
#pragma unroll
    for (int q = 0; q < 2; ++q) {
        const int item = st + 256 * q, kvl = item >> 3, ch = item & 7, kp = item >> 4, c4 = item & 15;
        if (t < 32) {
            const float* kptr = a.in[I_CK] + (((size_t)b * 2048 + 64 * t + kvl) * 16 + h) * 64 + 8 * ch;
            R.k[2 * q] = *(const u32x4*)kptr; R.k[2 * q + 1] = *(const u32x4*)(kptr + 4);
            const float* vptr = a.in[I_CV] + (((size_t)b * 2048 + 64 * t + 2 * kp) * 16 + h) * 64 + 4 * c4;
            R.v[2 * q] = *(const u32x4*)vptr; R.v[2 * q + 1] = *(const u32x4*)(vptr + 1024);
        } else {
            const size_t rowbase = (size_t)(MP + b * 64);
            const bf16_t* qkv = (const bf16_t*)(a.ws + WS_PROJ);
            R.k[2 * q] = *(const u32x4*)(qkv + (rowbase + kvl) * NPJ + 1024 + h * 64 + 8 * ch);
            const bf16_t* vptr = qkv + (rowbase + 2 * kp) * NPJ + 2048 + h * 64 + 4 * c4;
            const u32x2 x0 = *(const u32x2*)vptr, x1 = *(const u32x2*)(vptr + NPJ);
            R.v[2 * q].x = x0.x; R.v[2 * q].y = x0.y; R.v[2 * q + 1].x = x1.x; R.v[2 * q + 1].y = x1.y;
        }
    }
    R.ck = cbase[64 * t + (st & 63)];
}
__device__ __forceinline__ void sload2a(TileRegs2& R, const Args& a, int b, int h, int t, const float* cbase, int st) {
#pragma unroll
    for (int q = 0; q < 2; ++q) {
        const int item = st + 256 * q, kvl = item >> 3, ch = item & 7, kp = item >> 4, c4 = item & 15;
        const float* kptr = a.in[I_CK] + (((size_t)b * 2048 + 64 * t + kvl) * 16 + h) * 64 + 8 * ch;
        gld16(R.k[2 * q], kptr); gld16(R.k[2 * q + 1], kptr + 4);
        const float* vptr = a.in[I_CV] + (((size_t)b * 2048 + 64 * t + 2 * kp) * 16 + h) * 64 + 4 * c4;
        gld16(R.v[2 * q], vptr); gld16(R.v[2 * q + 1], vptr + 1024);
    }
    gld4(R.ck, cbase + 64 * t + (st & 63));
}
#define WAIT_R2(N, R) asm volatile("s_waitcnt vmcnt(" #N ")" : "+v"(R.k[0]), "+v"(R.k[1]), "+v"(R.k[2]), "+v"(R.k[3]), "+v"(R.v[0]), "+v"(R.v[1]), "+v"(R.v[2]), "+v"(R.v[3]), "+v"(R.ck))
__device__ __forceinline__ void sstore2(const TileRegs2& R, LAS unsigned char* buf, bool f32src, int st) {
    LAS unsigned* VT32 = (LAS unsigned*)(buf + AT_VOFF);
#pragma unroll
    for (int q = 0; q < 2; ++q) {
        const int item = st + 256 * q, kvl = item >> 3, ch = item & 7, kp = item >> 4, c4 = item & 15;
        if (f32src) {
            const u32x4 k0 = R.k[2 * q], k1 = R.k[2 * q + 1];
            u32x4 o; o.x = pk(__uint_as_float(k0.x), __uint_as_float(k0.y)); o.y = pk(__uint_as_float(k0.z), __uint_as_float(k0.w));
            o.z = pk(__uint_as_float(k1.x), __uint_as_float(k1.y)); o.w = pk(__uint_as_float(k1.z), __uint_as_float(k1.w));
            *(LAS u32x4*)(buf + (kvl * AT_KS + 8 * ch) * 2) = o;
#pragma unroll
            for (int i = 0; i < 4; ++i) VT32[(4 * c4 + i) * (AT_VS / 2) + kp] = pk(__uint_as_float(R.v[2 * q][i]), __uint_as_float(R.v[2 * q + 1][i]));
        } else {
            *(LAS u32x4*)(buf + (kvl * AT_KS + 8 * ch) * 2) = R.k[2 * q];
            const u32x4 v0 = R.v[2 * q], v1 = R.v[2 * q + 1];
            VT32[(4 * c4 + 0) * (AT_VS / 2) + kp] = (v0.x & 0xffffu) | (v1.x << 16);
            VT32[(4 * c4 + 1) * (AT_VS / 2) + kp] = (v0.x >> 16) | (v1.x & 0xffff0000u);
            VT32[(4 * c4 + 2) * (AT_VS / 2) + kp] = (v0.y & 0xffffu) | (v1.y << 16);
            VT32[(4 * c4 + 3) * (AT_VS / 2) + kp] = (v0.y >> 16) | (v1.y & 0xffff0000u);
        }
    }
    if (st < 64) { const float c = -R.ck * LOG2E; const unsigned h1 = f2bf(c); const float r1 = c - bf2f(h1); const unsigned h2 = f2bf(r1); const unsigned h3 = f2bf(r1 - bf2f(h2));
        u32x2 o; o.x = h1 | (h2 << 16); o.y = h3; ((LAS u32x2*)(buf + AT_COFF))[st] = o; }
}
__device__ __forceinline__ void attn_unit_sample(const Args& a, LAS unsigned char* lds, int b, int h) {
    int tid_ = threadIdx.x; asm volatile("" : "+v"(tid_));
    const int tid = tid_, lane = tid & 63, w = __builtin_amdgcn_readfirstlane(tid >> 6), l31 = lane & 31, hi = lane >> 5;
    const float* cbase = (const float*)(a.ws + WS_CS) + (size_t)(b * 16 + h) * 2112;
    if (w >= 2 && w < 6) {
        const int st = tid - 128;
        TileRegs2 R0, R1, R2, R3;
        sload2(R0, a, b, h, 32, cbase, st); sload2a(R1, a, b, h, 31, cbase, st); sload2a(R2, a, b, h, 30, cbase, st); sload2a(R3, a, b, h, 29, cbase, st);
        sstore2(R0, lds, false, st);
        sload2a(R0, a, b, h, 28, cbase, st);
        __syncthreads();
#define SSTEP(tt, RR) do { WAIT_R2(27, RR); sstore2(RR, lds + (((tt) + 1) & 1) * AT_BUF, true, st); sload2a(RR, a, b, h, (27 - (tt)) > 0 ? 27 - (tt) : 0, cbase, st); __syncthreads(); } while (0)
#pragma unroll 1
        for (int t = 0; t < 32; t += 4) { SSTEP(t, R1); SSTEP(t + 1, R2); SSTEP(t + 2, R3); SSTEP(t + 3, R0); }
        SSTEP(32, R1);
#undef SSTEP
        WAIT_R2(0, R0); WAIT_R2(0, R1); WAIT_R2(0, R2); WAIT_R2(0, R3);
    } else {
        const bool active = w < 2;
        const int qpos = 2048 + 32 * (w & 1) + l31;
        const size_t qrow = (size_t)(MP + b * 64 + 32 * (w & 1) + l31);
        const bf16_t* qkv = (const bf16_t*)(a.ws + WS_PROJ);
        bf16x8 qf[4];
#pragma unroll
        for (int ks = 0; ks < 4; ++ks) qf[ks] = *(const bf16x8*)(qkv + qrow * NPJ + h * 64 + 16 * ks + 8 * hi);
        const float cq2 = cbase[qpos] * LOG2E;
        float mrun = -INFINITY, lrun = 0.f;
        f32x16 ot[2]; ot[0] = f32x16{}; ot[1] = f32x16{};
        __syncthreads();
#pragma unroll 1
        for (int tt = 0; tt < 33; ++tt) {
            if (active) attn_tile<false>(lds + (tt & 1) * AT_BUF, qf, nullptr, cq2, qpos, 64 * (32 - tt), tt == 0, mrun, lrun, ot, l31, hi);
            __syncthreads();
        }
        if (active) {
            lrun += __shfl_xor(lrun, 32);
            const float inv = 1.f / lrun;
            bf16_t* og = (bf16_t*)(a.ws + WS_OG) + qrow * DM + h * 64;
#pragma unroll
            for (int db = 0; db < 2; ++db)
#pragma unroll
                for (int j = 0; j < 4; ++j) { u32x2 o; o.x = pk(ot[db][4 * j] * inv, ot[db][4 * j + 1] * inv); o.y = pk(ot[db][4 * j + 2] * inv, ot[db][4 * j + 3] * inv);
                    *(u32x2*)(og + 32 * db + 8 * j + 4 * hi) = o; }
        }
    }
}

__device__ __forceinline__ void fox_attention(const Args& a, LAS unsigned char* lds, int vcu, int G) {
#pragma unroll 1
    for (int pass = 0; pass < 2; ++pass) {
        if ((pass ^ (vcu & 1)) == 0) {
#ifdef ATT_DUP_PROMPT
          for (int rep2_ = 0; rep2_ < 2; ++rep2_)
#endif
            if (G == 256) {
                const int bh = vcu >> 1, s0 = 2 * (vcu & 1);
#pragma unroll 1
                for (int i = 0; i < 4; ++i) attn_unit_prompt(a, lds, bh >> 4, bh & 15, (i & 1) ? s0 + (i >> 1) : 7 - s0 - (i >> 1));
            } else {
#pragma unroll 1
                for (int u = vcu; u < 1024; u += G) attn_unit_prompt(a, lds, (u & 127) >> 4, u & 15, 7 - (u >> 7));
            }
        } else {
#ifdef ATT_DUP_SAMPLE
            for (int rep3_ = 0; rep3_ < 2; ++rep3_)
#endif
#pragma unroll 1
            for (int u = vcu; u < 512; u += G) attn_unit_sample(a, lds, u >> 4, u & 15);
        }
    }
}

#ifndef PH_MASK
#define PH_MASK 0x7fff
#endif
#define IN(k) (((PH_MASK >> (k)) & 1) && a.ph_lo <= (k) && (k) < a.ph_hi)
#define SEAM(k) do { if (IN(k) && IN((k) + 1)) { if ((k) == 0) cg::this_grid().sync(); else xcd_barrier(xbar); } } while (0)
#ifndef DUP_MASK
#define DUP_MASK 0
#endif
#define REP(k) _Pragma("unroll 1") for (int rep_ = 0; rep_ < ((((DUP_MASK) >> (k)) & 1) ? 2 : 1); ++rep_)
#define REPSYNC(k) do { if ((((DUP_MASK) >> (k)) & 1)) xcd_barrier(xbar); } while (0)
template <int L> __device__ __forceinline__ void common_gemms(const Args& a, LAS unsigned char* lds, int G, int bx, const XcdBarrier& xbar) {
    unsigned char* ws = a.ws;
    float* SS = (float*)(ws + WS_SS);
    bf16_t* XB = (bf16_t*)(ws + WS_XB); float* XR = (float*)(ws + WS_XR); bf16_t* OG = (bf16_t*)(ws + WS_OG); bf16_t* ACT = (bf16_t*)(ws + WS_ACT);
    constexpr int po = L ? 11 : 5;
    if (IN(po)) { pg8::Gemm g{OG, (const bf16_t*)(ws + (L ? WS_WFOUT : WS_WGOUT)), MT, DM, DM}; pg8::StaticOrder S; S.init(MT, DM, G, bx);
        EpiResid E{L ? XR : a.in[I_XP], L ? XR + (size_t)MP * DM : a.in[I_XS], XR, XB, SS + (L ? 3 : 1) * 32768};
        pg8::gemm_phase<EpiResid, pg8::StaticOrder, true, true>(lds, g, S, E);
        if (L == 0 && G == 256 && !MK_MULTI && bx >= 32) convert_weights(a, lds, 1, (bx - 32) * 8 + (int)(threadIdx.x >> 6), 224 * 8); }
    SEAM(po);
    if (IN(po + 1)) REP(po + 1) { pg8::Gemm g{XB, (const bf16_t*)(ws + WS_WFFI + (size_t)L * 11 * MiB), MT, 2 * DFF, DM}; pg8::StaticOrder S; S.init(MT, 2 * DFF, G, bx);
        EpiSwiglu E{SS + (L ? 3 : 1) * 32768, ACT}; pg8::gemm_phase<EpiSwiglu, pg8::StaticOrder, true, true>(lds, g, S, E); REPSYNC(po + 1); }
    SEAM(po + 1);
    if (IN(po + 2)) { pg8::Gemm g{ACT, (const bf16_t*)(ws + WS_WFFD + (size_t)L * 6 * MiB), MT, DM, DFF}; pg8::StaticOrder S; S.init(MT, DM, G, bx);
        EpiResid E{XR, XR + (size_t)MP * DM, XR, XB, SS + (L ? 4 : 2) * 32768};
        pg8::gemm_phase<EpiResid, pg8::StaticOrder, true, true>(lds, g, S, E); }
    SEAM(po + 2);
}
constexpr int NPH = 15;
__global__ void __launch_bounds__(512, 2) fwd(Args a) {
    extern __shared__ __attribute__((aligned(16))) unsigned char lds_raw[];
    LAS unsigned char* lds = (LAS unsigned char*)lds_raw;
    const int G = gridDim.x, bx = blockIdx.x;
    const int vcu = (G % 8 == 0) ? (bx % 8) * (G / 8) + bx / 8 : bx;
    unsigned char* ws = a.ws;
    float* SS = (float*)(ws + WS_SS);
    bf16_t* XB = (bf16_t*)(ws + WS_XB); bf16_t* PROJ = (bf16_t*)(ws + WS_PROJ);

    volatile LAS unsigned* MISC = (volatile LAS unsigned*)(lds + 131072);
    if (threadIdx.x < 64) MISC[threadIdx.x] = 0u;
    __syncthreads();
    XcdBarrier xbar; xbar.bar = (unsigned*)ws; xbar.x = 0; xbar.st = nullptr;
    if (a.ph_hi - a.ph_lo > 1) xbar = xcd_barrier_post((unsigned*)ws, MISC + 8);
    if (IN(0)) REP(0) { p0_prologue(a, lds, vcu, G); REPSYNC(0); }
    SEAM(0);
    if (IN(1)) { pg8::Gemm g{XB, (const bf16_t*)(ws + WS_WGIN), MT, NPROJ, DM}; pg8::StaticOrder S; S.init(MT, NPROJ, G, bx);
        EpiGlaProj E{SS, PROJ, (float*)(ws + WS_GL)}; pg8::gemm_phase<EpiGlaProj, pg8::StaticOrder, true, true>(lds, g, S, E); }
    SEAM(1);
    if (IN(2)) REP(2) {
        { GlaPre pf; if (vcu < 1152) gla_prefetch(pf, a, vcu >> 2, vcu & 3);
#pragma unroll 1
        for (int it = vcu; it < 1152; it += G) gla_item<0>(a, lds, it >> 2, it & 3, pf, (it + G < 1152) ? it + G : -1); }
        REPSYNC(2); }
    SEAM(2);
    if (IN(3)) REP(3) { gla_scan(a, vcu, G); REPSYNC(3); }
    SEAM(3);
    if (IN(4)) REP(4) {
        { GlaPre pf; if (vcu < 1152) gla_prefetch(pf, a, vcu >> 2, vcu & 3);
#pragma unroll 1
        for (int it = vcu; it < 1152; it += G) gla_item<1>(a, lds, it >> 2, it & 3, pf, (it + G < 1152) ? it + G : -1); }
        REPSYNC(4); }
    SEAM(4);
    common_gemms<0>(a, lds, G, bx, xbar);
    if (IN(8)) { pg8::Gemm g{XB, (const bf16_t*)(ws + WS_WFIN), MT, NPROJ, DM}; pg8::StaticOrder S; S.init(MT, NPROJ, G, bx);
        EpiFoxProj E{SS + 2 * 32768, PROJ, a.out, a.in[I_FBF]}; pg8::gemm_phase<EpiFoxProj, pg8::StaticOrder, true, true>(lds, g, S, E); }
    SEAM(8);
    if (IN(9)) REP(9) { fox_cumsum(a, lds, vcu, G); REPSYNC(9); }
    SEAM(9);
    if (IN(10)) REP(10) { fox_attention(a, lds, vcu, G); REPSYNC(10); }
    SEAM(10);
    common_gemms<1>(a, lds, G, bx, xbar);
#ifdef EXTRA_SYNCS
    for (int i_ = 0; i_ < EXTRA_SYNCS; ++i_) xcd_barrier(xbar);
#endif
    if (IN(14)) p_final(a, vcu, G);
#undef IN
#undef SEAM
}

extern "C" void kernel_launch(void* const* d_in, const int* in_sizes, int n_in, void* d_out, int out_size, void* d_ws, size_t ws_size, hipStream_t stream) {
    static int grid = 0;
    if (grid == 0) {
        if (n_in != 19 || ws_size < WS_END || out_size != 62160896) { fprintf(stderr, "kernel_launch: unexpected problem shape (n_in %d, out %d, ws %zu)\n", n_in, out_size, ws_size); grid = -1; return; }
        if (hipFuncSetAttribute((const void*)fwd, hipFuncAttributeMaxDynamicSharedMemorySize, LDS_BYTES) != hipSuccess) { fprintf(stderr, "kernel_launch: hipFuncSetAttribute failed\n"); grid = -1; return; }
        int dev = 0, cus = 0, per_cu = 0;
        (void)hipGetDevice(&dev); (void)hipDeviceGetAttribute(&cus, hipDeviceAttributeMultiprocessorCount, dev);
        (void)hipOccupancyMaxActiveBlocksPerMultiprocessor(&per_cu, (const void*)fwd, 512, LDS_BYTES);
        (void)hipGetLastError();
        if (per_cu < 1) per_cu = 1;
        grid = cus * 1;
        if (grid <= 0) grid = 256;
    }
    if (grid < 0) return;
    (void)hipMemsetAsync((char*)d_ws + WS_CTL, 0, CTL_BYTES, stream);
    Args a{};
    for (int i = 0; i < 19; ++i) a.in[i] = (const float*)d_in[i];
    a.out = (float*)d_out; a.ws = (unsigned char*)d_ws;
#if MK_MULTI
    for (int ph = 0; ph < NPH; ++ph) { a.ph_lo = ph; a.ph_hi = ph + 1; hipLaunchKernelGGL(fwd, dim3(grid), dim3(512), LDS_BYTES, stream, a); }
#else
    a.ph_lo = 0; a.ph_hi = NPH;
    void* args[] = {&a};
    hipError_t e = hipLaunchCooperativeKernel((const void*)fwd, dim3(grid), dim3(512), args, LDS_BYTES, stream);
    if (e != hipSuccess) fprintf(stderr, "kernel_launch: cooperative launch failed: %s (grid %d)\n", hipGetErrorString(e), grid);
#endif
}
```

```cpp
#include <hip/hip_runtime.h>
#include <hip/hip_cooperative_groups.h>
#include <cstdio>
#include <cstdint>
#include <cmath>
namespace cg = cooperative_groups;
#define MK_MULTI 0
namespace pg8 {
#define PG8_LAS __attribute__((address_space(3)))
typedef unsigned short bf16_t;
typedef short bf16x8 __attribute__((ext_vector_type(8)));
typedef float f32x4 __attribute__((ext_vector_type(4)));
typedef unsigned u32x4 __attribute__((ext_vector_type(4)));
constexpr int BM = 256, BK = 64, HALF = 128, HTB = HALF * BK * 2  , STAGE_BYTES = 8 * HTB, NXCD = 8, WGM = 8;

__host__ __device__ __forceinline__ int lds_byte(int r, int c) { const int st = (r >> 4) * 2 + (c >> 5), rr = r & 15, cc = c & 31, ob = rr * 64 + cc * 2; return st * 1024 + (ob ^ (((ob >> 9) & 1) << 5)); }
__host__ __device__ __forceinline__ void stage_rc(int b, int& R, int& C) { const int st = b / 1024, sb = b % 1024, swz = sb ^ (((sb >> 9) & 1) << 5); R = (st >> 1) * 16 + swz / 64; C = (st & 1) * 32 + (swz % 64) / 2; }
__host__ __device__ __forceinline__ int perm32(int rho) { const int n = rho >> 4, i = rho & 15; return 8 * (i >> 2) + 4 * n + (i & 3); }

struct Unit { int pm, pn; };
struct Gemm { const bf16_t* A; const bf16_t* Bt; int M, N, K; int ld; };

struct StaticOrder {
    int nM, nN, nwg, G, c;
    __host__ __device__ void init(int M, int N, int G_, int c_) { nM = M / BM; nN = N / BM; nwg = nM * nN; G = G_; c = c_; }
    __host__ __device__ bool next(int i, Unit& u) const {
        const long L = (long)i * G + c; if (L >= nwg) return false;
        int wgid = (int)L; { const int q = nwg / NXCD, r = nwg % NXCD, xcd = wgid % NXCD, off = wgid / NXCD; wgid = (xcd < r ? xcd * (q + 1) : r * (q + 1) + (xcd - r) * q) + off; }
        const int nig = WGM * nN, gid = wgid / nig, fm = gid * WGM, gsz = (nM - fm) < WGM ? (nM - fm) : WGM;
        u.pm = fm + ((wgid % nig) % gsz); u.pn = (wgid % nig) / gsz; return true;
    }
    __device__ __forceinline__ void a_ready(const Unit&) const {}
    __device__ __forceinline__ void done(const Unit&) const {}
};

__device__ __forceinline__ unsigned cvt_pk_bf16(float lo, float hi) { unsigned r; asm volatile("v_cvt_pk_bf16_f32 %0, %1, %2" : "=v"(r) : "v"(lo), "v"(hi)); return r; }
template <class Epi, class Sched, bool ALIGN_EPI = false, bool SP2 = false>
__device__ __forceinline__ void gemm_phase(PG8_LAS unsigned char* lds, const Gemm g, const Sched& S, const Epi& E) {
    const int tid = threadIdx.x, wid = __builtin_amdgcn_readfirstlane(tid >> 6), lane = tid & 63, wr = wid >> 2, wc = wid & 3, fr = lane & 15, fq = lane >> 4;
    const int K = g.ld ? g.ld : g.K, nt = g.K / BK;
    unsigned voffA[2], voffB[2];
#pragma unroll
    for (int i = 0; i < 2; ++i) { int R, C; stage_rc(tid * 16 + i * 8192, R, C); const int Rb = Epi::PERM ? ((R & ~31) + perm32(R & 31)) : R;
        voffA[i] = (unsigned)(R * K + C) * 2u; voffB[i] = (unsigned)(Rb * K + C) * 2u; }
    const size_t kstep = (size_t)(BK * 2);
    const size_t hstep = (size_t)HALF * K * 2;
    const size_t tstep = 2 * hstep;
    const unsigned ldsw = (unsigned)wid * 1024u;
    const int aoff = lds_byte(wr * 64 + fr, fq * 8), boff = lds_byte(wc * 32 + fr, fq * 8);
#define PG8_SA(b, h) (((b) * 2 + (h)) * HTB)
#define PG8_SB(b, h) ((4 + (b) * 2 + (h)) * HTB)
#define PG8_STAGE(bufoff, gbase, voff) do { _Pragma("unroll") for (int _i = 0; _i < 2; ++_i) \
        __builtin_amdgcn_global_load_lds((const unsigned*)((const char*)(gbase) + (voff)[_i]), (PG8_LAS unsigned*)(lds + (bufoff) + ldsw + _i * 8192), 16, 0, 0); } while (0)
#define PG8_LDA(dst, b, h) do { _Pragma("unroll") for (int m = 0; m < 4; ++m) _Pragma("unroll") for (int k = 0; k < 2; ++k) dst[m][k] = *(const PG8_LAS bf16x8*)(lds + PG8_SA(b, h) + aoff + m * 2048 + k * 1024); } while (0)
#define PG8_LDB(dst, b, h) do { _Pragma("unroll") for (int n = 0; n < 2; ++n) _Pragma("unroll") for (int k = 0; k < 2; ++k) dst[n][k] = *(const PG8_LAS bf16x8*)(lds + PG8_SB(b, h) + boff + n * 2048 + k * 1024); } while (0)
#define PG8_MMA(ai, bj, At, Bt) do { __builtin_amdgcn_s_setprio(1); _Pragma("unroll") for (int m = 0; m < 4; ++m) _Pragma("unroll") for (int n = 0; n < 2; ++n) _Pragma("unroll") for (int k = 0; k < 2; ++k) \
        acc[ai][bj][m][n] = __builtin_amdgcn_mfma_f32_16x16x32_bf16(Bt[n][k], At[m][k], acc[ai][bj][m][n], 0, 0, 0); __builtin_amdgcn_s_setprio(0); } while (0)
#define PG8_WAIT_V(n) asm volatile("s_waitcnt vmcnt(" #n ")" ::: "memory")
#define PG8_WAIT_L(n) asm volatile("s_waitcnt lgkmcnt(" #n ")" ::: "memory")
#define PG8_BAR __builtin_amdgcn_s_barrier()
#define PG8_SCHED __builtin_amdgcn_sched_barrier(0)
    Unit cur, nxt; int ui = 0;
    if (!S.next(0, cur)) return;
    f32x4 acc[2][2][4][2];
#pragma unroll
    for (int a = 0; a < 2; ++a)
#pragma unroll
        for (int b = 0; b < 2; ++b)
#pragma unroll
            for (int m = 0; m < 4; ++m)
#pragma unroll
                for (int n = 0; n < 2; ++n) acc[a][b][m][n] = (f32x4){0.f, 0.f, 0.f, 0.f};
    bf16x8 At[4][2], B0[2][2], B1[2][2];
    const char* cA = (const char*)g.A + (size_t)cur.pm * tstep; const char* cB = (const char*)g.Bt + (size_t)cur.pn * tstep;
    S.a_ready(cur);
    if constexpr (SP2) {
        PG8_STAGE(PG8_SB(0, 0), cB, voffB); PG8_STAGE(PG8_SB(0, 1), cB + hstep, voffB); PG8_STAGE(PG8_SA(0, 0), cA, voffA); PG8_STAGE(PG8_SA(0, 1), cA + hstep, voffA);
        if (wr == 1) PG8_BAR;
        PG8_WAIT_V(2); PG8_BAR;
        PG8_STAGE(PG8_SB(1, 0), cB + kstep, voffB); PG8_STAGE(PG8_SA(1, 0), cA + kstep, voffA); PG8_STAGE(PG8_SB(1, 1), cB + hstep + kstep, voffB);
        PG8_WAIT_V(6); PG8_BAR;
    } else {
        PG8_STAGE(PG8_SB(0, 0), cB, voffB); PG8_STAGE(PG8_SA(0, 0), cA, voffA); PG8_STAGE(PG8_SB(0, 1), cB + hstep, voffB); PG8_STAGE(PG8_SA(0, 1), cA + hstep, voffA);
        if (wr == 1) PG8_BAR;
        PG8_WAIT_V(4); PG8_BAR;
        PG8_STAGE(PG8_SB(1, 0), cB + kstep, voffB); PG8_STAGE(PG8_SA(1, 0), cA + kstep, voffA); PG8_STAGE(PG8_SB(1, 1), cB + hstep + kstep, voffB);
        PG8_WAIT_V(6); PG8_BAR;
    }
    for (;;) {
        const bool has_next = S.next(ui + 1, nxt);
        const char* nA = has_next ? (const char*)g.A + (size_t)nxt.pm * tstep : cA; const char* nB = has_next ? (const char*)g.Bt + (size_t)nxt.pn * tstep : cB;
        for (int t = 0; t < nt; t += 2) {
            const bool last = (t == nt - 2);
            const char* a1 = cA + (size_t)(t + 1) * kstep;
            const char* a2 = last ? nA : cA + (size_t)(t + 2) * kstep; const char* b2 = last ? nB : cB + (size_t)(t + 2) * kstep;
            const char* a3 = a2 + kstep; const char* b3 = b2 + kstep;
            if (last && has_next) S.a_ready(nxt);
            if constexpr (SP2) {
            PG8_LDB(B0, 0, 0); PG8_LDB(B1, 0, 1); PG8_SCHED; PG8_LDA(At, 0, 0); PG8_STAGE(PG8_SA(1, 1), a1 + hstep, voffA);
            PG8_WAIT_V(8); PG8_WAIT_L(0); PG8_BAR; PG8_MMA(0, 0, At, B0); PG8_MMA(0, 1, At, B1); PG8_BAR; PG8_SCHED;
            PG8_LDA(At, 0, 1); PG8_STAGE(PG8_SB(0, 0), b2, voffB); PG8_STAGE(PG8_SB(0, 1), b2 + hstep, voffB); PG8_STAGE(PG8_SA(0, 0), a2, voffA);
            PG8_WAIT_V(8); PG8_WAIT_L(0); PG8_BAR; PG8_MMA(1, 0, At, B0); PG8_MMA(1, 1, At, B1); PG8_BAR; PG8_SCHED;
            PG8_LDB(B0, 1, 0); PG8_LDB(B1, 1, 1); PG8_SCHED; PG8_LDA(At, 1, 0); PG8_STAGE(PG8_SA(0, 1), a2 + hstep, voffA);
            PG8_WAIT_V(8); PG8_WAIT_L(0); PG8_BAR; PG8_MMA(0, 0, At, B0); PG8_MMA(0, 1, At, B1); PG8_BAR; PG8_SCHED;
            PG8_LDA(At, 1, 1); PG8_STAGE(PG8_SB(1, 0), b3, voffB); PG8_STAGE(PG8_SB(1, 1), b3 + hstep, voffB); PG8_STAGE(PG8_SA(1, 0), a3, voffA);
            PG8_WAIT_V(8); PG8_WAIT_L(0); PG8_BAR; PG8_MMA(1, 0, At, B0); PG8_MMA(1, 1, At, B1); PG8_BAR; PG8_SCHED;
            } else {
            PG8_LDB(B0, 0, 0); PG8_SCHED; PG8_LDA(At, 0, 0); PG8_STAGE(PG8_SA(1, 1), a1 + hstep, voffA);
            PG8_WAIT_L(8); PG8_BAR; PG8_WAIT_L(0); PG8_MMA(0, 0, At, B0); PG8_BAR; PG8_SCHED;
            PG8_LDB(B1, 0, 1); PG8_STAGE(PG8_SB(0, 0), b2, voffB);
            PG8_BAR; PG8_WAIT_L(0); PG8_MMA(0, 1, At, B1); PG8_BAR;
            PG8_LDA(At, 0, 1); PG8_STAGE(PG8_SA(0, 0), a2, voffA);
            PG8_BAR; PG8_WAIT_L(0); PG8_MMA(1, 0, At, B0); PG8_BAR; PG8_SCHED;
            PG8_STAGE(PG8_SB(0, 1), b2 + hstep, voffB);
            PG8_WAIT_V(6); PG8_BAR; PG8_MMA(1, 1, At, B1); PG8_BAR;
            PG8_LDB(B0, 1, 0); PG8_SCHED; PG8_LDA(At, 1, 0); PG8_STAGE(PG8_SA(0, 1), a2 + hstep, voffA);
            PG8_WAIT_L(8); PG8_BAR; PG8_WAIT_L(0); PG8_MMA(0, 0, At, B0); PG8_BAR; PG8_SCHED;
            PG8_LDB(B1, 1, 1); PG8_STAGE(PG8_SB(1, 0), b3, voffB);
            PG8_BAR; PG8_WAIT_L(0); PG8_MMA(0, 1, At, B1); PG8_BAR;
            PG8_LDA(At, 1, 1); PG8_STAGE(PG8_SA(1, 0), a3, voffA);
            PG8_BAR; PG8_WAIT_L(0); PG8_MMA(1, 0, At, B0); PG8_BAR; PG8_SCHED;
            PG8_STAGE(PG8_SB(1, 1), b3 + hstep, voffB);
            PG8_WAIT_V(6); PG8_BAR; PG8_MMA(1, 1, At, B1); PG8_BAR;
            }
        }
        if constexpr (ALIGN_EPI) { if (wr == 0) PG8_BAR; }
        if constexpr (!Epi::AFTER_DRAIN) { E(acc, cur, wr, wc, fr, fq); S.done(cur); }
        if (!has_next) break;
#pragma unroll
        for (int a = 0; a < 2; ++a)
#pragma unroll
            for (int b = 0; b < 2; ++b)
#pragma unroll
                for (int m = 0; m < 4; ++m)
#pragma unroll
                    for (int n = 0; n < 2; ++n) acc[a][b][m][n] = (f32x4){0.f, 0.f, 0.f, 0.f};
        cur = nxt; cA = nA; cB = nB; ++ui;
        if constexpr (ALIGN_EPI) { if (wr == 1) PG8_BAR; }
    }
    PG8_WAIT_V(0);
    if constexpr (!ALIGN_EPI) { if (wr == 0) PG8_BAR; }
    PG8_BAR;
    if constexpr (Epi::AFTER_DRAIN) { E.fused(acc, cur, wr, wc, fr, fq, lds, wid, lane); S.done(cur); }
#undef PG8_SA
#undef PG8_SB
#undef PG8_STAGE
#undef PG8_LDA
#undef PG8_LDB
#undef PG8_MMA
#undef PG8_WAIT_V
#undef PG8_WAIT_L
#undef PG8_BAR
#undef PG8_SCHED
}
}

#define LAS __attribute__((address_space(3)))
typedef unsigned short bf16_t;
typedef short bf16x8 __attribute__((ext_vector_type(8)));
typedef float f32x4 __attribute__((ext_vector_type(4)));
typedef float f32x16 __attribute__((ext_vector_type(16)));
typedef unsigned u32x4 __attribute__((ext_vector_type(4)));
typedef unsigned u32x2 __attribute__((ext_vector_type(2)));

#ifndef MK_MULTI
#define MK_MULTI 0
#endif

constexpr int DM = 1024, MP = 16384, MS = 2048, MT = MP + MS;
constexpr int NPROJ = 3328, NPJ = 3072, DFF = 2816;
constexpr float EPS = 1e-6f;
constexpr float LOG2E = 1.4426950408889634f;
constexpr float QSCALE2 = 0.125f * LOG2E;
constexpr size_t O_Y = 0, O_GSP = 18874368, O_FKP = 19922944, O_FVP = 36700160, O_FLP = 53477376, O_GSS = 53739520, O_FKS = 57933824, O_FVS = 60030976, O_FLS = 62128128;
constexpr size_t MiB = 1u << 20;
constexpr size_t WS_CTL = 0, CTL_BYTES = 2 * MiB;
constexpr size_t WS_SS = 65536;
constexpr size_t WS_WGIN = 2 * MiB, WS_WFIN = 9 * MiB, WS_WGOUT = 16 * MiB, WS_WFOUT = 18 * MiB, WS_WFFI = 20 * MiB  , WS_WFFD = 42 * MiB  ;
constexpr size_t WS_XB = 54 * MiB, WS_XR = 90 * MiB, WS_PROJ = 162 * MiB, WS_GL = 270 * MiB, WS_DST = 272 * MiB, WS_DEC = 400 * MiB, WS_SPREV = 401 * MiB;
constexpr size_t WS_OG = 465 * MiB, WS_ACT = 501 * MiB, WS_CP = 600 * MiB, WS_CS = 601 * MiB, WS_PART = 606 * MiB  , WS_END = 672 * MiB;
constexpr int LDS_BYTES = 135168;

struct Args {
    const float* in[19];
    float* out; unsigned char* ws;
    int ph_lo, ph_hi;
};
enum { I_XP = 0, I_XS, I_STATE, I_CK, I_CV, I_CLF, I_NMIX, I_GWIN, I_GWG2, I_GBG, I_GNORM, I_GWOUT, I_FWIN, I_FBF, I_FWOUT, I_NFFN, I_FFIN, I_FFDN, I_NFIN };

__device__ __forceinline__ float bf2f(unsigned u) { return __uint_as_float(u << 16); }
__device__ __forceinline__ unsigned f2bf(float f) { unsigned u = __float_as_uint(f); return (u + 0x7fffu + ((u >> 16) & 1u)) >> 16; }
__device__ __forceinline__ unsigned pk(float lo, float hi) { return pg8::cvt_pk_bf16(lo, hi); }
__device__ __forceinline__ float wave_sum(float v) {
#pragma unroll
    for (int o = 1; o < 64; o <<= 1) v += __shfl_xor(v, o);
    return v;
}
__device__ __forceinline__ float log_sigmoid(float z) { return fminf(z, 0.f) - __logf(1.f + __expf(-fabsf(z))); }
__device__ __forceinline__ int crow(int r, int hi) { return (r & 3) + 8 * (r >> 2) + 4 * hi; }
__device__ __forceinline__ float dot4(f32x4 v) { return (v[0] * v[0] + v[1] * v[1]) + (v[2] * v[2] + v[3] * v[3]); }
#define MFMA32(a, b, c) __builtin_amdgcn_mfma_f32_32x32x16_bf16((a), (b), (c), 0, 0, 0)

#define XB_TMO      128
#define XB_XCNT(j)  (256  + 64 * (j))
#define XB_XSUB(j)  (1280 + 64 * (j))
#define XB_XGEN(j)  (2304 + 64 * (j))
#define XB_TOP      3328
#define XB_TOPGEN   3392
#define XCD_BAR_WORDS 3456
#define XB_SPIN_CAP (1u << 18)

__device__ __forceinline__ unsigned xb_ld(unsigned* p)              { return __hip_atomic_load(p, __ATOMIC_RELAXED, __HIP_MEMORY_SCOPE_AGENT); }
__device__ __forceinline__ unsigned xb_add(unsigned* p, unsigned v) { return __hip_atomic_fetch_add(p, v, __ATOMIC_RELAXED, __HIP_MEMORY_SCOPE_AGENT); }
__device__ __forceinline__ unsigned xb_xcc_id() { return (unsigned)__builtin_amdgcn_s_getreg((3 << 11) | 20) & 0xFu; }
#define XB_SPIN(cond, bar) do { unsigned _sp = 0; while (cond) { __builtin_amdgcn_s_sleep(1); \
    if ((++_sp & 255u) == 0u) { if (xb_ld(&(bar)[XB_TMO])) break; if (_sp > XB_SPIN_CAP) { atomicAdd(&(bar)[XB_TMO], 1u); break; } } } } while (0)

struct XcdBarrier {
    unsigned* bar; unsigned x;
    volatile LAS unsigned* st;
};

__device__ __forceinline__ XcdBarrier xcd_barrier_post(unsigned* bar, volatile LAS unsigned* st) {
    XcdBarrier b; b.bar = bar; b.x = xb_xcc_id(); b.st = st;
    if (threadIdx.x == 0) (void)xb_add(&bar[XB_XCNT(b.x)], 1u);
    return b;
}
__device__ __forceinline__ void xcd_barrier_complete(unsigned* bar, unsigned x, unsigned& nloc, unsigned& nx) {
    const unsigned G = gridDim.x * gridDim.y * gridDim.z;
    unsigned sum, cnt, mine, sp = 0u;
    for (;;) {
        sum = 0u; cnt = 0u; mine = 0u;
#pragma unroll
        for (unsigned j = 0; j < 16; ++j) { const unsigned c = xb_ld(&bar[XB_XCNT(j)]); sum += c; cnt += (c > 0u) ? 1u : 0u; mine = (j == x) ? c : mine; }
        if (sum == G) break;
        __builtin_amdgcn_s_sleep(1);
        if ((++sp & 255u) == 0u) { if (xb_ld(&bar[XB_TMO])) break; if (sp > XB_SPIN_CAP) { atomicAdd(&bar[XB_TMO], 1u); break; } }
    }
    nloc = mine > 0u ? mine : 1u; nx = cnt > 0u ? cnt : 1u;
}

__device__ __forceinline__ void xcd_barrier(const XcdBarrier& b) {
    asm volatile("s_waitcnt vmcnt(0)" ::: "memory");
    __syncthreads();
    if (threadIdx.x == 0) {
        unsigned* bar = b.bar;
        __builtin_amdgcn_s_waitcnt(0);
        unsigned nloc = b.st[0], nx = b.st[1];
        if (nloc == 0u) { xcd_barrier_complete(bar, b.x, nloc, nx); b.st[0] = nloc; b.st[1] = nx; }
        const unsigned old = xb_add(&bar[XB_XSUB(b.x)], 1u);
        const unsigned gen = old / nloc;
        if (old + 1u == (gen + 1u) * nloc) {
            __builtin_amdgcn_fence(__ATOMIC_RELEASE, "agent");
            asm volatile("s_waitcnt vmcnt(0)" ::: "memory");
            const unsigned og = xb_add(&bar[XB_TOP], 1u);
            const unsigned tg = og / nx;
            if (og + 1u == (tg + 1u) * nx) xb_add(&bar[XB_TOPGEN], 1u);
            else XB_SPIN(xb_ld(&bar[XB_TOPGEN]) == tg, bar);
            __builtin_amdgcn_fence(__ATOMIC_ACQUIRE, "agent");
            xb_add(&bar[XB_XGEN(b.x)], 1u);
            asm volatile("s_waitcnt vmcnt(0)" ::: "memory");
        } else {
            XB_SPIN(xb_ld(&bar[XB_XGEN(b.x)]) == gen, bar);
            __builtin_amdgcn_fence(__ATOMIC_ACQUIRE, "agent");
            asm volatile("s_waitcnt vmcnt(0)" ::: "memory");
        }
    }
    __syncthreads();
}

__device__ __forceinline__ void tr_item(const float* __restrict__ W, int K, int N, int nsrc0, bf16_t* WT, int drow0, const float* __restrict__ gain, LAS float* scr, int k0, int lane) {
    const int n = nsrc0 + (lane & 31);
    float wv_[32];
    const float* wp_ = W + (size_t)(k0 + (lane >> 5)) * N + ((n < N) ? n : 0);
#pragma unroll
    for (int i = 0; i < 32; ++i) wv_[i] = wp_[(size_t)(2 * i) * N];
#pragma unroll
    for (int i = 0; i < 32; ++i) {
        const int kk = 2 * i + (lane >> 5);
        float v = (n < N) ? wv_[i] : 0.f;
        if (gain) v *= gain[k0 + kk];
        scr[kk * 33 + (lane & 31)] = v;
    }
    asm volatile("s_waitcnt lgkmcnt(0)" ::: "memory");
    const int c = lane & 7;
#pragma unroll
    for (int j = 0; j < 4; ++j) {
        const int nn = (lane >> 3) + 8 * j; const LAS float* s = scr + (8 * c) * 33 + nn;
        u32x4 o; o.x = pk(s[0 * 33], s[1 * 33]); o.y = pk(s[2 * 33], s[3 * 33]); o.z = pk(s[4 * 33], s[5 * 33]); o.w = pk(s[6 * 33], s[7 * 33]);
        *(u32x4*)(WT + (size_t)(drow0 + nn) * K + k0 + 8 * c) = o;
    }
    asm volatile("s_waitcnt lgkmcnt(0)" ::: "memory");
}

__device__ __forceinline__ void convert_weights(const Args& a, LAS unsigned char* lds, int sel, int gw, int NGW) {
    const int tid = threadIdx.x, lane = tid & 63, wave = tid >> 6;
    LAS float* scr = (LAS float*)(lds + wave * 16384);
    unsigned char* ws = a.ws;
    constexpr int I_IN = 16 * 104, I_OUT = 16 * 32, I_FI = 16 * 176, I_FD = 44 * 32;
    constexpr int NITEMS = I_IN + I_OUT + I_FI + I_FD;
    for (int it = gw; it < NITEMS; it += NGW) {
        int r = it;
        if (r < I_IN) { const int kb = r / 104, nb = r % 104; tr_item(a.in[sel ? I_FWIN : I_GWIN], 1024, 3088, 32 * nb, (bf16_t*)(ws + (sel ? WS_WFIN : WS_WGIN)), 32 * nb, a.in[I_NMIX] + sel * 1024, scr, 64 * kb, lane); continue; } r -= I_IN;
        if (r < I_OUT) { const int kb = r / 32, nb = r % 32; tr_item(a.in[sel ? I_FWOUT : I_GWOUT], 1024, 1024, 32 * nb, (bf16_t*)(ws + (sel ? WS_WFOUT : WS_WGOUT)), 32 * nb, nullptr, scr, 64 * kb, lane); continue; } r -= I_OUT;
        if (r < I_FI) { const int kb = r / 176, nb = r % 176, ns = 32 * nb, bj = ns / DFF, j = ns % DFF, drow = 256 * (j / 128) + 128 * bj + (j % 128);
            tr_item(a.in[I_FFIN] + (size_t)sel * 1024 * 5632, 1024, 5632, ns, (bf16_t*)(ws + WS_WFFI + (size_t)sel * 11 * MiB), drow, a.in[I_NFFN] + sel * 1024, scr, 64 * kb, lane); continue; } r -= I_FI;
        { const int kb = r / 32, nb = r % 32;
            tr_item(a.in[I_FFDN] + (size_t)sel * DFF * 1024, DFF, 1024, 32 * nb, (bf16_t*)(ws + WS_WFFD + (size_t)sel * 6 * MiB), 32 * nb, nullptr, scr, 64 * kb, lane); }
    }
}
__device__ __forceinline__ void p0_prologue(const Args& a, LAS unsigned char* lds, int vcu, int G) {
    const int tid = threadIdx.x, lane = tid & 63, wave = tid >> 6;
    const int gw = vcu * 8 + wave, NGW = G * 8;
    unsigned char* ws = a.ws;
    convert_weights(a, lds, 0, gw, NGW);
    if (G != 256 || MK_MULTI) convert_weights(a, lds, 1, gw, NGW);
    float* ss0 = (float*)(ws + WS_SS);
    bf16_t* XB = (bf16_t*)(ws + WS_XB);
    for (int m0 = gw; m0 < MT; m0 += 3 * NGW) {
        f32x4 v[3][4];
#pragma unroll
        for (int q = 0; q < 3; ++q) { const int m = m0 + q * NGW; if (m < MT) { const float* xr = (m < MP) ? a.in[I_XP] + (size_t)m * DM : a.in[I_XS] + (size_t)(m - MP) * DM;
#pragma unroll
            for (int j = 0; j < 4; ++j) v[q][j] = ((const f32x4*)xr)[lane + 64 * j]; } }
#pragma unroll
        for (int q = 0; q < 3; ++q) { const int m = m0 + q * NGW; if (m < MT) { float s = 0.f;
#pragma unroll
            for (int j = 0; j < 4; ++j) s += dot4(v[q][j]);
            s = wave_sum(s);
            if (lane == 0) ss0[m] = s;
#pragma unroll
            for (int j = 0; j < 4; ++j) { u32x2 o; o.x = pk(v[q][j][0], v[q][j][1]); o.y = pk(v[q][j][2], v[q][j][3]); ((u32x2*)(XB + (size_t)m * DM))[lane + 64 * j] = o; } } }
    }
}

__device__ __forceinline__ void p_final(const Args& a, int vcu, int G) {
    const int tid = threadIdx.x, lane = tid & 63, wave = tid >> 6;
    const int gw = vcu * 8 + wave, NGW = G * 8;
    const float* ss = (const float*)(a.ws + WS_SS + 4 * 131072);
    const float* XR = (const float*)(a.ws + WS_XR);
    const float* g = a.in[I_NFIN];
    f32x4 gv[4];
#pragma unroll
    for (int j = 0; j < 4; ++j) gv[j] = ((const f32x4*)g)[lane + 64 * j];
    for (int m0 = gw; m0 < MT; m0 += 3 * NGW) {
        f32x4 v[3][4]; float rs[3];
#pragma unroll
        for (int q = 0; q < 3; ++q) { const int m = m0 + q * NGW; if (m < MT) { rs[q] = rsqrtf(ss[m] * (1.f / DM) + EPS);
#pragma unroll
            for (int j = 0; j < 4; ++j) v[q][j] = ((const f32x4*)(XR + (size_t)m * DM))[lane + 64 * j]; } }
#pragma unroll
        for (int q = 0; q < 3; ++q) { const int m = m0 + q * NGW; if (m < MT) {
#pragma unroll
            for (int j = 0; j < 4; ++j) ((f32x4*)(a.out + O_Y + (size_t)m * DM))[lane + 64 * j] = v[q][j] * rs[q] * gv[j]; } }
    }
}

struct EpiGlaProj {
    static constexpr bool PERM = true, AFTER_DRAIN = false;
    const float* ss; bf16_t* proj; float* gl;
    __device__ __forceinline__ void operator()(const pg8::f32x4 (&acc)[2][2][4][2], const pg8::Unit& u, int wr, int wc, int fr, int fq) const {
        const int row0 = u.pm * 256 + wr * 64 + fr;
#pragma unroll
        for (int ai = 0; ai < 2; ++ai)
#pragma unroll
            for (int m = 0; m < 4; ++m) {
                const int row = row0 + ai * 128 + m * 16; const float rs = rsqrtf(ss[row] * (1.f / DM) + EPS);
                if (u.pn < 12) {
#pragma unroll
                    for (int bj = 0; bj < 2; ++bj) { const f32x4 v0 = acc[ai][bj][m][0] * rs, v1 = acc[ai][bj][m][1] * rs;
                        u32x4 w; w.x = pk(v0[0], v0[1]); w.y = pk(v0[2], v0[3]); w.z = pk(v1[0], v1[1]); w.w = pk(v1[2], v1[3]);
                        *(u32x4*)(proj + (size_t)row * NPJ + u.pn * 256 + bj * 128 + wc * 32 + 8 * fq) = w; }
                } else if (wc == 0 && fq < 2) {
#pragma unroll
                    for (int n = 0; n < 2; ++n) *(f32x4*)(gl + (size_t)row * 16 + 8 * fq + 4 * n) = acc[ai][0][m][n] * rs;
                }
            }
    }
};
struct EpiResid {
    static constexpr bool PERM = true, AFTER_DRAIN = false;
    const float* xin_p; const float* xin_s; float* xout; bf16_t* xb; float* ssout;
    __device__ __forceinline__ void operator()(const pg8::f32x4 (&acc)[2][2][4][2], const pg8::Unit& u, int wr, int wc, int fr, int fq) const {
        const int row0 = u.pm * 256 + wr * 64 + fr;
#pragma unroll
        for (int ai = 0; ai < 2; ++ai)
#pragma unroll
            for (int m = 0; m < 4; ++m) {
                const int row = row0 + ai * 128 + m * 16;
                const float* xi = (row < MP) ? xin_p + (size_t)row * DM : xin_s + (size_t)(row - MP) * DM;
                float sq = 0.f;
#pragma unroll
                for (int bj = 0; bj < 2; ++bj) { const int col = u.pn * 256 + bj * 128 + wc * 32 + 8 * fq;
                    const f32x4 a0 = *(const f32x4*)(xi + col) + acc[ai][bj][m][0], a1 = *(const f32x4*)(xi + col + 4) + acc[ai][bj][m][1];
                    *(f32x4*)(xout + (size_t)row * DM + col) = a0; *(f32x4*)(xout + (size_t)row * DM + col + 4) = a1;
                    u32x4 w; w.x = pk(a0[0], a0[1]); w.y = pk(a0[2], a0[3]); w.z = pk(a1[0], a1[1]); w.w = pk(a1[2], a1[3]);
                    *(u32x4*)(xb + (size_t)row * DM + col) = w;
                    sq += dot4(a0) + dot4(a1); }
                sq += __shfl_xor(sq, 16); sq += __shfl_xor(sq, 32);
                if (fq == 0) atomicAdd(ssout + row, sq);
            }
    }
};
struct EpiSwiglu {
    static constexpr bool PERM = true, AFTER_DRAIN = false;
    const float* ss; bf16_t* act;
    __device__ __forceinline__ void operator()(const pg8::f32x4 (&acc)[2][2][4][2], const pg8::Unit& u, int wr, int wc, int fr, int fq) const {
        const int row0 = u.pm * 256 + wr * 64 + fr;
#pragma unroll
        for (int ai = 0; ai < 2; ++ai)
#pragma unroll
            for (int m = 0; m < 4; ++m) {
                const int row = row0 + ai * 128 + m * 16; const float rs = rsqrtf(ss[row] * (1.f / DM) + EPS);
                float y[8];
#pragma unroll
                for (int n = 0; n < 2; ++n)
#pragma unroll
                    for (int i = 0; i < 4; ++i) { const float g = acc[ai][0][m][n][i] * rs, up = acc[ai][1][m][n][i] * rs; y[4 * n + i] = g * up * __builtin_amdgcn_rcpf(1.f + __expf(-g)); }
                u32x4 w; w.x = pk(y[0], y[1]); w.y = pk(y[2], y[3]); w.z = pk(y[4], y[5]); w.w = pk(y[6], y[7]);
                *(u32x4*)(act + (size_t)row * DFF + u.pn * 128 + wc * 32 + 8 * fq) = w;
            }
    }
};
struct EpiFoxProj {
    static constexpr bool PERM = true, AFTER_DRAIN = false;
    const float* ss; bf16_t* qkv; float* out; const float* bf;
    __device__ __forceinline__ void operator()(const pg8::f32x4 (&acc)[2][2][4][2], const pg8::Unit& u, int wr, int wc, int fr, int fq) const {
        const int row0 = u.pm * 256 + wr * 64 + fr;
        const int sect = u.pn >> 2;
#pragma unroll
        for (int ai = 0; ai < 2; ++ai)
#pragma unroll
            for (int m = 0; m < 4; ++m) {
                const int row = row0 + ai * 128 + m * 16; const float rs = rsqrtf(ss[row] * (1.f / DM) + EPS);
                if (u.pn < 12) {
                    const float sc = (sect == 0) ? rs * QSCALE2 : rs;
                    float* fdst = nullptr;
                    if (sect == 1) fdst = (row < MP) ? out + O_FKP + (size_t)row * DM : out + O_FKS + (size_t)(row - MP) * DM;
                    if (sect == 2) fdst = (row < MP) ? out + O_FVP + (size_t)row * DM : out + O_FVS + (size_t)(row - MP) * DM;
#pragma unroll
                    for (int bj = 0; bj < 2; ++bj) { const f32x4 v0 = acc[ai][bj][m][0] * sc, v1 = acc[ai][bj][m][1] * sc;
                        u32x4 w; w.x = pk(v0[0], v0[1]); w.y = pk(v0[2], v0[3]); w.z = pk(v1[0], v1[1]); w.w = pk(v1[2], v1[3]);
                        const int cl = bj * 128 + wc * 32 + 8 * fq;
                        *(u32x4*)(qkv + (size_t)row * NPJ + u.pn * 256 + cl) = w;
                        if (sect > 0) { float* d = fdst + (u.pn & 3) * 256 + cl; *(f32x4*)d = v0; *(f32x4*)(d + 4) = v1; } }
                } else if (wc == 0 && fq < 2) {
                    float* d = (row < MP) ? out + O_FLP + (size_t)row * 16 : out + O_FLS + (size_t)(row - MP) * 16;
#pragma unroll
                    for (int n = 0; n < 2; ++n) { const f32x4 v = acc[ai][0][m][n] * rs; f32x4 o;
#pragma unroll
                        for (int i = 0; i < 4; ++i) o[i] = log_sigmoid(v[i] + bf[8 * fq + 4 * n + i]);
                        *(f32x4*)(d + 8 * fq + 4 * n) = o; }
                }
            }
    }
};

constexpr int GL_OFF = 0, GSUM_OFF = 4096, DECS_OFF = 6144, QE_OFF = 8192, KE_OFF = 25600, VT_OFF = 43008, AL_OFF = 79872, KDT_OFF = 8192, OL_OFF = 8192;
constexpr int QES = 136, VTS = 72, OLS = 260;

struct GlaPre { unsigned v[32]; f32x4 gl; };
__device__ __forceinline__ void gla_prefetch(GlaPre& pf, const Args& a, int cid, int h) {
    const int tid = threadIdx.x, dvv = tid & 255, th = tid >> 8, row0 = cid * 64;
    const bf16_t* vp = (const bf16_t*)(a.ws + WS_PROJ) + (size_t)(row0 + 32 * th) * NPJ + 1024 + h * 256 + dvv;
#pragma unroll
    for (int i = 0; i < 32; ++i) pf.v[i] = vp[(size_t)i * NPJ];
    pf.gl = *(const f32x4*)((const float*)(a.ws + WS_GL) + (size_t)(row0 + ((tid & 255) >> 2)) * 16 + (tid & 3) * 4);
}
template <int MODE> __device__ __forceinline__ void gla_item(const Args& a, LAS unsigned char* lds, int cid, int h, GlaPre& pf, int next) {
    const int tid = threadIdx.x, lane = tid & 63, w = tid >> 6, l31 = lane & 31, hi = lane >> 5;
    const int row0 = cid * 64;
    const bool prompt = cid < 256;
    LAS float* GLs = (LAS float*)(lds + GL_OFF); LAS float* GSUM = (LAS float*)(lds + GSUM_OFF); LAS float* DECS = (LAS float*)(lds + DECS_OFF);
    LAS bf16_t* QE = (LAS bf16_t*)(lds + QE_OFF); LAS bf16_t* KE = (LAS bf16_t*)(lds + KE_OFF); LAS bf16_t* VT = (LAS bf16_t*)(lds + VT_OFF);
    LAS bf16_t* AL = (LAS bf16_t*)(lds + AL_OFF); LAS bf16_t* KDT = (LAS bf16_t*)(lds + KDT_OFF);
    const bf16_t* P = (const bf16_t*)(a.ws + WS_PROJ) + (size_t)row0 * NPJ;
    const float* GL = (const float*)(a.ws + WS_GL);
    const float* state = a.in[I_STATE];

    bf16x8 sfr[8];
    if (MODE == 1) {
        if (prompt) {
            const bf16_t* sp = (const bf16_t*)(a.ws + WS_SPREV) + ((size_t)(cid * 4 + h) * 256 + 32 * w + l31) * 128 + 8 * hi;
#pragma unroll
            for (int ks = 0; ks < 8; ++ks) sfr[ks] = *(const bf16x8*)(sp + 16 * ks);
        } else {
            const float* s0 = state + ((size_t)((cid - 256) * 4 + h) * 128) * 256 + 32 * w + l31;
#pragma unroll
            for (int ks = 0; ks < 8; ++ks) { float f[8];
#pragma unroll
                for (int j = 0; j < 8; ++j) f[j] = s0[(size_t)(16 * ks + 8 * hi + j) * 256];
                u32x4 o; o.x = pk(f[0], f[1]); o.y = pk(f[2], f[3]); o.z = pk(f[4], f[5]); o.w = pk(f[6], f[7]); sfr[ks] = __builtin_bit_cast(bf16x8, o); }
        }
    }
    unsigned kraw[16], qraw[16];
    {
        const int dk_ = tid & 127, tg_ = tid >> 7;
        const bf16_t* kp_ = P + (size_t)(16 * tg_) * NPJ + 512 + h * 128 + dk_;
#pragma unroll
        for (int i = 0; i < 16; ++i) kraw[i] = kp_[(size_t)i * NPJ];
        if (MODE == 1) { const bf16_t* qp_ = P + (size_t)(16 * tg_) * NPJ + h * 128 + dk_;
#pragma unroll
            for (int i = 0; i < 16; ++i) qraw[i] = qp_[(size_t)i * NPJ]; }
    }
    float wv[16];
#pragma unroll
    for (int j = 0; j < 16; ++j) wv[j] = a.in[I_GWG2][j * 512 + h * 128 + (tid & 127)];
    const float bias = a.in[I_GBG][h * 128 + (tid & 127)];
    if (tid < 256) ((LAS f32x4*)GLs)[tid] = pf.gl;
    {
        const int dvv = tid & 255, th = tid >> 8;
#pragma unroll
        for (int q4 = 0; q4 < 4; ++q4) { u32x4 o; o.x = pf.v[8 * q4] | (pf.v[8 * q4 + 1] << 16); o.y = pf.v[8 * q4 + 2] | (pf.v[8 * q4 + 3] << 16);
            o.z = pf.v[8 * q4 + 4] | (pf.v[8 * q4 + 5] << 16); o.w = pf.v[8 * q4 + 6] | (pf.v[8 * q4 + 7] << 16);
            *(LAS u32x4*)(VT + dvv * VTS + 32 * th + 8 * q4) = o; }
    }
    if (next >= 0) gla_prefetch(pf, a, next >> 2, next & 3);
    __syncthreads();
    const int dk = tid & 127, tg = tid >> 7;
    float bc[16];
    {
        float run = 0.f;
#pragma unroll
        for (int i = 0; i < 16; ++i) { const LAS f32x4* gp = (const LAS f32x4*)(GLs + (16 * tg + i) * 16); float z = bias;
#pragma unroll
            for (int j4 = 0; j4 < 4; ++j4) { const f32x4 gq = gp[j4]; z += gq[0] * wv[4 * j4] + gq[1] * wv[4 * j4 + 1] + gq[2] * wv[4 * j4 + 2] + gq[3] * wv[4 * j4 + 3]; }
            run += log_sigmoid(z) * (1.f / 16.f); bc[i] = run; }
        GSUM[tg * 128 + dk] = run;
    }
    __syncthreads();
    float off = 0.f, blast = 0.f;
#pragma unroll
    for (int g = 0; g < 4; ++g) { const float s = GSUM[g * 128 + dk]; blast += s; if (g < tg) off += s; }
    if (MODE == 0) {
        float kd[16];
#pragma unroll
        for (int i = 0; i < 16; ++i) { const float b = bc[i] + off; kd[i] = bf2f(kraw[i]) * __expf(blast - b); }
        u32x4 o0, o1; o0.x = pk(kd[0], kd[1]); o0.y = pk(kd[2], kd[3]); o0.z = pk(kd[4], kd[5]); o0.w = pk(kd[6], kd[7]);
        o1.x = pk(kd[8], kd[9]); o1.y = pk(kd[10], kd[11]); o1.z = pk(kd[12], kd[13]); o1.w = pk(kd[14], kd[15]);
        *(LAS u32x4*)(KDT + dk * VTS + 16 * tg) = o0; *(LAS u32x4*)(KDT + dk * VTS + 16 * tg + 8) = o1;
        if (tg == 0) { const float d = __expf(blast); DECS[dk] = d; if (prompt) ((float*)(a.ws + WS_DEC))[(size_t)(cid * 4 + h) * 128 + dk] = d; }
    } else {
#pragma unroll
        for (int i = 0; i < 16; ++i) { const float b = bc[i] + off; const int t = 16 * tg + i;
            const float qe = bf2f(qraw[i]) * __expf(b) * 0.08838834764831845f, ke = bf2f(kraw[i]) * __expf(-b);
            QE[t * QES + dk] = (bf16_t)f2bf(qe); KE[t * QES + dk] = (bf16_t)f2bf(ke); }
    }
    __syncthreads();
    if (MODE == 0) {
        bf16x8 vf[4];
#pragma unroll
        for (int ks = 0; ks < 4; ++ks) vf[ks] = *(const LAS bf16x8*)(VT + (32 * w + l31) * VTS + 16 * ks + 8 * hi);
        f32x16 acc[4];
#pragma unroll
        for (int d = 0; d < 4; ++d) acc[d] = f32x16{};
#pragma unroll
        for (int d = 0; d < 4; ++d)
#pragma unroll
            for (int ks = 0; ks < 4; ++ks) { const bf16x8 kf = *(const LAS bf16x8*)(KDT + (32 * d + l31) * VTS + 16 * ks + 8 * hi);
                acc[d] = prompt ? MFMA32(vf[ks], kf, acc[d]) : MFMA32(kf, vf[ks], acc[d]); }
        if (prompt) {
            bf16_t* dst = (bf16_t*)(a.ws + WS_DST) + ((size_t)(cid * 4 + h) * 256 + 32 * w) * 128;
#pragma unroll
            for (int d = 0; d < 4; ++d)
#pragma unroll
                for (int r = 0; r < 16; ++r) dst[(size_t)crow(r, hi) * 128 + 32 * d + l31] = (bf16_t)f2bf(acc[d][r]);
        } else {
            const size_t base = ((size_t)((cid - 256) * 4 + h) * 128) * 256;
            float* outs = a.out + O_GSS;
#pragma unroll
            for (int d = 0; d < 4; ++d)
#pragma unroll
                for (int r = 0; r < 16; ++r) { const int dkk = 32 * d + crow(r, hi); const size_t idx = base + (size_t)dkk * 256 + 32 * w + l31; outs[idx] = state[idx] * DECS[dkk] + acc[d][r]; }
        }
    } else {
        u32x2 rraw[8];
#pragma unroll
        for (int i = 0; i < 8; ++i) rraw[i] = *(const u32x2*)(P + (size_t)(8 * w + i) * NPJ + 2048 + h * 256 + 4 * lane);
        f32x16 o[2]; o[0] = f32x16{}; o[1] = f32x16{};
#pragma unroll
        for (int tb = 0; tb < 2; ++tb)
#pragma unroll
            for (int ks = 0; ks < 8; ++ks) { const bf16x8 qa = *(const LAS bf16x8*)(QE + (32 * tb + l31) * QES + 16 * ks + 8 * hi); o[tb] = MFMA32(qa, sfr[ks], o[tb]); }
        if (w < 3) {
            const int tb = (w > 0) ? 1 : 0, sb = (w == 2) ? 1 : 0;
            f32x16 am = f32x16{};
#pragma unroll
            for (int ks = 0; ks < 8; ++ks) { const bf16x8 qa = *(const LAS bf16x8*)(QE + (32 * tb + l31) * QES + 16 * ks + 8 * hi), kb = *(const LAS bf16x8*)(KE + (32 * sb + l31) * QES + 16 * ks + 8 * hi);
                am = MFMA32(qa, kb, am); }
#pragma unroll
            for (int r = 0; r < 16; ++r) { const int tl = crow(r, hi); float v = am[r]; if (tb == sb && l31 > tl) v = 0.f; AL[(32 * tb + tl) * VTS + 32 * sb + l31] = (bf16_t)f2bf(v); }
        }
        __syncthreads();
#pragma unroll
        for (int tb = 0; tb < 2; ++tb)
#pragma unroll
            for (int ks = 0; ks < 4; ++ks) { if (tb == 0 && ks >= 2) continue;
                const bf16x8 aa = *(const LAS bf16x8*)(AL + (32 * tb + l31) * VTS + 16 * ks + 8 * hi), vb = *(const LAS bf16x8*)(VT + (32 * w + l31) * VTS + 16 * ks + 8 * hi);
                o[tb] = MFMA32(aa, vb, o[tb]); }
        __syncthreads();
        LAS float* OL = (LAS float*)(lds + OL_OFF);
#pragma unroll
        for (int tb = 0; tb < 2; ++tb)
#pragma unroll
            for (int r = 0; r < 16; ++r) OL[(32 * tb + crow(r, hi)) * OLS + 32 * w + l31] = o[tb][r];
        __syncthreads();
        const f32x4 ng = *(const f32x4*)(a.in[I_GNORM] + h * 256 + 4 * lane);
        bf16_t* OG = (bf16_t*)(a.ws + WS_OG);
#pragma unroll
        for (int i = 0; i < 8; ++i) { const int t = 8 * w + i; const f32x4 v = *(const LAS f32x4*)(OL + t * OLS + 4 * lane);
            const float rs = rsqrtf(wave_sum(dot4(v)) * (1.f / 256.f) + EPS);
            const u32x2 rr = rraw[i];
            float rv[4] = {bf2f(rr.x & 0xffffu), bf2f(rr.x >> 16), bf2f(rr.y & 0xffffu), bf2f(rr.y >> 16)}; float y[4];
#pragma unroll
            for (int j = 0; j < 4; ++j) y[j] = v[j] * rs * ng[j] * rv[j] * __builtin_amdgcn_rcpf(1.f + __expf(-rv[j]));
            u32x2 ov; ov.x = pk(y[0], y[1]); ov.y = pk(y[2], y[3]);
            *(u32x2*)(OG + (size_t)(row0 + t) * DM + h * 256 + 4 * lane) = ov; }
    }
    __syncthreads();
}

__device__ __forceinline__ void gla_scan(const Args& a, int vcu, int G) {
    const int gt = vcu * 512 + threadIdx.x, NT_ = G * 512;
    const bf16_t* DST = (const bf16_t*)(a.ws + WS_DST); const float* DEC = (const float*)(a.ws + WS_DEC); bf16_t* SP = (bf16_t*)(a.ws + WS_SPREV);
    for (int it0 = gt; it0 < 32 * 8192; it0 += 2 * NT_) {
        const int it1 = it0 + NT_; const bool two = it1 < 32 * 8192;
        const int bhA = it0 >> 13, eA = it0 & 8191, dvA = eA >> 5, dkA = (eA & 31) * 4;
        const int itB = two ? it1 : it0; const int bhB = itB >> 13, eB = itB & 8191, dvB = eB >> 5, dkB = (eB & 31) * 4;
        f32x4 SA = (f32x4){0.f, 0.f, 0.f, 0.f}, SB = SA;
#pragma unroll 8
        for (int c = 0; c < 32; ++c) {
            const size_t chA = (size_t)(((bhA >> 2) * 32 + c) * 4 + (bhA & 3)), chB = (size_t)(((bhB >> 2) * 32 + c) * 4 + (bhB & 3));
            const size_t baseA = (chA * 256 + dvA) * 128 + dkA, baseB = (chB * 256 + dvB) * 128 + dkB;
            const u32x2 rA = *(const u32x2*)(DST + baseA), rB = *(const u32x2*)(DST + baseB);
            const f32x4 deA = *(const f32x4*)(DEC + chA * 128 + dkA), deB = *(const f32x4*)(DEC + chB * 128 + dkB);
            const f32x4 dsA = (f32x4){bf2f(rA.x & 0xffffu), bf2f(rA.x >> 16), bf2f(rA.y & 0xffffu), bf2f(rA.y >> 16)};
            const f32x4 dsB = (f32x4){bf2f(rB.x & 0xffffu), bf2f(rB.x >> 16), bf2f(rB.y & 0xffffu), bf2f(rB.y >> 16)};
            u32x2 o; o.x = pk(SA[0], SA[1]); o.y = pk(SA[2], SA[3]); *(u32x2*)(SP + baseA) = o;
            if (two) { o.x = pk(SB[0], SB[1]); o.y = pk(SB[2], SB[3]); *(u32x2*)(SP + baseB) = o; }
            SA = SA * deA + dsA; SB = SB * deB + dsB;
        }
        float* ogA = a.out + O_GSP + ((size_t)bhA * 128 + dkA) * 256 + dvA;
#pragma unroll
        for (int i = 0; i < 4; ++i) ogA[(size_t)i * 256] = SA[i];
        if (two) { float* ogB = a.out + O_GSP + ((size_t)bhB * 128 + dkB) * 256 + dvB;
#pragma unroll
            for (int i = 0; i < 4; ++i) ogB[(size_t)i * 256] = SB[i]; }
    }
}

template <int L, int C> __device__ __forceinline__ void cumsum_item(const float* src0, const float* src1, float* dst, LAS float* SEG, int hh, int seg) {
    float s = 0.f;
#pragma unroll 1
    for (int c0 = 0; c0 < L; c0 += C) { float v[C];
#pragma unroll
        for (int i = 0; i < C; ++i) { const int t = seg * L + c0 + i; v[i] = (t < 2048) ? src0[(unsigned)(t * 16 + hh)] : src1[(unsigned)((t - 2048) * 16 + hh)]; }
#pragma unroll
        for (int i = 0; i < C; ++i) s += v[i]; }
    SEG[seg * 16 + hh] = s;
    __syncthreads();
    float run = 0.f;
    for (int g = 0; g < seg; ++g) run += SEG[g * 16 + hh];
#pragma unroll 1
    for (int c0 = 0; c0 < L; c0 += C) { float v[C];
#pragma unroll
        for (int i = 0; i < C; ++i) { const int t = seg * L + c0 + i; v[i] = (t < 2048) ? src0[(unsigned)(t * 16 + hh)] : src1[(unsigned)((t - 2048) * 16 + hh)]; }
#pragma unroll
        for (int i = 0; i < C; ++i) { run += v[i]; dst[seg * L + c0 + i] = run; } }
    __syncthreads();
}
__device__ __forceinline__ void fox_cumsum(const Args& a, LAS unsigned char* lds, int vcu, int G) {
    const int tid = threadIdx.x, hh = tid & 15, seg = tid >> 4;
    LAS float* SEG = (LAS float*)lds;
    for (int it = vcu; it < 40; it += G) {
        const bool prompt = it < 8; const int b = prompt ? it : it - 8;
        const float* src0 = prompt ? a.out + O_FLP + (size_t)b * 2048 * 16 : a.in[I_CLF] + (size_t)b * 2048 * 16;
        const float* src1 = a.out + O_FLS + (size_t)b * 64 * 16;
        if (prompt) cumsum_item<64, 32>(src0, src1, (float*)(a.ws + WS_CP) + (size_t)(b * 16 + hh) * 2048, SEG, hh, seg);
        else cumsum_item<66, 22>(src0, src1, (float*)(a.ws + WS_CS) + (size_t)(b * 16 + hh) * 2112, SEG, hh, seg);
    }
}

constexpr int AT_KS = 72, AT_VS = 68, AT_BUF = 18432, AT_VOFF = 9216, AT_COFF = 17920;
struct TileRegs { u32x4 k0, k1, v0, v1; float ck; };

template <bool SAMPLE> __device__ __forceinline__ void attn_load(TileRegs& R, const Args& a, int b, int h, int t, const float* cbase, int tid) {
    const int kvl = tid >> 3, ch = tid & 7, kp = tid >> 4, c4 = tid & 15;
    if (SAMPLE && t < 32) {
        const float* kptr = a.in[I_CK] + (((size_t)b * 2048 + 64 * t + kvl) * 16 + h) * 64 + 8 * ch;
        R.k0 = *(const u32x4*)kptr; R.k1 = *(const u32x4*)(kptr + 4);
        const float* vptr = a.in[I_CV] + (((size_t)b * 2048 + 64 * t + 2 * kp) * 16 + h) * 64 + 4 * c4;
        R.v0 = *(const u32x4*)vptr; R.v1 = *(const u32x4*)(vptr + 1024);
    } else {
        const size_t rowbase = SAMPLE ? (size_t)(MP + b * 64) : (size_t)(b * 2048 + 64 * t);
        const bf16_t* qkv = (const bf16_t*)(a.ws + WS_PROJ);
        R.k0 = *(const u32x4*)(qkv + (rowbase + kvl) * NPJ + 1024 + h * 64 + 8 * ch);
        const bf16_t* vptr = qkv + (rowbase + 2 * kp) * NPJ + 2048 + h * 64 + 4 * c4;
        const u32x2 x0 = *(const u32x2*)vptr, x1 = *(const u32x2*)(vptr + NPJ);
        R.v0.x = x0.x; R.v0.y = x0.y; R.v1.x = x1.x; R.v1.y = x1.y;
    }
    R.ck = cbase[64 * t + (tid & 63)];
}
__device__ __forceinline__ void attn_store(const TileRegs& R, LAS unsigned char* buf, bool f32src, int tid) {
    const int kvl = tid >> 3, ch = tid & 7, kp = tid >> 4, c4 = tid & 15;
    LAS unsigned* VT32 = (LAS unsigned*)(buf + AT_VOFF);
    if (f32src) {
        u32x4 o; o.x = pk(__uint_as_float(R.k0.x), __uint_as_float(R.k0.y)); o.y = pk(__uint_as_float(R.k0.z), __uint_as_float(R.k0.w));
        o.z = pk(__uint_as_float(R.k1.x), __uint_as_float(R.k1.y)); o.w = pk(__uint_as_float(R.k1.z), __uint_as_float(R.k1.w));
        *(LAS u32x4*)(buf + (kvl * AT_KS + 8 * ch) * 2) = o;
#pragma unroll
        for (int i = 0; i < 4; ++i) VT32[(4 * c4 + i) * (AT_VS / 2) + kp] = pk(__uint_as_float(R.v0[i]), __uint_as_float(R.v1[i]));
    } else {
        *(LAS u32x4*)(buf + (kvl * AT_KS + 8 * ch) * 2) = R.k0;
        VT32[(4 * c4 + 0) * (AT_VS / 2) + kp] = (R.v0.x & 0xffffu) | (R.v1.x << 16);
        VT32[(4 * c4 + 1) * (AT_VS / 2) + kp] = (R.v0.x >> 16) | (R.v1.x & 0xffff0000u);
        VT32[(4 * c4 + 2) * (AT_VS / 2) + kp] = (R.v0.y & 0xffffu) | (R.v1.y << 16);
        VT32[(4 * c4 + 3) * (AT_VS / 2) + kp] = (R.v0.y >> 16) | (R.v1.y & 0xffff0000u);
    }
    if (tid < 64) { const float c = -R.ck * LOG2E; const unsigned h1 = f2bf(c); const float r1 = c - bf2f(h1); const unsigned h2 = f2bf(r1); const unsigned h3 = f2bf(r1 - bf2f(h2));
        u32x2 o; o.x = h1 | (h2 << 16); o.y = h3; ((LAS u32x2*)(buf + AT_COFF))[tid] = o; }
}

template <bool QLDS> __device__ __forceinline__ void attn_tile(const LAS unsigned char* buf, const bf16x8 (&qf)[4], const LAS bf16x8* qlds, float cq2, int qpos, int kv0, bool diag, float& mrun, float& lrun, f32x16 (&ot)[2], int l31, int hi) {
    const LAS bf16_t* Ks = (const LAS bf16_t*)buf; const LAS bf16_t* VTs = (const LAS bf16_t*)(buf + AT_VOFF); const LAS u32x2* CKs = (const LAS u32x2*)(buf + AT_COFF);
    f32x16 p0, p1;
#pragma unroll
    for (int r = 0; r < 16; ++r) { p0[r] = cq2; p1[r] = cq2; }
    {
        const u32x2 b0 = CKs[l31], b1 = CKs[32 + l31];
        const unsigned msk = hi ? 0u : 0xffffffffu;
        u32x4 x0; x0.x = b0.x & msk; x0.y = b0.y & msk; x0.z = 0u; x0.w = 0u;
        u32x4 x1; x1.x = b1.x & msk; x1.y = b1.y & msk; x1.z = 0u; x1.w = 0u;
        u32x4 qx; qx.x = 0x3F803F80u & msk; qx.y = 0x00003F80u & msk; qx.z = 0u; qx.w = 0u;
        p0 = MFMA32(__builtin_bit_cast(bf16x8, x0), __builtin_bit_cast(bf16x8, qx), p0); p1 = MFMA32(__builtin_bit_cast(bf16x8, x1), __builtin_bit_cast(bf16x8, qx), p1);
    }
#pragma unroll
    for (int ks = 0; ks < 4; ++ks) { const bf16x8 k0 = *(const LAS bf16x8*)(Ks + l31 * AT_KS + 16 * ks + 8 * hi), k1 = *(const LAS bf16x8*)(Ks + (32 + l31) * AT_KS + 16 * ks + 8 * hi);
        const bf16x8 qq = QLDS ? qlds[ks * 64] : qf[ks];
        p0 = MFMA32(k0, qq, p0); p1 = MFMA32(k1, qq, p1); }
    __builtin_amdgcn_sched_barrier(0);
    if (diag) {
        int qp = qpos - kv0; asm volatile("" : "+v"(qp));
#pragma unroll
        for (int r = 0; r < 16; ++r) { const int kv = crow(r, hi); if (kv > qp) p0[r] = -INFINITY; if (kv + 32 > qp) p1[r] = -INFINITY; }
    }
    float rm = fmaxf(p0[0], p1[0]);
#pragma unroll
    for (int r = 1; r < 16; ++r) rm = fmaxf(rm, fmaxf(p0[r], p1[r]));
    rm = fmaxf(rm, __shfl_xor(rm, 32));
    if (__all(rm < mrun - 40.f)) return;
    const float mn = fmaxf(mrun, rm);
    if (__any(mn > mrun)) {
        const float alpha = __builtin_amdgcn_exp2f(mrun - mn);
        lrun *= alpha;
#pragma unroll
        for (int r = 0; r < 16; ++r) { ot[0][r] *= alpha; ot[1][r] *= alpha; }
        mrun = mn;
    }
    float rs = 0.f;
#pragma unroll
    for (int r = 0; r < 16; ++r) { p0[r] = __builtin_amdgcn_exp2f(p0[r] - mrun); p1[r] = __builtin_amdgcn_exp2f(p1[r] - mrun); rs += p0[r] + p1[r]; }
    lrun += rs;
    bf16x8 pf[4];
    { u32x4 x; x.x = pk(p0[0], p0[1]); x.y = pk(p0[2], p0[3]); x.z = pk(p0[4], p0[5]); x.w = pk(p0[6], p0[7]); pf[0] = __builtin_bit_cast(bf16x8, x);
      x.x = pk(p0[8], p0[9]); x.y = pk(p0[10], p0[11]); x.z = pk(p0[12], p0[13]); x.w = pk(p0[14], p0[15]); pf[1] = __builtin_bit_cast(bf16x8, x);
      x.x = pk(p1[0], p1[1]); x.y = pk(p1[2], p1[3]); x.z = pk(p1[4], p1[5]); x.w = pk(p1[6], p1[7]); pf[2] = __builtin_bit_cast(bf16x8, x);
      x.x = pk(p1[8], p1[9]); x.y = pk(p1[10], p1[11]); x.z = pk(p1[12], p1[13]); x.w = pk(p1[14], p1[15]); pf[3] = __builtin_bit_cast(bf16x8, x); }
    __builtin_amdgcn_sched_barrier(0);
#pragma unroll
    for (int db = 0; db < 2; ++db)
#pragma unroll
        for (int ks = 0; ks < 4; ++ks) { const LAS bf16_t* vp = VTs + (32 * db + l31) * AT_VS + 16 * ks + 4 * hi;
            const u32x2 lo = *(const LAS u32x2*)vp, hh2 = *(const LAS u32x2*)(vp + 8);
            u32x4 x; x.x = lo.x; x.y = lo.y; x.z = hh2.x; x.w = hh2.y;
            ot[db] = MFMA32(__builtin_bit_cast(bf16x8, x), pf[ks], ot[db]); }
}

__device__ __forceinline__ void gld16(u32x4& d, const void* p) { asm volatile("global_load_dwordx4 %0, %1, off" : "=v"(d) : "v"(p)); }
__device__ __forceinline__ void gld8(u32x2& d, const void* p) { asm volatile("global_load_dwordx2 %0, %1, off" : "=v"(d) : "v"(p)); }
__device__ __forceinline__ void gld4(float& d, const void* p) { asm volatile("global_load_dword %0, %1, off" : "=v"(d) : "v"(p)); }
struct PRegs { u32x4 k; u32x2 v0, v1; float ck; };
__device__ __forceinline__ void pload_a(PRegs& R, const Args& a, int b, int h, int t, const float* cbase, int tid) {
    const int kvl = tid >> 3, ch = tid & 7, kp = tid >> 4, c4 = tid & 15;
    const size_t rowbase = (size_t)(b * 2048 + 64 * t);
    const bf16_t* qkv = (const bf16_t*)(a.ws + WS_PROJ);
    gld16(R.k, qkv + (rowbase + kvl) * NPJ + 1024 + h * 64 + 8 * ch);
    const bf16_t* vptr = qkv + (rowbase + 2 * kp) * NPJ + 2048 + h * 64 + 4 * c4;
    gld8(R.v0, vptr); gld8(R.v1, vptr + NPJ);
    gld4(R.ck, cbase + 64 * t + (tid & 63));
}
#define WAIT_P(N, R) asm volatile("s_waitcnt vmcnt(" #N ")" : "+v"(R.k), "+v"(R.v0), "+v"(R.v1), "+v"(R.ck))
__device__ __forceinline__ void pstore(const PRegs& R, LAS unsigned char* buf, int tid) {
    const int kvl = tid >> 3, ch = tid & 7, kp = tid >> 4, c4 = tid & 15;
    LAS unsigned* VT32 = (LAS unsigned*)(buf + AT_VOFF);
    *(LAS u32x4*)(buf + (kvl * AT_KS + 8 * ch) * 2) = R.k;
    VT32[(4 * c4 + 0) * (AT_VS / 2) + kp] = (R.v0.x & 0xffffu) | (R.v1.x << 16);
    VT32[(4 * c4 + 1) * (AT_VS / 2) + kp] = (R.v0.x >> 16) | (R.v1.x & 0xffff0000u);
    VT32[(4 * c4 + 2) * (AT_VS / 2) + kp] = (R.v0.y & 0xffffu) | (R.v1.y << 16);
    VT32[(4 * c4 + 3) * (AT_VS / 2) + kp] = (R.v0.y >> 16) | (R.v1.y & 0xffff0000u);
    if (tid < 64) { const float c = -R.ck * LOG2E; const unsigned h1 = f2bf(c); const float r1 = c - bf2f(h1); const unsigned h2 = f2bf(r1); const unsigned h3 = f2bf(r1 - bf2f(h2));
        u32x2 o; o.x = h1 | (h2 << 16); o.y = h3; ((LAS u32x2*)(buf + AT_COFF))[tid] = o; }
}
__device__ __forceinline__ void attn_unit_prompt(const Args& a, LAS unsigned char* lds, int b, int h, int qb) {
    int tid_ = threadIdx.x; asm volatile("" : "+v"(tid_));
    const int tid = tid_, lane = tid & 63, w = __builtin_amdgcn_readfirstlane(tid >> 6), l31 = lane & 31, hi = lane >> 5;
    const int NT = 4 * (qb + 1);
    const int qpos = 256 * qb + 32 * w + l31;
    const size_t qrow = (size_t)(b * 2048 + qpos);
    const float* cbase = (const float*)(a.ws + WS_CP) + (size_t)(b * 16 + h) * 2048;
    const bf16_t* qkv = (const bf16_t*)(a.ws + WS_PROJ);
    bf16x8 qf[4];
#pragma unroll
    for (int ks = 0; ks < 4; ++ks) qf[ks] = *(const bf16x8*)(qkv + qrow * NPJ + h * 64 + 16 * ks + 8 * hi);
    const float cq2 = cbase[qpos] * LOG2E;
    const int qmax_w = 256 * qb + 32 * w + 31;
    PRegs R0, R1, R2;
    pload_a(R0, a, b, h, NT - 1, cbase, tid); pload_a(R1, a, b, h, NT - 2, cbase, tid); pload_a(R2, a, b, h, NT - 3, cbase, tid);
    WAIT_P(8, R0); pstore(R0, lds, tid);
    pload_a(R0, a, b, h, NT - 4, cbase, tid);
    __syncthreads();
    float mrun = -INFINITY, lrun = 0.f;
    f32x16 ot[2]; ot[0] = f32x16{}; ot[1] = f32x16{};
#define PSTEP(tt, RR) do { if ((tt) < NT) { const int ti_ = NT - 1 - (tt); if (64 * ti_ <= qmax_w) attn_tile<false>(lds + ((tt) & 1) * AT_BUF, qf, nullptr, cq2, qpos, 64 * ti_, ti_ >= 4 * qb, mrun, lrun, ot, l31, hi); \
        { WAIT_P(8, RR); pstore(RR, lds + (((tt) + 1) & 1) * AT_BUF, tid); pload_a(RR, a, b, h, (NT - 5 - (tt)) > 0 ? NT - 5 - (tt) : 0, cbase, tid); } \
        __syncthreads(); } } while (0)
#pragma unroll 1
    for (int t = 0; t < NT; t += 3) { PSTEP(t, R1); PSTEP(t + 1, R2); PSTEP(t + 2, R0); }
#undef PSTEP
    WAIT_P(0, R0); WAIT_P(0, R1); WAIT_P(0, R2);
    lrun += __shfl_xor(lrun, 32);
    const float inv = 1.f / lrun;
    bf16_t* og = (bf16_t*)(a.ws + WS_OG) + qrow * DM + h * 64;
#pragma unroll
    for (int db = 0; db < 2; ++db)
#pragma unroll
        for (int j = 0; j < 4; ++j) { u32x2 o; o.x = pk(ot[db][4 * j] * inv, ot[db][4 * j + 1] * inv); o.y = pk(ot[db][4 * j + 2] * inv, ot[db][4 * j + 3] * inv);
            *(u32x2*)(og + 32 * db + 8 * j + 4 * hi) = o; }
}

struct TileRegs2 { u32x4 k[4], v[4]; float ck; };
__device__ __forceinline__ void sload2(TileRegs2& R, const Args& a, int b, int h, int t, const float* cbase, int st) {
#pragma unroll
    for (int q = 0; q < 2; ++q) {
        const int item = st + 256 * q, kvl = item >> 3, ch = item & 7, kp = item >> 4, c4 = item & 15;
        if (t < 32) {
            const float* kptr = a.in[I_CK] + (((size_t)b * 2048 + 64 * t + kvl) * 16 + h) * 64 + 8 * ch;
            R.k[2 * q] = *(const u32x4*)kptr; R.k[2 * q + 1] = *(const u32x4*)(kptr + 4);
            const float* vptr = a.in[I_CV] + (((size_t)b * 2048 + 64 * t + 2 * kp) * 16 + h) * 64 + 4 * c4;
            R.v[2 * q] = *(const u32x4*)vptr; R.v[2 * q + 1] = *(const u32x4*)(vptr + 1024);
        } else {
            const size_t rowbase = (size_t)(MP + b * 64);
            const bf16_t* qkv = (const bf16_t*)(a.ws + WS_PROJ);
            R.k[2 * q] = *(const u32x4*)(qkv + (rowbase + kvl) * NPJ + 1024 + h * 64 + 8 * ch);
            const bf16_t* vptr = qkv + (rowbase + 2 * kp) * NPJ + 2048 + h * 64 + 4 * c4;
            const u32x2 x0 = *(const u32x2*)vptr, x1 = *(const u32x2*)(vptr + NPJ);
            R.v[2 * q].x = x0.x; R.v[2 * q].y = x0.y; R.v[2 * q + 1].x = x1.x; R.v[2 * q + 1].y = x1.y;
        }
    }
    R.ck = cbase[64 * t + (st & 63)];
}
__device__ __forceinline__ void sload2a(TileRegs2& R, const Args& a, int b, int h, int t, const float* cbase, int st) {
#pragma unroll
    for (int q = 0; q < 2; ++q) {
        const int item = st + 256 * q, kvl = item >> 3, ch = item & 7, kp = item >> 4, c4 = item & 15;
        const float* kptr = a.in[I_CK] + (((size_t)b * 2048 + 64 * t + kvl) * 16 + h) * 64 + 8 * ch;
        gld16(R.k[2 * q], kptr); gld16(R.k[2 * q + 1], kptr + 4);
        const float* vptr = a.in[I_CV] + (((size_t)b * 2048 + 64 * t + 2 * kp) * 16 + h) * 64 + 4 * c4;
        gld16(R.v[2 * q], vptr); gld16(R.v[2 * q + 1], vptr + 1024);
    }
    gld4(R.ck, cbase + 64 * t + (st & 63));
}
#define WAIT_R2(N, R) asm volatile("s_waitcnt vmcnt(" #N ")" : "+v"(R.k[0]), "+v"(R.k[1]), "+v"(R.k[2]), "+v"(R.k[3]), "+v"(R.v[0]), "+v"(R.v[1]), "+v"(R.v[2]), "+v"(R.v[3]), "+v"(R.ck))
__device__ __forceinline__ void sstore2(const TileRegs2& R, LAS unsigned char* buf, bool f32src, int st) {
    LAS unsigned* VT32 = (LAS unsigned*)(buf + AT_VOFF);
#pragma unroll
    for (int q = 0; q < 2; ++q) {
        const int item = st + 256 * q, kvl = item >> 3, ch = item & 7, kp = item >> 4, c4 = item & 15;
        if (f32src) {
            const u32x4 k0 = R.k[2 * q], k1 = R.k[2 * q + 1];
            u32x4 o; o.x = pk(__uint_as_float(k0.x), __uint_as_float(k0.y)); o.y = pk(__uint_as_float(k0.z), __uint_as_float(k0.w));
            o.z = pk(__uint_as_float(k1.x), __uint_as_float(k1.y)); o.w = pk(__uint_as_float(k1.z), __uint_as_float(k1.w));
            *(LAS u32x4*)(buf + (kvl * AT_KS + 8 * ch) * 2) = o;
#pragma unroll
            for (int i = 0; i < 4; ++i) VT32[(4 * c4 + i) * (AT_VS / 2) + kp] = pk(__uint_as_float(R.v[2 * q][i]), __uint_as_float(R.v[2 * q + 1][i]));
        } else {
            *(LAS u32x4*)(buf + (kvl * AT_KS + 8 * ch) * 2) = R.k[2 * q];
            const u32x4 v0 = R.v[2 * q], v1 = R.v[2 * q + 1];
            VT32[(4 * c4 + 0) * (AT_VS / 2) + kp] = (v0.x & 0xffffu) | (v1.x << 16);
            VT32[(4 * c4 + 1) * (AT_VS / 2) + kp] = (v0.x >> 16) | (v1.x & 0xffff0000u);
            VT32[(4 * c4 + 2) * (AT_VS / 2) + kp] = (v0.y & 0xffffu) | (v1.y << 16);
            VT32[(4 * c4 + 3) * (AT_VS / 2) + kp] = (v0.y >> 16) | (v1.y & 0xffff0000u);
        }
    }
    if (st < 64) { const float c = -R.ck * LOG2E; const unsigned h1 = f2bf(c); const float r1 = c - bf2f(h1); const unsigned h2 = f2bf(r1); const unsigned h3 = f2bf(r1 - bf2f(h2));
        u32x2 o; o.x = h1 | (h2 << 16); o.y = h3; ((LAS u32x2*)(buf + AT_COFF))[st] = o; }
}
__device__ __forceinline__ void attn_unit_sample(const Args& a, LAS unsigned char* lds, int b, int h) {
    int tid_ = threadIdx.x; asm volatile("" : "+v"(tid_));
    const int tid = tid_, lane = tid & 63, w = __builtin_amdgcn_readfirstlane(tid >> 6), l31 = lane & 31, hi = lane >> 5;
    const float* cbase = (const float*)(a.ws + WS_CS) + (size_t)(b * 16 + h) * 2112;
    if (w >= 2 && w < 6) {
        const int st = tid - 128;
        TileRegs2 R0, R1, R2, R3;
        sload2(R0, a, b, h, 32, cbase, st); sload2a(R1, a, b, h, 31, cbase, st); sload2a(R2, a, b, h, 30, cbase, st); sload2a(R3, a, b, h, 29, cbase, st);
        sstore2(R0, lds, false, st);
        sload2a(R0, a, b, h, 28, cbase, st);
        __syncthreads();
#define SSTEP(tt, RR) do { WAIT_R2(27, RR); sstore2(RR, lds + (((tt) + 1) & 1) * AT_BUF, true, st); sload2a(RR, a, b, h, (27 - (tt)) > 0 ? 27 - (tt) : 0, cbase, st); __syncthreads(); } while (0)
#pragma unroll 1
        for (int t = 0; t < 32; t += 4) { SSTEP(t, R1); SSTEP(t + 1, R2); SSTEP(t + 2, R3); SSTEP(t + 3, R0); }
        SSTEP(32, R1);
#undef SSTEP
        WAIT_R2(0, R0); WAIT_R2(0, R1); WAIT_R2(0, R2); WAIT_R2(0, R3);
    } else {
        const bool active = w < 2;
        const int qpos = 2048 + 32 * (w & 1) + l31;
        const size_t qrow = (size_t)(MP + b * 64 + 32 * (w & 1) + l31);
        const bf16_t* qkv = (const bf16_t*)(a.ws + WS_PROJ);
        bf16x8 qf[4];
#pragma unroll
        for (int ks = 0; ks < 4; ++ks) qf[ks] = *(const bf16x8*)(qkv + qrow * NPJ + h * 64 + 16 * ks + 8 * hi);
        const float cq2 = cbase[qpos] * LOG2E;
        float mrun = -INFINITY, lrun = 0.f;
        f32x16 ot[2]; ot[0] = f32x16{}; ot[1] = f32x16{};
        __syncthreads();
#pragma unroll 1
        for (int tt = 0; tt < 33; ++tt) {
            if (active) attn_tile<false>(lds + (tt & 1) * AT_BUF, qf, nullptr, cq2, qpos, 64 * (32 - tt), tt == 0, mrun, lrun, ot, l31, hi);
            __syncthreads();
        }
        if (active) {
            lrun += __shfl_xor(lrun, 32);
            const float inv = 1.f / lrun;
            bf16_t* og = (bf16_t*)(a.ws + WS_OG) + qrow * DM + h * 64;
#pragma unroll
            for (int db = 0; db < 2; ++db)
#pragma unroll
                for (int j = 0; j < 4; ++j) { u32x2 o; o.x = pk(ot[db][4 * j] * inv, ot[db][4 * j + 1] * inv); o.y = pk(ot[db][4 * j + 2] * inv, ot[db][4 * j + 3] * inv);
                    *(u32x2*)(og + 32 * db + 8 * j + 4 * hi) = o; }
        }
    }
}

__device__ __forceinline__ void fox_attention(const Args& a, LAS unsigned char* lds, int vcu, int G) {
#pragma unroll 1
    for (int pass = 0; pass < 2; ++pass) {
        if ((pass ^ (vcu & 1)) == 0) {
#ifdef ATT_DUP_PROMPT
          for (int rep2_ = 0; rep2_ < 2; ++rep2_)
#endif
            if (G == 256) {
                const int bh = vcu >> 1, s0 = 2 * (vcu & 1);
#pragma unroll 1
                for (int i = 0; i < 4; ++i) attn_unit_prompt(a, lds, bh >> 4, bh & 15, (i & 1) ? s0 + (i >> 1) : 7 - s0 - (i >> 1));
            } else {
#pragma unroll 1
                for (int u = vcu; u < 1024; u += G) attn_unit_prompt(a, lds, (u & 127) >> 4, u & 15, 7 - (u >> 7));
            }
        } else {
#ifdef ATT_DUP_SAMPLE
            for (int rep3_ = 0; rep3_ < 2; ++rep3_)
#endif
#pragma unroll 1
            for (int u = vcu; u < 512; u += G) attn_unit_sample(a, lds, u >> 4, u & 15);
        }
    }
}

#ifndef PH_MASK
#define PH_MASK 0x7fff
#endif
#define IN(k) (((PH_MASK >> (k)) & 1) && a.ph_lo <= (k) && (k) < a.ph_hi)
#define SEAM(k) do { if (IN(k) && IN((k) + 1)) { if ((k) == 0) cg::this_grid().sync(); else xcd_barrier(xbar); } } while (0)
#ifndef DUP_MASK
#define DUP_MASK 0
#endif
#define REP(k) _Pragma("unroll 1") for (int rep_ = 0; rep_ < ((((DUP_MASK) >> (k)) & 1) ? 2 : 1); ++rep_)
#define REPSYNC(k) do { if ((((DUP_MASK) >> (k)) & 1)) xcd_barrier(xbar); } while (0)
struct SliceOrder {
    int pm, pn;
    __device__ __forceinline__ bool next(int i, pg8::Unit& u) const { if (i > 0) return false; u.pm = pm; u.pn = pn; return true; }
    __device__ __forceinline__ void a_ready(const pg8::Unit&) const {}
    __device__ __forceinline__ void done(const pg8::Unit&) const {}
};
struct EpiPartial {
    static constexpr bool PERM = true, AFTER_DRAIN = false;
    float* part;
    __device__ __forceinline__ void operator()(const pg8::f32x4 (&acc)[2][2][4][2], const pg8::Unit& u, int wr, int wc, int fr, int fq) const {
#pragma unroll
        for (int ai = 0; ai < 2; ++ai)
#pragma unroll
            for (int m = 0; m < 4; ++m) { float* rowp = part + (size_t)(ai * 128 + wr * 64 + m * 16 + fr) * 256 + wc * 32 + 8 * fq;
#pragma unroll
                for (int bj = 0; bj < 2; ++bj) { *(f32x4*)(rowp + bj * 128) = acc[ai][bj][m][0]; *(f32x4*)(rowp + bj * 128 + 4) = acc[ai][bj][m][1]; } }
    }
};
__device__ __forceinline__ void ffd_sample_rows(const Args& a, int vcu, int G, float* ssout) {
    const int tid = threadIdx.x, lane = tid & 63, wave = tid >> 6;
    const int gw = vcu * 8 + wave, NGW = G * 8;
    float* XR = (float*)(a.ws + WS_XR); bf16_t* XB = (bf16_t*)(a.ws + WS_XB); const float* PART = (const float*)(a.ws + WS_PART);
    for (int r = gw; r < MS; r += NGW) {
        const int pml = r >> 8, rr = r & 255; const size_t row = (size_t)(MP + r);
        f32x4 acc[4];
#pragma unroll
        for (int pn = 0; pn < 4; ++pn) { acc[pn] = *(const f32x4*)(XR + row * DM + pn * 256 + 4 * lane);
#pragma unroll
            for (int sl = 0; sl < 8; ++sl) acc[pn] += *(const f32x4*)(PART + ((size_t)((pml * 4 + pn) * 8 + sl) * 256 + rr) * 256 + 4 * lane); }
        float sq = 0.f;
#pragma unroll
        for (int pn = 0; pn < 4; ++pn) { sq += dot4(acc[pn]); *(f32x4*)(XR + row * DM + pn * 256 + 4 * lane) = acc[pn];
            u32x2 o; o.x = pk(acc[pn][0], acc[pn][1]); o.y = pk(acc[pn][2], acc[pn][3]); *(u32x2*)(XB + row * DM + pn * 256 + 4 * lane) = o; }
        sq = wave_sum(sq);
        if (lane == 0) ssout[row] = sq;
    }
}
template <int L> __device__ __forceinline__ void common_gemms(const Args& a, LAS unsigned char* lds, int G, int bx, const XcdBarrier& xbar) {
    unsigned char* ws = a.ws;
    float* SS = (float*)(ws + WS_SS);
    bf16_t* XB = (bf16_t*)(ws + WS_XB); float* XR = (float*)(ws + WS_XR); bf16_t* OG = (bf16_t*)(ws + WS_OG); bf16_t* ACT = (bf16_t*)(ws + WS_ACT);
    constexpr int po = L ? 11 : 5;
    if (IN(po)) { pg8::Gemm g{OG, (const bf16_t*)(ws + (L ? WS_WFOUT : WS_WGOUT)), MT, DM, DM}; pg8::StaticOrder S; S.init(MT, DM, G, bx);
        EpiResid E{L ? XR : a.in[I_XP], L ? XR + (size_t)MP * DM : a.in[I_XS], XR, XB, SS + (L ? 3 : 1) * 32768};
        pg8::gemm_phase<EpiResid, pg8::StaticOrder, true, true>(lds, g, S, E);
        if (L == 0 && G == 256 && !MK_MULTI && bx >= 32) convert_weights(a, lds, 1, (bx - 32) * 8 + (int)(threadIdx.x >> 6), 224 * 8); }
    SEAM(po);
    if (IN(po + 1)) REP(po + 1) { pg8::Gemm g{XB, (const bf16_t*)(ws + WS_WFFI + (size_t)L * 11 * MiB), MT, 2 * DFF, DM}; pg8::StaticOrder S; S.init(MT, 2 * DFF, G, bx);
        EpiSwiglu E{SS + (L ? 3 : 1) * 32768, ACT}; pg8::gemm_phase<EpiSwiglu, pg8::StaticOrder, true, true>(lds, g, S, E); REPSYNC(po + 1); }
    SEAM(po + 1);
    if (IN(po + 2)) {
        const bf16_t* W = (const bf16_t*)(ws + WS_WFFD + (size_t)L * 6 * MiB);
        if (G == 256 && !MK_MULTI) {
            { pg8::Gemm g{ACT, W, MP, DM, DFF, 0}; pg8::StaticOrder S; S.init(MP, DM, G, bx);
              EpiResid E{XR, XR + (size_t)MP * DM, XR, XB, SS + (L ? 4 : 2) * 32768};
              pg8::gemm_phase<EpiResid, pg8::StaticOrder, true, true>(lds, g, S, E); }
            { const int un = bx >> 3, sl = bx & 7, kb0 = (sl < 6) ? 3 * sl : 18 + 2 * (sl - 6), kbn = (sl < 6) ? 3 : 2;
              pg8::Gemm g{ACT + 128 * kb0, W + 128 * kb0, MT, DM, 128 * kbn, DFF}; SliceOrder S{64 + (un >> 2), un & 3};
              EpiPartial E{(float*)(ws + WS_PART) + (size_t)(un * 8 + sl) * 65536};
              pg8::gemm_phase<EpiPartial, SliceOrder, true, true>(lds, g, S, E); }
            xcd_barrier(xbar);
            ffd_sample_rows(a, (bx % 8) * (G / 8) + bx / 8, G, SS + (L ? 4 : 2) * 32768);
        } else {
            pg8::Gemm g{ACT, W, MT, DM, DFF, 0}; pg8::StaticOrder S; S.init(MT, DM, G, bx);
            EpiResid E{XR, XR + (size_t)MP * DM, XR, XB, SS + (L ? 4 : 2) * 32768};
            pg8::gemm_phase<EpiResid, pg8::StaticOrder, true, true>(lds, g, S, E);
        }
    }
    SEAM(po + 2);
}
constexpr int NPH = 15;
__global__ void __launch_bounds__(512, 2) fwd(Args a) {
    extern __shared__ __attribute__((aligned(16))) unsigned char lds_raw[];
    LAS unsigned char* lds = (LAS unsigned char*)lds_raw;
    const int G = gridDim.x, bx = blockIdx.x;
    const int vcu = (G % 8 == 0) ? (bx % 8) * (G / 8) + bx / 8 : bx;
    unsigned char* ws = a.ws;
    float* SS = (float*)(ws + WS_SS);
    bf16_t* XB = (bf16_t*)(ws + WS_XB); bf16_t* PROJ = (bf16_t*)(ws + WS_PROJ);

    volatile LAS unsigned* MISC = (volatile LAS unsigned*)(lds + 131072);
    if (threadIdx.x < 64) MISC[threadIdx.x] = 0u;
    __syncthreads();
    XcdBarrier xbar; xbar.bar = (unsigned*)ws; xbar.x = 0; xbar.st = nullptr;
    if (a.ph_hi - a.ph_lo > 1) xbar = xcd_barrier_post((unsigned*)ws, MISC + 8);
    if (IN(0)) REP(0) { p0_prologue(a, lds, vcu, G); REPSYNC(0); }
    SEAM(0);
    if (IN(1)) { pg8::Gemm g{XB, (const bf16_t*)(ws + WS_WGIN), MT, NPROJ, DM}; pg8::StaticOrder S; S.init(MT, NPROJ, G, bx);
        EpiGlaProj E{SS, PROJ, (float*)(ws + WS_GL)}; pg8::gemm_phase<EpiGlaProj, pg8::StaticOrder, true, true>(lds, g, S, E); }
    SEAM(1);
    if (IN(2)) REP(2) {
        { GlaPre pf; if (vcu < 1152) gla_prefetch(pf, a, vcu >> 2, vcu & 3);
#pragma unroll 1
        for (int it = vcu; it < 1152; it += G) gla_item<0>(a, lds, it >> 2, it & 3, pf, (it + G < 1152) ? it + G : -1); }
        REPSYNC(2); }
    SEAM(2);
    if (IN(3)) REP(3) { gla_scan(a, vcu, G); REPSYNC(3); }
    SEAM(3);
    if (IN(4)) REP(4) {
        { GlaPre pf; if (vcu < 1152) gla_prefetch(pf, a, vcu >> 2, vcu & 3);
#pragma unroll 1
        for (int it = vcu; it < 1152; it += G) gla_item<1>(a, lds, it >> 2, it & 3, pf, (it + G < 1152) ? it + G : -1); }
        REPSYNC(4); }
    SEAM(4);
    common_gemms<0>(a, lds, G, bx, xbar);
    if (IN(8)) { pg8::Gemm g{XB, (const bf16_t*)(ws + WS_WFIN), MT, NPROJ, DM}; pg8::StaticOrder S; S.init(MT, NPROJ, G, bx);
        EpiFoxProj E{SS + 2 * 32768, PROJ, a.out, a.in[I_FBF]}; pg8::gemm_phase<EpiFoxProj, pg8::StaticOrder, true, true>(lds, g, S, E); }
    SEAM(8);
    if (IN(9)) REP(9) { fox_cumsum(a, lds, vcu, G); REPSYNC(9); }
    SEAM(9);
    if (IN(10)) REP(10) { fox_attention(a, lds, vcu, G); REPSYNC(10); }
    SEAM(10);
    common_gemms<1>(a, lds, G, bx, xbar);
#ifdef EXTRA_SYNCS
    for (int i_ = 0; i_ < EXTRA_SYNCS; ++i_) xcd_barrier(xbar);
#endif
    if (IN(14)) p_final(a, vcu, G);
#undef IN
#undef SEAM
}

extern "C" void kernel_launch(void* const* d_in, const int* in_sizes, int n_in, void* d_out, int out_size, void* d_ws, size_t ws_size, hipStream_t stream) {
    static int grid = 0;
    if (grid == 0) {
        if (n_in != 19 || ws_size < WS_END || out_size != 62160896) { fprintf(stderr, "kernel_launch: unexpected problem shape (n_in %d, out %d, ws %zu)\n", n_in, out_size, ws_size); grid = -1; return; }
        if (hipFuncSetAttribute((const void*)fwd, hipFuncAttributeMaxDynamicSharedMemorySize, LDS_BYTES) != hipSuccess) { fprintf(stderr, "kernel_launch: hipFuncSetAttribute failed\n"); grid = -1; return; }
        int dev = 0, cus = 0, per_cu = 0;
        (void)hipGetDevice(&dev); (void)hipDeviceGetAttribute(&cus, hipDeviceAttributeMultiprocessorCount, dev);
        (void)hipOccupancyMaxActiveBlocksPerMultiprocessor(&per_cu, (const void*)fwd, 512, LDS_BYTES);
        (void)hipGetLastError();
        if (per_cu < 1) per_cu = 1;
        grid = cus * 1;
        if (grid <= 0) grid = 256;
    }
    if (grid < 0) return;
    (void)hipMemsetAsync((char*)d_ws + WS_CTL, 0, CTL_BYTES, stream);
    Args a{};
    for (int i = 0; i < 19; ++i) a.in[i] = (const float*)d_in[i];
    a.out = (float*)d_out; a.ws = (unsigned char*)d_ws;
#if MK_MULTI
    for (int ph = 0; ph < NPH; ++ph) { a.ph_lo = ph; a.ph_hi = ph + 1; hipLaunchKernelGGL(fwd, dim3(grid), dim3(512), LDS_BYTES, stream, a); }
#else
    a.ph_lo = 0; a.ph_hi = NPH;
    void* args[] = {&a};
    hipError_t e = hipLaunchCooperativeKernel((const void*)fwd, dim3(grid), dim3(512), args, LDS_BYTES, stream);
    if (e != hipSuccess) fprintf(stderr, "kernel_launch: cooperative launch failed: %s (grid %d)\n", hipGetErrorString(e), grid);
#endif
}
```

```cpp
#include <hip/hip_runtime.h>
#include <hip/hip_cooperative_groups.h>
#include <cstdio>
#include <cstdint>
#include <cmath>
namespace cg = cooperative_groups;
#define MK_MULTI 0
namespace pg8 {
#define PG8_LAS __attribute__((address_space(3)))
typedef unsigned short bf16_t;
typedef short bf16x8 __attribute__((ext_vector_type(8)));
typedef float f32x4 __attribute__((ext_vector_type(4)));
typedef unsigned u32x4 __attribute__((ext_vector_type(4)));
constexpr int BM = 256, BK = 64, HALF = 128, HTB = HALF * BK * 2  , STAGE_BYTES = 8 * HTB, NXCD = 8, WGM = 8;

__host__ __device__ __forceinline__ int lds_byte(int r, int c) { const int st = (r >> 4) * 2 + (c >> 5), rr = r & 15, cc = c & 31, ob = rr * 64 + cc * 2; return st * 1024 + (ob ^ (((ob >> 9) & 1) << 5)); }
__host__ __device__ __forceinline__ void stage_rc(int b, int& R, int& C) { const int st = b / 1024, sb = b % 1024, swz = sb ^ (((sb >> 9) & 1) << 5); R = (st >> 1) * 16 + swz / 64; C = (st & 1) * 32 + (swz % 64) / 2; }
__host__ __device__ __forceinline__ int perm32(int rho) { const int n = rho >> 4, i = rho & 15; return 8 * (i >> 2) + 4 * n + (i & 3); }

struct Unit { int pm, pn; };
struct Gemm { const bf16_t* A; const bf16_t* Bt; int M, N, K; int ld; };

struct StaticOrder {
    int nM, nN, nwg, G, c;
    __host__ __device__ void init(int M, int N, int G_, int c_) { nM = M / BM; nN = N / BM; nwg = nM * nN; G = G_; c = c_; }
    __host__ __device__ bool next(int i, Unit& u) const {
        const long L = (long)i * G + c; if (L >= nwg) return false;
        int wgid = (int)L; { const int q = nwg / NXCD, r = nwg % NXCD, xcd = wgid % NXCD, off = wgid / NXCD; wgid = (xcd < r ? xcd * (q + 1) : r * (q + 1) + (xcd - r) * q) + off; }
        const int nig = WGM * nN, gid = wgid / nig, fm = gid * WGM, gsz = (nM - fm) < WGM ? (nM - fm) : WGM;
        u.pm = fm + ((wgid % nig) % gsz); u.pn = (wgid % nig) / gsz; return true;
    }
    __device__ __forceinline__ void a_ready(const Unit&) const {}
    __device__ __forceinline__ void done(const Unit&) const {}
};

__device__ __forceinline__ unsigned cvt_pk_bf16(float lo, float hi) { unsigned r; asm volatile("v_cvt_pk_bf16_f32 %0, %1, %2" : "=v"(r) : "v"(lo), "v"(hi)); return r; }
template <class Epi, class Sched, bool ALIGN_EPI = false, bool SP2 = false>
__device__ __forceinline__ void gemm_phase(PG8_LAS unsigned char* lds, const Gemm g, const Sched& S, const Epi& E) {
    const int tid = threadIdx.x, wid = __builtin_amdgcn_readfirstlane(tid >> 6), lane = tid & 63, wr = wid >> 2, wc = wid & 3, fr = lane & 15, fq = lane >> 4;
    const int K = g.ld ? g.ld : g.K, nt = g.K / BK;
    unsigned voffA[2], voffB[2];
#pragma unroll
    for (int i = 0; i < 2; ++i) { int R, C; stage_rc(tid * 16 + i * 8192, R, C); const int Rb = Epi::PERM ? ((R & ~31) + perm32(R & 31)) : R;
        voffA[i] = (unsigned)(R * K + C) * 2u; voffB[i] = (unsigned)(Rb * K + C) * 2u; }
    const size_t kstep = (size_t)(BK * 2);
    const size_t hstep = (size_t)HALF * K * 2;
    const size_t tstep = 2 * hstep;
    const unsigned ldsw = (unsigned)wid * 1024u;
    const int aoff = lds_byte(wr * 64 + fr, fq * 8), boff = lds_byte(wc * 32 + fr, fq * 8);
#define PG8_SA(b, h) (((b) * 2 + (h)) * HTB)
#define PG8_SB(b, h) ((4 + (b) * 2 + (h)) * HTB)
#define PG8_STAGE(bufoff, gbase, voff) do { _Pragma("unroll") for (int _i = 0; _i < 2; ++_i) \
        __builtin_amdgcn_global_load_lds((const unsigned*)((const char*)(gbase) + (voff)[_i]), (PG8_LAS unsigned*)(lds + (bufoff) + ldsw + _i * 8192), 16, 0, 0); } while (0)
#define PG8_LDA(dst, b, h) do { _Pragma("unroll") for (int m = 0; m < 4; ++m) _Pragma("unroll") for (int k = 0; k < 2; ++k) dst[m][k] = *(const PG8_LAS bf16x8*)(lds + PG8_SA(b, h) + aoff + m * 2048 + k * 1024); } while (0)
#define PG8_LDB(dst, b, h) do { _Pragma("unroll") for (int n = 0; n < 2; ++n) _Pragma("unroll") for (int k = 0; k < 2; ++k) dst[n][k] = *(const PG8_LAS bf16x8*)(lds + PG8_SB(b, h) + boff + n * 2048 + k * 1024); } while (0)
#define PG8_MMA(ai, bj, At, Bt) do { __builtin_amdgcn_s_setprio(1); _Pragma("unroll") for (int m = 0; m < 4; ++m) _Pragma("unroll") for (int n = 0; n < 2; ++n) _Pragma("unroll") for (int k = 0; k < 2; ++k) \
        acc[ai][bj][m][n] = __builtin_amdgcn_mfma_f32_16x16x32_bf16(Bt[n][k], At[m][k], acc[ai][bj][m][n], 0, 0, 0); __builtin_amdgcn_s_setprio(0); } while (0)
#define PG8_WAIT_V(n) asm volatile("s_waitcnt vmcnt(" #n ")" ::: "memory")
#define PG8_WAIT_L(n) asm volatile("s_waitcnt lgkmcnt(" #n ")" ::: "memory")
#define PG8_BAR __builtin_amdgcn_s_barrier()
#define PG8_SCHED __builtin_amdgcn_sched_barrier(0)
    Unit cur, nxt; int ui = 0;
    if (!S.next(0, cur)) return;
    f32x4 acc[2][2][4][2];
#pragma unroll
    for (int a = 0; a < 2; ++a)
#pragma unroll
        for (int b = 0; b < 2; ++b)
#pragma unroll
            for (int m = 0; m < 4; ++m)
#pragma unroll
                for (int n = 0; n < 2; ++n) acc[a][b][m][n] = (f32x4){0.f, 0.f, 0.f, 0.f};
    bf16x8 At[4][2], B0[2][2], B1[2][2];
    const char* cA = (const char*)g.A + (size_t)cur.pm * tstep; const char* cB = (const char*)g.Bt + (size_t)cur.pn * tstep;
    S.a_ready(cur);
    if constexpr (SP2) {
        PG8_STAGE(PG8_SB(0, 0), cB, voffB); PG8_STAGE(PG8_SB(0, 1), cB + hstep, voffB); PG8_STAGE(PG8_SA(0, 0), cA, voffA); PG8_STAGE(PG8_SA(0, 1), cA + hstep, voffA);
        if (wr == 1) PG8_BAR;
        PG8_WAIT_V(2); PG8_BAR;
        PG8_STAGE(PG8_SB(1, 0), cB + kstep, voffB); PG8_STAGE(PG8_SA(1, 0), cA + kstep, voffA); PG8_STAGE(PG8_SB(1, 1), cB + hstep + kstep, voffB);
        PG8_WAIT_V(6); PG8_BAR;
    } else {
        PG8_STAGE(PG8_SB(0, 0), cB, voffB); PG8_STAGE(PG8_SA(0, 0), cA, voffA); PG8_STAGE(PG8_SB(0, 1), cB + hstep, voffB); PG8_STAGE(PG8_SA(0, 1), cA + hstep, voffA);
        if (wr == 1) PG8_BAR;
        PG8_WAIT_V(4); PG8_BAR;
        PG8_STAGE(PG8_SB(1, 0), cB + kstep, voffB); PG8_STAGE(PG8_SA(1, 0), cA + kstep, voffA); PG8_STAGE(PG8_SB(1, 1), cB + hstep + kstep, voffB);
        PG8_WAIT_V(6); PG8_BAR;
    }
    for (;;) {
        const bool has_next = S.next(ui + 1, nxt);
        const char* nA = has_next ? (const char*)g.A + (size_t)nxt.pm * tstep : cA; const char* nB = has_next ? (const char*)g.Bt + (size_t)nxt.pn * tstep : cB;
        for (int t = 0; t < nt; t += 2) {
            const bool last = (t == nt - 2);
            const char* a1 = cA + (size_t)(t + 1) * kstep;
            const char* a2 = last ? nA : cA + (size_t)(t + 2) * kstep; const char* b2 = last ? nB : cB + (size_t)(t + 2) * kstep;
            const char* a3 = a2 + kstep; const char* b3 = b2 + kstep;
            if (last && has_next) S.a_ready(nxt);
            if constexpr (SP2) {
            PG8_LDB(B0, 0, 0); PG8_LDB(B1, 0, 1); PG8_SCHED; PG8_LDA(At, 0, 0); PG8_STAGE(PG8_SA(1, 1), a1 + hstep, voffA);
            PG8_WAIT_V(8); PG8_WAIT_L(0); PG8_BAR; PG8_MMA(0, 0, At, B0); PG8_MMA(0, 1, At, B1); PG8_BAR; PG8_SCHED;
            PG8_LDA(At, 0, 1); PG8_STAGE(PG8_SB(0, 0), b2, voffB); PG8_STAGE(PG8_SB(0, 1), b2 + hstep, voffB); PG8_STAGE(PG8_SA(0, 0), a2, voffA);
            PG8_WAIT_V(8); PG8_WAIT_L(0); PG8_BAR; PG8_MMA(1, 0, At, B0); PG8_MMA(1, 1, At, B1); PG8_BAR; PG8_SCHED;
            PG8_LDB(B0, 1, 0); PG8_LDB(B1, 1, 1); PG8_SCHED; PG8_LDA(At, 1, 0); PG8_STAGE(PG8_SA(0, 1), a2 + hstep, voffA);
            PG8_WAIT_V(8); PG8_WAIT_L(0); PG8_BAR; PG8_MMA(0, 0, At, B0); PG8_MMA(0, 1, At, B1); PG8_BAR; PG8_SCHED;
            PG8_LDA(At, 1, 1); PG8_STAGE(PG8_SB(1, 0), b3, voffB); PG8_STAGE(PG8_SB(1, 1), b3 + hstep, voffB); PG8_STAGE(PG8_SA(1, 0), a3, voffA);
            PG8_WAIT_V(8); PG8_WAIT_L(0); PG8_BAR; PG8_MMA(1, 0, At, B0); PG8_MMA(1, 1, At, B1); PG8_BAR; PG8_SCHED;
            } else {
            PG8_LDB(B0, 0, 0); PG8_SCHED; PG8_LDA(At, 0, 0); PG8_STAGE(PG8_SA(1, 1), a1 + hstep, voffA);
            PG8_WAIT_L(8); PG8_BAR; PG8_WAIT_L(0); PG8_MMA(0, 0, At, B0); PG8_BAR; PG8_SCHED;
            PG8_LDB(B1, 0, 1); PG8_STAGE(PG8_SB(0, 0), b2, voffB);
            PG8_BAR; PG8_WAIT_L(0); PG8_MMA(0, 1, At, B1); PG8_BAR;
            PG8_LDA(At, 0, 1); PG8_STAGE(PG8_SA(0, 0), a2, voffA);
            PG8_BAR; PG8_WAIT_L(0); PG8_MMA(1, 0, At, B0); PG8_BAR; PG8_SCHED;
            PG8_STAGE(PG8_SB(0, 1), b2 + hstep, voffB);
            PG8_WAIT_V(6); PG8_BAR; PG8_MMA(1, 1, At, B1); PG8_BAR;
            PG8_LDB(B0, 1, 0); PG8_SCHED; PG8_LDA(At, 1, 0); PG8_STAGE(PG8_SA(0, 1), a2 + hstep, voffA);
            PG8_WAIT_L(8); PG8_BAR; PG8_WAIT_L(0); PG8_MMA(0, 0, At, B0); PG8_BAR; PG8_SCHED;
            PG8_LDB(B1, 1, 1); PG8_STAGE(PG8_SB(1, 0), b3, voffB);
            PG8_BAR; PG8_WAIT_L(0); PG8_MMA(0, 1, At, B1); PG8_BAR;
            PG8_LDA(At, 1, 1); PG8_STAGE(PG8_SA(1, 0), a3, voffA);
            PG8_BAR; PG8_WAIT_L(0); PG8_MMA(1, 0, At, B0); PG8_BAR; PG8_SCHED;
            PG8_STAGE(PG8_SB(1, 1), b3 + hstep, voffB);
            PG8_WAIT_V(6); PG8_BAR; PG8_MMA(1, 1, At, B1); PG8_BAR;
            }
        }
        if constexpr (ALIGN_EPI) { if (wr == 0) PG8_BAR; }
        if constexpr (!Epi::AFTER_DRAIN) { E(acc, cur, wr, wc, fr, fq); S.done(cur); }
        if (!has_next) break;
#pragma unroll
        for (int a = 0; a < 2; ++a)
#pragma unroll
            for (int b = 0; b < 2; ++b)
#pragma unroll
                for (int m = 0; m < 4; ++m)
#pragma unroll
                    for (int n = 0; n < 2; ++n) acc[a][b][m][n] = (f32x4){0.f, 0.f, 0.f, 0.f};
        cur = nxt; cA = nA; cB = nB; ++ui;
        if constexpr (ALIGN_EPI) { if (wr == 1) PG8_BAR; }
    }
    PG8_WAIT_V(0);
    if constexpr (!ALIGN_EPI) { if (wr == 0) PG8_BAR; }
    PG8_BAR;
    if constexpr (Epi::AFTER_DRAIN) { E.fused(acc, cur, wr, wc, fr, fq, lds, wid, lane); S.done(cur); }
#undef PG8_SA
#undef PG8_SB
#undef PG8_STAGE
#undef PG8_LDA
#undef PG8_LDB
#undef PG8_MMA
#undef PG8_WAIT_V
#undef PG8_WAIT_L
#undef PG8_BAR
#undef PG8_SCHED
}
}

#define LAS __attribute__((address_space(3)))
typedef unsigned short bf16_t;
typedef short bf16x8 __attribute__((ext_vector_type(8)));
typedef float f32x4 __attribute__((ext_vector_type(4)));
typedef float f32x16 __attribute__((ext_vector_type(16)));
typedef unsigned u32x4 __attribute__((ext_vector_type(4)));
typedef unsigned u32x2 __attribute__((ext_vector_type(2)));

#ifndef MK_MULTI
#define MK_MULTI 0
#endif

constexpr int DM = 1024, MP = 16384, MS = 2048, MT = MP + MS;
constexpr int NPROJ = 3328, NPJ = 3072, DFF = 2816;
constexpr float EPS = 1e-6f;
constexpr float LOG2E = 1.4426950408889634f;
constexpr float QSCALE2 = 0.125f * LOG2E;
constexpr size_t O_Y = 0, O_GSP = 18874368, O_FKP = 19922944, O_FVP = 36700160, O_FLP = 53477376, O_GSS = 53739520, O_FKS = 57933824, O_FVS = 60030976, O_FLS = 62128128;
constexpr size_t MiB = 1u << 20;
constexpr size_t WS_CTL = 0, CTL_BYTES = 2 * MiB;
constexpr size_t WS_SS = 65536;
constexpr size_t WS_WGIN = 2 * MiB, WS_WFIN = 9 * MiB, WS_WGOUT = 16 * MiB, WS_WFOUT = 18 * MiB, WS_WFFI = 20 * MiB  , WS_WFFD = 42 * MiB  ;
constexpr size_t WS_XB = 54 * MiB, WS_XR = 90 * MiB, WS_PROJ = 162 * MiB, WS_GL = 270 * MiB, WS_DST = 272 * MiB, WS_DEC = 400 * MiB, WS_SPREV = 401 * MiB;
constexpr size_t WS_OG = 465 * MiB, WS_ACT = 501 * MiB, WS_CP = 600 * MiB, WS_CS = 601 * MiB, WS_PART = 606 * MiB  , WS_END = 672 * MiB;
constexpr int LDS_BYTES = 135168;

struct Args {
    const float* in[19];
    float* out; unsigned char* ws;
    int ph_lo, ph_hi;
};
enum { I_XP = 0, I_XS, I_STATE, I_CK, I_CV, I_CLF, I_NMIX, I_GWIN, I_GWG2, I_GBG, I_GNORM, I_GWOUT, I_FWIN, I_FBF, I_FWOUT, I_NFFN, I_FFIN, I_FFDN, I_NFIN };

__device__ __forceinline__ float bf2f(unsigned u) { return __uint_as_float(u << 16); }
__device__ __forceinline__ unsigned f2bf(float f) { unsigned u = __float_as_uint(f); return (u + 0x7fffu + ((u >> 16) & 1u)) >> 16; }
__device__ __forceinline__ unsigned pk(float lo, float hi) { return pg8::cvt_pk_bf16(lo, hi); }
__device__ __forceinline__ float wave_sum(float v) {
#pragma unroll
    for (int o = 1; o < 64; o <<= 1) v += __shfl_xor(v, o);
    return v;
}
__device__ __forceinline__ float log_sigmoid(float z) { return fminf(z, 0.f) - __logf(1.f + __expf(-fabsf(z))); }
__device__ __forceinline__ int crow(int r, int hi) { return (r & 3) + 8 * (r >> 2) + 4 * hi; }
__device__ __forceinline__ float dot4(f32x4 v) { return (v[0] * v[0] + v[1] * v[1]) + (v[2] * v[2] + v[3] * v[3]); }
#define MFMA32(a, b, c) __builtin_amdgcn_mfma_f32_32x32x16_bf16((a), (b), (c), 0, 0, 0)

#define XB_TMO      128
#define XB_XCNT(j)  (256  + 64 * (j))
#define XB_XSUB(j)  (1280 + 64 * (j))
#define XB_XGEN(j)  (2304 + 64 * (j))
#define XB_TOP      3328
#define XB_TOPGEN   3392
#define XCD_BAR_WORDS 3456
#define XB_SPIN_CAP (1u << 18)

__device__ __forceinline__ unsigned xb_ld(unsigned* p)              { return __hip_atomic_load(p, __ATOMIC_RELAXED, __HIP_MEMORY_SCOPE_AGENT); }
__device__ __forceinline__ unsigned xb_add(unsigned* p, unsigned v) { return __hip_atomic_fetch_add(p, v, __ATOMIC_RELAXED, __HIP_MEMORY_SCOPE_AGENT); }
__device__ __forceinline__ unsigned xb_xcc_id() { return (unsigned)__builtin_amdgcn_s_getreg((3 << 11) | 20) & 0xFu; }
#define XB_SPIN(cond, bar) do { unsigned _sp = 0; while (cond) { __builtin_amdgcn_s_sleep(1); \
    if ((++_sp & 255u) == 0u) { if (xb_ld(&(bar)[XB_TMO])) break; if (_sp > XB_SPIN_CAP) { atomicAdd(&(bar)[XB_TMO], 1u); break; } } } } while (0)

struct XcdBarrier {
    unsigned* bar; unsigned x;
    volatile LAS unsigned* st;
};

__device__ __forceinline__ XcdBarrier xcd_barrier_post(unsigned* bar, volatile LAS unsigned* st) {
    XcdBarrier b; b.bar = bar; b.x = xb_xcc_id(); b.st = st;
    if (threadIdx.x == 0) (void)xb_add(&bar[XB_XCNT(b.x)], 1u);
    return b;
}
__device__ __forceinline__ void xcd_barrier_complete(unsigned* bar, unsigned x, unsigned& nloc, unsigned& nx) {
    const unsigned G = gridDim.x * gridDim.y * gridDim.z;
    unsigned sum, cnt, mine, sp = 0u;
    for (;;) {
        sum = 0u; cnt = 0u; mine = 0u;
#pragma unroll
        for (unsigned j = 0; j < 16; ++j) { const unsigned c = xb_ld(&bar[XB_XCNT(j)]); sum += c; cnt += (c > 0u) ? 1u : 0u; mine = (j == x) ? c : mine; }
        if (sum == G) break;
        __builtin_amdgcn_s_sleep(1);
        if ((++sp & 255u) == 0u) { if (xb_ld(&bar[XB_TMO])) break; if (sp > XB_SPIN_CAP) { atomicAdd(&bar[XB_TMO], 1u); break; } }
    }
    nloc = mine > 0u ? mine : 1u; nx = cnt > 0u ? cnt : 1u;
}

__device__ __forceinline__ void xcd_barrier(const XcdBarrier& b) {
    asm volatile("s_waitcnt vmcnt(0)" ::: "memory");
    __syncthreads();
    if (threadIdx.x == 0) {
        unsigned* bar = b.bar;
        __builtin_amdgcn_s_waitcnt(0);
        unsigned nloc = b.st[0], nx = b.st[1];
        if (nloc == 0u) { xcd_barrier_complete(bar, b.x, nloc, nx); b.st[0] = nloc; b.st[1] = nx; }
        const unsigned old = xb_add(&bar[XB_XSUB(b.x)], 1u);
        const unsigned gen = old / nloc;
        if (old + 1u == (gen + 1u) * nloc) {
            __builtin_amdgcn_fence(__ATOMIC_RELEASE, "agent");
            asm volatile("s_waitcnt vmcnt(0)" ::: "memory");
            const unsigned og = xb_add(&bar[XB_TOP], 1u);
            const unsigned tg = og / nx;
            if (og + 1u == (tg + 1u) * nx) xb_add(&bar[XB_TOPGEN], 1u);
            else XB_SPIN(xb_ld(&bar[XB_TOPGEN]) == tg, bar);
            __builtin_amdgcn_fence(__ATOMIC_ACQUIRE, "agent");
            xb_add(&bar[XB_XGEN(b.x)], 1u);
            asm volatile("s_waitcnt vmcnt(0)" ::: "memory");
        } else {
            XB_SPIN(xb_ld(&bar[XB_XGEN(b.x)]) == gen, bar);
            __builtin_amdgcn_fence(__ATOMIC_ACQUIRE, "agent");
            asm volatile("s_waitcnt vmcnt(0)" ::: "memory");
        }
    }
    __syncthreads();
}

__device__ __forceinline__ void tr_item(const float* __restrict__ W, int K, int N, int nsrc0, bf16_t* WT, int drow0, const float* __restrict__ gain, LAS float* scr, int k0, int lane) {
    const int n = nsrc0 + (lane & 31);
    float wv_[32];
    const float* wp_ = W + (size_t)(k0 + (lane >> 5)) * N + ((n < N) ? n : 0);
#pragma unroll
    for (int i = 0; i < 32; ++i) wv_[i] = wp_[(size_t)(2 * i) * N];
#pragma unroll
    for (int i = 0; i < 32; ++i) {
        const int kk = 2 * i + (lane >> 5);
        float v = (n < N) ? wv_[i] : 0.f;
        if (gain) v *= gain[k0 + kk];
        scr[kk * 33 + (lane & 31)] = v;
    }
    asm volatile("s_waitcnt lgkmcnt(0)" ::: "memory");
    const int c = lane & 7;
#pragma unroll
    for (int j = 0; j < 4; ++j) {
        const int nn = (lane >> 3) + 8 * j; const LAS float* s = scr + (8 * c) * 33 + nn;
        u32x4 o; o.x = pk(s[0 * 33], s[1 * 33]); o.y = pk(s[2 * 33], s[3 * 33]); o.z = pk(s[4 * 33], s[5 * 33]); o.w = pk(s[6 * 33], s[7 * 33]);
        *(u32x4*)(WT + (size_t)(drow0 + nn) * K + k0 + 8 * c) = o;
    }
    asm volatile("s_waitcnt lgkmcnt(0)" ::: "memory");
}

__device__ __forceinline__ void convert_weights(const Args& a, LAS unsigned char* lds, int sel, int gw, int NGW) {
    const int tid = threadIdx.x, lane = tid & 63, wave = tid >> 6;
    LAS float* scr = (LAS float*)(lds + wave * 16384);
    unsigned char* ws = a.ws;
    constexpr int I_IN = 16 * 104, I_OUT = 16 * 32, I_FI = 16 * 176, I_FD = 44 * 32;
    constexpr int NITEMS = I_IN + I_OUT + I_FI + I_FD;
    for (int it = gw; it < NITEMS; it += NGW) {
        int r = it;
        if (r < I_IN) { const int kb = r / 104, nb = r % 104; tr_item(a.in[sel ? I_FWIN : I_GWIN], 1024, 3088, 32 * nb, (bf16_t*)(ws + (sel ? WS_WFIN : WS_WGIN)), 32 * nb, a.in[I_NMIX] + sel * 1024, scr, 64 * kb, lane); continue; } r -= I_IN;
        if (r < I_OUT) { const int kb = r / 32, nb = r % 32; tr_item(a.in[sel ? I_FWOUT : I_GWOUT], 1024, 1024, 32 * nb, (bf16_t*)(ws + (sel ? WS_WFOUT : WS_WGOUT)), 32 * nb, nullptr, scr, 64 * kb, lane); continue; } r -= I_OUT;
        if (r < I_FI) { const int kb = r / 176, nb = r % 176, ns = 32 * nb, bj = ns / DFF, j = ns % DFF, drow = 256 * (j / 128) + 128 * bj + (j % 128);
            tr_item(a.in[I_FFIN] + (size_t)sel * 1024 * 5632, 1024, 5632, ns, (bf16_t*)(ws + WS_WFFI + (size_t)sel * 11 * MiB), drow, a.in[I_NFFN] + sel * 1024, scr, 64 * kb, lane); continue; } r -= I_FI;
        { const int kb = r / 32, nb = r % 32;
            tr_item(a.in[I_FFDN] + (size_t)sel * DFF * 1024, DFF, 1024, 32 * nb, (bf16_t*)(ws + WS_WFFD + (size_t)sel * 6 * MiB), 32 * nb, nullptr, scr, 64 * kb, lane); }
    }
}
__device__ __forceinline__ void p0_prologue(const Args& a, LAS unsigned char* lds, int vcu, int G) {
    const int tid = threadIdx.x, lane = tid & 63, wave = tid >> 6;
    const int gw = vcu * 8 + wave, NGW = G * 8;
    unsigned char* ws = a.ws;
    convert_weights(a, lds, 0, gw, NGW);
    if (G != 256 || MK_MULTI) convert_weights(a, lds, 1, gw, NGW);
    float* ss0 = (float*)(ws + WS_SS);
    bf16_t* XB = (bf16_t*)(ws + WS_XB);
    for (int m0 = gw; m0 < MT; m0 += 3 * NGW) {
        f32x4 v[3][4];
#pragma unroll
        for (int q = 0; q < 3; ++q) { const int m = m0 + q * NGW; if (m < MT) { const float* xr = (m < MP) ? a.in[I_XP] + (size_t)m * DM : a.in[I_XS] + (size_t)(m - MP) * DM;
#pragma unroll
            for (int j = 0; j < 4; ++j) v[q][j] = ((const f32x4*)xr)[lane + 64 * j]; } }
#pragma unroll
        for (int q = 0; q < 3; ++q) { const int m = m0 + q * NGW; if (m < MT) { float s = 0.f;
#pragma unroll
            for (int j = 0; j < 4; ++j) s += dot4(v[q][j]);
            s = wave_sum(s);
            if (lane == 0) ss0[m] = s;
#pragma unroll
            for (int j = 0; j < 4; ++j) { u32x2 o; o.x = pk(v[q][j][0], v[q][j][1]); o.y = pk(v[q][j][2], v[q][j][3]); ((u32x2*)(XB + (size_t)m * DM))[lane + 64 * j] = o; } } }
    }
}

__device__ __forceinline__ void p_final(const Args& a, int vcu, int G) {
    const int tid = threadIdx.x, lane = tid & 63, wave = tid >> 6;
    const int gw = vcu * 8 + wave, NGW = G * 8;
    const float* ss = (const float*)(a.ws + WS_SS + 4 * 131072);
    const float* XR = (const float*)(a.ws + WS_XR);
    const float* g = a.in[I_NFIN];
    f32x4 gv[4];
#pragma unroll
    for (int j = 0; j < 4; ++j) gv[j] = ((const f32x4*)g)[lane + 64 * j];
    for (int m0 = gw; m0 < MT; m0 += 3 * NGW) {
        f32x4 v[3][4]; float rs[3];
#pragma unroll
        for (int q = 0; q < 3; ++q) { const int m = m0 + q * NGW; if (m < MT) { rs[q] = rsqrtf(ss[m] * (1.f / DM) + EPS);
#pragma unroll
            for (int j = 0; j < 4; ++j) v[q][j] = ((const f32x4*)(XR + (size_t)m * DM))[lane + 64 * j]; } }
#pragma unroll
        for (int q = 0; q < 3; ++q) { const int m = m0 + q * NGW; if (m < MT) {
#pragma unroll
            for (int j = 0; j < 4; ++j) ((f32x4*)(a.out + O_Y + (size_t)m * DM))[lane + 64 * j] = v[q][j] * rs[q] * gv[j]; } }
    }
}

struct EpiGlaProj {
    static constexpr bool PERM = true, AFTER_DRAIN = false;
    const float* ss; bf16_t* proj; float* gl;
    __device__ __forceinline__ void operator()(const pg8::f32x4 (&acc)[2][2][4][2], const pg8::Unit& u, int wr, int wc, int fr, int fq) const {
        const int row0 = u.pm * 256 + wr * 64 + fr;
#pragma unroll
        for (int ai = 0; ai < 2; ++ai)
#pragma unroll
            for (int m = 0; m < 4; ++m) {
                const int row = row0 + ai * 128 + m * 16; const float rs = rsqrtf(ss[row] * (1.f / DM) + EPS);
                if (u.pn < 12) {
#pragma unroll
                    for (int bj = 0; bj < 2; ++bj) { const f32x4 v0 = acc[ai][bj][m][0] * rs, v1 = acc[ai][bj][m][1] * rs;
                        u32x4 w; w.x = pk(v0[0], v0[1]); w.y = pk(v0[2], v0[3]); w.z = pk(v1[0], v1[1]); w.w = pk(v1[2], v1[3]);
                        *(u32x4*)(proj + (size_t)row * NPJ + u.pn * 256 + bj * 128 + wc * 32 + 8 * fq) = w; }
                } else if (wc == 0 && fq < 2) {
#pragma unroll
                    for (int n = 0; n < 2; ++n) *(f32x4*)(gl + (size_t)row * 16 + 8 * fq + 4 * n) = acc[ai][0][m][n] * rs;
                }
            }
    }
};
struct EpiResid {
    static constexpr bool PERM = true, AFTER_DRAIN = false;
    const float* xin_p; const float* xin_s; float* xout; bf16_t* xb; float* ssout;
    __device__ __forceinline__ void operator()(const pg8::f32x4 (&acc)[2][2][4][2], const pg8::Unit& u, int wr, int wc, int fr, int fq) const {
        const int row0 = u.pm * 256 + wr * 64 + fr;
#pragma unroll
        for (int ai = 0; ai < 2; ++ai)
#pragma unroll
            for (int m = 0; m < 4; ++m) {
                const int row = row0 + ai * 128 + m * 16;
                const float* xi = (row < MP) ? xin_p + (size_t)row * DM : xin_s + (size_t)(row - MP) * DM;
                float sq = 0.f;
#pragma unroll
                for (int bj = 0; bj < 2; ++bj) { const int col = u.pn * 256 + bj * 128 + wc * 32 + 8 * fq;
                    const f32x4 a0 = *(const f32x4*)(xi + col) + acc[ai][bj][m][0], a1 = *(const f32x4*)(xi + col + 4) + acc[ai][bj][m][1];
                    *(f32x4*)(xout + (size_t)row * DM + col) = a0; *(f32x4*)(xout + (size_t)row * DM + col + 4) = a1;
                    u32x4 w; w.x = pk(a0[0], a0[1]); w.y = pk(a0[2], a0[3]); w.z = pk(a1[0], a1[1]); w.w = pk(a1[2], a1[3]);
                    *(u32x4*)(xb + (size_t)row * DM + col) = w;
                    sq += dot4(a0) + dot4(a1); }
                sq += __shfl_xor(sq, 16); sq += __shfl_xor(sq, 32);
                if (fq == 0) atomicAdd(ssout + row, sq);
            }
    }
};
struct EpiSwiglu {
    static constexpr bool PERM = true, AFTER_DRAIN = false;
    const float* ss; bf16_t* act;
    __device__ __forceinline__ void operator()(const pg8::f32x4 (&acc)[2][2][4][2], const pg8::Unit& u, int wr, int wc, int fr, int fq) const {
        const int row0 = u.pm * 256 + wr * 64 + fr;
#pragma unroll
        for (int ai = 0; ai < 2; ++ai)
#pragma unroll
            for (int m = 0; m < 4; ++m) {
                const int row = row0 + ai * 128 + m * 16; const float rs = rsqrtf(ss[row] * (1.f / DM) + EPS);
                float y[8];
#pragma unroll
                for (int n = 0; n < 2; ++n)
#pragma unroll
                    for (int i = 0; i < 4; ++i) { const float g = acc[ai][0][m][n][i] * rs, up = acc[ai][1][m][n][i] * rs; y[4 * n + i] = g * up * __builtin_amdgcn_rcpf(1.f + __expf(-g)); }
                u32x4 w; w.x = pk(y[0], y[1]); w.y = pk(y[2], y[3]); w.z = pk(y[4], y[5]); w.w = pk(y[6], y[7]);
                *(u32x4*)(act + (size_t)row * DFF + u.pn * 128 + wc * 32 + 8 * fq) = w;
            }
    }
};
struct EpiFoxProj {
    static constexpr bool PERM = true, AFTER_DRAIN = false;
    const float* ss; bf16_t* qkv; float* out; const float* bf;
    __device__ __forceinline__ void operator()(const pg8::f32x4 (&acc)[2][2][4][2], const pg8::Unit& u, int wr, int wc, int fr, int fq) const {
        const int row0 = u.pm * 256 + wr * 64 + fr;
        const int sect = u.pn >> 2;
#pragma unroll
        for (int ai = 0; ai < 2; ++ai)
#pragma unroll
            for (int m = 0; m < 4; ++m) {
                const int row = row0 + ai * 128 + m * 16; const float rs = rsqrtf(ss[row] * (1.f / DM) + EPS);
                if (u.pn < 12) {
                    const float sc = (sect == 0) ? rs * QSCALE2 : rs;
                    float* fdst = nullptr;
                    if (sect == 1) fdst = (row < MP) ? out + O_FKP + (size_t)row * DM : out + O_FKS + (size_t)(row - MP) * DM;
                    if (sect == 2) fdst = (row < MP) ? out + O_FVP + (size_t)row * DM : out + O_FVS + (size_t)(row - MP) * DM;
#pragma unroll
                    for (int bj = 0; bj < 2; ++bj) { const f32x4 v0 = acc[ai][bj][m][0] * sc, v1 = acc[ai][bj][m][1] * sc;
                        u32x4 w; w.x = pk(v0[0], v0[1]); w.y = pk(v0[2], v0[3]); w.z = pk(v1[0], v1[1]); w.w = pk(v1[2], v1[3]);
                        const int cl = bj * 128 + wc * 32 + 8 * fq;
                        *(u32x4*)(qkv + (size_t)row * NPJ + u.pn * 256 + cl) = w;
                        if (sect > 0) { float* d = fdst + (u.pn & 3) * 256 + cl; *(f32x4*)d = v0; *(f32x4*)(d + 4) = v1; } }
                } else if (wc == 0 && fq < 2) {
                    float* d = (row < MP) ? out + O_FLP + (size_t)row * 16 : out + O_FLS + (size_t)(row - MP) * 16;
#pragma unroll
                    for (int n = 0; n < 2; ++n) { const f32x4 v = acc[ai][0][m][n] * rs; f32x4 o;
#pragma unroll
                        for (int i = 0; i < 4; ++i) o[i] = log_sigmoid(v[i] + bf[8 * fq + 4 * n + i]);
                        *(f32x4*)(d + 8 * fq + 4 * n) = o; }
                }
            }
    }
};

constexpr int GL_OFF = 0, GSUM_OFF = 4096, DECS_OFF = 6144, QE_OFF = 8192, KE_OFF = 25600, VT_OFF = 43008, AL_OFF = 79872, KDT_OFF = 8192, OL_OFF = 8192;
constexpr int QES = 136, VTS = 72, OLS = 260;

struct GlaPre { unsigned v[32]; f32x4 gl; };
__device__ __forceinline__ void gla_prefetch(GlaPre& pf, const Args& a, int cid, int h) {
    const int tid = threadIdx.x, dvv = tid & 255, th = tid >> 8, row0 = cid * 64;
    const bf16_t* vp = (const bf16_t*)(a.ws + WS_PROJ) + (size_t)(row0 + 32 * th) * NPJ + 1024 + h * 256 + dvv;
#pragma unroll
    for (int i = 0; i < 32; ++i) pf.v[i] = vp[(size_t)i * NPJ];
    pf.gl = *(const f32x4*)((const float*)(a.ws + WS_GL) + (size_t)(row0 + ((tid & 255) >> 2)) * 16 + (tid & 3) * 4);
}
template <int MODE> __device__ __forceinline__ void gla_item(const Args& a, LAS unsigned char* lds, int cid, int h, GlaPre& pf, int next) {
    const int tid = threadIdx.x, lane = tid & 63, w = tid >> 6, l31 = lane & 31, hi = lane >> 5;
    const int row0 = cid * 64;
    const bool prompt = cid < 256;
    LAS float* GLs = (LAS float*)(lds + GL_OFF); LAS float* GSUM = (LAS float*)(lds + GSUM_OFF); LAS float* DECS = (LAS float*)(lds + DECS_OFF);
    LAS bf16_t* QE = (LAS bf16_t*)(lds + QE_OFF); LAS bf16_t* KE = (LAS bf16_t*)(lds + KE_OFF); LAS bf16_t* VT = (LAS bf16_t*)(lds + VT_OFF);
    LAS bf16_t* AL = (LAS bf16_t*)(lds + AL_OFF); LAS bf16_t* KDT = (LAS bf16_t*)(lds + KDT_OFF);
    const bf16_t* P = (const bf16_t*)(a.ws + WS_PROJ) + (size_t)row0 * NPJ;
    const float* GL = (const float*)(a.ws + WS_GL);
    const float* state = a.in[I_STATE];

    bf16x8 sfr[8];
    if (MODE == 1) {
        if (prompt) {
            const bf16_t* sp = (const bf16_t*)(a.ws + WS_SPREV) + ((size_t)(cid * 4 + h) * 256 + 32 * w + l31) * 128 + 8 * hi;
#pragma unroll
            for (int ks = 0; ks < 8; ++ks) sfr[ks] = *(const bf16x8*)(sp + 16 * ks);
        } else {
            const float* s0 = state + ((size_t)((cid - 256) * 4 + h) * 128) * 256 + 32 * w + l31;
#pragma unroll
            for (int ks = 0; ks < 8; ++ks) { float f[8];
#pragma unroll
                for (int j = 0; j < 8; ++j) f[j] = s0[(size_t)(16 * ks + 8 * hi + j) * 256];
                u32x4 o; o.x = pk(f[0], f[1]); o.y = pk(f[2], f[3]); o.z = pk(f[4], f[5]); o.w = pk(f[6], f[7]); sfr[ks] = __builtin_bit_cast(bf16x8, o); }
        }
    }
    unsigned kraw[16], qraw[16];
    {
        const int dk_ = tid & 127, tg_ = tid >> 7;
        const bf16_t* kp_ = P + (size_t)(16 * tg_) * NPJ + 512 + h * 128 + dk_;
#pragma unroll
        for (int i = 0; i < 16; ++i) kraw[i] = kp_[(size_t)i * NPJ];
        if (MODE == 1) { const bf16_t* qp_ = P + (size_t)(16 * tg_) * NPJ + h * 128 + dk_;
#pragma unroll
            for (int i = 0; i < 16; ++i) qraw[i] = qp_[(size_t)i * NPJ]; }
    }
    float wv[16];
#pragma unroll
    for (int j = 0; j < 16; ++j) wv[j] = a.in[I_GWG2][j * 512 + h * 128 + (tid & 127)];
    const float bias = a.in[I_GBG][h * 128 + (tid & 127)];
    if (tid < 256) ((LAS f32x4*)GLs)[tid] = pf.gl;
    {
        const int dvv = tid & 255, th = tid >> 8;
#pragma unroll
        for (int q4 = 0; q4 < 4; ++q4) { u32x4 o; o.x = pf.v[8 * q4] | (pf.v[8 * q4 + 1] << 16); o.y = pf.v[8 * q4 + 2] | (pf.v[8 * q4 + 3] << 16);
            o.z = pf.v[8 * q4 + 4] | (pf.v[8 * q4 + 5] << 16); o.w = pf.v[8 * q4 + 6] | (pf.v[8 * q4 + 7] << 16);
            *(LAS u32x4*)(VT + dvv * VTS + 32 * th + 8 * q4) = o; }
    }
    if (next >= 0) gla_prefetch(pf, a, next >> 2, next & 3);
    __syncthreads();
    const int dk = tid & 127, tg = tid >> 7;
    float bc[16];
    {
        float run = 0.f;
#pragma unroll
        for (int i = 0; i < 16; ++i) { const LAS f32x4* gp = (const LAS f32x4*)(GLs + (16 * tg + i) * 16); float z = bias;
#pragma unroll
            for (int j4 = 0; j4 < 4; ++j4) { const f32x4 gq = gp[j4]; z += gq[0] * wv[4 * j4] + gq[1] * wv[4 * j4 + 1] + gq[2] * wv[4 * j4 + 2] + gq[3] * wv[4 * j4 + 3]; }
            run += log_sigmoid(z) * (1.f / 16.f); bc[i] = run; }
        GSUM[tg * 128 + dk] = run;
    }
    __syncthreads();
    float off = 0.f, blast = 0.f;
#pragma unroll
    for (int g = 0; g < 4; ++g) { const float s = GSUM[g * 128 + dk]; blast += s; if (g < tg) off += s; }
    if (MODE == 0) {
        float kd[16];
#pragma unroll
        for (int i = 0; i < 16; ++i) { const float b = bc[i] + off; kd[i] = bf2f(kraw[i]) * __expf(blast - b); }
        u32x4 o0, o1; o0.x = pk(kd[0], kd[1]); o0.y = pk(kd[2], kd[3]); o0.z = pk(kd[4], kd[5]); o0.w = pk(kd[6], kd[7]);
        o1.x = pk(kd[8], kd[9]); o1.y = pk(kd[10], kd[11]); o1.z = pk(kd[12], kd[13]); o1.w = pk(kd[14], kd[15]);
        *(LAS u32x4*)(KDT + dk * VTS + 16 * tg) = o0; *(LAS u32x4*)(KDT + dk * VTS + 16 * tg + 8) = o1;
        if (tg == 0) { const float d = __expf(blast); DECS[dk] = d; if (prompt) ((float*)(a.ws + WS_DEC))[(size_t)(cid * 4 + h) * 128 + dk] = d; }
    } else {
#pragma unroll
        for (int i = 0; i < 16; ++i) { const float b = bc[i] + off; const int t = 16 * tg + i;
            const float qe = bf2f(qraw[i]) * __expf(b) * 0.08838834764831845f, ke = bf2f(kraw[i]) * __expf(-b);
            QE[t * QES + dk] = (bf16_t)f2bf(qe); KE[t * QES + dk] = (bf16_t)f2bf(ke); }
    }
    __syncthreads();
    if (MODE == 0) {
        bf16x8 vf[4];
#pragma unroll
        for (int ks = 0; ks < 4; ++ks) vf[ks] = *(const LAS bf16x8*)(VT + (32 * w + l31) * VTS + 16 * ks + 8 * hi);
        f32x16 acc[4];
#pragma unroll
        for (int d = 0; d < 4; ++d) acc[d] = f32x16{};
#pragma unroll
        for (int d = 0; d < 4; ++d)
#pragma unroll
            for (int ks = 0; ks < 4; ++ks) { const bf16x8 kf = *(const LAS bf16x8*)(KDT + (32 * d + l31) * VTS + 16 * ks + 8 * hi);
                acc[d] = prompt ? MFMA32(vf[ks], kf, acc[d]) : MFMA32(kf, vf[ks], acc[d]); }
        if (prompt) {
            bf16_t* dst = (bf16_t*)(a.ws + WS_DST) + ((size_t)(cid * 4 + h) * 256 + 32 * w) * 128;
#pragma unroll
            for (int d = 0; d < 4; ++d)
#pragma unroll
                for (int r = 0; r < 16; ++r) dst[(size_t)crow(r, hi) * 128 + 32 * d + l31] = (bf16_t)f2bf(acc[d][r]);
        } else {
            const size_t base = ((size_t)((cid - 256) * 4 + h) * 128) * 256;
            float* outs = a.out + O_GSS;
#pragma unroll
            for (int d = 0; d < 4; ++d)
#pragma unroll
                for (int r = 0; r < 16; ++r) { const int dkk = 32 * d + crow(r, hi); const size_t idx = base + (size_t)dkk * 256 + 32 * w + l31; outs[idx] = state[idx] * DECS[dkk] + acc[d][r]; }
        }
    } else {
        u32x2 rraw[8];
#pragma unroll
        for (int i = 0; i < 8; ++i) rraw[i] = *(const u32x2*)(P + (size_t)(8 * w + i) * NPJ + 2048 + h * 256 + 4 * lane);
        f32x16 o[2]; o[0] = f32x16{}; o[1] = f32x16{};
#pragma unroll
        for (int tb = 0; tb < 2; ++tb)
#pragma unroll
            for (int ks = 0; ks < 8; ++ks) { const bf16x8 qa = *(const LAS bf16x8*)(QE + (32 * tb + l31) * QES + 16 * ks + 8 * hi); o[tb] = MFMA32(qa, sfr[ks], o[tb]); }
        if (w < 3) {
            const int tb = (w > 0) ? 1 : 0, sb = (w == 2) ? 1 : 0;
            f32x16 am = f32x16{};
#pragma unroll
            for (int ks = 0; ks < 8; ++ks) { const bf16x8 qa = *(const LAS bf16x8*)(QE + (32 * tb + l31) * QES + 16 * ks + 8 * hi), kb = *(const LAS bf16x8*)(KE + (32 * sb + l31) * QES + 16 * ks + 8 * hi);
                am = MFMA32(qa, kb, am); }
#pragma unroll
            for (int r = 0; r < 16; ++r) { const int tl = crow(r, hi); float v = am[r]; if (tb == sb && l31 > tl) v = 0.f; AL[(32 * tb + tl) * VTS + 32 * sb + l31] = (bf16_t)f2bf(v); }
        }
        __syncthreads();
#pragma unroll
        for (int tb = 0; tb < 2; ++tb)
#pragma unroll
            for (int ks = 0; ks < 4; ++ks) { if (tb == 0 && ks >= 2) continue;
                const bf16x8 aa = *(const LAS bf16x8*)(AL + (32 * tb + l31) * VTS + 16 * ks + 8 * hi), vb = *(const LAS bf16x8*)(VT + (32 * w + l31) * VTS + 16 * ks + 8 * hi);
                o[tb] = MFMA32(aa, vb, o[tb]); }
        __syncthreads();
        LAS float* OL = (LAS float*)(lds + OL_OFF);
#pragma unroll
        for (int tb = 0; tb < 2; ++tb)
#pragma unroll
            for (int r = 0; r < 16; ++r) OL[(32 * tb + crow(r, hi)) * OLS + 32 * w + l31] = o[tb][r];
        __syncthreads();
        const f32x4 ng = *(const f32x4*)(a.in[I_GNORM] + h * 256 + 4 * lane);
        bf16_t* OG = (bf16_t*)(a.ws + WS_OG);
#pragma unroll
        for (int i = 0; i < 8; ++i) { const int t = 8 * w + i; const f32x4 v = *(const LAS f32x4*)(OL + t * OLS + 4 * lane);
            const float rs = rsqrtf(wave_sum(dot4(v)) * (1.f / 256.f) + EPS);
            const u32x2 rr = rraw[i];
            float rv[4] = {bf2f(rr.x & 0xffffu), bf2f(rr.x >> 16), bf2f(rr.y & 0xffffu), bf2f(rr.y >> 16)}; float y[4];
#pragma unroll
            for (int j = 0; j < 4; ++j) y[j] = v[j] * rs * ng[j] * rv[j] * __builtin_amdgcn_rcpf(1.f + __expf(-rv[j]));
            u32x2 ov; ov.x = pk(y[0], y[1]); ov.y = pk(y[2], y[3]);
            *(u32x2*)(OG + (size_t)(row0 + t) * DM + h * 256 + 4 * lane) = ov; }
    }
    __syncthreads();
}

__device__ __forceinline__ void gla_scan(const Args& a, int vcu, int G) {
    const int gt = vcu * 512 + threadIdx.x, NT_ = G * 512;
    const bf16_t* DST = (const bf16_t*)(a.ws + WS_DST); const float* DEC = (const float*)(a.ws + WS_DEC); bf16_t* SP = (bf16_t*)(a.ws + WS_SPREV);
    for (int it0 = gt; it0 < 32 * 8192; it0 += 2 * NT_) {
        const int it1 = it0 + NT_; const bool two = it1 < 32 * 8192;
        const int bhA = it0 >> 13, eA = it0 & 8191, dvA = eA >> 5, dkA = (eA & 31) * 4;
        const int itB = two ? it1 : it0; const int bhB = itB >> 13, eB = itB & 8191, dvB = eB >> 5, dkB = (eB & 31) * 4;
        f32x4 SA = (f32x4){0.f, 0.f, 0.f, 0.f}, SB = SA;
#pragma unroll 8
        for (int c = 0; c < 32; ++c) {
            const size_t chA = (size_t)(((bhA >> 2) * 32 + c) * 4 + (bhA & 3)), chB = (size_t)(((bhB >> 2) * 32 + c) * 4 + (bhB & 3));
            const size_t baseA = (chA * 256 + dvA) * 128 + dkA, baseB = (chB * 256 + dvB) * 128 + dkB;
            const u32x2 rA = *(const u32x2*)(DST + baseA), rB = *(const u32x2*)(DST + baseB);
            const f32x4 deA = *(const f32x4*)(DEC + chA * 128 + dkA), deB = *(const f32x4*)(DEC + chB * 128 + dkB);
            const f32x4 dsA = (f32x4){bf2f(rA.x & 0xffffu), bf2f(rA.x >> 16), bf2f(rA.y & 0xffffu), bf2f(rA.y >> 16)};
            const f32x4 dsB = (f32x4){bf2f(rB.x & 0xffffu), bf2f(rB.x >> 16), bf2f(rB.y & 0xffffu), bf2f(rB.y >> 16)};
            u32x2 o; o.x = pk(SA[0], SA[1]); o.y = pk(SA[2], SA[3]); *(u32x2*)(SP + baseA) = o;
            if (two) { o.x = pk(SB[0], SB[1]); o.y = pk(SB[2], SB[3]); *(u32x2*)(SP + baseB) = o; }
            SA = SA * deA + dsA; SB = SB * deB + dsB;
        }
        float* ogA = a.out + O_GSP + ((size_t)bhA * 128 + dkA) * 256 + dvA;
#pragma unroll
        for (int i = 0; i < 4; ++i) ogA[(size_t)i * 256] = SA[i];
        if (two) { float* ogB = a.out + O_GSP + ((size_t)bhB * 128 + dkB) * 256 + dvB;
#pragma unroll
            for (int i = 0; i < 4; ++i) ogB[(size_t)i * 256] = SB[i]; }
    }
}

template <int L, int C> __device__ __forceinline__ void cumsum_item(const float* src0, const float* src1, float* dst, LAS float* SEG, int hh, int seg) {
    float s = 0.f;
#pragma unroll 1
    for (int c0 = 0; c0 < L; c0 += C) { float v[C];
#pragma unroll
        for (int i = 0; i < C; ++i) { const int t = seg * L + c0 + i; v[i] = (t < 2048) ? src0[(unsigned)(t * 16 + hh)] : src1[(unsigned)((t - 2048) * 16 + hh)]; }
#pragma unroll
        for (int i = 0; i < C; ++i) s += v[i]; }
    SEG[seg * 16 + hh] = s;
    __syncthreads();
    float run = 0.f;
    for (int g = 0; g < seg; ++g) run += SEG[g * 16 + hh];
#pragma unroll 1
    for (int c0 = 0; c0 < L; c0 += C) { float v[C];
#pragma unroll
        for (int i = 0; i < C; ++i) { const int t = seg * L + c0 + i; v[i] = (t < 2048) ? src0[(unsigned)(t * 16 + hh)] : src1[(unsigned)((t - 2048) * 16 + hh)]; }
#pragma unroll
        for (int i = 0; i < C; ++i) { run += v[i]; dst[seg * L + c0 + i] = run; } }
    __syncthreads();
}
__device__ __forceinline__ void fox_cumsum(const Args& a, LAS unsigned char* lds, int vcu, int G) {
    const int tid = threadIdx.x, hh = tid & 15, seg = tid >> 4;
    LAS float* SEG = (LAS float*)lds;
    for (int it = vcu; it < 40; it += G) {
        const bool prompt = it < 8; const int b = prompt ? it : it - 8;
        const float* src0 = prompt ? a.out + O_FLP + (size_t)b * 2048 * 16 : a.in[I_CLF] + (size_t)b * 2048 * 16;
        const float* src1 = a.out + O_FLS + (size_t)b * 64 * 16;
        if (prompt) cumsum_item<64, 32>(src0, src1, (float*)(a.ws + WS_CP) + (size_t)(b * 16 + hh) * 2048, SEG, hh, seg);
        else cumsum_item<66, 22>(src0, src1, (float*)(a.ws + WS_CS) + (size_t)(b * 16 + hh) * 2112, SEG, hh, seg);
    }
}

constexpr int AT_KS = 72, AT_VS = 68, AT_BUF = 18432, AT_VOFF = 9216, AT_COFF = 17920;
struct TileRegs { u32x4 k0, k1, v0, v1; float ck; };

template <bool SAMPLE> __device__ __forceinline__ void attn_load(TileRegs& R, const Args& a, int b, int h, int t, const float* cbase, int tid) {
    const int kvl = tid >> 3, ch = tid & 7, kp = tid >> 4, c4 = tid & 15;
    if (SAMPLE && t < 32) {
        const float* kptr = a.in[I_CK] + (((size_t)b * 2048 + 64 * t + kvl) * 16 + h) * 64 + 8 * ch;
        R.k0 = *(const u32x4*)kptr; R.k1 = *(const u32x4*)(kptr + 4);
        const float* vptr = a.in[I_CV] + (((size_t)b * 2048 + 64 * t + 2 * kp) * 16 + h) * 64 + 4 * c4;
        R.v0 = *(const u32x4*)vptr; R.v1 = *(const u32x4*)(vptr + 1024);
    } else {
        const size_t rowbase = SAMPLE ? (size_t)(MP + b * 64) : (size_t)(b * 2048 + 64 * t);
        const bf16_t* qkv = (const bf16_t*)(a.ws + WS_PROJ);
        R.k0 = *(const u32x4*)(qkv + (rowbase + kvl) * NPJ + 1024 + h * 64 + 8 * ch);
        const bf16_t* vptr = qkv + (rowbase + 2 * kp) * NPJ + 2048 + h * 64 + 4 * c4;
        const u32x2 x0 = *(const u32x2*)vptr, x1 = *(const u32x2*)(vptr + NPJ);
        R.v0.x = x0.x; R.v0.y = x0.y; R.v1.x = x1.x; R.v1.y = x1.y;
    }
    R.ck = cbase[64 * t + (tid & 63)];
}
__device__ __forceinline__ void attn_store(const TileRegs& R, LAS unsigned char* buf, bool f32src, int tid) {
    const int kvl = tid >> 3, ch = tid & 7, kp = tid >> 4, c4 = tid & 15;
    LAS unsigned* VT32 = (LAS unsigned*)(buf + AT_VOFF);
    if (f32src) {
        u32x4 o; o.x = pk(__uint_as_float(R.k0.x), __uint_as_float(R.k0.y)); o.y = pk(__uint_as_float(R.k0.z), __uint_as_float(R.k0.w));
        o.z = pk(__uint_as_float(R.k1.x), __uint_as_float(R.k1.y)); o.w = pk(__uint_as_float(R.k1.z), __uint_as_float(R.k1.w));
        *(LAS u32x4*)(buf + (kvl * AT_KS + 8 * ch) * 2) = o;
#pragma unroll
        for (int i = 0; i < 4; ++i) VT32[(4 * c4 + i) * (AT_VS / 2) + kp] = pk(__uint_as_float(R.v0[i]), __uint_as_float(R.v1[i]));
    } else {
        *(LAS u32x4*)(buf + (kvl * AT_KS + 8 * ch) * 2) = R.k0;
        VT32[(4 * c4 + 0) * (AT_VS / 2) + kp] = (R.v0.x & 0xffffu) | (R.v1.x << 16);
        VT32[(4 * c4 + 1) * (AT_VS / 2) + kp] = (R.v0.x >> 16) | (R.v1.x & 0xffff0000u);
        VT32[(4 * c4 + 2) * (AT_VS / 2) + kp] = (R.v0.y & 0xffffu) | (R.v1.y << 16);
        VT32[(4 * c4 + 3) * (AT_VS / 2) + kp] = (R.v0.y >> 16) | (R.v1.y & 0xffff0000u);
    }
    if (tid < 64) { const float c = -R.ck * LOG2E; const unsigned h1 = f2bf(c); const float r1 = c - bf2f(h1); const unsigned h2 = f2bf(r1); const unsigned h3 = f2bf(r1 - bf2f(h2));
        u32x2 o; o.x = h1 | (h2 << 16); o.y = h3; ((LAS u32x2*)(buf + AT_COFF))[tid] = o; }
}

template <bool QLDS> __device__ __forceinline__ void attn_tile(const LAS unsigned char* buf, const bf16x8 (&qf)[4], const LAS bf16x8* qlds, float cq2, int qpos, int kv0, bool diag, float& mrun, float& lrun, f32x16 (&ot)[2], int l31, int hi) {
    const LAS bf16_t* Ks = (const LAS bf16_t*)buf; const LAS bf16_t* VTs = (const LAS bf16_t*)(buf + AT_VOFF); const LAS u32x2* CKs = (const LAS u32x2*)(buf + AT_COFF);
    f32x16 p0, p1;
#pragma unroll
    for (int r = 0; r < 16; ++r) { p0[r] = cq2; p1[r] = cq2; }
    {
        const u32x2 b0 = CKs[l31], b1 = CKs[32 + l31];
        const unsigned msk = hi ? 0u : 0xffffffffu;
        u32x4 x0; x0.x = b0.x & msk; x0.y = b0.y & msk; x0.z = 0u; x0.w = 0u;
        u32x4 x1; x1.x = b1.x & msk; x1.y = b1.y & msk; x1.z = 0u; x1.w = 0u;
        u32x4 qx; qx.x = 0x3F803F80u & msk; qx.y = 0x00003F80u & msk; qx.z = 0u; qx.w = 0u;
        p0 = MFMA32(__builtin_bit_cast(bf16x8, x0), __builtin_bit_cast(bf16x8, qx), p0); p1 = MFMA32(__builtin_bit_cast(bf16x8, x1), __builtin_bit_cast(bf16x8, qx), p1);
    }
#pragma unroll
    for (int ks = 0; ks < 4; ++ks) { const bf16x8 k0 = *(const LAS bf16x8*)(Ks + l31 * AT_KS + 16 * ks + 8 * hi), k1 = *(const LAS bf16x8*)(Ks + (32 + l31) * AT_KS + 16 * ks + 8 * hi);
        const bf16x8 qq = QLDS ? qlds[ks * 64] : qf[ks];
        p0 = MFMA32(k0, qq, p0); p1 = MFMA32(k1, qq, p1); }
    __builtin_amdgcn_sched_barrier(0);
    if (diag) {
        int qp = qpos - kv0; asm volatile("" : "+v"(qp));
#pragma unroll
        for (int r = 0; r < 16; ++r) { const int kv = crow(r, hi); if (kv > qp) p0[r] = -INFINITY; if (kv + 32 > qp) p1[r] = -INFINITY; }
    }
    float rm = fmaxf(p0[0], p1[0]);
#pragma unroll
    for (int r = 1; r < 16; ++r) rm = fmaxf(rm, fmaxf(p0[r], p1[r]));
    rm = fmaxf(rm, __shfl_xor(rm, 32));
    if (__all(rm < mrun - 40.f)) return;
    const float mn = fmaxf(mrun, rm);
    if (__any(mn > mrun)) {
        const float alpha = __builtin_amdgcn_exp2f(mrun - mn);
        lrun *= alpha;
#pragma unroll
        for (int r = 0; r < 16; ++r) { ot[0][r] *= alpha; ot[1][r] *= alpha; }
        mrun = mn;
    }
    float rs = 0.f;
#pragma unroll
    for (int r = 0; r < 16; ++r) { p0[r] = __builtin_amdgcn_exp2f(p0[r] - mrun); p1[r] = __builtin_amdgcn_exp2f(p1[r] - mrun); rs += p0[r] + p1[r]; }
    lrun += rs;
    bf16x8 pf[4];
    { u32x4 x; x.x = pk(p0[0], p0[1]); x.y = pk(p0[2], p0[3]); x.z = pk(p0[4], p0[5]); x.w = pk(p0[6], p0[7]); pf[0] = __builtin_bit_cast(bf16x8, x);
      x.x = pk(p0[8], p0[9]); x.y = pk(p0[10], p0[11]); x.z = pk(p0[12], p0[13]); x.w = pk(p0[14], p0[15]); pf[1] = __builtin_bit_cast(bf16x8, x);
      x.x = pk(p1[0], p1[1]); x.y = pk(p1[2], p1[3]); x.z = pk(p1[4], p1[5]); x.w = pk(p1[6], p1[7]); pf[2] = __builtin_bit_cast(bf16x8, x);
      x.x = pk(p1[8], p1[9]); x.y = pk(p1[10], p1[11]); x.z = pk(p1[12], p1[13]); x.w = pk(p1[14], p1[15]); pf[3] = __builtin_bit_cast(bf16x8, x); }
    __builtin_amdgcn_sched_barrier(0);
#pragma unroll
    for (int db = 0; db < 2; ++db)
#pragma unroll
        for (int ks = 0; ks < 4; ++ks) { const LAS bf16_t* vp = VTs + (32 * db + l31) * AT_VS + 16 * ks + 4 * hi;
            const u32x2 lo = *(const LAS u32x2*)vp, hh2 = *(const LAS u32x2*)(vp + 8);
            u32x4 x; x.x = lo.x; x.y = lo.y; x.z = hh2.x; x.w = hh2.y;
            ot[db] = MFMA32(__builtin_bit_cast(bf16x8, x), pf[ks], ot[db]); }
}

__device__ __forceinline__ void gld16(u32x4& d, const void* p) { asm volatile("global_load_dwordx4 %0, %1, off" : "=v"(d) : "v"(p)); }
__device__ __forceinline__ void gld8(u32x2& d, const void* p) { asm volatile("global_load_dwordx2 %0, %1, off" : "=v"(d) : "v"(p)); }
__device__ __forceinline__ void gld4(float& d, const void* p) { asm volatile("global_load_dword %0, %1, off" : "=v"(d) : "v"(p)); }
struct PRegs { u32x4 k; u32x2 v0, v1; float ck; };
__device__ __forceinline__ void pload_a(PRegs& R, const Args& a, int b, int h, int t, const float* cbase, int tid) {
    const int kvl = tid >> 3, ch = tid & 7, kp = tid >> 4, c4 = tid & 15;
    const size_t rowbase = (size_t)(b * 2048 + 64 * t);
    const bf16_t* qkv = (const bf16_t*)(a.ws + WS_PROJ);
    gld16(R.k, qkv + (rowbase + kvl) * NPJ + 1024 + h * 64 + 8 * ch);
    const bf16_t* vptr = qkv + (rowbase + 2 * kp) * NPJ + 2048 + h * 64 + 4 * c4;
    gld8(R.v0, vptr); gld8(R.v1, vptr + NPJ);
    gld4(R.ck, cbase + 64 * t + (tid & 63));
}
#define WAIT_P(N, R) asm volatile("s_waitcnt vmcnt(" #N ")" : "+v"(R.k), "+v"(R.v0), "+v"(R.v1), "+v"(R.ck))
__device__ __forceinline__ void pstore(const PRegs& R, LAS unsigned char* buf, int tid) {
    const int kvl = tid >> 3, ch = tid & 7, kp = tid >> 4, c4 = tid & 15;
    LAS unsigned* VT32 = (LAS unsigned*)(buf + AT_VOFF);
    *(LAS u32x4*)(buf + (kvl * AT_KS + 8 * ch) * 2) = R.k;
    VT32[(4 * c4 + 0) * (AT_VS / 2) + kp] = (R.v0.x & 0xffffu) | (R.v1.x << 16);
    VT32[(4 * c4 + 1) * (AT_VS / 2) + kp] = (R.v0.x >> 16) | (R.v1.x & 0xffff0000u);
    VT32[(4 * c4 + 2) * (AT_VS / 2) + kp] = (R.v0.y & 0xffffu) | (R.v1.y << 16);
    VT32[(4 * c4 + 3) * (AT_VS / 2) + kp] = (R.v0.y >> 16) | (R.v1.y & 0xffff0000u);
    if (tid < 64) { const float c = -R.ck * LOG2E; const unsigned h1 = f2bf(c); const float r1 = c - bf2f(h1); const unsigned h2 = f2bf(r1); const unsigned h3 = f2bf(r1 - bf2f(h2));
        u32x2 o; o.x = h1 | (h2 << 16); o.y = h3; ((LAS u32x2*)(buf + AT_COFF))[tid] = o; }
}
__device__ __forceinline__ void attn_unit_prompt(const Args& a, LAS unsigned char* lds, int b, int h, int qb) {
    int tid_ = threadIdx.x; asm volatile("" : "+v"(tid_));
    const int tid = tid_, lane = tid & 63, w = __builtin_amdgcn_readfirstlane(tid >> 6), l31 = lane & 31, hi = lane >> 5;
    const int NT = 4 * (qb + 1);
    const int qpos = 256 * qb + 32 * w + l31;
    const size_t qrow = (size_t)(b * 2048 + qpos);
    const float* cbase = (const float*)(a.ws + WS_CP) + (size_t)(b * 16 + h) * 2048;
    const bf16_t* qkv = (const bf16_t*)(a.ws + WS_PROJ);
    bf16x8 qf[4];
#pragma unroll
    for (int ks = 0; ks < 4; ++ks) qf[ks] = *(const bf16x8*)(qkv + qrow * NPJ + h * 64 + 16 * ks + 8 * hi);
    const float cq2 = cbase[qpos] * LOG2E;
    const int qmax_w = 256 * qb + 32 * w + 31;
    PRegs R0, R1, R2;
    pload_a(R0, a, b, h, NT - 1, cbase, tid); pload_a(R1, a, b, h, NT - 2, cbase, tid); pload_a(R2, a, b, h, NT - 3, cbase, tid);
    WAIT_P(8, R0); pstore(R0, lds, tid);
    pload_a(R0, a, b, h, NT - 4, cbase, tid);
    __syncthreads();
    float mrun = -INFINITY, lrun = 0.f;
    f32x16 ot[2]; ot[0] = f32x16{}; ot[1] = f32x16{};
#define PSTEP(tt, RR) do { if ((tt) < NT) { const int ti_ = NT - 1 - (tt); if (64 * ti_ <= qmax_w) attn_tile<false>(lds + ((tt) & 1) * AT_BUF, qf, nullptr, cq2, qpos, 64 * ti_, ti_ >= 4 * qb, mrun, lrun, ot, l31, hi); \
        { WAIT_P(8, RR); pstore(RR, lds + (((tt) + 1) & 1) * AT_BUF, tid); pload_a(RR, a, b, h, (NT - 5 - (tt)) > 0 ? NT - 5 - (tt) : 0, cbase, tid); } \
        __syncthreads(); } } while (0)
#pragma unroll 1
    for (int t = 0; t < NT; t += 3) { PSTEP(t, R1); PSTEP(t + 1, R2); PSTEP(t + 2, R0); }
#undef PSTEP
    WAIT_P(0, R0); WAIT_P(0, R1); WAIT_P(0, R2);
    lrun += __shfl_xor(lrun, 32);
    const float inv = 1.f / lrun;
    bf16_t* og = (bf16_t*)(a.ws + WS_OG) + qrow * DM + h * 64;
#pragma unroll
    for (int db = 0; db < 2; ++db)
#pragma unroll
        for (int j = 0; j < 4; ++j) { u32x2 o; o.x = pk(ot[db][4 * j] * inv, ot[db][4 * j + 1] * inv); o.y = pk(ot[db][4 * j + 2] * inv, ot[db][4 * j + 3] * inv);
            *(u32x2*)(og + 32 * db + 8 * j + 4 * hi) = o; }
}

struct TileRegs2 { u32x4 k[4], v[4]; float ck; };
__device__ __forceinline__ void sload2(TileRegs2& R, const Args& a, int b, int h, int t, const float* cbase, int st) {
#pragma unroll
    for (int q = 0; q < 2; ++q) {
        const int item = st + 256 * q, kvl = item >> 3, ch = item & 7, kp = item >> 4, c4 = item & 15;
        if (t < 32) {
            const float* kptr = a.in[I_CK] + (((size_t)b * 2048 + 64 * t + kvl) * 16 + h) * 64 + 8 * ch;
            R.k[2 * q] = *(const u32x4*)kptr; R.k[2 * q + 1] = *(const u32x4*)(kptr + 4);
            const float* vptr = a.in[I_CV] + (((size_t)b * 2048 + 64 * t + 2 * kp) * 16 + h) * 64 + 4 * c4;
            R.v[2 * q] = *(const u32x4*)vptr; R.v[2 * q + 1] = *(const u32x4*)(vptr + 1024);
        } else {
            const size_t rowbase = (size_t)(MP + b * 64);
            const bf16_t* qkv = (const bf16_t*)(a.ws + WS_PROJ);
            R.k[2 * q] = *(const u32x4*)(qkv + (rowbase + kvl) * NPJ + 1024 + h * 64 + 8 * ch);
            const bf16_t* vptr = qkv + (rowbase + 2 * kp) * NPJ + 2048 + h * 64 + 4 * c4;
            const u32x2 x0 = *(const u32x2*)vptr, x1 = *(const u32x2*)(vptr + NPJ);
            R.v[2 * q].x = x0.x; R.v[2 * q].y = x0.y; R.v[2 * q + 1].x = x1.x; R.v[2 * q + 1].y = x1.y;
        }
    }
    R.ck = cbase[64 * t + (st & 63)];
}
__device__ __forceinline__ void sload2a(TileRegs2& R, const Args& a, int b, int h, int t, const float* cbase, int st) {
#pragma unroll
    for (int q = 0; q < 2; ++q) {
        const int item = st + 256 * q, kvl = item >> 3, ch = item & 7, kp = item >> 4, c4 = item & 15;
        const float* kptr = a.in[I_CK] + (((size_t)b * 2048 + 64 * t + kvl) * 16 + h) * 64 + 8 * ch;
        gld16(R.k[2 * q], kptr); gld16(R.k[2 * q + 1], kptr + 4);
        const float* vptr = a.in[I_CV] + (((size_t)b * 2048 + 64 * t + 2 * kp) * 16 + h) * 64 + 4 * c4;
        gld16(R.v[2 * q], vptr); gld16(R.v[2 * q + 1], vptr + 1024);
    }
    gld4(R.ck, cbase + 64 * t + (st & 63));
}
#define WAIT_R2(N, R) asm volatile("s_waitcnt vmcnt(" #N ")" : "+v"(R.k[0]), "+v"(R.k[1]), "+v"(R.k[2]), "+v"(R.k[3]), "+v"(R.v[0]), "+v"(R.v[1]), "+v"(R.v[2]), "+v"(R.v[3]), "+v"(R.ck))
__device__ __forceinline__ void sstore2(const TileRegs2& R, LAS unsigned char* buf, bool f32src, int st) {
    LAS unsigned* VT32 = (LAS unsigned*)(buf + AT_VOFF);
#pragma unroll
    for (int q = 0; q < 2; ++q) {
        const int item = st + 256 * q, kvl = item >> 3, ch = item & 7, kp = item >> 4, c4 = item & 15;
        if (f32src) {
            const u32x4 k0 = R.k[2 * q], k1 = R.k[2 * q + 1];
            u32x4 o; o.x = pk(__uint_as_float(k0.x), __uint_as_float(k0.y)); o.y = pk(__uint_as_float(k0.z), __uint_as_float(k0.w));
            o.z = pk(__uint_as_float(k1.x), __uint_as_float(k1.y)); o.w = pk(__uint_as_float(k1.z), __uint_as_float(k1.w));
            *(LAS u32x4*)(buf + (kvl * AT_KS + 8 * ch) * 2) = o;
#pragma unroll
            for (int i = 0; i < 4; ++i) VT32[(4 * c4 + i) * (AT_VS / 2) + kp] = pk(__uint_as_float(R.v[2 * q][i]), __uint_as_float(R.v[2 * q + 1][i]));
        } else {
            *(LAS u32x4*)(buf + (kvl * AT_KS + 8 * ch) * 2) = R.k[2 * q];
            const u32x4 v0 = R.v[2 * q], v1 = R.v[2 * q + 1];
            VT32[(4 * c4 + 0) * (AT_VS / 2) + kp] = (v0.x & 0xffffu) | (v1.x << 16);
            VT32[(4 * c4 + 1) * (AT_VS / 2) + kp] = (v0.x >> 16) | (v1.x & 0xffff0000u);
            VT32[(4 * c4 + 2) * (AT_VS / 2) + kp] = (v0.y & 0xffffu) | (v1.y << 16);
            VT32[(4 * c4 + 3) * (AT_VS / 2) + kp] = (v0.y >> 16) | (v1.y & 0xffff0000u);
        }
    }
    if (st < 64) { const float c = -R.ck * LOG2E; const unsigned h1 = f2bf(c); const float r1 = c - bf2f(h1); const unsigned h2 = f2bf(r1); const unsigned h3 = f2bf(r1 - bf2f(h2));
        u32x2 o; o.x = h1 | (h2 << 16); o.y = h3; ((LAS u32x2*)(buf + AT_COFF))[st] = o; }
}
__device__ __forceinline__ void attn_unit_sample(const Args& a, LAS unsigned char* lds, int b, int h) {
    int tid_ = threadIdx.x; asm volatile("" : "+v"(tid_));
    const int tid = tid_, lane = tid & 63, w = __builtin_amdgcn_readfirstlane(tid >> 6), l31 = lane & 31, hi = lane >> 5;
    const float* cbase = (const float*)(a.ws + WS_CS) + (size_t)(b * 16 + h) * 2112;
    if (w >= 2 && w < 6) {
        const int st = tid - 128;
        TileRegs2 R0, R1, R2, R3;
        sload2(R0, a, b, h, 32, cbase, st); sload2a(R1, a, b, h, 31, cbase, st); sload2a(R2, a, b, h, 30, cbase, st); sload2a(R3, a, b, h, 29, cbase, st);
        sstore2(R0, lds, false, st);
        sload2a(R0, a, b, h, 28, cbase, st);
        __syncthreads();
#define SSTEP(tt, RR) do { WAIT_R2(27, RR); sstore2(RR, lds + (((tt) + 1) & 1) * AT_BUF, true, st); sload2a(RR, a, b, h, (27 - (tt)) > 0 ? 27 - (tt) : 0, cbase, st); __syncthreads(); } while (0)
#pragma unroll 1
        for (int t = 0; t < 32; t += 4) { SSTEP(t, R1); SSTEP(t + 1, R2); SSTEP(t + 2, R3); SSTEP(t + 3, R0); }
        SSTEP(32, R1);
#undef SSTEP
        WAIT_R2(0, R0); WAIT_R2(0, R1); WAIT_R2(0, R2); WAIT_R2(0, R3);
    } else {
        const bool active = w < 2;
        const int qpos = 2048 + 32 * (w & 1) + l31;
        const size_t qrow = (size_t)(MP + b * 64 + 32 * (w & 1) + l31);
        const bf16_t* qkv = (const bf16_t*)(a.ws + WS_PROJ);
        bf16x8 qf[4];
#pragma unroll
        for (int ks = 0; ks < 4; ++ks) qf[ks] = *(const bf16x8*)(qkv + qrow * NPJ + h * 64 + 16 * ks + 8 * hi);
        const float cq2 = cbase[qpos] * LOG2E;
        float mrun = -INFINITY, lrun = 0.f;
        f32x16 ot[2]; ot[0] = f32x16{}; ot[1] = f32x16{};
        __syncthreads();
#pragma unroll 1
        for (int tt = 0; tt < 33; ++tt) {
            if (active) attn_tile<false>(lds + (tt & 1) * AT_BUF, qf, nullptr, cq2, qpos, 64 * (32 - tt), tt == 0, mrun, lrun, ot, l31, hi);
            __syncthreads();
        }
        if (active) {
            lrun += __shfl_xor(lrun, 32);
            const float inv = 1.f / lrun;
            bf16_t* og = (bf16_t*)(a.ws + WS_OG) + qrow * DM + h * 64;
#pragma unroll
            for (int db = 0; db < 2; ++db)
#pragma unroll
                for (int j = 0; j < 4; ++j) { u32x2 o; o.x = pk(ot[db][4 * j] * inv, ot[db][4 * j + 1] * inv); o.y = pk(ot[db][4 * j + 2] * inv, ot[db][4 * j + 3] * inv);
                    *(u32x2*)(og + 32 * db + 8 * j + 4 * hi) = o; }
        }
    }
}

__device__ __forceinline__ void fox_attention(const Args& a, LAS unsigned char* lds, int vcu, int G) {
#pragma unroll 1
    for (int pass = 0; pass < 2; ++pass) {
        if ((pass ^ (vcu & 1)) == 0) {
#ifdef ATT_DUP_PROMPT
          for (int rep2_ = 0; rep2_ < 2; ++rep2_)
#endif
            if (G == 256) {
                const int bh = vcu >> 1, s0 = 2 * (vcu & 1);
#pragma unroll 1
                for (int i = 0; i < 4; ++i) attn_unit_prompt(a, lds, bh >> 4, bh & 15, (i & 1) ? s0 + (i >> 1) : 7 - s0 - (i >> 1));
            } else {
#pragma unroll 1
                for (int u = vcu; u < 1024; u += G) attn_unit_prompt(a, lds, (u & 127) >> 4, u & 15, 7 - (u >> 7));
            }
        } else {
#ifdef ATT_DUP_SAMPLE
            for (int rep3_ = 0; rep3_ < 2; ++rep3_)
#endif
#pragma unroll 1
            for (int u = vcu; u < 512; u += G) attn_unit_sample(a, lds, u >> 4, u & 15);
        }
    }
}

#ifndef PH_MASK
#define PH_MASK 0x7fff
#endif
#define IN(k) (((PH_MASK >> (k)) & 1) && a.ph_lo <= (k) && (k) < a.ph_hi)
#define SEAM(k) do { if (IN(k) && IN((k) + 1)) { if ((k) == 0 && a.ph_hi < 0) cg::this_grid().sync(); xcd_barrier(xbar); } } while (0)
#ifndef DUP_MASK
#define DUP_MASK 0
#endif
#define REP(k) _Pragma("unroll 1") for (int rep_ = 0; rep_ < ((((DUP_MASK) >> (k)) & 1) ? 2 : 1); ++rep_)
#define REPSYNC(k) do { if ((((DUP_MASK) >> (k)) & 1)) xcd_barrier(xbar); } while (0)
struct SliceOrder {
    int pm, pn;
    __device__ __forceinline__ bool next(int i, pg8::Unit& u) const { if (i > 0) return false; u.pm = pm; u.pn = pn; return true; }
    __device__ __forceinline__ void a_ready(const pg8::Unit&) const {}
    __device__ __forceinline__ void done(const pg8::Unit&) const {}
};
struct EpiPartial {
    static constexpr bool PERM = true, AFTER_DRAIN = false;
    float* part;
    __device__ __forceinline__ void operator()(const pg8::f32x4 (&acc)[2][2][4][2], const pg8::Unit& u, int wr, int wc, int fr, int fq) const {
#pragma unroll
        for (int ai = 0; ai < 2; ++ai)
#pragma unroll
            for (int m = 0; m < 4; ++m) { float* rowp = part + (size_t)(ai * 128 + wr * 64 + m * 16 + fr) * 256 + wc * 32 + 8 * fq;
#pragma unroll
                for (int bj = 0; bj < 2; ++bj) { *(f32x4*)(rowp + bj * 128) = acc[ai][bj][m][0]; *(f32x4*)(rowp + bj * 128 + 4) = acc[ai][bj][m][1]; } }
    }
};
__device__ __forceinline__ void ffd_sample_rows(const Args& a, int vcu, int G, float* ssout) {
    const int tid = threadIdx.x, lane = tid & 63, wave = tid >> 6;
    const int gw = vcu * 8 + wave, NGW = G * 8;
    float* XR = (float*)(a.ws + WS_XR); bf16_t* XB = (bf16_t*)(a.ws + WS_XB); const float* PART = (const float*)(a.ws + WS_PART);
    for (int r = gw; r < MS; r += NGW) {
        const int pml = r >> 8, rr = r & 255; const size_t row = (size_t)(MP + r);
        f32x4 acc[4];
#pragma unroll
        for (int pn = 0; pn < 4; ++pn) { acc[pn] = *(const f32x4*)(XR + row * DM + pn * 256 + 4 * lane);
#pragma unroll
            for (int sl = 0; sl < 8; ++sl) acc[pn] += *(const f32x4*)(PART + ((size_t)((pml * 4 + pn) * 8 + sl) * 256 + rr) * 256 + 4 * lane); }
        float sq = 0.f;
#pragma unroll
        for (int pn = 0; pn < 4; ++pn) { sq += dot4(acc[pn]); *(f32x4*)(XR + row * DM + pn * 256 + 4 * lane) = acc[pn];
            u32x2 o; o.x = pk(acc[pn][0], acc[pn][1]); o.y = pk(acc[pn][2], acc[pn][3]); *(u32x2*)(XB + row * DM + pn * 256 + 4 * lane) = o; }
        sq = wave_sum(sq);
        if (lane == 0) ssout[row] = sq;
    }
}
template <int L> __device__ __forceinline__ void common_gemms(const Args& a, LAS unsigned char* lds, int G, int bx, const XcdBarrier& xbar) {
    unsigned char* ws = a.ws;
    float* SS = (float*)(ws + WS_SS);
    bf16_t* XB = (bf16_t*)(ws + WS_XB); float* XR = (float*)(ws + WS_XR); bf16_t* OG = (bf16_t*)(ws + WS_OG); bf16_t* ACT = (bf16_t*)(ws + WS_ACT);
    constexpr int po = L ? 11 : 5;
    if (IN(po)) { pg8::Gemm g{OG, (const bf16_t*)(ws + (L ? WS_WFOUT : WS_WGOUT)), MT, DM, DM}; pg8::StaticOrder S; S.init(MT, DM, G, bx);
        EpiResid E{L ? XR : a.in[I_XP], L ? XR + (size_t)MP * DM : a.in[I_XS], XR, XB, SS + (L ? 3 : 1) * 32768};
        pg8::gemm_phase<EpiResid, pg8::StaticOrder, true, true>(lds, g, S, E);
        if (L == 0 && G == 256 && !MK_MULTI && bx >= 32) convert_weights(a, lds, 1, (bx - 32) * 8 + (int)(threadIdx.x >> 6), 224 * 8); }
    SEAM(po);
    if (IN(po + 1)) REP(po + 1) { pg8::Gemm g{XB, (const bf16_t*)(ws + WS_WFFI + (size_t)L * 11 * MiB), MT, 2 * DFF, DM}; pg8::StaticOrder S; S.init(MT, 2 * DFF, G, bx);
        EpiSwiglu E{SS + (L ? 3 : 1) * 32768, ACT}; pg8::gemm_phase<EpiSwiglu, pg8::StaticOrder, true, true>(lds, g, S, E); REPSYNC(po + 1); }
    SEAM(po + 1);
    if (IN(po + 2)) {
        const bf16_t* W = (const bf16_t*)(ws + WS_WFFD + (size_t)L * 6 * MiB);
        if (G == 256 && !MK_MULTI) {
            { pg8::Gemm g{ACT, W, MP, DM, DFF, 0}; pg8::StaticOrder S; S.init(MP, DM, G, bx);
              EpiResid E{XR, XR + (size_t)MP * DM, XR, XB, SS + (L ? 4 : 2) * 32768};
              pg8::gemm_phase<EpiResid, pg8::StaticOrder, true, true>(lds, g, S, E); }
            { const int un = bx >> 3, sl = bx & 7, kb0 = (sl < 6) ? 3 * sl : 18 + 2 * (sl - 6), kbn = (sl < 6) ? 3 : 2;
              pg8::Gemm g{ACT + 128 * kb0, W + 128 * kb0, MT, DM, 128 * kbn, DFF}; SliceOrder S{64 + (un >> 2), un & 3};
              EpiPartial E{(float*)(ws + WS_PART) + (size_t)(un * 8 + sl) * 65536};
              pg8::gemm_phase<EpiPartial, SliceOrder, true, true>(lds, g, S, E); }
            xcd_barrier(xbar);
            ffd_sample_rows(a, (bx % 8) * (G / 8) + bx / 8, G, SS + (L ? 4 : 2) * 32768);
        } else {
            pg8::Gemm g{ACT, W, MT, DM, DFF, 0}; pg8::StaticOrder S; S.init(MT, DM, G, bx);
            EpiResid E{XR, XR + (size_t)MP * DM, XR, XB, SS + (L ? 4 : 2) * 32768};
            pg8::gemm_phase<EpiResid, pg8::StaticOrder, true, true>(lds, g, S, E);
        }
    }
    SEAM(po + 2);
}
constexpr int NPH = 15;
__global__ void __launch_bounds__(512, 2) fwd(Args a) {
    extern __shared__ __attribute__((aligned(16))) unsigned char lds_raw[];
    LAS unsigned char* lds = (LAS unsigned char*)lds_raw;
    const int G = gridDim.x, bx = blockIdx.x;
    const int vcu = (G % 8 == 0) ? (bx % 8) * (G / 8) + bx / 8 : bx;
    unsigned char* ws = a.ws;
    float* SS = (float*)(ws + WS_SS);
    bf16_t* XB = (bf16_t*)(ws + WS_XB); bf16_t* PROJ = (bf16_t*)(ws + WS_PROJ);

    volatile LAS unsigned* MISC = (volatile LAS unsigned*)(lds + 131072);
    if (threadIdx.x < 64) MISC[threadIdx.x] = 0u;
    __syncthreads();
    XcdBarrier xbar; xbar.bar = (unsigned*)ws; xbar.x = 0; xbar.st = nullptr;
    if (a.ph_hi - a.ph_lo > 1) xbar = xcd_barrier_post((unsigned*)ws, MISC + 8);
    if (IN(0)) REP(0) { p0_prologue(a, lds, vcu, G); REPSYNC(0); }
    SEAM(0);
    if (IN(1)) { pg8::Gemm g{XB, (const bf16_t*)(ws + WS_WGIN), MT, NPROJ, DM}; pg8::StaticOrder S; S.init(MT, NPROJ, G, bx);
        EpiGlaProj E{SS, PROJ, (float*)(ws + WS_GL)}; pg8::gemm_phase<EpiGlaProj, pg8::StaticOrder, true, true>(lds, g, S, E); }
    SEAM(1);
    if (IN(2)) REP(2) {
        { GlaPre pf; if (vcu < 1152) gla_prefetch(pf, a, vcu >> 2, vcu & 3);
#pragma unroll 1
        for (int it = vcu; it < 1152; it += G) gla_item<0>(a, lds, it >> 2, it & 3, pf, (it + G < 1152) ? it + G : -1); }
        REPSYNC(2); }
    SEAM(2);
    if (IN(3)) REP(3) { gla_scan(a, vcu, G); REPSYNC(3); }
    SEAM(3);
    if (IN(4)) REP(4) {
        { GlaPre pf; if (vcu < 1152) gla_prefetch(pf, a, vcu >> 2, vcu & 3);
#pragma unroll 1
        for (int it = vcu; it < 1152; it += G) gla_item<1>(a, lds, it >> 2, it & 3, pf, (it + G < 1152) ? it + G : -1); }
        REPSYNC(4); }
    SEAM(4);
    common_gemms<0>(a, lds, G, bx, xbar);
    if (IN(8)) { pg8::Gemm g{XB, (const bf16_t*)(ws + WS_WFIN), MT, NPROJ, DM}; pg8::StaticOrder S; S.init(MT, NPROJ, G, bx);
        EpiFoxProj E{SS + 2 * 32768, PROJ, a.out, a.in[I_FBF]}; pg8::gemm_phase<EpiFoxProj, pg8::StaticOrder, true, true>(lds, g, S, E); }
    SEAM(8);
    if (IN(9)) REP(9) { fox_cumsum(a, lds, vcu, G); REPSYNC(9); }
    SEAM(9);
    if (IN(10)) REP(10) { fox_attention(a, lds, vcu, G); REPSYNC(10); }
    SEAM(10);
    common_gemms<1>(a, lds, G, bx, xbar);
#ifdef EXTRA_SYNCS
    for (int i_ = 0; i_ < EXTRA_SYNCS; ++i_) xcd_barrier(xbar);
#endif
    if (IN(14)) p_final(a, vcu, G);
#undef IN
#undef SEAM
}

extern "C" void kernel_launch(void* const* d_in, const int* in_sizes, int n_in, void* d_out, int out_size, void* d_ws, size_t ws_size, hipStream_t stream) {
    static int grid = 0;
    if (grid == 0) {
        if (n_in != 19 || ws_size < WS_END || out_size != 62160896) { fprintf(stderr, "kernel_launch: unexpected problem shape (n_in %d, out %d, ws %zu)\n", n_in, out_size, ws_size); grid = -1; return; }
        if (hipFuncSetAttribute((const void*)fwd, hipFuncAttributeMaxDynamicSharedMemorySize, LDS_BYTES) != hipSuccess) { fprintf(stderr, "kernel_launch: hipFuncSetAttribute failed\n"); grid = -1; return; }
        int dev = 0, cus = 0, per_cu = 0;
        (void)hipGetDevice(&dev); (void)hipDeviceGetAttribute(&cus, hipDeviceAttributeMultiprocessorCount, dev);
        (void)hipOccupancyMaxActiveBlocksPerMultiprocessor(&per_cu, (const void*)fwd, 512, LDS_BYTES);
        (void)hipGetLastError();
        if (per_cu < 1) per_cu = 1;
        grid = cus * 1;
        if (grid <= 0) grid = 256;
    }
    if (grid < 0) return;
    (void)hipMemsetAsync((char*)d_ws + WS_CTL, 0, CTL_BYTES, stream);
    Args a{};
    for (int i = 0; i < 19; ++i) a.in[i] = (const float*)d_in[i];
    a.out = (float*)d_out; a.ws = (unsigned char*)d_ws;
#if MK_MULTI
    for (int ph = 0; ph < NPH; ++ph) { a.ph_lo = ph; a.ph_hi = ph + 1; hipLaunchKernelGGL(fwd, dim3(grid), dim3(512), LDS_BYTES, stream, a); }
#else
    a.ph_lo = 0; a.ph_hi = NPH;
    void* args[] = {&a};
    hipError_t e = hipLaunchCooperativeKernel((const void*)fwd, dim3(grid), dim3(512), args, LDS_BYTES, stream);
    if (e != hipSuccess) fprintf(stderr, "kernel_launch: cooperative launch failed: %s (grid %d)\n", hipGetErrorString(e), grid);
#endif
}
```

```cpp
#include <hip/hip_runtime.h>
#include <hip/hip_cooperative_groups.h>
#include <cstdio>
#include <cstdint>
#include <cmath>
namespace cg = cooperative_groups;
#define MK_MULTI 0
namespace pg8 {
#define PG8_LAS __attribute__((address_space(3)))
typedef unsigned short bf16_t;
typedef short bf16x8 __attribute__((ext_vector_type(8)));
typedef float f32x4 __attribute__((ext_vector_type(4)));
typedef unsigned u32x4 __attribute__((ext_vector_type(4)));
constexpr int BM = 256, BK = 64, HALF = 128, HTB = HALF * BK * 2  , STAGE_BYTES = 8 * HTB, NXCD = 8, WGM = 8;

__host__ __device__ __forceinline__ int lds_byte(int r, int c) { const int st = (r >> 4) * 2 + (c >> 5), rr = r & 15, cc = c & 31, ob = rr * 64 + cc * 2; return st * 1024 + (ob ^ (((ob >> 9) & 1) << 5)); }
__host__ __device__ __forceinline__ void stage_rc(int b, int& R, int& C) { const int st = b / 1024, sb = b % 1024, swz = sb ^ (((sb >> 9) & 1) << 5); R = (st >> 1) * 16 + swz / 64; C = (st & 1) * 32 + (swz % 64) / 2; }
__host__ __device__ __forceinline__ int perm32(int rho) { const int n = rho >> 4, i = rho & 15; return 8 * (i >> 2) + 4 * n + (i & 3); }

struct Unit { int pm, pn; };
struct Gemm { const bf16_t* A; const bf16_t* Bt; int M, N, K; int ld; };

struct StaticOrder {
    int nM, nN, nwg, G, c;
    __host__ __device__ void init(int M, int N, int G_, int c_) { nM = M / BM; nN = N / BM; nwg = nM * nN; G = G_; c = c_; }
    __host__ __device__ bool next(int i, Unit& u) const {
        const long L = (long)i * G + c; if (L >= nwg) return false;
        int wgid = (int)L; { const int q = nwg / NXCD, r = nwg % NXCD, xcd = wgid % NXCD, off = wgid / NXCD; wgid = (xcd < r ? xcd * (q + 1) : r * (q + 1) + (xcd - r) * q) + off; }
        const int nig = WGM * nN, gid = wgid / nig, fm = gid * WGM, gsz = (nM - fm) < WGM ? (nM - fm) : WGM;
        u.pm = fm + ((wgid % nig) % gsz); u.pn = (wgid % nig) / gsz; return true;
    }
    __device__ __forceinline__ void a_ready(const Unit&) const {}
    __device__ __forceinline__ void done(const Unit&) const {}
};

__device__ __forceinline__ unsigned cvt_pk_bf16(float lo, float hi) { unsigned r; asm volatile("v_cvt_pk_bf16_f32 %0, %1, %2" : "=v"(r) : "v"(lo), "v"(hi)); return r; }
template <class Epi, class Sched, bool ALIGN_EPI = false, bool SP2 = false>
__device__ __forceinline__ void gemm_phase(PG8_LAS unsigned char* lds, const Gemm g, const Sched& S, const Epi& E) {
    const int tid = threadIdx.x, wid = __builtin_amdgcn_readfirstlane(tid >> 6), lane = tid & 63, wr = wid >> 2, wc = wid & 3, fr = lane & 15, fq = lane >> 4;
    const int K = g.ld ? g.ld : g.K, nt = g.K / BK;
    unsigned voffA[2], voffB[2];
#pragma unroll
    for (int i = 0; i < 2; ++i) { int R, C; stage_rc(tid * 16 + i * 8192, R, C); const int Rb = Epi::PERM ? ((R & ~31) + perm32(R & 31)) : R;
        voffA[i] = (unsigned)(R * K + C) * 2u; voffB[i] = (unsigned)(Rb * K + C) * 2u; }
    const size_t kstep = (size_t)(BK * 2);
    const size_t hstep = (size_t)HALF * K * 2;
    const size_t tstep = 2 * hstep;
    const unsigned ldsw = (unsigned)wid * 1024u;
    const int aoff = lds_byte(wr * 64 + fr, fq * 8), boff = lds_byte(wc * 32 + fr, fq * 8);
#define PG8_SA(b, h) (((b) * 2 + (h)) * HTB)
#define PG8_SB(b, h) ((4 + (b) * 2 + (h)) * HTB)
#define PG8_STAGE(bufoff, gbase, voff) do { _Pragma("unroll") for (int _i = 0; _i < 2; ++_i) \
        __builtin_amdgcn_global_load_lds((const unsigned*)((const char*)(gbase) + (voff)[_i]), (PG8_LAS unsigned*)(lds + (bufoff) + ldsw + _i * 8192), 16, 0, 0); } while (0)
#define PG8_LDA(dst, b, h) do { _Pragma("unroll") for (int m = 0; m < 4; ++m) _Pragma("unroll") for (int k = 0; k < 2; ++k) dst[m][k] = *(const PG8_LAS bf16x8*)(lds + PG8_SA(b, h) + aoff + m * 2048 + k * 1024); } while (0)
#define PG8_LDB(dst, b, h) do { _Pragma("unroll") for (int n = 0; n < 2; ++n) _Pragma("unroll") for (int k = 0; k < 2; ++k) dst[n][k] = *(const PG8_LAS bf16x8*)(lds + PG8_SB(b, h) + boff + n * 2048 + k * 1024); } while (0)
#define PG8_MMA(ai, bj, At, Bt) do { __builtin_amdgcn_s_setprio(1); _Pragma("unroll") for (int m = 0; m < 4; ++m) _Pragma("unroll") for (int n = 0; n < 2; ++n) _Pragma("unroll") for (int k = 0; k < 2; ++k) \
        acc[ai][bj][m][n] = __builtin_amdgcn_mfma_f32_16x16x32_bf16(Bt[n][k], At[m][k], acc[ai][bj][m][n], 0, 0, 0); __builtin_amdgcn_s_setprio(0); } while (0)
#define PG8_WAIT_V(n) asm volatile("s_waitcnt vmcnt(" #n ")" ::: "memory")
#define PG8_WAIT_L(n) asm volatile("s_waitcnt lgkmcnt(" #n ")" ::: "memory")
#define PG8_BAR __builtin_amdgcn_s_barrier()
#define PG8_SCHED __builtin_amdgcn_sched_barrier(0)
    Unit cur, nxt; int ui = 0;
    if (!S.next(0, cur)) return;
    f32x4 acc[2][2][4][2];
#pragma unroll
    for (int a = 0; a < 2; ++a)
#pragma unroll
        for (int b = 0; b < 2; ++b)
#pragma unroll
            for (int m = 0; m < 4; ++m)
#pragma unroll
                for (int n = 0; n < 2; ++n) acc[a][b][m][n] = (f32x4){0.f, 0.f, 0.f, 0.f};
    bf16x8 At[4][2], B0[2][2], B1[2][2];
    const char* cA = (const char*)g.A + (size_t)cur.pm * tstep; const char* cB = (const char*)g.Bt + (size_t)cur.pn * tstep;
    S.a_ready(cur);
    if constexpr (SP2) {
        PG8_STAGE(PG8_SB(0, 0), cB, voffB); PG8_STAGE(PG8_SB(0, 1), cB + hstep, voffB); PG8_STAGE(PG8_SA(0, 0), cA, voffA); PG8_STAGE(PG8_SA(0, 1), cA + hstep, voffA);
        if (wr == 1) PG8_BAR;
        PG8_WAIT_V(2); PG8_BAR;
        PG8_STAGE(PG8_SB(1, 0), cB + kstep, voffB); PG8_STAGE(PG8_SA(1, 0), cA + kstep, voffA); PG8_STAGE(PG8_SB(1, 1), cB + hstep + kstep, voffB);
        PG8_WAIT_V(6); PG8_BAR;
    } else {
        PG8_STAGE(PG8_SB(0, 0), cB, voffB); PG8_STAGE(PG8_SA(0, 0), cA, voffA); PG8_STAGE(PG8_SB(0, 1), cB + hstep, voffB); PG8_STAGE(PG8_SA(0, 1), cA + hstep, voffA);
        if (wr == 1) PG8_BAR;
        PG8_WAIT_V(4); PG8_BAR;
        PG8_STAGE(PG8_SB(1, 0), cB + kstep, voffB); PG8_STAGE(PG8_SA(1, 0), cA + kstep, voffA); PG8_STAGE(PG8_SB(1, 1), cB + hstep + kstep, voffB);
        PG8_WAIT_V(6); PG8_BAR;
    }
    for (;;) {
        const bool has_next = S.next(ui + 1, nxt);
        const char* nA = has_next ? (const char*)g.A + (size_t)nxt.pm * tstep : cA; const char* nB = has_next ? (const char*)g.Bt + (size_t)nxt.pn * tstep : cB;
        for (int t = 0; t < nt; t += 2) {
            const bool last = (t == nt - 2);
            const char* a1 = cA + (size_t)(t + 1) * kstep;
            const char* a2 = last ? nA : cA + (size_t)(t + 2) * kstep; const char* b2 = last ? nB : cB + (size_t)(t + 2) * kstep;
            const char* a3 = a2 + kstep; const char* b3 = b2 + kstep;
            if (last && has_next) S.a_ready(nxt);
            if constexpr (SP2) {
            PG8_LDB(B0, 0, 0); PG8_LDB(B1, 0, 1); PG8_SCHED; PG8_LDA(At, 0, 0); PG8_STAGE(PG8_SA(1, 1), a1 + hstep, voffA);
            PG8_WAIT_V(8); PG8_WAIT_L(0); PG8_BAR; PG8_MMA(0, 0, At, B0); PG8_MMA(0, 1, At, B1); PG8_BAR; PG8_SCHED;
            PG8_LDA(At, 0, 1); PG8_STAGE(PG8_SB(0, 0), b2, voffB); PG8_STAGE(PG8_SB(0, 1), b2 + hstep, voffB); PG8_STAGE(PG8_SA(0, 0), a2, voffA);
            PG8_WAIT_V(8); PG8_WAIT_L(0); PG8_BAR; PG8_MMA(1, 0, At, B0); PG8_MMA(1, 1, At, B1); PG8_BAR; PG8_SCHED;
            PG8_LDB(B0, 1, 0); PG8_LDB(B1, 1, 1); PG8_SCHED; PG8_LDA(At, 1, 0); PG8_STAGE(PG8_SA(0, 1), a2 + hstep, voffA);
            PG8_WAIT_V(8); PG8_WAIT_L(0); PG8_BAR; PG8_MMA(0, 0, At, B0); PG8_MMA(0, 1, At, B1); PG8_BAR; PG8_SCHED;
            PG8_LDA(At, 1, 1); PG8_STAGE(PG8_SB(1, 0), b3, voffB); PG8_STAGE(PG8_SB(1, 1), b3 + hstep, voffB); PG8_STAGE(PG8_SA(1, 0), a3, voffA);
            PG8_WAIT_V(8); PG8_WAIT_L(0); PG8_BAR; PG8_MMA(1, 0, At, B0); PG8_MMA(1, 1, At, B1); PG8_BAR; PG8_SCHED;
            } else {
            PG8_LDB(B0, 0, 0); PG8_SCHED; PG8_LDA(At, 0, 0); PG8_STAGE(PG8_SA(1, 1), a1 + hstep, voffA);
            PG8_WAIT_L(8); PG8_BAR; PG8_WAIT_L(0); PG8_MMA(0, 0, At, B0); PG8_BAR; PG8_SCHED;
            PG8_LDB(B1, 0, 1); PG8_STAGE(PG8_SB(0, 0), b2, voffB);
            PG8_BAR; PG8_WAIT_L(0); PG8_MMA(0, 1, At, B1); PG8_BAR;
            PG8_LDA(At, 0, 1); PG8_STAGE(PG8_SA(0, 0), a2, voffA);
            PG8_BAR; PG8_WAIT_L(0); PG8_MMA(1, 0, At, B0); PG8_BAR; PG8_SCHED;
            PG8_STAGE(PG8_SB(0, 1), b2 + hstep, voffB);
            PG8_WAIT_V(6); PG8_BAR; PG8_MMA(1, 1, At, B1); PG8_BAR;
            PG8_LDB(B0, 1, 0); PG8_SCHED; PG8_LDA(At, 1, 0); PG8_STAGE(PG8_SA(0, 1), a2 + hstep, voffA);
            PG8_WAIT_L(8); PG8_BAR; PG8_WAIT_L(0); PG8_MMA(0, 0, At, B0); PG8_BAR; PG8_SCHED;
            PG8_LDB(B1, 1, 1); PG8_STAGE(PG8_SB(1, 0), b3, voffB);
            PG8_BAR; PG8_WAIT_L(0); PG8_MMA(0, 1, At, B1); PG8_BAR;
            PG8_LDA(At, 1, 1); PG8_STAGE(PG8_SA(1, 0), a3, voffA);
            PG8_BAR; PG8_WAIT_L(0); PG8_MMA(1, 0, At, B0); PG8_BAR; PG8_SCHED;
            PG8_STAGE(PG8_SB(1, 1), b3 + hstep, voffB);
            PG8_WAIT_V(6); PG8_BAR; PG8_MMA(1, 1, At, B1); PG8_BAR;
            }
        }
        if constexpr (ALIGN_EPI) { if (wr == 0) PG8_BAR; }
        if constexpr (!Epi::AFTER_DRAIN) { E(acc, cur, wr, wc, fr, fq); S.done(cur); }
        if (!has_next) break;
#pragma unroll
        for (int a = 0; a < 2; ++a)
#pragma unroll
            for (int b = 0; b < 2; ++b)
#pragma unroll
                for (int m = 0; m < 4; ++m)
#pragma unroll
                    for (int n = 0; n < 2; ++n) acc[a][b][m][n] = (f32x4){0.f, 0.f, 0.f, 0.f};
        cur = nxt; cA = nA; cB = nB; ++ui;
        if constexpr (ALIGN_EPI) { if (wr == 1) PG8_BAR; }
    }
    PG8_WAIT_V(0);
    if constexpr (!ALIGN_EPI) { if (wr == 0) PG8_BAR; }
    PG8_BAR;
    if constexpr (Epi::AFTER_DRAIN) { E.fused(acc, cur, wr, wc, fr, fq, lds, wid, lane); S.done(cur); }
#undef PG8_SA
#undef PG8_SB
#undef PG8_STAGE
#undef PG8_LDA
#undef PG8_LDB
#undef PG8_MMA
#undef PG8_WAIT_V
#undef PG8_WAIT_L
#undef PG8_BAR
#undef PG8_SCHED
}
}

#define LAS __attribute__((address_space(3)))
typedef unsigned short bf16_t;
typedef short bf16x8 __attribute__((ext_vector_type(8)));
typedef float f32x4 __attribute__((ext_vector_type(4)));
typedef float f32x16 __attribute__((ext_vector_type(16)));
typedef unsigned u32x4 __attribute__((ext_vector_type(4)));
typedef unsigned u32x2 __attribute__((ext_vector_type(2)));

#ifndef MK_MULTI
#define MK_MULTI 0
#endif

constexpr int DM = 1024, MP = 16384, MS = 2048, MT = MP + MS;
constexpr int NPROJ = 3328, NPJ = 3072, DFF = 2816;
constexpr float EPS = 1e-6f;
constexpr float LOG2E = 1.4426950408889634f;
constexpr float QSCALE2 = 0.125f * LOG2E;
constexpr size_t O_Y = 0, O_GSP = 18874368, O_FKP = 19922944, O_FVP = 36700160, O_FLP = 53477376, O_GSS = 53739520, O_FKS = 57933824, O_FVS = 60030976, O_FLS = 62128128;
constexpr size_t MiB = 1u << 20;
constexpr size_t WS_CTL = 0, CTL_BYTES = 2 * MiB;
constexpr size_t WS_SS = 65536;
constexpr size_t WS_WGIN = 2 * MiB, WS_WFIN = 9 * MiB, WS_WGOUT = 16 * MiB, WS_WFOUT = 18 * MiB, WS_WFFI = 20 * MiB  , WS_WFFD = 42 * MiB  ;
constexpr size_t WS_XB = 54 * MiB, WS_XR = 90 * MiB, WS_PROJ = 162 * MiB, WS_GL = 270 * MiB, WS_DST = 272 * MiB, WS_DEC = 400 * MiB, WS_SPREV = 401 * MiB;
constexpr size_t WS_OG = 465 * MiB, WS_ACT = 501 * MiB, WS_CP = 600 * MiB, WS_CS = 601 * MiB, WS_PART = 606 * MiB  , WS_END = 672 * MiB;
constexpr int LDS_BYTES = 135168;

struct Args {
    const float* in[19];
    float* out; unsigned char* ws;
    int ph_lo, ph_hi;
};
enum { I_XP = 0, I_XS, I_STATE, I_CK, I_CV, I_CLF, I_NMIX, I_GWIN, I_GWG2, I_GBG, I_GNORM, I_GWOUT, I_FWIN, I_FBF, I_FWOUT, I_NFFN, I_FFIN, I_FFDN, I_NFIN };

__device__ __forceinline__ float bf2f(unsigned u) { return __uint_as_float(u << 16); }
__device__ __forceinline__ unsigned f2bf(float f) { unsigned u = __float_as_uint(f); return (u + 0x7fffu + ((u >> 16) & 1u)) >> 16; }
__device__ __forceinline__ unsigned pk(float lo, float hi) { return pg8::cvt_pk_bf16(lo, hi); }
__device__ __forceinline__ float wave_sum(float v) {
#pragma unroll
    for (int o = 1; o < 64; o <<= 1) v += __shfl_xor(v, o);
    return v;
}
__device__ __forceinline__ float log_sigmoid(float z) { return fminf(z, 0.f) - __logf(1.f + __expf(-fabsf(z))); }
__device__ __forceinline__ int crow(int r, int hi) { return (r & 3) + 8 * (r >> 2) + 4 * hi; }
__device__ __forceinline__ float dot4(f32x4 v) { return (v[0] * v[0] + v[1] * v[1]) + (v[2] * v[2] + v[3] * v[3]); }
#define MFMA32(a, b, c) __builtin_amdgcn_mfma_f32_32x32x16_bf16((a), (b), (c), 0, 0, 0)

#define XB_TMO      128
#define XB_XCNT(j)  (256  + 64 * (j))
#define XB_XSUB(j)  (1280 + 64 * (j))
#define XB_XGEN(j)  (2304 + 64 * (j))
#define XB_TOP      3328
#define XB_TOPGEN   3392
#define XCD_BAR_WORDS 3456
#define XB_SPIN_CAP (1u << 18)

__device__ __forceinline__ unsigned xb_ld(unsigned* p)              { return __hip_atomic_load(p, __ATOMIC_RELAXED, __HIP_MEMORY_SCOPE_AGENT); }
__device__ __forceinline__ unsigned xb_add(unsigned* p, unsigned v) { return __hip_atomic_fetch_add(p, v, __ATOMIC_RELAXED, __HIP_MEMORY_SCOPE_AGENT); }
__device__ __forceinline__ unsigned xb_xcc_id() { return (unsigned)__builtin_amdgcn_s_getreg((3 << 11) | 20) & 0xFu; }
#define XB_SPIN(cond, bar) do { unsigned _sp = 0; while (cond) { __builtin_amdgcn_s_sleep(1); \
    if ((++_sp & 255u) == 0u) { if (xb_ld(&(bar)[XB_TMO])) break; if (_sp > XB_SPIN_CAP) { atomicAdd(&(bar)[XB_TMO], 1u); break; } } } } while (0)

struct XcdBarrier {
    unsigned* bar; unsigned x;
    volatile LAS unsigned* st;
};

__device__ __forceinline__ XcdBarrier xcd_barrier_post(unsigned* bar, volatile LAS unsigned* st) {
    XcdBarrier b; b.bar = bar; b.x = xb_xcc_id(); b.st = st;
    if (threadIdx.x == 0) (void)xb_add(&bar[XB_XCNT(b.x)], 1u);
    return b;
}
__device__ __forceinline__ void xcd_barrier_complete(unsigned* bar, unsigned x, unsigned& nloc, unsigned& nx) {
    const unsigned G = gridDim.x * gridDim.y * gridDim.z;
    unsigned sum, cnt, mine, sp = 0u;
    for (;;) {
        sum = 0u; cnt = 0u; mine = 0u;
#pragma unroll
        for (unsigned j = 0; j < 16; ++j) { const unsigned c = xb_ld(&bar[XB_XCNT(j)]); sum += c; cnt += (c > 0u) ? 1u : 0u; mine = (j == x) ? c : mine; }
        if (sum == G) break;
        __builtin_amdgcn_s_sleep(1);
        if ((++sp & 255u) == 0u) { if (xb_ld(&bar[XB_TMO])) break; if (sp > XB_SPIN_CAP) { atomicAdd(&bar[XB_TMO], 1u); break; } }
    }
    nloc = mine > 0u ? mine : 1u; nx = cnt > 0u ? cnt : 1u;
}

__device__ __forceinline__ void xcd_barrier(const XcdBarrier& b) {
    asm volatile("s_waitcnt vmcnt(0)" ::: "memory");
    __syncthreads();
    if (threadIdx.x == 0) {
        unsigned* bar = b.bar;
        __builtin_amdgcn_s_waitcnt(0);
        unsigned nloc = b.st[0], nx = b.st[1];
        if (nloc == 0u) { xcd_barrier_complete(bar, b.x, nloc, nx); b.st[0] = nloc; b.st[1] = nx; }
        const unsigned old = xb_add(&bar[XB_XSUB(b.x)], 1u);
        const unsigned gen = old / nloc;
        if (old + 1u == (gen + 1u) * nloc) {
            __builtin_amdgcn_fence(__ATOMIC_RELEASE, "agent");
            asm volatile("s_waitcnt vmcnt(0)" ::: "memory");
            const unsigned og = xb_add(&bar[XB_TOP], 1u);
            const unsigned tg = og / nx;
            if (og + 1u == (tg + 1u) * nx) xb_add(&bar[XB_TOPGEN], 1u);
            else XB_SPIN(xb_ld(&bar[XB_TOPGEN]) == tg, bar);
            __builtin_amdgcn_fence(__ATOMIC_ACQUIRE, "agent");
            xb_add(&bar[XB_XGEN(b.x)], 1u);
            asm volatile("s_waitcnt vmcnt(0)" ::: "memory");
        } else {
            XB_SPIN(xb_ld(&bar[XB_XGEN(b.x)]) == gen, bar);
            __builtin_amdgcn_fence(__ATOMIC_ACQUIRE, "agent");
            asm volatile("s_waitcnt vmcnt(0)" ::: "memory");
        }
    }
    __syncthreads();
}

__device__ __forceinline__ void tr_item(const float* __restrict__ W, int K, int N, int nsrc0, bf16_t* WT, int drow0, const float* __restrict__ gain, LAS float* scr, int k0, int lane) {
    const int n = nsrc0 + (lane & 31);
    float wv_[32];
    const float* wp_ = W + (size_t)(k0 + (lane >> 5)) * N + ((n < N) ? n : 0);
#pragma unroll
    for (int i = 0; i < 32; ++i) wv_[i] = wp_[(size_t)(2 * i) * N];
#pragma unroll
    for (int i = 0; i < 32; ++i) {
        const int kk = 2 * i + (lane >> 5);
        float v = (n < N) ? wv_[i] : 0.f;
        if (gain) v *= gain[k0 + kk];
        scr[kk * 33 + (lane & 31)] = v;
    }
    asm volatile("s_waitcnt lgkmcnt(0)" ::: "memory");
    const int c = lane & 7;
#pragma unroll
    for (int j = 0; j < 4; ++j) {
        const int nn = (lane >> 3) + 8 * j; const LAS float* s = scr + (8 * c) * 33 + nn;
        u32x4 o; o.x = pk(s[0 * 33], s[1 * 33]); o.y = pk(s[2 * 33], s[3 * 33]); o.z = pk(s[4 * 33], s[5 * 33]); o.w = pk(s[6 * 33], s[7 * 33]);
        *(u32x4*)(WT + (size_t)(drow0 + nn) * K + k0 + 8 * c) = o;
    }
    asm volatile("s_waitcnt lgkmcnt(0)" ::: "memory");
}

__device__ __forceinline__ void convert_weights(const Args& a, LAS unsigned char* lds, int sel, int gw, int NGW) {
    const int tid = threadIdx.x, lane = tid & 63, wave = tid >> 6;
    LAS float* scr = (LAS float*)(lds + wave * 16384);
    unsigned char* ws = a.ws;
    constexpr int I_IN = 16 * 104, I_OUT = 16 * 32, I_FI = 16 * 176, I_FD = 44 * 32;
    constexpr int NITEMS = I_IN + I_OUT + I_FI + I_FD;
    for (int it = gw; it < NITEMS; it += NGW) {
        int r = it;
        if (r < I_IN) { const int kb = r / 104, nb = r % 104; tr_item(a.in[sel ? I_FWIN : I_GWIN], 1024, 3088, 32 * nb, (bf16_t*)(ws + (sel ? WS_WFIN : WS_WGIN)), 32 * nb, a.in[I_NMIX] + sel * 1024, scr, 64 * kb, lane); continue; } r -= I_IN;
        if (r < I_OUT) { const int kb = r / 32, nb = r % 32; tr_item(a.in[sel ? I_FWOUT : I_GWOUT], 1024, 1024, 32 * nb, (bf16_t*)(ws + (sel ? WS_WFOUT : WS_WGOUT)), 32 * nb, nullptr, scr, 64 * kb, lane); continue; } r -= I_OUT;
        if (r < I_FI) { const int kb = r / 176, nb = r % 176, ns = 32 * nb, bj = ns / DFF, j = ns % DFF, drow = 256 * (j / 128) + 128 * bj + (j % 128);
            tr_item(a.in[I_FFIN] + (size_t)sel * 1024 * 5632, 1024, 5632, ns, (bf16_t*)(ws + WS_WFFI + (size_t)sel * 11 * MiB), drow, a.in[I_NFFN] + sel * 1024, scr, 64 * kb, lane); continue; } r -= I_FI;
        { const int kb = r / 32, nb = r % 32;
            tr_item(a.in[I_FFDN] + (size_t)sel * DFF * 1024, DFF, 1024, 32 * nb, (bf16_t*)(ws + WS_WFFD + (size_t)sel * 6 * MiB), 32 * nb, nullptr, scr, 64 * kb, lane); }
    }
}
__device__ __forceinline__ void p0_prologue(const Args& a, LAS unsigned char* lds, int vcu, int G) {
    const int tid = threadIdx.x, lane = tid & 63, wave = tid >> 6;
    const int gw = vcu * 8 + wave, NGW = G * 8;
    unsigned char* ws = a.ws;
    convert_weights(a, lds, 0, gw, NGW);
    if (G != 256 || MK_MULTI) convert_weights(a, lds, 1, gw, NGW);
    float* ss0 = (float*)(ws + WS_SS);
    bf16_t* XB = (bf16_t*)(ws + WS_XB);
    for (int m0 = gw; m0 < MT; m0 += 3 * NGW) {
        f32x4 v[3][4];
#pragma unroll
        for (int q = 0; q < 3; ++q) { const int m = m0 + q * NGW; if (m < MT) { const float* xr = (m < MP) ? a.in[I_XP] + (size_t)m * DM : a.in[I_XS] + (size_t)(m - MP) * DM;
#pragma unroll
            for (int j = 0; j < 4; ++j) v[q][j] = ((const f32x4*)xr)[lane + 64 * j]; } }
#pragma unroll
        for (int q = 0; q < 3; ++q) { const int m = m0 + q * NGW; if (m < MT) { float s = 0.f;
#pragma unroll
            for (int j = 0; j < 4; ++j) s += dot4(v[q][j]);
            s = wave_sum(s);
            if (lane == 0) ss0[m] = s;
#pragma unroll
            for (int j = 0; j < 4; ++j) { u32x2 o; o.x = pk(v[q][j][0], v[q][j][1]); o.y = pk(v[q][j][2], v[q][j][3]); ((u32x2*)(XB + (size_t)m * DM))[lane + 64 * j] = o; } } }
    }
}

__device__ __forceinline__ void p_final(const Args& a, int vcu, int G) {
    const int tid = threadIdx.x, lane = tid & 63, wave = tid >> 6;
    const int gw = vcu * 8 + wave, NGW = G * 8;
    const float* ss = (const float*)(a.ws + WS_SS + 4 * 131072);
    const float* XR = (const float*)(a.ws + WS_XR);
    const float* g = a.in[I_NFIN];
    f32x4 gv[4];
#pragma unroll
    for (int j = 0; j < 4; ++j) gv[j] = ((const f32x4*)g)[lane + 64 * j];
    for (int m0 = gw; m0 < MT; m0 += 3 * NGW) {
        f32x4 v[3][4]; float rs[3];
#pragma unroll
        for (int q = 0; q < 3; ++q) { const int m = m0 + q * NGW; if (m < MT) { rs[q] = rsqrtf(ss[m] * (1.f / DM) + EPS);
#pragma unroll
            for (int j = 0; j < 4; ++j) v[q][j] = ((const f32x4*)(XR + (size_t)m * DM))[lane + 64 * j]; } }
#pragma unroll
        for (int q = 0; q < 3; ++q) { const int m = m0 + q * NGW; if (m < MT) {
#pragma unroll
            for (int j = 0; j < 4; ++j) ((f32x4*)(a.out + O_Y + (size_t)m * DM))[lane + 64 * j] = v[q][j] * rs[q] * gv[j]; } }
    }
}

struct EpiGlaProj {
    static constexpr bool PERM = true, AFTER_DRAIN = false;
    const float* ss; bf16_t* proj; float* gl;
    __device__ __forceinline__ void operator()(const pg8::f32x4 (&acc)[2][2][4][2], const pg8::Unit& u, int wr, int wc, int fr, int fq) const {
        const int row0 = u.pm * 256 + wr * 64 + fr;
#pragma unroll
        for (int ai = 0; ai < 2; ++ai)
#pragma unroll
            for (int m = 0; m < 4; ++m) {
                const int row = row0 + ai * 128 + m * 16; const float rs = rsqrtf(ss[row] * (1.f / DM) + EPS);
                if (u.pn < 12) {
#pragma unroll
                    for (int bj = 0; bj < 2; ++bj) { const f32x4 v0 = acc[ai][bj][m][0] * rs, v1 = acc[ai][bj][m][1] * rs;
                        u32x4 w; w.x = pk(v0[0], v0[1]); w.y = pk(v0[2], v0[3]); w.z = pk(v1[0], v1[1]); w.w = pk(v1[2], v1[3]);
                        *(u32x4*)(proj + (size_t)row * NPJ + u.pn * 256 + bj * 128 + wc * 32 + 8 * fq) = w; }
                } else if (wc == 0 && fq < 2) {
#pragma unroll
                    for (int n = 0; n < 2; ++n) *(f32x4*)(gl + (size_t)row * 16 + 8 * fq + 4 * n) = acc[ai][0][m][n] * rs;
                }
            }
    }
};
struct EpiResid {
    static constexpr bool PERM = true, AFTER_DRAIN = false;
    const float* xin_p; const float* xin_s; float* xout; bf16_t* xb; float* ssout;
    __device__ __forceinline__ void operator()(const pg8::f32x4 (&acc)[2][2][4][2], const pg8::Unit& u, int wr, int wc, int fr, int fq) const {
        const int row0 = u.pm * 256 + wr * 64 + fr;
#pragma unroll
        for (int ai = 0; ai < 2; ++ai)
#pragma unroll
            for (int m = 0; m < 4; ++m) {
                const int row = row0 + ai * 128 + m * 16;
                const float* xi = (row < MP) ? xin_p + (size_t)row * DM : xin_s + (size_t)(row - MP) * DM;
                float sq = 0.f;
#pragma unroll
                for (int bj = 0; bj < 2; ++bj) { const int col = u.pn * 256 + bj * 128 + wc * 32 + 8 * fq;
                    const f32x4 a0 = *(const f32x4*)(xi + col) + acc[ai][bj][m][0], a1 = *(const f32x4*)(xi + col + 4) + acc[ai][bj][m][1];
                    *(f32x4*)(xout + (size_t)row * DM + col) = a0; *(f32x4*)(xout + (size_t)row * DM + col + 4) = a1;
                    u32x4 w; w.x = pk(a0[0], a0[1]); w.y = pk(a0[2], a0[3]); w.z = pk(a1[0], a1[1]); w.w = pk(a1[2], a1[3]);
                    *(u32x4*)(xb + (size_t)row * DM + col) = w;
                    sq += dot4(a0) + dot4(a1); }
                sq += __shfl_xor(sq, 16); sq += __shfl_xor(sq, 32);
                if (fq == 0) atomicAdd(ssout + row, sq);
            }
    }
};
struct EpiSwiglu {
    static constexpr bool PERM = true, AFTER_DRAIN = false;
    const float* ss; bf16_t* act;
    __device__ __forceinline__ void operator()(const pg8::f32x4 (&acc)[2][2][4][2], const pg8::Unit& u, int wr, int wc, int fr, int fq) const {
        const int row0 = u.pm * 256 + wr * 64 + fr;
#pragma unroll
        for (int ai = 0; ai < 2; ++ai)
#pragma unroll
            for (int m = 0; m < 4; ++m) {
                const int row = row0 + ai * 128 + m * 16; const float rs = rsqrtf(ss[row] * (1.f / DM) + EPS);
                float y[8];
#pragma unroll
                for (int n = 0; n < 2; ++n)
#pragma unroll
                    for (int i = 0; i < 4; ++i) { const float g = acc[ai][0][m][n][i] * rs, up = acc[ai][1][m][n][i] * rs; y[4 * n + i] = g * up * __builtin_amdgcn_rcpf(1.f + __expf(-g)); }
                u32x4 w; w.x = pk(y[0], y[1]); w.y = pk(y[2], y[3]); w.z = pk(y[4], y[5]); w.w = pk(y[6], y[7]);
                *(u32x4*)(act + (size_t)row * DFF + u.pn * 128 + wc * 32 + 8 * fq) = w;
            }
    }
};
struct EpiFoxProj {
    static constexpr bool PERM = true, AFTER_DRAIN = false;
    const float* ss; bf16_t* qkv; float* out; const float* bf;
    __device__ __forceinline__ void operator()(const pg8::f32x4 (&acc)[2][2][4][2], const pg8::Unit& u, int wr, int wc, int fr, int fq) const {
        const int row0 = u.pm * 256 + wr * 64 + fr;
        const int sect = u.pn >> 2;
#pragma unroll
        for (int ai = 0; ai < 2; ++ai)
#pragma unroll
            for (int m = 0; m < 4; ++m) {
                const int row = row0 + ai * 128 + m * 16; const float rs = rsqrtf(ss[row] * (1.f / DM) + EPS);
                if (u.pn < 12) {
                    const float sc = (sect == 0) ? rs * QSCALE2 : rs;
                    float* fdst = nullptr;
                    if (sect == 1) fdst = (row < MP) ? out + O_FKP + (size_t)row * DM : out + O_FKS + (size_t)(row - MP) * DM;
                    if (sect == 2) fdst = (row < MP) ? out + O_FVP + (size_t)row * DM : out + O_FVS + (size_t)(row - MP) * DM;
#pragma unroll
                    for (int bj = 0; bj < 2; ++bj) { const f32x4 v0 = acc[ai][bj][m][0] * sc, v1 = acc[ai][bj][m][1] * sc;
                        u32x4 w; w.x = pk(v0[0], v0[1]); w.y = pk(v0[2], v0[3]); w.z = pk(v1[0], v1[1]); w.w = pk(v1[2], v1[3]);
                        const int cl = bj * 128 + wc * 32 + 8 * fq;
                        *(u32x4*)(qkv + (size_t)row * NPJ + u.pn * 256 + cl) = w;
                        if (sect > 0) { float* d = fdst + (u.pn & 3) * 256 + cl; *(f32x4*)d = v0; *(f32x4*)(d + 4) = v1; } }
                } else if (wc == 0 && fq < 2) {
                    float* d = (row < MP) ? out + O_FLP + (size_t)row * 16 : out + O_FLS + (size_t)(row - MP) * 16;
#pragma unroll
                    for (int n = 0; n < 2; ++n) { const f32x4 v = acc[ai][0][m][n] * rs; f32x4 o;
#pragma unroll
                        for (int i = 0; i < 4; ++i) o[i] = log_sigmoid(v[i] + bf[8 * fq + 4 * n + i]);
                        *(f32x4*)(d + 8 * fq + 4 * n) = o; }
                }
            }
    }
};

constexpr int GL_OFF = 0, GSUM_OFF = 4096, DECS_OFF = 6144, QE_OFF = 8192, KE_OFF = 25600, VT_OFF = 43008, AL_OFF = 79872, KDT_OFF = 8192, OL_OFF = 8192;
constexpr int QES = 136, VTS = 72, OLS = 260;

struct GlaPre { unsigned v[32]; f32x4 gl; };
__device__ __forceinline__ void gla_prefetch(GlaPre& pf, const Args& a, int cid, int h) {
    const int tid = threadIdx.x, dvv = tid & 255, th = tid >> 8, row0 = cid * 64;
    const bf16_t* vp = (const bf16_t*)(a.ws + WS_PROJ) + (size_t)(row0 + 32 * th) * NPJ + 1024 + h * 256 + dvv;
#pragma unroll
    for (int i = 0; i < 32; ++i) pf.v[i] = vp[(size_t)i * NPJ];
    pf.gl = *(const f32x4*)((const float*)(a.ws + WS_GL) + (size_t)(row0 + ((tid & 255) >> 2)) * 16 + (tid & 3) * 4);
}
template <int MODE> __device__ __forceinline__ void gla_item(const Args& a, LAS unsigned char* lds, int cid, int h, GlaPre& pf, int next) {
    int tid_ = threadIdx.x; asm volatile("" : "+v"(tid_));
    const int tid = tid_, lane = tid & 63, w = __builtin_amdgcn_readfirstlane(tid >> 6), l31 = lane & 31, hi = lane >> 5;
    const int row0 = cid * 64;
    const bool prompt = cid < 256;
    LAS float* GLs = (LAS float*)(lds + GL_OFF); LAS float* GSUM = (LAS float*)(lds + GSUM_OFF); LAS float* DECS = (LAS float*)(lds + DECS_OFF);
    LAS bf16_t* QE = (LAS bf16_t*)(lds + QE_OFF); LAS bf16_t* KE = (LAS bf16_t*)(lds + KE_OFF); LAS bf16_t* VT = (LAS bf16_t*)(lds + VT_OFF);
    LAS bf16_t* AL = (LAS bf16_t*)(lds + AL_OFF); LAS bf16_t* KDT = (LAS bf16_t*)(lds + KDT_OFF);
    const bf16_t* P = (const bf16_t*)(a.ws + WS_PROJ) + (size_t)row0 * NPJ;
    const float* GL = (const float*)(a.ws + WS_GL);
    const float* state = a.in[I_STATE];

    bf16x8 sfr[8];
    if (MODE == 1) {
        if (prompt) {
            const bf16_t* sp = (const bf16_t*)(a.ws + WS_SPREV) + ((size_t)(cid * 4 + h) * 256 + 32 * w + l31) * 128 + 8 * hi;
#pragma unroll
            for (int ks = 0; ks < 8; ++ks) sfr[ks] = *(const bf16x8*)(sp + 16 * ks);
        } else {
            const float* s0 = state + ((size_t)((cid - 256) * 4 + h) * 128) * 256 + 32 * w + l31;
#pragma unroll
            for (int ks = 0; ks < 8; ++ks) { float f[8];
#pragma unroll
                for (int j = 0; j < 8; ++j) f[j] = s0[(size_t)(16 * ks + 8 * hi + j) * 256];
                u32x4 o; o.x = pk(f[0], f[1]); o.y = pk(f[2], f[3]); o.z = pk(f[4], f[5]); o.w = pk(f[6], f[7]); sfr[ks] = __builtin_bit_cast(bf16x8, o); }
        }
    }
    unsigned kraw[16], qraw[16];
    {
        const int dk_ = tid & 127, tg_ = tid >> 7;
        const bf16_t* kp_ = P + (size_t)(16 * tg_) * NPJ + 512 + h * 128 + dk_;
#pragma unroll
        for (int i = 0; i < 16; ++i) kraw[i] = kp_[(size_t)i * NPJ];
        if (MODE == 1) { const bf16_t* qp_ = P + (size_t)(16 * tg_) * NPJ + h * 128 + dk_;
#pragma unroll
            for (int i = 0; i < 16; ++i) qraw[i] = qp_[(size_t)i * NPJ]; }
    }
    float wv[16];
#pragma unroll
    for (int j = 0; j < 16; ++j) wv[j] = a.in[I_GWG2][j * 512 + h * 128 + (tid & 127)];
    const float bias = a.in[I_GBG][h * 128 + (tid & 127)];
    if (tid < 256) ((LAS f32x4*)GLs)[tid] = pf.gl;
    {
        const int dvv = tid & 255, th = tid >> 8;
#pragma unroll
        for (int q4 = 0; q4 < 4; ++q4) { u32x4 o; o.x = pf.v[8 * q4] | (pf.v[8 * q4 + 1] << 16); o.y = pf.v[8 * q4 + 2] | (pf.v[8 * q4 + 3] << 16);
            o.z = pf.v[8 * q4 + 4] | (pf.v[8 * q4 + 5] << 16); o.w = pf.v[8 * q4 + 6] | (pf.v[8 * q4 + 7] << 16);
            *(LAS u32x4*)(VT + dvv * VTS + 32 * th + 8 * q4) = o; }
    }
    if (next >= 0) gla_prefetch(pf, a, next >> 2, next & 3);
    __syncthreads();
    const int dk = tid & 127, tg = tid >> 7;
    float bc[16];
    {
        float run = 0.f;
#pragma unroll
        for (int i = 0; i < 16; ++i) { const LAS f32x4* gp = (const LAS f32x4*)(GLs + (16 * tg + i) * 16); float z = bias;
#pragma unroll
            for (int j4 = 0; j4 < 4; ++j4) { const f32x4 gq = gp[j4]; z += gq[0] * wv[4 * j4] + gq[1] * wv[4 * j4 + 1] + gq[2] * wv[4 * j4 + 2] + gq[3] * wv[4 * j4 + 3]; }
            run += log_sigmoid(z) * (1.f / 16.f); bc[i] = run; }
        GSUM[tg * 128 + dk] = run;
    }
    __syncthreads();
    float off = 0.f, blast = 0.f;
#pragma unroll
    for (int g = 0; g < 4; ++g) { const float s = GSUM[g * 128 + dk]; blast += s; if (g < tg) off += s; }
    if (MODE == 0) {
        float kd[16];
#pragma unroll
        for (int i = 0; i < 16; ++i) { const float b = bc[i] + off; kd[i] = bf2f(kraw[i]) * __expf(blast - b); }
        u32x4 o0, o1; o0.x = pk(kd[0], kd[1]); o0.y = pk(kd[2], kd[3]); o0.z = pk(kd[4], kd[5]); o0.w = pk(kd[6], kd[7]);
        o1.x = pk(kd[8], kd[9]); o1.y = pk(kd[10], kd[11]); o1.z = pk(kd[12], kd[13]); o1.w = pk(kd[14], kd[15]);
        *(LAS u32x4*)(KDT + dk * VTS + 16 * tg) = o0; *(LAS u32x4*)(KDT + dk * VTS + 16 * tg + 8) = o1;
        if (tg == 0) { const float d = __expf(blast); DECS[dk] = d; if (prompt) ((float*)(a.ws + WS_DEC))[(size_t)(cid * 4 + h) * 128 + dk] = d; }
    } else {
#pragma unroll
        for (int i = 0; i < 16; ++i) { const float b = bc[i] + off; const int t = 16 * tg + i;
            const float qe = bf2f(qraw[i]) * __expf(b) * 0.08838834764831845f, ke = bf2f(kraw[i]) * __expf(-b);
            QE[t * QES + dk] = (bf16_t)f2bf(qe); KE[t * QES + dk] = (bf16_t)f2bf(ke); }
    }
    __syncthreads();
    if (MODE == 0) {
        bf16x8 vf[4];
#pragma unroll
        for (int ks = 0; ks < 4; ++ks) vf[ks] = *(const LAS bf16x8*)(VT + (32 * w + l31) * VTS + 16 * ks + 8 * hi);
        f32x16 acc[4];
#pragma unroll
        for (int d = 0; d < 4; ++d) acc[d] = f32x16{};
#pragma unroll
        for (int d = 0; d < 4; ++d)
#pragma unroll
            for (int ks = 0; ks < 4; ++ks) { const bf16x8 kf = *(const LAS bf16x8*)(KDT + (32 * d + l31) * VTS + 16 * ks + 8 * hi);
                acc[d] = prompt ? MFMA32(vf[ks], kf, acc[d]) : MFMA32(kf, vf[ks], acc[d]); }
        if (prompt) {
            bf16_t* dst = (bf16_t*)(a.ws + WS_DST) + ((size_t)(cid * 4 + h) * 256 + 32 * w) * 128;
#pragma unroll
            for (int d = 0; d < 4; ++d)
#pragma unroll
                for (int r = 0; r < 16; ++r) dst[(size_t)crow(r, hi) * 128 + 32 * d + l31] = (bf16_t)f2bf(acc[d][r]);
        } else {
            const size_t base = ((size_t)((cid - 256) * 4 + h) * 128) * 256;
            float* outs = a.out + O_GSS;
#pragma unroll
            for (int d = 0; d < 4; ++d)
#pragma unroll
                for (int r = 0; r < 16; ++r) { const int dkk = 32 * d + crow(r, hi); const size_t idx = base + (size_t)dkk * 256 + 32 * w + l31; outs[idx] = state[idx] * DECS[dkk] + acc[d][r]; }
        }
    } else {
        u32x2 rraw[8];
#pragma unroll
        for (int i = 0; i < 8; ++i) rraw[i] = *(const u32x2*)(P + (size_t)(8 * w + i) * NPJ + 2048 + h * 256 + 4 * lane);
        f32x16 o[2]; o[0] = f32x16{}; o[1] = f32x16{};
#pragma unroll
        for (int tb = 0; tb < 2; ++tb)
#pragma unroll
            for (int ks = 0; ks < 8; ++ks) { const bf16x8 qa = *(const LAS bf16x8*)(QE + (32 * tb + l31) * QES + 16 * ks + 8 * hi); o[tb] = MFMA32(qa, sfr[ks], o[tb]); }
        if (w < 3) {
            const int tb = (w > 0) ? 1 : 0, sb = (w == 2) ? 1 : 0;
            f32x16 am = f32x16{};
#pragma unroll
            for (int ks = 0; ks < 8; ++ks) { const bf16x8 qa = *(const LAS bf16x8*)(QE + (32 * tb + l31) * QES + 16 * ks + 8 * hi), kb = *(const LAS bf16x8*)(KE + (32 * sb + l31) * QES + 16 * ks + 8 * hi);
                am = MFMA32(qa, kb, am); }
#pragma unroll
            for (int r = 0; r < 16; ++r) { const int tl = crow(r, hi); float v = am[r]; if (tb == sb && l31 > tl) v = 0.f; AL[(32 * tb + tl) * VTS + 32 * sb + l31] = (bf16_t)f2bf(v); }
        }
        __syncthreads();
#pragma unroll
        for (int tb = 0; tb < 2; ++tb)
#pragma unroll
            for (int ks = 0; ks < 4; ++ks) { if (tb == 0 && ks >= 2) continue;
                const bf16x8 aa = *(const LAS bf16x8*)(AL + (32 * tb + l31) * VTS + 16 * ks + 8 * hi), vb = *(const LAS bf16x8*)(VT + (32 * w + l31) * VTS + 16 * ks + 8 * hi);
                o[tb] = MFMA32(aa, vb, o[tb]); }
        __syncthreads();
        LAS float* OL = (LAS float*)(lds + OL_OFF);
#pragma unroll
        for (int tb = 0; tb < 2; ++tb)
#pragma unroll
            for (int r = 0; r < 16; ++r) OL[(32 * tb + crow(r, hi)) * OLS + 32 * w + l31] = o[tb][r];
        __syncthreads();
        const f32x4 ng = *(const f32x4*)(a.in[I_GNORM] + h * 256 + 4 * lane);
        bf16_t* OG = (bf16_t*)(a.ws + WS_OG);
#pragma unroll
        for (int i = 0; i < 8; ++i) { const int t = 8 * w + i; const f32x4 v = *(const LAS f32x4*)(OL + t * OLS + 4 * lane);
            const float rs = rsqrtf(wave_sum(dot4(v)) * (1.f / 256.f) + EPS);
            const u32x2 rr = rraw[i];
            float rv[4] = {bf2f(rr.x & 0xffffu), bf2f(rr.x >> 16), bf2f(rr.y & 0xffffu), bf2f(rr.y >> 16)}; float y[4];
#pragma unroll
            for (int j = 0; j < 4; ++j) y[j] = v[j] * rs * ng[j] * rv[j] * __builtin_amdgcn_rcpf(1.f + __expf(-rv[j]));
            u32x2 ov; ov.x = pk(y[0], y[1]); ov.y = pk(y[2], y[3]);
            *(u32x2*)(OG + (size_t)(row0 + t) * DM + h * 256 + 4 * lane) = ov; }
    }
    __syncthreads();
}

__device__ __forceinline__ void gla_scan(const Args& a, int vcu, int G) {
    const int gt = vcu * 512 + threadIdx.x, NT_ = G * 512;
    const bf16_t* DST = (const bf16_t*)(a.ws + WS_DST); const float* DEC = (const float*)(a.ws + WS_DEC); bf16_t* SP = (bf16_t*)(a.ws + WS_SPREV);
    for (int it0 = gt; it0 < 32 * 8192; it0 += 2 * NT_) {
        const int it1 = it0 + NT_; const bool two = it1 < 32 * 8192;
        const int bhA = it0 >> 13, eA = it0 & 8191, dvA = eA >> 5, dkA = (eA & 31) * 4;
        const int itB = two ? it1 : it0; const int bhB = itB >> 13, eB = itB & 8191, dvB = eB >> 5, dkB = (eB & 31) * 4;
        f32x4 SA = (f32x4){0.f, 0.f, 0.f, 0.f}, SB = SA;
#pragma unroll 8
        for (int c = 0; c < 32; ++c) {
            const size_t chA = (size_t)(((bhA >> 2) * 32 + c) * 4 + (bhA & 3)), chB = (size_t)(((bhB >> 2) * 32 + c) * 4 + (bhB & 3));
            const size_t baseA = (chA * 256 + dvA) * 128 + dkA, baseB = (chB * 256 + dvB) * 128 + dkB;
            const u32x2 rA = *(const u32x2*)(DST + baseA), rB = *(const u32x2*)(DST + baseB);
            const f32x4 deA = *(const f32x4*)(DEC + chA * 128 + dkA), deB = *(const f32x4*)(DEC + chB * 128 + dkB);
            const f32x4 dsA = (f32x4){bf2f(rA.x & 0xffffu), bf2f(rA.x >> 16), bf2f(rA.y & 0xffffu), bf2f(rA.y >> 16)};
            const f32x4 dsB = (f32x4){bf2f(rB.x & 0xffffu), bf2f(rB.x >> 16), bf2f(rB.y & 0xffffu), bf2f(rB.y >> 16)};
            u32x2 o; o.x = pk(SA[0], SA[1]); o.y = pk(SA[2], SA[3]); *(u32x2*)(SP + baseA) = o;
            if (two) { o.x = pk(SB[0], SB[1]); o.y = pk(SB[2], SB[3]); *(u32x2*)(SP + baseB) = o; }
            SA = SA * deA + dsA; SB = SB * deB + dsB;
        }
        float* ogA = a.out + O_GSP + ((size_t)bhA * 128 + dkA) * 256 + dvA;
#pragma unroll
        for (int i = 0; i < 4; ++i) ogA[(size_t)i * 256] = SA[i];
        if (two) { float* ogB = a.out + O_GSP + ((size_t)bhB * 128 + dkB) * 256 + dvB;
#pragma unroll
            for (int i = 0; i < 4; ++i) ogB[(size_t)i * 256] = SB[i]; }
    }
}

template <int L, int C> __device__ __forceinline__ void cumsum_item(const float* src0, const float* src1, float* dst, LAS float* SEG, int hh, int seg) {
    float s = 0.f;
#pragma unroll 1
    for (int c0 = 0; c0 < L; c0 += C) { float v[C];
#pragma unroll
        for (int i = 0; i < C; ++i) { const int t = seg * L + c0 + i; v[i] = (t < 2048) ? src0[(unsigned)(t * 16 + hh)] : src1[(unsigned)((t - 2048) * 16 + hh)]; }
#pragma unroll
        for (int i = 0; i < C; ++i) s += v[i]; }
    SEG[seg * 16 + hh] = s;
    __syncthreads();
    float run = 0.f;
    for (int g = 0; g < seg; ++g) run += SEG[g * 16 + hh];
#pragma unroll 1
    for (int c0 = 0; c0 < L; c0 += C) { float v[C];
#pragma unroll
        for (int i = 0; i < C; ++i) { const int t = seg * L + c0 + i; v[i] = (t < 2048) ? src0[(unsigned)(t * 16 + hh)] : src1[(unsigned)((t - 2048) * 16 + hh)]; }
#pragma unroll
        for (int i = 0; i < C; ++i) { run += v[i]; dst[seg * L + c0 + i] = run; } }
    __syncthreads();
}
__device__ __forceinline__ void fox_cumsum(const Args& a, LAS unsigned char* lds, int vcu, int G) {
    const int tid = threadIdx.x, hh = tid & 15, seg = tid >> 4;
    LAS float* SEG = (LAS float*)lds;
    for (int it = vcu; it < 40; it += G) {
        const bool prompt = it < 8; const int b = prompt ? it : it - 8;
        const float* src0 = prompt ? a.out + O_FLP + (size_t)b * 2048 * 16 : a.in[I_CLF] + (size_t)b * 2048 * 16;
        const float* src1 = a.out + O_FLS + (size_t)b * 64 * 16;
        if (prompt) cumsum_item<64, 32>(src0, src1, (float*)(a.ws + WS_CP) + (size_t)(b * 16 + hh) * 2048, SEG, hh, seg);
        else cumsum_item<66, 22>(src0, src1, (float*)(a.ws + WS_CS) + (size_t)(b * 16 + hh) * 2112, SEG, hh, seg);
    }
}

constexpr int AT_KS = 72, AT_VS = 68, AT_BUF = 18432, AT_VOFF = 9216, AT_COFF = 17920;
struct TileRegs { u32x4 k0, k1, v0, v1; float ck; };

template <bool SAMPLE> __device__ __forceinline__ void attn_load(TileRegs& R, const Args& a, int b, int h, int t, const float* cbase, int tid) {
    const int kvl = tid >> 3, ch = tid & 7, kp = tid >> 4, c4 = tid & 15;
    if (SAMPLE && t < 32) {
        const float* kptr = a.in[I_CK] + (((size_t)b * 2048 + 64 * t + kvl) * 16 + h) * 64 + 8 * ch;
        R.k0 = *(const u32x4*)kptr; R.k1 = *(const u32x4*)(kptr + 4);
        const float* vptr = a.in[I_CV] + (((size_t)b * 2048 + 64 * t + 2 * kp) * 16 + h) * 64 + 4 * c4;
        R.v0 = *(const u32x4*)vptr; R.v1 = *(const u32x4*)(vptr + 1024);
    } else {
        const size_t rowbase = SAMPLE ? (size_t)(MP + b * 64) : (size_t)(b * 2048 + 64 * t);
        const bf16_t* qkv = (const bf16_t*)(a.ws + WS_PROJ);
        R.k0 = *(const u32x4*)(qkv + (rowbase + kvl) * NPJ + 1024 + h * 64 + 8 * ch);
        const bf16_t* vptr = qkv + (rowbase + 2 * kp) * NPJ + 2048 + h * 64 + 4 * c4;
        const u32x2 x0 = *(const u32x2*)vptr, x1 = *(const u32x2*)(vptr + NPJ);
        R.v0.x = x0.x; R.v0.y = x0.y; R.v1.x = x1.x; R.v1.y = x1.y;
    }
    R.ck = cbase[64 * t + (tid & 63)];
}
__device__ __forceinline__ void attn_store(const TileRegs& R, LAS unsigned char* buf, bool f32src, int tid) {
    const int kvl = tid >> 3, ch = tid & 7, kp = tid >> 4, c4 = tid & 15;
    LAS unsigned* VT32 = (LAS unsigned*)(buf + AT_VOFF);
    if (f32src) {
        u32x4 o; o.x = pk(__uint_as_float(R.k0.x), __uint_as_float(R.k0.y)); o.y = pk(__uint_as_float(R.k0.z), __uint_as_float(R.k0.w));
        o.z = pk(__uint_as_float(R.k1.x), __uint_as_float(R.k1.y)); o.w = pk(__uint_as_float(R.k1.z), __uint_as_float(R.k1.w));
        *(LAS u32x4*)(buf + (kvl * AT_KS + 8 * ch) * 2) = o;
#pragma unroll
        for (int i = 0; i < 4; ++i) VT32[(4 * c4 + i) * (AT_VS / 2) + kp] = pk(__uint_as_float(R.v0[i]), __uint_as_float(R.v1[i]));
    } else {
        *(LAS u32x4*)(buf + (kvl * AT_KS + 8 * ch) * 2) = R.k0;
        VT32[(4 * c4 + 0) * (AT_VS / 2) + kp] = (R.v0.x & 0xffffu) | (R.v1.x << 16);
        VT32[(4 * c4 + 1) * (AT_VS / 2) + kp] = (R.v0.x >> 16) | (R.v1.x & 0xffff0000u);
        VT32[(4 * c4 + 2) * (AT_VS / 2) + kp] = (R.v0.y & 0xffffu) | (R.v1.y << 16);
        VT32[(4 * c4 + 3) * (AT_VS / 2) + kp] = (R.v0.y >> 16) | (R.v1.y & 0xffff0000u);
    }
    if (tid < 64) { const float c = -R.ck * LOG2E; const unsigned h1 = f2bf(c); const float r1 = c - bf2f(h1); const unsigned h2 = f2bf(r1); const unsigned h3 = f2bf(r1 - bf2f(h2));
        u32x2 o; o.x = h1 | (h2 << 16); o.y = h3; ((LAS u32x2*)(buf + AT_COFF))[tid] = o; }
}

template <bool QLDS> __device__ __forceinline__ void attn_tile(const LAS unsigned char* buf, const bf16x8 (&qf)[4], const LAS bf16x8* qlds, float cq2, int qpos, int kv0, bool diag, float& mrun, float& lrun, f32x16 (&ot)[2], int l31, int hi) {
    const LAS bf16_t* Ks = (const LAS bf16_t*)buf; const LAS bf16_t* VTs = (const LAS bf16_t*)(buf + AT_VOFF); const LAS u32x2* CKs = (const LAS u32x2*)(buf + AT_COFF);
    f32x16 p0, p1;
#pragma unroll
    for (int r = 0; r < 16; ++r) { p0[r] = cq2; p1[r] = cq2; }
    {
        const u32x2 b0 = CKs[l31], b1 = CKs[32 + l31];
        const unsigned msk = hi ? 0u : 0xffffffffu;
        u32x4 x0; x0.x = b0.x & msk; x0.y = b0.y & msk; x0.z = 0u; x0.w = 0u;
        u32x4 x1; x1.x = b1.x & msk; x1.y = b1.y & msk; x1.z = 0u; x1.w = 0u;
        u32x4 qx; qx.x = 0x3F803F80u & msk; qx.y = 0x00003F80u & msk; qx.z = 0u; qx.w = 0u;
        p0 = MFMA32(__builtin_bit_cast(bf16x8, x0), __builtin_bit_cast(bf16x8, qx), p0); p1 = MFMA32(__builtin_bit_cast(bf16x8, x1), __builtin_bit_cast(bf16x8, qx), p1);
    }
#pragma unroll
    for (int ks = 0; ks < 4; ++ks) { const bf16x8 k0 = *(const LAS bf16x8*)(Ks + l31 * AT_KS + 16 * ks + 8 * hi), k1 = *(const LAS bf16x8*)(Ks + (32 + l31) * AT_KS + 16 * ks + 8 * hi);
        const bf16x8 qq = QLDS ? qlds[ks * 64] : qf[ks];
        p0 = MFMA32(k0, qq, p0); p1 = MFMA32(k1, qq, p1); }
    __builtin_amdgcn_sched_barrier(0);
    if (diag) {
        int qp = qpos - kv0; asm volatile("" : "+v"(qp));
#pragma unroll
        for (int r = 0; r < 16; ++r) { const int kv = crow(r, hi); if (kv > qp) p0[r] = -INFINITY; if (kv + 32 > qp) p1[r] = -INFINITY; }
    }
    float rm = fmaxf(p0[0], p1[0]);
#pragma unroll
    for (int r = 1; r < 16; ++r) rm = fmaxf(rm, fmaxf(p0[r], p1[r]));
    rm = fmaxf(rm, __shfl_xor(rm, 32));
    if (__all(rm < mrun - 40.f)) return;
    const float mn = fmaxf(mrun, rm);
    if (__any(mn > mrun)) {
        const float alpha = __builtin_amdgcn_exp2f(mrun - mn);
        lrun *= alpha;
#pragma unroll
        for (int r = 0; r < 16; ++r) { ot[0][r] *= alpha; ot[1][r] *= alpha; }
        mrun = mn;
    }
    float rs = 0.f;
#pragma unroll
    for (int r = 0; r < 16; ++r) { p0[r] = __builtin_amdgcn_exp2f(p0[r] - mrun); p1[r] = __builtin_amdgcn_exp2f(p1[r] - mrun); rs += p0[r] + p1[r]; }
    lrun += rs;
    bf16x8 pf[4];
    { u32x4 x; x.x = pk(p0[0], p0[1]); x.y = pk(p0[2], p0[3]); x.z = pk(p0[4], p0[5]); x.w = pk(p0[6], p0[7]); pf[0] = __builtin_bit_cast(bf16x8, x);
      x.x = pk(p0[8], p0[9]); x.y = pk(p0[10], p0[11]); x.z = pk(p0[12], p0[13]); x.w = pk(p0[14], p0[15]); pf[1] = __builtin_bit_cast(bf16x8, x);
      x.x = pk(p1[0], p1[1]); x.y = pk(p1[2], p1[3]); x.z = pk(p1[4], p1[5]); x.w = pk(p1[6], p1[7]); pf[2] = __builtin_bit_cast(bf16x8, x);
      x.x = pk(p1[8], p1[9]); x.y = pk(p1[10], p1[11]); x.z = pk(p1[12], p1[13]); x.w = pk(p1[14], p1[15]); pf[3] = __builtin_bit_cast(bf16x8, x); }
    __builtin_amdgcn_sched_barrier(0);
#pragma unroll
    for (int db = 0; db < 2; ++db)
#pragma unroll
        for (int ks = 0; ks < 4; ++ks) { const LAS bf16_t* vp = VTs + (32 * db + l31) * AT_VS + 16 * ks + 4 * hi;
            const u32x2 lo = *(const LAS u32x2*)vp, hh2 = *(const LAS u32x2*)(vp + 8);
            u32x4 x; x.x = lo.x; x.y = lo.y; x.z = hh2.x; x.w = hh2.y;
            ot[db] = MFMA32(__builtin_bit_cast(bf16x8, x), pf[ks], ot[db]); }
}

__device__ __forceinline__ void gld16(u32x4& d, const void* p) { asm volatile("global_load_dwordx4 %0, %1, off" : "=v"(d) : "v"(p)); }
__device__ __forceinline__ void gld8(u32x2& d, const void* p) { asm volatile("global_load_dwordx2 %0, %1, off" : "=v"(d) : "v"(p)); }
__device__ __forceinline__ void gld4(float& d, const void* p) { asm volatile("global_load_dword %0, %1, off" : "=v"(d) : "v"(p)); }
struct PRegs { u32x4 k; u32x2 v0, v1; float ck; };
__device__ __forceinline__ void pload_a(PRegs& R, const Args& a, int b, int h, int t, const float* cbase, int tid) {
    const int kvl = tid >> 3, ch = tid & 7, kp = tid >> 4, c4 = tid & 15;
    const size_t rowbase = (size_t)(b * 2048 + 64 * t);
    const bf16_t* qkv = (const bf16_t*)(a.ws + WS_PROJ);
    gld16(R.k, qkv + (rowbase + kvl) * NPJ + 1024 + h * 64 + 8 * ch);
    const bf16_t* vptr = qkv + (rowbase + 2 * kp) * NPJ + 2048 + h * 64 + 4 * c4;
    gld8(R.v0, vptr); gld8(R.v1, vptr + NPJ);
    gld4(R.ck, cbase + 64 * t + (tid & 63));
}
#define WAIT_P(N, R) asm volatile("s_waitcnt vmcnt(" #N ")" : "+v"(R.k), "+v"(R.v0), "+v"(R.v1), "+v"(R.ck))
__device__ __forceinline__ void pstore(const PRegs& R, LAS unsigned char* buf, int tid) {
    const int kvl = tid >> 3, ch = tid & 7, kp = tid >> 4, c4 = tid & 15;
    LAS unsigned* VT32 = (LAS unsigned*)(buf + AT_VOFF);
    *(LAS u32x4*)(buf + (kvl * AT_KS + 8 * ch) * 2) = R.k;
    VT32[(4 * c4 + 0) * (AT_VS / 2) + kp] = (R.v0.x & 0xffffu) | (R.v1.x << 16);
    VT32[(4 * c4 + 1) * (AT_VS / 2) + kp] = (R.v0.x >> 16) | (R.v1.x & 0xffff0000u);
    VT32[(4 * c4 + 2) * (AT_VS / 2) + kp] = (R.v0.y & 0xffffu) | (R.v1.y << 16);
    VT32[(4 * c4 + 3) * (AT_VS / 2) + kp] = (R.v0.y >> 16) | (R.v1.y & 0xffff0000u);
    if (tid < 64) { const float c = -R.ck * LOG2E; const unsigned h1 = f2bf(c); const float r1 = c - bf2f(h1); const unsigned h2 = f2bf(r1); const unsigned h3 = f2bf(r1 - bf2f(h2));
        u32x2 o; o.x = h1 | (h2 << 16); o.y = h3; ((LAS u32x2*)(buf + AT_COFF))[tid] = o; }
}
__device__ __forceinline__ void attn_unit_prompt(const Args& a, LAS unsigned char* lds, int b, int h, int qb) {
    int tid_ = threadIdx.x; asm volatile("" : "+v"(tid_));
    const int tid = tid_, lane = tid & 63, w = __builtin_amdgcn_readfirstlane(tid >> 6), l31 = lane & 31, hi = lane >> 5;
    const int NT = 4 * (qb + 1);
    const int qpos = 256 * qb + 32 * w + l31;
    const size_t qrow = (size_t)(b * 2048 + qpos);
    const float* cbase = (const float*)(a.ws + WS_CP) + (size_t)(b * 16 + h) * 2048;
    const bf16_t* qkv = (const bf16_t*)(a.ws + WS_PROJ);
    bf16x8 qf[4];
#pragma unroll
    for (int ks = 0; ks < 4; ++ks) qf[ks] = *(const bf16x8*)(qkv + qrow * NPJ + h * 64 + 16 * ks + 8 * hi);
    const float cq2 = cbase[qpos] * LOG2E;
    const int qmax_w = 256 * qb + 32 * w + 31;
    PRegs R0, R1, R2;
    pload_a(R0, a, b, h, NT - 1, cbase, tid); pload_a(R1, a, b, h, NT - 2, cbase, tid); pload_a(R2, a, b, h, NT - 3, cbase, tid);
    WAIT_P(8, R0); pstore(R0, lds, tid);
    pload_a(R0, a, b, h, NT - 4, cbase, tid);
    __syncthreads();
    float mrun = -INFINITY, lrun = 0.f;
    f32x16 ot[2]; ot[0] = f32x16{}; ot[1] = f32x16{};
#define PSTEP(tt, RR) do { if ((tt) < NT) { const int ti_ = NT - 1 - (tt); if (64 * ti_ <= qmax_w) attn_tile<false>(lds + ((tt) & 1) * AT_BUF, qf, nullptr, cq2, qpos, 64 * ti_, ti_ >= 4 * qb, mrun, lrun, ot, l31, hi); \
        { WAIT_P(8, RR); pstore(RR, lds + (((tt) + 1) & 1) * AT_BUF, tid); pload_a(RR, a, b, h, (NT - 5 - (tt)) > 0 ? NT - 5 - (tt) : 0, cbase, tid); } \
        __syncthreads(); } } while (0)
#pragma unroll 1
    for (int t = 0; t < NT; t += 3) { PSTEP(t, R1); PSTEP(t + 1, R2); PSTEP(t + 2, R0); }
#undef PSTEP
    WAIT_P(0, R0); WAIT_P(0, R1); WAIT_P(0, R2);
    lrun += __shfl_xor(lrun, 32);
    const float inv = 1.f / lrun;
    bf16_t* og = (bf16_t*)(a.ws + WS_OG) + qrow * DM + h * 64;
#pragma unroll
    for (int db = 0; db < 2; ++db)
#pragma unroll
        for (int j = 0; j < 4; ++j) { u32x2 o; o.x = pk(ot[db][4 * j] * inv, ot[db][4 * j + 1] * inv); o.y = pk(ot[db][4 * j + 2] * inv, ot[db][4 * j + 3] * inv);
            *(u32x2*)(og + 32 * db + 8 * j + 4 * hi) = o; }
}

struct TileRegs2 { u32x4 k[4], v[4]; float ck; };
__device__ __forceinline__ void sload2(TileRegs2& R, const Args& a, int b, int h, int t, const float* cbase, int st) {
#pragma unroll
    for (int q = 0; q < 2; ++q) {
        const int item = st + 256 * q, kvl = item >> 3, ch = item & 7, kp = item >> 4, c4 = item & 15;
        if (t < 32) {
            const float* kptr = a.in[I_CK] + (((size_t)b * 2048 + 64 * t + kvl) * 16 + h) * 64 + 8 * ch;
            R.k[2 * q] = *(const u32x4*)kptr; R.k[2 * q + 1] = *(const u32x4*)(kptr + 4);
            const float* vptr = a.in[I_CV] + (((size_t)b * 2048 + 64 * t + 2 * kp) * 16 + h) * 64 + 4 * c4;
            R.v[2 * q] = *(const u32x4*)vptr; R.v[2 * q + 1] = *(const u32x4*)(vptr + 1024);
        } else {
            const size_t rowbase = (size_t)(MP + b * 64);
            const bf16_t* qkv = (const bf16_t*)(a.ws + WS_PROJ);
            R.k[2 * q] = *(const u32x4*)(qkv + (rowbase + kvl) * NPJ + 1024 + h * 64 + 8 * ch);
            const bf16_t* vptr = qkv + (rowbase + 2 * kp) * NPJ + 2048 + h * 64 + 4 * c4;
            const u32x2 x0 = *(const u32x2*)vptr, x1 = *(const u32x2*)(vptr + NPJ);
            R.v[2 * q].x = x0.x; R.v[2 * q].y = x0.y; R.v[2 * q + 1].x = x1.x; R.v[2 * q + 1].y = x1.y;
        }
    }
    R.ck = cbase[64 * t + (st & 63)];
}
__device__ __forceinline__ void sload2a(TileRegs2& R, const Args& a, int b, int h, int t, const float* cbase, int st) {
#pragma unroll
    for (int q = 0; q < 2; ++q) {
        const int item = st + 256 * q, kvl = item >> 3, ch = item & 7, kp = item >> 4, c4 = item & 15;
        const float* kptr = a.in[I_CK] + (((size_t)b * 2048 + 64 * t + kvl) * 16 + h) * 64 + 8 * ch;
        gld16(R.k[2 * q], kptr); gld16(R.k[2 * q + 1], kptr + 4);
        const float* vptr = a.in[I_CV] + (((size_t)b * 2048 + 64 * t + 2 * kp) * 16 + h) * 64 + 4 * c4;
        gld16(R.v[2 * q], vptr); gld16(R.v[2 * q + 1], vptr + 1024);
    }
    gld4(R.ck, cbase + 64 * t + (st & 63));
}
#define WAIT_R2(N, R) asm volatile("s_waitcnt vmcnt(" #N ")" : "+v"(R.k[0]), "+v"(R.k[1]), "+v"(R.k[2]), "+v"(R.k[3]), "+v"(R.v[0]), "+v"(R.v[1]), "+v"(R.v[2]), "+v"(R.v[3]), "+v"(R.ck))
__device__ __forceinline__ void sstore2(const TileRegs2& R, LAS unsigned char* buf, bool f32src, int st) {
    LAS unsigned* VT32 = (LAS unsigned*)(buf + AT_VOFF);
#pragma unroll
    for (int q = 0; q < 2; ++q) {
        const int item = st + 256 * q, kvl = item >> 3, ch = item & 7, kp = item >> 4, c4 = item & 15;
        if (f32src) {
            const u32x4 k0 = R.k[2 * q], k1 = R.k[2 * q + 1];
            u32x4 o; o.x = pk(__uint_as_float(k0.x), __uint_as_float(k0.y)); o.y = pk(__uint_as_float(k0.z), __uint_as_float(k0.w));
            o.z = pk(__uint_as_float(k1.x), __uint_as_float(k1.y)); o.w = pk(__uint_as_float(k1.z), __uint_as_float(k1.w));
            *(LAS u32x4*)(buf + (kvl * AT_KS + 8 * ch) * 2) = o;
#pragma unroll
            for (int i = 0; i < 4; ++i) VT32[(4 * c4 + i) * (AT_VS / 2) + kp] = pk(__uint_as_float(R.v[2 * q][i]), __uint_as_float(R.v[2 * q + 1][i]));
        } else {
            *(LAS u32x4*)(buf + (kvl * AT_KS + 8 * ch) * 2) = R.k[2 * q];
            const u32x4 v0 = R.v[2 * q], v1 = R.v[2 * q + 1];
            VT32[(4 * c4 + 0) * (AT_VS / 2) + kp] = (v0.x & 0xffffu) | (v1.x << 16);
            VT32[(4 * c4 + 1) * (AT_VS / 2) + kp] = (v0.x >> 16) | (v1.x & 0xffff0000u);
            VT32[(4 * c4 + 2) * (AT_VS / 2) + kp] = (v0.y & 0xffffu) | (v1.y << 16);
            VT32[(4 * c4 + 3) * (AT_VS / 2) + kp] = (v0.y >> 16) | (v1.y & 0xffff0000u);
        }
    }
    if (st < 64) { const float c = -R.ck * LOG2E; const unsigned h1 = f2bf(c); const float r1 = c - bf2f(h1); const unsigned h2 = f2bf(r1); const unsigned h3 = f2bf(r1 - bf2f(h2));
        u32x2 o; o.x = h1 | (h2 << 16); o.y = h3; ((LAS u32x2*)(buf + AT_COFF))[st] = o; }
}
__device__ __forceinline__ void attn_unit_sample(const Args& a, LAS unsigned char* lds, int b, int h) {
    int tid_ = threadIdx.x; asm volatile("" : "+v"(tid_));
    const int tid = tid_, lane = tid & 63, w = __builtin_amdgcn_readfirstlane(tid >> 6), l31 = lane & 31, hi = lane >> 5;
    const float* cbase = (const float*)(a.ws + WS_CS) + (size_t)(b * 16 + h) * 2112;
    if (w >= 2 && w < 6) {
        const int st = tid - 128;
        TileRegs2 R0, R1, R2, R3;
        sload2(R0, a, b, h, 32, cbase, st); sload2a(R1, a, b, h, 31, cbase, st); sload2a(R2, a, b, h, 30, cbase, st); sload2a(R3, a, b, h, 29, cbase, st);
        sstore2(R0, lds, false, st);
        sload2a(R0, a, b, h, 28, cbase, st);
        __syncthreads();
#define SSTEP(tt, RR) do { WAIT_R2(27, RR); sstore2(RR, lds + (((tt) + 1) & 1) * AT_BUF, true, st); sload2a(RR, a, b, h, (27 - (tt)) > 0 ? 27 - (tt) : 0, cbase, st); __syncthreads(); } while (0)
#pragma unroll 1
        for (int t = 0; t < 32; t += 4) { SSTEP(t, R1); SSTEP(t + 1, R2); SSTEP(t + 2, R3); SSTEP(t + 3, R0); }
        SSTEP(32, R1);
#undef SSTEP
        WAIT_R2(0, R0); WAIT_R2(0, R1); WAIT_R2(0, R2); WAIT_R2(0, R3);
    } else {
        const bool active = w < 2;
        const int qpos = 2048 + 32 * (w & 1) + l31;
        const size_t qrow = (size_t)(MP + b * 64 + 32 * (w & 1) + l31);
        const bf16_t* qkv = (const bf16_t*)(a.ws + WS_PROJ);
        bf16x8 qf[4];
#pragma unroll
        for (int ks = 0; ks < 4; ++ks) qf[ks] = *(const bf16x8*)(qkv + qrow * NPJ + h * 64 + 16 * ks + 8 * hi);
        const float cq2 = cbase[qpos] * LOG2E;
        float mrun = -INFINITY, lrun = 0.f;
        f32x16 ot[2]; ot[0] = f32x16{}; ot[1] = f32x16{};
        __syncthreads();
#pragma unroll 1
        for (int tt = 0; tt < 33; ++tt) {
            if (active) attn_tile<false>(lds + (tt & 1) * AT_BUF, qf, nullptr, cq2, qpos, 64 * (32 - tt), tt == 0, mrun, lrun, ot, l31, hi);
            __syncthreads();
        }
        if (active) {
            lrun += __shfl_xor(lrun, 32);
            const float inv = 1.f / lrun;
            bf16_t* og = (bf16_t*)(a.ws + WS_OG) + qrow * DM + h * 64;
#pragma unroll
            for (int db = 0; db < 2; ++db)
#pragma unroll
                for (int j = 0; j < 4; ++j) { u32x2 o; o.x = pk(ot[db][4 * j] * inv, ot[db][4 * j + 1] * inv); o.y = pk(ot[db][4 * j + 2] * inv, ot[db][4 * j + 3] * inv);
                    *(u32x2*)(og + 32 * db + 8 * j + 4 * hi) = o; }
        }
    }
}

__device__ __forceinline__ void fox_attention(const Args& a, LAS unsigned char* lds, int vcu, int G) {
#pragma unroll 1
    for (int pass = 0; pass < 2; ++pass) {
        if ((pass ^ (vcu & 1)) == 0) {
#ifdef ATT_DUP_PROMPT
          for (int rep2_ = 0; rep2_ < 2; ++rep2_)
#endif
            if (G == 256) {
                const int bh = vcu >> 1, s0 = 2 * (vcu & 1);
#pragma unroll 1
                for (int i = 0; i < 4; ++i) attn_unit_prompt(a, lds, bh >> 4, bh & 15, (i & 1) ? s0 + (i >> 1) : 7 - s0 - (i >> 1));
            } else {
#pragma unroll 1
                for (int u = vcu; u < 1024; u += G) attn_unit_prompt(a, lds, (u & 127) >> 4, u & 15, 7 - (u >> 7));
            }
        } else {
#ifdef ATT_DUP_SAMPLE
            for (int rep3_ = 0; rep3_ < 2; ++rep3_)
#endif
#pragma unroll 1
            for (int u = vcu; u < 512; u += G) attn_unit_sample(a, lds, u >> 4, u & 15);
        }
    }
}

#ifndef PH_MASK
#define PH_MASK 0x7fff
#endif
#define IN(k) (((PH_MASK >> (k)) & 1) && a.ph_lo <= (k) && (k) < a.ph_hi)
#define SEAM(k) do { if (IN(k) && IN((k) + 1)) { if ((k) == 0 && a.ph_hi < 0) cg::this_grid().sync(); xcd_barrier(xbar); } } while (0)
#ifndef DUP_MASK
#define DUP_MASK 0
#endif
#define REP(k) _Pragma("unroll 1") for (int rep_ = 0; rep_ < ((((DUP_MASK) >> (k)) & 1) ? 2 : 1); ++rep_)
#define REPSYNC(k) do { if ((((DUP_MASK) >> (k)) & 1)) xcd_barrier(xbar); } while (0)
struct SliceOrder {
    int pm, pn;
    __device__ __forceinline__ bool next(int i, pg8::Unit& u) const { if (i > 0) return false; u.pm = pm; u.pn = pn; return true; }
    __device__ __forceinline__ void a_ready(const pg8::Unit&) const {}
    __device__ __forceinline__ void done(const pg8::Unit&) const {}
};
struct EpiPartial {
    static constexpr bool PERM = true, AFTER_DRAIN = false;
    float* part;
    __device__ __forceinline__ void operator()(const pg8::f32x4 (&acc)[2][2][4][2], const pg8::Unit& u, int wr, int wc, int fr, int fq) const {
#pragma unroll
        for (int ai = 0; ai < 2; ++ai)
#pragma unroll
            for (int m = 0; m < 4; ++m) { float* rowp = part + (size_t)(ai * 128 + wr * 64 + m * 16 + fr) * 256 + wc * 32 + 8 * fq;
#pragma unroll
                for (int bj = 0; bj < 2; ++bj) { *(f32x4*)(rowp + bj * 128) = acc[ai][bj][m][0]; *(f32x4*)(rowp + bj * 128 + 4) = acc[ai][bj][m][1]; } }
    }
};
__device__ __forceinline__ void ffd_sample_rows(const Args& a, int vcu, int G, float* ssout) {
    const int tid = threadIdx.x, lane = tid & 63, wave = tid >> 6;
    const int gw = vcu * 8 + wave, NGW = G * 8;
    float* XR = (float*)(a.ws + WS_XR); bf16_t* XB = (bf16_t*)(a.ws + WS_XB); const float* PART = (const float*)(a.ws + WS_PART);
    for (int r = gw; r < MS; r += NGW) {
        const int pml = r >> 8, rr = r & 255; const size_t row = (size_t)(MP + r);
        f32x4 acc[4];
#pragma unroll
        for (int pn = 0; pn < 4; ++pn) { acc[pn] = *(const f32x4*)(XR + row * DM + pn * 256 + 4 * lane);
#pragma unroll
            for (int sl = 0; sl < 8; ++sl) acc[pn] += *(const f32x4*)(PART + ((size_t)((pml * 4 + pn) * 8 + sl) * 256 + rr) * 256 + 4 * lane); }
        float sq = 0.f;
#pragma unroll
        for (int pn = 0; pn < 4; ++pn) { sq += dot4(acc[pn]); *(f32x4*)(XR + row * DM + pn * 256 + 4 * lane) = acc[pn];
            u32x2 o; o.x = pk(acc[pn][0], acc[pn][1]); o.y = pk(acc[pn][2], acc[pn][3]); *(u32x2*)(XB + row * DM + pn * 256 + 4 * lane) = o; }
        sq = wave_sum(sq);
        if (lane == 0) ssout[row] = sq;
    }
}
template <int L> __device__ __forceinline__ void common_gemms(const Args& a, LAS unsigned char* lds, int G, int bx, const XcdBarrier& xbar) {
    unsigned char* ws = a.ws;
    float* SS = (float*)(ws + WS_SS);
    bf16_t* XB = (bf16_t*)(ws + WS_XB); float* XR = (float*)(ws + WS_XR); bf16_t* OG = (bf16_t*)(ws + WS_OG); bf16_t* ACT = (bf16_t*)(ws + WS_ACT);
    constexpr int po = L ? 11 : 5;
    if (IN(po)) { pg8::Gemm g{OG, (const bf16_t*)(ws + (L ? WS_WFOUT : WS_WGOUT)), MT, DM, DM}; pg8::StaticOrder S; S.init(MT, DM, G, bx);
        EpiResid E{L ? XR : a.in[I_XP], L ? XR + (size_t)MP * DM : a.in[I_XS], XR, XB, SS + (L ? 3 : 1) * 32768};
        pg8::gemm_phase<EpiResid, pg8::StaticOrder, true, true>(lds, g, S, E);
        if (L == 0 && G == 256 && !MK_MULTI && bx >= 32) convert_weights(a, lds, 1, (bx - 32) * 8 + (int)(threadIdx.x >> 6), 224 * 8); }
    SEAM(po);
    if (IN(po + 1)) REP(po + 1) { pg8::Gemm g{XB, (const bf16_t*)(ws + WS_WFFI + (size_t)L * 11 * MiB), MT, 2 * DFF, DM}; pg8::StaticOrder S; S.init(MT, 2 * DFF, G, bx);
        EpiSwiglu E{SS + (L ? 3 : 1) * 32768, ACT}; pg8::gemm_phase<EpiSwiglu, pg8::StaticOrder, true, true>(lds, g, S, E); REPSYNC(po + 1); }
    SEAM(po + 1);
    if (IN(po + 2)) {
        const bf16_t* W = (const bf16_t*)(ws + WS_WFFD + (size_t)L * 6 * MiB);
        if (G == 256 && !MK_MULTI) {
            { pg8::Gemm g{ACT, W, MP, DM, DFF, 0}; pg8::StaticOrder S; S.init(MP, DM, G, bx);
              EpiResid E{XR, XR + (size_t)MP * DM, XR, XB, SS + (L ? 4 : 2) * 32768};
              pg8::gemm_phase<EpiResid, pg8::StaticOrder, true, true>(lds, g, S, E); }
            { const int un = bx >> 3, sl = bx & 7, kb0 = (sl < 6) ? 3 * sl : 18 + 2 * (sl - 6), kbn = (sl < 6) ? 3 : 2;
              pg8::Gemm g{ACT + 128 * kb0, W + 128 * kb0, MT, DM, 128 * kbn, DFF}; SliceOrder S{64 + (un >> 2), un & 3};
              EpiPartial E{(float*)(ws + WS_PART) + (size_t)(un * 8 + sl) * 65536};
              pg8::gemm_phase<EpiPartial, SliceOrder, true, true>(lds, g, S, E); }
            xcd_barrier(xbar);
            ffd_sample_rows(a, (bx % 8) * (G / 8) + bx / 8, G, SS + (L ? 4 : 2) * 32768);
        } else {
            pg8::Gemm g{ACT, W, MT, DM, DFF, 0}; pg8::StaticOrder S; S.init(MT, DM, G, bx);
            EpiResid E{XR, XR + (size_t)MP * DM, XR, XB, SS + (L ? 4 : 2) * 32768};
            pg8::gemm_phase<EpiResid, pg8::StaticOrder, true, true>(lds, g, S, E);
        }
    }
    SEAM(po + 2);
}
constexpr int NPH = 15;
__global__ void __launch_bounds__(512, 2) fwd(Args a) {
    extern __shared__ __attribute__((aligned(16))) unsigned char lds_raw[];
    LAS unsigned char* lds = (LAS unsigned char*)lds_raw;
    const int G = gridDim.x, bx = blockIdx.x;
    const int vcu = (G % 8 == 0) ? (bx % 8) * (G / 8) + bx / 8 : bx;
    unsigned char* ws = a.ws;
    float* SS = (float*)(ws + WS_SS);
    bf16_t* XB = (bf16_t*)(ws + WS_XB); bf16_t* PROJ = (bf16_t*)(ws + WS_PROJ);

    volatile LAS unsigned* MISC = (volatile LAS unsigned*)(lds + 131072);
    if (threadIdx.x < 64) MISC[threadIdx.x] = 0u;
    __syncthreads();
    XcdBarrier xbar; xbar.bar = (unsigned*)ws; xbar.x = 0; xbar.st = nullptr;
    if (a.ph_hi - a.ph_lo > 1) xbar = xcd_barrier_post((unsigned*)ws, MISC + 8);
    if (IN(0)) REP(0) { p0_prologue(a, lds, vcu, G); REPSYNC(0); }
    SEAM(0);
    if (IN(1)) { pg8::Gemm g{XB, (const bf16_t*)(ws + WS_WGIN), MT, NPROJ, DM}; pg8::StaticOrder S; S.init(MT, NPROJ, G, bx);
        EpiGlaProj E{SS, PROJ, (float*)(ws + WS_GL)}; pg8::gemm_phase<EpiGlaProj, pg8::StaticOrder, true, true>(lds, g, S, E); }
    SEAM(1);
    if (IN(2)) REP(2) {
        if (G == 256 && !MK_MULTI) {
            GlaPre pf; gla_prefetch(pf, a, vcu >> 2, vcu & 3);
            const int it4 = 1024 + (vcu & 127);
#pragma unroll 1
            for (int it = vcu; it < 1024; it += G) gla_item<0>(a, lds, it >> 2, it & 3, pf, (it + G < 1024) ? it + G : it4);
            if (vcu < 128) gla_item<0>(a, lds, it4 >> 2, it4 & 3, pf, -1);
            else gla_item<1>(a, lds, it4 >> 2, it4 & 3, pf, -1);
        } else {
            GlaPre pf; if (vcu < 1152) gla_prefetch(pf, a, vcu >> 2, vcu & 3);
#pragma unroll 1
            for (int it = vcu; it < 1152; it += G) gla_item<0>(a, lds, it >> 2, it & 3, pf, (it + G < 1152) ? it + G : -1);
        }
        REPSYNC(2); }
    SEAM(2);
    if (IN(3)) REP(3) { gla_scan(a, vcu, G); REPSYNC(3); }
    SEAM(3);
    if (IN(4)) REP(4) {
        { const int nit = (G == 256 && !MK_MULTI) ? 1024 : 1152;
        GlaPre pf; if (vcu < nit) gla_prefetch(pf, a, vcu >> 2, vcu & 3);
#pragma unroll 1
        for (int it = vcu; it < nit; it += G) gla_item<1>(a, lds, it >> 2, it & 3, pf, (it + G < nit) ? it + G : -1); }
        REPSYNC(4); }
    SEAM(4);
    common_gemms<0>(a, lds, G, bx, xbar);
    if (IN(8)) { pg8::Gemm g{XB, (const bf16_t*)(ws + WS_WFIN), MT, NPROJ, DM}; pg8::StaticOrder S; S.init(MT, NPROJ, G, bx);
        EpiFoxProj E{SS + 2 * 32768, PROJ, a.out, a.in[I_FBF]}; pg8::gemm_phase<EpiFoxProj, pg8::StaticOrder, true, true>(lds, g, S, E); }
    SEAM(8);
    if (IN(9)) REP(9) { fox_cumsum(a, lds, vcu, G); REPSYNC(9); }
    SEAM(9);
    if (IN(10)) REP(10) { fox_attention(a, lds, vcu, G); REPSYNC(10); }
    SEAM(10);
    common_gemms<1>(a, lds, G, bx, xbar);
#ifdef EXTRA_SYNCS
    for (int i_ = 0; i_ < EXTRA_SYNCS; ++i_) xcd_barrier(xbar);
#endif
    if (IN(14)) p_final(a, vcu, G);
#undef IN
#undef SEAM
}

extern "C" void kernel_launch(void* const* d_in, const int* in_sizes, int n_in, void* d_out, int out_size, void* d_ws, size_t ws_size, hipStream_t stream) {
    static int grid = 0;
    if (grid == 0) {
        if (n_in != 19 || ws_size < WS_END || out_size != 62160896) { fprintf(stderr, "kernel_launch: unexpected problem shape (n_in %d, out %d, ws %zu)\n", n_in, out_size, ws_size); grid = -1; return; }
        if (hipFuncSetAttribute((const void*)fwd, hipFuncAttributeMaxDynamicSharedMemorySize, LDS_BYTES) != hipSuccess) { fprintf(stderr, "kernel_launch: hipFuncSetAttribute failed\n"); grid = -1; return; }
        int dev = 0, cus = 0, per_cu = 0;
        (void)hipGetDevice(&dev); (void)hipDeviceGetAttribute(&cus, hipDeviceAttributeMultiprocessorCount, dev);
        (void)hipOccupancyMaxActiveBlocksPerMultiprocessor(&per_cu, (const void*)fwd, 512, LDS_BYTES);
        (void)hipGetLastError();
        if (per_cu < 1) per_cu = 1;
        grid = cus * 1;
        if (grid <= 0) grid = 256;
    }
    if (grid < 0) return;
    (void)hipMemsetAsync((char*)d_ws + WS_CTL, 0, CTL_BYTES, stream);
    Args a{};
    for (int i = 0; i < 19; ++i) a.in[i] = (const float*)d_in[i];
    a.out = (float*)d_out; a.ws = (unsigned char*)d_ws;
#if MK_MULTI
    for (int ph = 0; ph < NPH; ++ph) { a.ph_lo = ph; a.ph_hi = ph + 1; hipLaunchKernelGGL(fwd, dim3(grid), dim3(512), LDS_BYTES, stream, a); }
#else
    a.ph_lo = 0; a.ph_hi = NPH;
    void* args[] = {&a};
    hipError_t e = hipLaunchCooperativeKernel((const void*)fwd, dim3(grid), dim3(512), args, LDS_BYTES, stream);
    if (e != hipSuccess) fprintf(stderr, "kernel_launch: cooperative launch failed: %s (grid %d)\n", hipGetErrorString(e), grid);
#endif
}
```

```cpp
#include <hip/hip_runtime.h>
#include <hip/hip_cooperative_groups.h>
#include <cstdio>
#include <cstdint>
#include <cmath>
namespace cg = cooperative_groups;
#define MK_MULTI 0
namespace pg8 {
#define PG8_LAS __attribute__((address_space(3)))
typedef unsigned short bf16_t;
typedef short bf16x8 __attribute__((ext_vector_type(8)));
typedef float f32x4 __attribute__((ext_vector_type(4)));
typedef unsigned u32x4 __attribute__((ext_vector_type(4)));
constexpr int BM = 256, BK = 64, HALF = 128, HTB = HALF * BK * 2  , STAGE_BYTES = 8 * HTB, NXCD = 8, WGM = 8;

__host__ __device__ __forceinline__ int lds_byte(int r, int c) { const int st = (r >> 4) * 2 + (c >> 5), rr = r & 15, cc = c & 31, ob = rr * 64 + cc * 2; return st * 1024 + (ob ^ (((ob >> 9) & 1) << 5)); }
__host__ __device__ __forceinline__ void stage_rc(int b, int& R, int& C) { const int st = b / 1024, sb = b % 1024, swz = sb ^ (((sb >> 9) & 1) << 5); R = (st >> 1) * 16 + swz / 64; C = (st & 1) * 32 + (swz % 64) / 2; }
__host__ __device__ __forceinline__ int perm32(int rho) { const int n = rho >> 4, i = rho & 15; return 8 * (i >> 2) + 4 * n + (i & 3); }

struct Unit { int pm, pn; };
struct Gemm { const bf16_t* A; const bf16_t* Bt; int M, N, K; int ld; };

struct StaticOrder {
    int nM, nN, nwg, G, c;
    __host__ __device__ void init(int M, int N, int G_, int c_) { nM = M / BM; nN = N / BM; nwg = nM * nN; G = G_; c = c_; }
    __host__ __device__ bool next(int i, Unit& u) const {
        const long L = (long)i * G + c; if (L >= nwg) return false;
        int wgid = (int)L; { const int q = nwg / NXCD, r = nwg % NXCD, xcd = wgid % NXCD, off = wgid / NXCD; wgid = (xcd < r ? xcd * (q + 1) : r * (q + 1) + (xcd - r) * q) + off; }
        const int nig = WGM * nN, gid = wgid / nig, fm = gid * WGM, gsz = (nM - fm) < WGM ? (nM - fm) : WGM;
        u.pm = fm + ((wgid % nig) % gsz); u.pn = (wgid % nig) / gsz; return true;
    }
    __device__ __forceinline__ void a_ready(const Unit&) const {}
    __device__ __forceinline__ void done(const Unit&) const {}
};

__device__ __forceinline__ unsigned cvt_pk_bf16(float lo, float hi) { unsigned r; asm volatile("v_cvt_pk_bf16_f32 %0, %1, %2" : "=v"(r) : "v"(lo), "v"(hi)); return r; }
template <class Epi, class Sched, bool ALIGN_EPI = false, bool SP2 = false>
__device__ __forceinline__ void gemm_phase(PG8_LAS unsigned char* lds, const Gemm g, const Sched& S, const Epi& E) {
    const int tid = threadIdx.x, wid = __builtin_amdgcn_readfirstlane(tid >> 6), lane = tid & 63, wr = wid >> 2, wc = wid & 3, fr = lane & 15, fq = lane >> 4;
    const int K = g.ld ? g.ld : g.K, nt = g.K / BK;
    unsigned voffA[2], voffB[2];
#pragma unroll
    for (int i = 0; i < 2; ++i) { int R, C; stage_rc(tid * 16 + i * 8192, R, C); const int Rb = Epi::PERM ? ((R & ~31) + perm32(R & 31)) : R;
        voffA[i] = (unsigned)(R * K + C) * 2u; voffB[i] = (unsigned)(Rb * K + C) * 2u; }
    const size_t kstep = (size_t)(BK * 2);
    const size_t hstep = (size_t)HALF * K * 2;
    const size_t tstep = 2 * hstep;
    const unsigned ldsw = (unsigned)wid * 1024u;
    const int aoff = lds_byte(wr * 64 + fr, fq * 8), boff = lds_byte(wc * 32 + fr, fq * 8);
#define PG8_SA(b, h) (((b) * 2 + (h)) * HTB)
#define PG8_SB(b, h) ((4 + (b) * 2 + (h)) * HTB)
#define PG8_STAGE(bufoff, gbase, voff) do { _Pragma("unroll") for (int _i = 0; _i < 2; ++_i) \
        __builtin_amdgcn_global_load_lds((const unsigned*)((const char*)(gbase) + (voff)[_i]), (PG8_LAS unsigned*)(lds + (bufoff) + ldsw + _i * 8192), 16, 0, 0); } while (0)
#define PG8_LDA(dst, b, h) do { _Pragma("unroll") for (int m = 0; m < 4; ++m) _Pragma("unroll") for (int k = 0; k < 2; ++k) dst[m][k] = *(const PG8_LAS bf16x8*)(lds + PG8_SA(b, h) + aoff + m * 2048 + k * 1024); } while (0)
#define PG8_LDB(dst, b, h) do { _Pragma("unroll") for (int n = 0; n < 2; ++n) _Pragma("unroll") for (int k = 0; k < 2; ++k) dst[n][k] = *(const PG8_LAS bf16x8*)(lds + PG8_SB(b, h) + boff + n * 2048 + k * 1024); } while (0)
#define PG8_MMA(ai, bj, At, Bt) do { __builtin_amdgcn_s_setprio(1); _Pragma("unroll") for (int m = 0; m < 4; ++m) _Pragma("unroll") for (int n = 0; n < 2; ++n) _Pragma("unroll") for (int k = 0; k < 2; ++k) \
        acc[ai][bj][m][n] = __builtin_amdgcn_mfma_f32_16x16x32_bf16(Bt[n][k], At[m][k], acc[ai][bj][m][n], 0, 0, 0); __builtin_amdgcn_s_setprio(0); } while (0)
#define PG8_WAIT_V(n) asm volatile("s_waitcnt vmcnt(" #n ")" ::: "memory")
#define PG8_WAIT_L(n) asm volatile("s_waitcnt lgkmcnt(" #n ")" ::: "memory")
#define PG8_BAR __builtin_amdgcn_s_barrier()
#define PG8_SCHED __builtin_amdgcn_sched_barrier(0)
    Unit cur, nxt; int ui = 0;
    if (!S.next(0, cur)) return;
    f32x4 acc[2][2][4][2];
#pragma unroll
    for (int a = 0; a < 2; ++a)
#pragma unroll
        for (int b = 0; b < 2; ++b)
#pragma unroll
            for (int m = 0; m < 4; ++m)
#pragma unroll
                for (int n = 0; n < 2; ++n) acc[a][b][m][n] = (f32x4){0.f, 0.f, 0.f, 0.f};
    bf16x8 At[4][2], B0[2][2], B1[2][2];
    const char* cA = (const char*)g.A + (size_t)cur.pm * tstep; const char* cB = (const char*)g.Bt + (size_t)cur.pn * tstep;
    S.a_ready(cur);
    if constexpr (SP2) {
        PG8_STAGE(PG8_SB(0, 0), cB, voffB); PG8_STAGE(PG8_SB(0, 1), cB + hstep, voffB); PG8_STAGE(PG8_SA(0, 0), cA, voffA); PG8_STAGE(PG8_SA(0, 1), cA + hstep, voffA);
        if (wr == 1) PG8_BAR;
        PG8_WAIT_V(2); PG8_BAR;
        PG8_STAGE(PG8_SB(1, 0), cB + kstep, voffB); PG8_STAGE(PG8_SA(1, 0), cA + kstep, voffA); PG8_STAGE(PG8_SB(1, 1), cB + hstep + kstep, voffB);
        PG8_WAIT_V(6); PG8_BAR;
    } else {
        PG8_STAGE(PG8_SB(0, 0), cB, voffB); PG8_STAGE(PG8_SA(0, 0), cA, voffA); PG8_STAGE(PG8_SB(0, 1), cB + hstep, voffB); PG8_STAGE(PG8_SA(0, 1), cA + hstep, voffA);
        if (wr == 1) PG8_BAR;
        PG8_WAIT_V(4); PG8_BAR;
        PG8_STAGE(PG8_SB(1, 0), cB + kstep, voffB); PG8_STAGE(PG8_SA(1, 0), cA + kstep, voffA); PG8_STAGE(PG8_SB(1, 1), cB + hstep + kstep, voffB);
        PG8_WAIT_V(6); PG8_BAR;
    }
    for (;;) {
        const bool has_next = S.next(ui + 1, nxt);
        const char* nA = has_next ? (const char*)g.A + (size_t)nxt.pm * tstep : cA; const char* nB = has_next ? (const char*)g.Bt + (size_t)nxt.pn * tstep : cB;
        for (int t = 0; t < nt; t += 2) {
            const bool last = (t == nt - 2);
            const char* a1 = cA + (size_t)(t + 1) * kstep;
            const char* a2 = last ? nA : cA + (size_t)(t + 2) * kstep; const char* b2 = last ? nB : cB + (size_t)(t + 2) * kstep;
            const char* a3 = a2 + kstep; const char* b3 = b2 + kstep;
            if (last && has_next) S.a_ready(nxt);
            if constexpr (SP2) {
            PG8_LDB(B0, 0, 0); PG8_LDB(B1, 0, 1); PG8_SCHED; PG8_LDA(At, 0, 0); PG8_STAGE(PG8_SA(1, 1), a1 + hstep, voffA);
            PG8_WAIT_V(8); PG8_WAIT_L(0); PG8_BAR; PG8_MMA(0, 0, At, B0); PG8_MMA(0, 1, At, B1); PG8_BAR; PG8_SCHED;
            PG8_LDA(At, 0, 1); PG8_STAGE(PG8_SB(0, 0), b2, voffB); PG8_STAGE(PG8_SB(0, 1), b2 + hstep, voffB); PG8_STAGE(PG8_SA(0, 0), a2, voffA);
            PG8_WAIT_V(8); PG8_WAIT_L(0); PG8_BAR; PG8_MMA(1, 0, At, B0); PG8_MMA(1, 1, At, B1); PG8_BAR; PG8_SCHED;
            PG8_LDB(B0, 1, 0); PG8_LDB(B1, 1, 1); PG8_SCHED; PG8_LDA(At, 1, 0); PG8_STAGE(PG8_SA(0, 1), a2 + hstep, voffA);
            PG8_WAIT_V(8); PG8_WAIT_L(0); PG8_BAR; PG8_MMA(0, 0, At, B0); PG8_MMA(0, 1, At, B1); PG8_BAR; PG8_SCHED;
            PG8_LDA(At, 1, 1); PG8_STAGE(PG8_SB(1, 0), b3, voffB); PG8_STAGE(PG8_SB(1, 1), b3 + hstep, voffB); PG8_STAGE(PG8_SA(1, 0), a3, voffA);
            PG8_WAIT_V(8); PG8_WAIT_L(0); PG8_BAR; PG8_MMA(1, 0, At, B0); PG8_MMA(1, 1, At, B1); PG8_BAR; PG8_SCHED;
            } else {
            PG8_LDB(B0, 0, 0); PG8_SCHED; PG8_LDA(At, 0, 0); PG8_STAGE(PG8_SA(1, 1), a1 + hstep, voffA);
            PG8_WAIT_L(8); PG8_BAR; PG8_WAIT_L(0); PG8_MMA(0, 0, At, B0); PG8_BAR; PG8_SCHED;
            PG8_LDB(B1, 0, 1); PG8_STAGE(PG8_SB(0, 0), b2, voffB);
            PG8_BAR; PG8_WAIT_L(0); PG8_MMA(0, 1, At, B1); PG8_BAR;
            PG8_LDA(At, 0, 1); PG8_STAGE(PG8_SA(0, 0), a2, voffA);
            PG8_BAR; PG8_WAIT_L(0); PG8_MMA(1, 0, At, B0); PG8_BAR; PG8_SCHED;
            PG8_STAGE(PG8_SB(0, 1), b2 + hstep, voffB);
            PG8_WAIT_V(6); PG8_BAR; PG8_MMA(1, 1, At, B1); PG8_BAR;
            PG8_LDB(B0, 1, 0); PG8_SCHED; PG8_LDA(At, 1, 0); PG8_STAGE(PG8_SA(0, 1), a2 + hstep, voffA);
            PG8_WAIT_L(8); PG8_BAR; PG8_WAIT_L(0); PG8_MMA(0, 0, At, B0); PG8_BAR; PG8_SCHED;
            PG8_LDB(B1, 1, 1); PG8_STAGE(PG8_SB(1, 0), b3, voffB);
            PG8_BAR; PG8_WAIT_L(0); PG8_MMA(0, 1, At, B1); PG8_BAR;
            PG8_LDA(At, 1, 1); PG8_STAGE(PG8_SA(1, 0), a3, voffA);
            PG8_BAR; PG8_WAIT_L(0); PG8_MMA(1, 0, At, B0); PG8_BAR; PG8_SCHED;
            PG8_STAGE(PG8_SB(1, 1), b3 + hstep, voffB);
            PG8_WAIT_V(6); PG8_BAR; PG8_MMA(1, 1, At, B1); PG8_BAR;
            }
        }
        if constexpr (ALIGN_EPI) { if (wr == 0) PG8_BAR; }
        if constexpr (!Epi::AFTER_DRAIN) { E(acc, cur, wr, wc, fr, fq); S.done(cur); }
        if (!has_next) break;
#pragma unroll
        for (int a = 0; a < 2; ++a)
#pragma unroll
            for (int b = 0; b < 2; ++b)
#pragma unroll
                for (int m = 0; m < 4; ++m)
#pragma unroll
                    for (int n = 0; n < 2; ++n) acc[a][b][m][n] = (f32x4){0.f, 0.f, 0.f, 0.f};
        cur = nxt; cA = nA; cB = nB; ++ui;
        if constexpr (ALIGN_EPI) { if (wr == 1) PG8_BAR; }
    }
    PG8_WAIT_V(0);
    if constexpr (!ALIGN_EPI) { if (wr == 0) PG8_BAR; }
    PG8_BAR;
    if constexpr (Epi::AFTER_DRAIN) { E.fused(acc, cur, wr, wc, fr, fq, lds, wid, lane); S.done(cur); }
#undef PG8_SA
#undef PG8_SB
#undef PG8_STAGE
#undef PG8_LDA
#undef PG8_LDB
#undef PG8_MMA
#undef PG8_WAIT_V
#undef PG8_WAIT_L
#undef PG8_BAR
#undef PG8_SCHED
}
}

#define LAS __attribute__((address_space(3)))
typedef unsigned short bf16_t;
typedef short bf16x8 __attribute__((ext_vector_type(8)));
typedef float f32x4 __attribute__((ext_vector_type(4)));
typedef float f32x16 __attribute__((ext_vector_type(16)));
typedef unsigned u32x4 __attribute__((ext_vector_type(4)));
typedef unsigned u32x2 __attribute__((ext_vector_type(2)));

#ifndef MK_MULTI
#define MK_MULTI 0
#endif

constexpr int DM = 1024, MP = 16384, MS = 2048, MT = MP + MS;
constexpr int NPROJ = 3328, NPJ = 3072, DFF = 2816;
constexpr float EPS = 1e-6f;
constexpr float LOG2E = 1.4426950408889634f;
constexpr float QSCALE2 = 0.125f * LOG2E;
constexpr size_t O_Y = 0, O_GSP = 18874368, O_FKP = 19922944, O_FVP = 36700160, O_FLP = 53477376, O_GSS = 53739520, O_FKS = 57933824, O_FVS = 60030976, O_FLS = 62128128;
constexpr size_t MiB = 1u << 20;
constexpr size_t WS_CTL = 0, CTL_BYTES = 2 * MiB;
constexpr size_t WS_SS = 65536;
constexpr size_t WS_WGIN = 2 * MiB, WS_WFIN = 9 * MiB, WS_WGOUT = 16 * MiB, WS_WFOUT = 18 * MiB, WS_WFFI = 20 * MiB  , WS_WFFD = 42 * MiB  ;
constexpr size_t WS_XB = 54 * MiB, WS_XR = 90 * MiB, WS_PROJ = 162 * MiB, WS_GL = 270 * MiB, WS_DST = 272 * MiB, WS_DEC = 400 * MiB, WS_SPREV = 401 * MiB;
constexpr size_t WS_OG = 465 * MiB, WS_ACT = 501 * MiB, WS_CP = 600 * MiB, WS_CS = 601 * MiB, WS_PART = 606 * MiB  , WS_END = 672 * MiB;
constexpr int LDS_BYTES = 135168;

struct Args {
    const float* in[19];
    float* out; unsigned char* ws;
    int ph_lo, ph_hi;
};
enum { I_XP = 0, I_XS, I_STATE, I_CK, I_CV, I_CLF, I_NMIX, I_GWIN, I_GWG2, I_GBG, I_GNORM, I_GWOUT, I_FWIN, I_FBF, I_FWOUT, I_NFFN, I_FFIN, I_FFDN, I_NFIN };

__device__ __forceinline__ float bf2f(unsigned u) { return __uint_as_float(u << 16); }
__device__ __forceinline__ unsigned f2bf(float f) { unsigned u = __float_as_uint(f); return (u + 0x7fffu + ((u >> 16) & 1u)) >> 16; }
__device__ __forceinline__ unsigned pk(float lo, float hi) { return pg8::cvt_pk_bf16(lo, hi); }
__device__ __forceinline__ float wave_sum(float v) {
#pragma unroll
    for (int o = 1; o < 64; o <<= 1) v += __shfl_xor(v, o);
    return v;
}
__device__ __forceinline__ float log_sigmoid(float z) { return fminf(z, 0.f) - __logf(1.f + __expf(-fabsf(z))); }
__device__ __forceinline__ int crow(int r, int hi) { return (r & 3) + 8 * (r >> 2) + 4 * hi; }
__device__ __forceinline__ float dot4(f32x4 v) { return (v[0] * v[0] + v[1] * v[1]) + (v[2] * v[2] + v[3] * v[3]); }
#define MFMA32(a, b, c) __builtin_amdgcn_mfma_f32_32x32x16_bf16((a), (b), (c), 0, 0, 0)

#define XB_TMO      128
#define XB_XCNT(j)  (256  + 64 * (j))
#define XB_XSUB(j)  (1280 + 64 * (j))
#define XB_XGEN(j)  (2304 + 64 * (j))
#define XB_TOP      3328
#define XB_TOPGEN   3392
#define XCD_BAR_WORDS 3456
#define XB_SPIN_CAP (1u << 18)

__device__ __forceinline__ unsigned xb_ld(unsigned* p)              { return __hip_atomic_load(p, __ATOMIC_RELAXED, __HIP_MEMORY_SCOPE_AGENT); }
__device__ __forceinline__ unsigned xb_add(unsigned* p, unsigned v) { return __hip_atomic_fetch_add(p, v, __ATOMIC_RELAXED, __HIP_MEMORY_SCOPE_AGENT); }
__device__ __forceinline__ unsigned xb_xcc_id() { return (unsigned)__builtin_amdgcn_s_getreg((3 << 11) | 20) & 0xFu; }
#define XB_SPIN(cond, bar) do { unsigned _sp = 0; while (cond) { __builtin_amdgcn_s_sleep(1); \
    if ((++_sp & 255u) == 0u) { if (xb_ld(&(bar)[XB_TMO])) break; if (_sp > XB_SPIN_CAP) { atomicAdd(&(bar)[XB_TMO], 1u); break; } } } } while (0)

struct XcdBarrier {
    unsigned* bar; unsigned x;
    volatile LAS unsigned* st;
};

__device__ __forceinline__ XcdBarrier xcd_barrier_post(unsigned* bar, volatile LAS unsigned* st) {
    XcdBarrier b; b.bar = bar; b.x = xb_xcc_id(); b.st = st;
    if (threadIdx.x == 0) (void)xb_add(&bar[XB_XCNT(b.x)], 1u);
    return b;
}
__device__ __forceinline__ void xcd_barrier_complete(unsigned* bar, unsigned x, unsigned& nloc, unsigned& nx) {
    const unsigned G = gridDim.x * gridDim.y * gridDim.z;
    unsigned sum, cnt, mine, sp = 0u;
    for (;;) {
        sum = 0u; cnt = 0u; mine = 0u;
#pragma unroll
        for (unsigned j = 0; j < 16; ++j) { const unsigned c = xb_ld(&bar[XB_XCNT(j)]); sum += c; cnt += (c > 0u) ? 1u : 0u; mine = (j == x) ? c : mine; }
        if (sum == G) break;
        __builtin_amdgcn_s_sleep(1);
        if ((++sp & 255u) == 0u) { if (xb_ld(&bar[XB_TMO])) break; if (sp > XB_SPIN_CAP) { atomicAdd(&bar[XB_TMO], 1u); break; } }
    }
    nloc = mine > 0u ? mine : 1u; nx = cnt > 0u ? cnt : 1u;
}

__device__ __forceinline__ void xcd_barrier(const XcdBarrier& b) {
    asm volatile("s_waitcnt vmcnt(0)" ::: "memory");
    __syncthreads();
    if (threadIdx.x == 0) {
        unsigned* bar = b.bar;
        __builtin_amdgcn_s_waitcnt(0);
        unsigned nloc = b.st[0], nx = b.st[1];
        if (nloc == 0u) { xcd_barrier_complete(bar, b.x, nloc, nx); b.st[0] = nloc; b.st[1] = nx; }
        const unsigned old = xb_add(&bar[XB_XSUB(b.x)], 1u);
        const unsigned gen = old / nloc;
        if (old + 1u == (gen + 1u) * nloc) {
            __builtin_amdgcn_fence(__ATOMIC_RELEASE, "agent");
            asm volatile("s_waitcnt vmcnt(0)" ::: "memory");
            const unsigned og = xb_add(&bar[XB_TOP], 1u);
            const unsigned tg = og / nx;
            if (og + 1u == (tg + 1u) * nx) xb_add(&bar[XB_TOPGEN], 1u);
            else XB_SPIN(xb_ld(&bar[XB_TOPGEN]) == tg, bar);
            __builtin_amdgcn_fence(__ATOMIC_ACQUIRE, "agent");
            xb_add(&bar[XB_XGEN(b.x)], 1u);
            asm volatile("s_waitcnt vmcnt(0)" ::: "memory");
        } else {
            XB_SPIN(xb_ld(&bar[XB_XGEN(b.x)]) == gen, bar);
            __builtin_amdgcn_fence(__ATOMIC_ACQUIRE, "agent");
            asm volatile("s_waitcnt vmcnt(0)" ::: "memory");
        }
    }
    __syncthreads();
}

__device__ __forceinline__ void tr_item(const float* __restrict__ W, int K, int N, int nsrc0, bf16_t* WT, int drow0, const float* __restrict__ gain, LAS float* scr, int k0, int lane) {
    const int n = nsrc0 + (lane & 31);
    float wv_[32];
    const float* wp_ = W + (size_t)(k0 + (lane >> 5)) * N + ((n < N) ? n : 0);
#pragma unroll
    for (int i = 0; i < 32; ++i) wv_[i] = wp_[(size_t)(2 * i) * N];
#pragma unroll
    for (int i = 0; i < 32; ++i) {
        const int kk = 2 * i + (lane >> 5);
        float v = (n < N) ? wv_[i] : 0.f;
        if (gain) v *= gain[k0 + kk];
        scr[kk * 33 + (lane & 31)] = v;
    }
    asm volatile("s_waitcnt lgkmcnt(0)" ::: "memory");
    const int c = lane & 7;
#pragma unroll
    for (int j = 0; j < 4; ++j) {
        const int nn = (lane >> 3) + 8 * j; const LAS float* s = scr + (8 * c) * 33 + nn;
        u32x4 o; o.x = pk(s[0 * 33], s[1 * 33]); o.y = pk(s[2 * 33], s[3 * 33]); o.z = pk(s[4 * 33], s[5 * 33]); o.w = pk(s[6 * 33], s[7 * 33]);
        *(u32x4*)(WT + (size_t)(drow0 + nn) * K + k0 + 8 * c) = o;
    }
    asm volatile("s_waitcnt lgkmcnt(0)" ::: "memory");
}

__device__ __forceinline__ void convert_weights(const Args& a, LAS unsigned char* lds, int sel, int gw, int NGW) {
    const int tid = threadIdx.x, lane = tid & 63, wave = tid >> 6;
    LAS float* scr = (LAS float*)(lds + wave * 16384);
    unsigned char* ws = a.ws;
    constexpr int I_IN = 16 * 104, I_OUT = 16 * 32, I_FI = 16 * 176, I_FD = 44 * 32;
    constexpr int NITEMS = I_IN + I_OUT + I_FI + I_FD;
    for (int it = gw; it < NITEMS; it += NGW) {
        int r = it;
        if (r < I_IN) { const int kb = r / 104, nb = r % 104; tr_item(a.in[sel ? I_FWIN : I_GWIN], 1024, 3088, 32 * nb, (bf16_t*)(ws + (sel ? WS_WFIN : WS_WGIN)), 32 * nb, a.in[I_NMIX] + sel * 1024, scr, 64 * kb, lane); continue; } r -= I_IN;
        if (r < I_OUT) { const int kb = r / 32, nb = r % 32; tr_item(a.in[sel ? I_FWOUT : I_GWOUT], 1024, 1024, 32 * nb, (bf16_t*)(ws + (sel ? WS_WFOUT : WS_WGOUT)), 32 * nb, nullptr, scr, 64 * kb, lane); continue; } r -= I_OUT;
        if (r < I_FI) { const int kb = r / 176, nb = r % 176, ns = 32 * nb, bj = ns / DFF, j = ns % DFF, drow = 256 * (j / 128) + 128 * bj + (j % 128);
            tr_item(a.in[I_FFIN] + (size_t)sel * 1024 * 5632, 1024, 5632, ns, (bf16_t*)(ws + WS_WFFI + (size_t)sel * 11 * MiB), drow, a.in[I_NFFN] + sel * 1024, scr, 64 * kb, lane); continue; } r -= I_FI;
        { const int kb = r / 32, nb = r % 32;
            tr_item(a.in[I_FFDN] + (size_t)sel * DFF * 1024, DFF, 1024, 32 * nb, (bf16_t*)(ws + WS_WFFD + (size_t)sel * 6 * MiB), 32 * nb, nullptr, scr, 64 * kb, lane); }
    }
}
__device__ __forceinline__ void p0_prologue(const Args& a, LAS unsigned char* lds, int vcu, int G) {
    const int tid = threadIdx.x, lane = tid & 63, wave = tid >> 6;
    const int gw = vcu * 8 + wave, NGW = G * 8;
    unsigned char* ws = a.ws;
    convert_weights(a, lds, 0, gw, NGW);
    if (G != 256 || MK_MULTI) convert_weights(a, lds, 1, gw, NGW);
    float* ss0 = (float*)(ws + WS_SS);
    bf16_t* XB = (bf16_t*)(ws + WS_XB);
    for (int m0 = gw; m0 < MT; m0 += 3 * NGW) {
        f32x4 v[3][4];
#pragma unroll
        for (int q = 0; q < 3; ++q) { const int m = m0 + q * NGW; if (m < MT) { const float* xr = (m < MP) ? a.in[I_XP] + (size_t)m * DM : a.in[I_XS] + (size_t)(m - MP) * DM;
#pragma unroll
            for (int j = 0; j < 4; ++j) v[q][j] = ((const f32x4*)xr)[lane + 64 * j]; } }
#pragma unroll
        for (int q = 0; q < 3; ++q) { const int m = m0 + q * NGW; if (m < MT) { float s = 0.f;
#pragma unroll
            for (int j = 0; j < 4; ++j) s += dot4(v[q][j]);
            s = wave_sum(s);
            if (lane == 0) ss0[m] = s;
#pragma unroll
            for (int j = 0; j < 4; ++j) { u32x2 o; o.x = pk(v[q][j][0], v[q][j][1]); o.y = pk(v[q][j][2], v[q][j][3]); ((u32x2*)(XB + (size_t)m * DM))[lane + 64 * j] = o; } } }
    }
}

__device__ __forceinline__ void p_final(const Args& a, int vcu, int G) {
    const int tid = threadIdx.x, lane = tid & 63, wave = tid >> 6;
    const int gw = vcu * 8 + wave, NGW = G * 8;
    const float* ss = (const float*)(a.ws + WS_SS + 4 * 131072);
    const float* XR = (const float*)(a.ws + WS_XR);
    const float* g = a.in[I_NFIN];
    f32x4 gv[4];
#pragma unroll
    for (int j = 0; j < 4; ++j) gv[j] = ((const f32x4*)g)[lane + 64 * j];
    for (int m0 = gw; m0 < MT; m0 += 3 * NGW) {
        f32x4 v[3][4]; float rs[3];
#pragma unroll
        for (int q = 0; q < 3; ++q) { const int m = m0 + q * NGW; if (m < MT) { rs[q] = rsqrtf(ss[m] * (1.f / DM) + EPS);
#pragma unroll
            for (int j = 0; j < 4; ++j) v[q][j] = ((const f32x4*)(XR + (size_t)m * DM))[lane + 64 * j]; } }
#pragma unroll
        for (int q = 0; q < 3; ++q) { const int m = m0 + q * NGW; if (m < MT) {
#pragma unroll
            for (int j = 0; j < 4; ++j) ((f32x4*)(a.out + O_Y + (size_t)m * DM))[lane + 64 * j] = v[q][j] * rs[q] * gv[j]; } }
    }
}

struct EpiGlaProj {
    static constexpr bool PERM = true, AFTER_DRAIN = false;
    const float* ss; bf16_t* proj; float* gl;
    __device__ __forceinline__ void operator()(const pg8::f32x4 (&acc)[2][2][4][2], const pg8::Unit& u, int wr, int wc, int fr, int fq) const {
        const int row0 = u.pm * 256 + wr * 64 + fr;
#pragma unroll
        for (int ai = 0; ai < 2; ++ai)
#pragma unroll
            for (int m = 0; m < 4; ++m) {
                const int row = row0 + ai * 128 + m * 16; const float rs = rsqrtf(ss[row] * (1.f / DM) + EPS);
                if (u.pn < 12) {
#pragma unroll
                    for (int bj = 0; bj < 2; ++bj) { const f32x4 v0 = acc[ai][bj][m][0] * rs, v1 = acc[ai][bj][m][1] * rs;
                        u32x4 w; w.x = pk(v0[0], v0[1]); w.y = pk(v0[2], v0[3]); w.z = pk(v1[0], v1[1]); w.w = pk(v1[2], v1[3]);
                        *(u32x4*)(proj + (size_t)row * NPJ + u.pn * 256 + bj * 128 + wc * 32 + 8 * fq) = w; }
                } else if (wc == 0 && fq < 2) {
#pragma unroll
                    for (int n = 0; n < 2; ++n) *(f32x4*)(gl + (size_t)row * 16 + 8 * fq + 4 * n) = acc[ai][0][m][n] * rs;
                }
            }
    }
};
struct EpiResid {
    static constexpr bool PERM = true, AFTER_DRAIN = false;
    const float* xin_p; const float* xin_s; float* xout; bf16_t* xb; float* ssout;
    __device__ __forceinline__ void operator()(const pg8::f32x4 (&acc)[2][2][4][2], const pg8::Unit& u, int wr, int wc, int fr, int fq) const {
        const int row0 = u.pm * 256 + wr * 64 + fr;
#pragma unroll
        for (int ai = 0; ai < 2; ++ai)
#pragma unroll
            for (int m = 0; m < 4; ++m) {
                const int row = row0 + ai * 128 + m * 16;
                const float* xi = (row < MP) ? xin_p + (size_t)row * DM : xin_s + (size_t)(row - MP) * DM;
                float sq = 0.f;
#pragma unroll
                for (int bj = 0; bj < 2; ++bj) { const int col = u.pn * 256 + bj * 128 + wc * 32 + 8 * fq;
                    const f32x4 a0 = *(const f32x4*)(xi + col) + acc[ai][bj][m][0], a1 = *(const f32x4*)(xi + col + 4) + acc[ai][bj][m][1];
                    *(f32x4*)(xout + (size_t)row * DM + col) = a0; *(f32x4*)(xout + (size_t)row * DM + col + 4) = a1;
                    u32x4 w; w.x = pk(a0[0], a0[1]); w.y = pk(a0[2], a0[3]); w.z = pk(a1[0], a1[1]); w.w = pk(a1[2], a1[3]);
                    *(u32x4*)(xb + (size_t)row * DM + col) = w;
                    sq += dot4(a0) + dot4(a1); }
                sq += __shfl_xor(sq, 16); sq += __shfl_xor(sq, 32);
                if (fq == 0) atomicAdd(ssout + row, sq);
            }
    }
};
struct EpiSwiglu {
    static constexpr bool PERM = true, AFTER_DRAIN = false;
    const float* ss; bf16_t* act;
    __device__ __forceinline__ void operator()(const pg8::f32x4 (&acc)[2][2][4][2], const pg8::Unit& u, int wr, int wc, int fr, int fq) const {
        const int row0 = u.pm * 256 + wr * 64 + fr;
#pragma unroll
        for (int ai = 0; ai < 2; ++ai)
#pragma unroll
            for (int m = 0; m < 4; ++m) {
                const int row = row0 + ai * 128 + m * 16; const float rs = rsqrtf(ss[row] * (1.f / DM) + EPS);
                float y[8];
#pragma unroll
                for (int n = 0; n < 2; ++n)
#pragma unroll
                    for (int i = 0; i < 4; ++i) { const float g = acc[ai][0][m][n][i] * rs, up = acc[ai][1][m][n][i] * rs; y[4 * n + i] = g * up * __builtin_amdgcn_rcpf(1.f + __expf(-g)); }
                u32x4 w; w.x = pk(y[0], y[1]); w.y = pk(y[2], y[3]); w.z = pk(y[4], y[5]); w.w = pk(y[6], y[7]);
                *(u32x4*)(act + (size_t)row * DFF + u.pn * 128 + wc * 32 + 8 * fq) = w;
            }
    }
};
struct EpiFoxProj {
    static constexpr bool PERM = true, AFTER_DRAIN = false;
    const float* ss; bf16_t* qkv; float* out; const float* bf;
    __device__ __forceinline__ void operator()(const pg8::f32x4 (&acc)[2][2][4][2], const pg8::Unit& u, int wr, int wc, int fr, int fq) const {
        const int row0 = u.pm * 256 + wr * 64 + fr;
        const int sect = u.pn >> 2;
#pragma unroll
        for (int ai = 0; ai < 2; ++ai)
#pragma unroll
            for (int m = 0; m < 4; ++m) {
                const int row = row0 + ai * 128 + m * 16; const float rs = rsqrtf(ss[row] * (1.f / DM) + EPS);
                if (u.pn < 12) {
                    const float sc = (sect == 0) ? rs * QSCALE2 : rs;
                    float* fdst = nullptr;
                    if (sect == 1) fdst = (row < MP) ? out + O_FKP + (size_t)row * DM : out + O_FKS + (size_t)(row - MP) * DM;
                    if (sect == 2) fdst = (row < MP) ? out + O_FVP + (size_t)row * DM : out + O_FVS + (size_t)(row - MP) * DM;
#pragma unroll
                    for (int bj = 0; bj < 2; ++bj) { const f32x4 v0 = acc[ai][bj][m][0] * sc, v1 = acc[ai][bj][m][1] * sc;
                        u32x4 w; w.x = pk(v0[0], v0[1]); w.y = pk(v0[2], v0[3]); w.z = pk(v1[0], v1[1]); w.w = pk(v1[2], v1[3]);
                        const int cl = bj * 128 + wc * 32 + 8 * fq;
                        *(u32x4*)(qkv + (size_t)row * NPJ + u.pn * 256 + cl) = w;
                        if (sect > 0) { float* d = fdst + (u.pn & 3) * 256 + cl; *(f32x4*)d = v0; *(f32x4*)(d + 4) = v1; } }
                } else if (wc == 0 && fq < 2) {
                    float* d = (row < MP) ? out + O_FLP + (size_t)row * 16 : out + O_FLS + (size_t)(row - MP) * 16;
#pragma unroll
                    for (int n = 0; n < 2; ++n) { const f32x4 v = acc[ai][0][m][n] * rs; f32x4 o;
#pragma unroll
                        for (int i = 0; i < 4; ++i) o[i] = log_sigmoid(v[i] + bf[8 * fq + 4 * n + i]);
                        *(f32x4*)(d + 8 * fq + 4 * n) = o; }
                }
            }
    }
};

constexpr int GL_OFF = 0, GSUM_OFF = 4096, DECS_OFF = 6144, QE_OFF = 8192, KE_OFF = 25600, VT_OFF = 43008, AL_OFF = 79872, KDT_OFF = 8192, OL_OFF = 8192;
constexpr int QES = 136, VTS = 72, OLS = 260;

struct GlaPre { unsigned v[32]; f32x4 gl; };
__device__ __forceinline__ void gla_prefetch(GlaPre& pf, const Args& a, int cid, int h) {
    const int tid = threadIdx.x, dvv = tid & 255, th = tid >> 8, row0 = cid * 64;
    const bf16_t* vp = (const bf16_t*)(a.ws + WS_PROJ) + (size_t)(row0 + 32 * th) * NPJ + 1024 + h * 256 + dvv;
#pragma unroll
    for (int i = 0; i < 32; ++i) pf.v[i] = vp[(size_t)i * NPJ];
    pf.gl = *(const f32x4*)((const float*)(a.ws + WS_GL) + (size_t)(row0 + ((tid & 255) >> 2)) * 16 + (tid & 3) * 4);
}
template <int MODE> __device__ __forceinline__ void gla_item(const Args& a, LAS unsigned char* lds, int cid, int h, GlaPre& pf, int next) {
    int tid_ = threadIdx.x; asm volatile("" : "+v"(tid_));
    const int tid = tid_, lane = tid & 63, w = __builtin_amdgcn_readfirstlane(tid >> 6), l31 = lane & 31, hi = lane >> 5;
    const int row0 = cid * 64;
    const bool prompt = cid < 256;
    LAS float* GLs = (LAS float*)(lds + GL_OFF); LAS float* GSUM = (LAS float*)(lds + GSUM_OFF); LAS float* DECS = (LAS float*)(lds + DECS_OFF);
    LAS bf16_t* QE = (LAS bf16_t*)(lds + QE_OFF); LAS bf16_t* KE = (LAS bf16_t*)(lds + KE_OFF); LAS bf16_t* VT = (LAS bf16_t*)(lds + VT_OFF);
    LAS bf16_t* AL = (LAS bf16_t*)(lds + AL_OFF); LAS bf16_t* KDT = (LAS bf16_t*)(lds + KDT_OFF);
    const bf16_t* P = (const bf16_t*)(a.ws + WS_PROJ) + (size_t)row0 * NPJ;
    const float* GL = (const float*)(a.ws + WS_GL);
    const float* state = a.in[I_STATE];

    bf16x8 sfr[8];
    if (MODE == 1) {
        if (prompt) {
            const bf16_t* sp = (const bf16_t*)(a.ws + WS_SPREV) + ((size_t)(cid * 4 + h) * 256 + 32 * w + l31) * 128 + 8 * hi;
#pragma unroll
            for (int ks = 0; ks < 8; ++ks) sfr[ks] = *(const bf16x8*)(sp + 16 * ks);
        } else {
            const float* s0 = state + ((size_t)((cid - 256) * 4 + h) * 128) * 256 + 32 * w + l31;
#pragma unroll
            for (int ks = 0; ks < 8; ++ks) { float f[8];
#pragma unroll
                for (int j = 0; j < 8; ++j) f[j] = s0[(size_t)(16 * ks + 8 * hi + j) * 256];
                u32x4 o; o.x = pk(f[0], f[1]); o.y = pk(f[2], f[3]); o.z = pk(f[4], f[5]); o.w = pk(f[6], f[7]); sfr[ks] = __builtin_bit_cast(bf16x8, o); }
        }
    }
    unsigned kraw[16], qraw[16];
    {
        const int dk_ = tid & 127, tg_ = tid >> 7;
        const bf16_t* kp_ = P + (size_t)(16 * tg_) * NPJ + 512 + h * 128 + dk_;
#pragma unroll
        for (int i = 0; i < 16; ++i) kraw[i] = kp_[(size_t)i * NPJ];
        if (MODE == 1) { const bf16_t* qp_ = P + (size_t)(16 * tg_) * NPJ + h * 128 + dk_;
#pragma unroll
            for (int i = 0; i < 16; ++i) qraw[i] = qp_[(size_t)i * NPJ]; }
    }
    float wv[16];
#pragma unroll
    for (int j = 0; j < 16; ++j) wv[j] = a.in[I_GWG2][j * 512 + h * 128 + (tid & 127)];
    const float bias = a.in[I_GBG][h * 128 + (tid & 127)];
    if (tid < 256) ((LAS f32x4*)GLs)[tid] = pf.gl;
    {
        const int dvv = tid & 255, th = tid >> 8;
#pragma unroll
        for (int q4 = 0; q4 < 4; ++q4) { u32x4 o; o.x = pf.v[8 * q4] | (pf.v[8 * q4 + 1] << 16); o.y = pf.v[8 * q4 + 2] | (pf.v[8 * q4 + 3] << 16);
            o.z = pf.v[8 * q4 + 4] | (pf.v[8 * q4 + 5] << 16); o.w = pf.v[8 * q4 + 6] | (pf.v[8 * q4 + 7] << 16);
            *(LAS u32x4*)(VT + dvv * VTS + 32 * th + 8 * q4) = o; }
    }
    if (next >= 0) gla_prefetch(pf, a, next >> 2, next & 3);
    __syncthreads();
    const int dk = tid & 127, tg = tid >> 7;
    float bc[16];
    {
        float run = 0.f;
#pragma unroll
        for (int i = 0; i < 16; ++i) { const LAS f32x4* gp = (const LAS f32x4*)(GLs + (16 * tg + i) * 16); float z = bias;
#pragma unroll
            for (int j4 = 0; j4 < 4; ++j4) { const f32x4 gq = gp[j4]; z += gq[0] * wv[4 * j4] + gq[1] * wv[4 * j4 + 1] + gq[2] * wv[4 * j4 + 2] + gq[3] * wv[4 * j4 + 3]; }
            run += log_sigmoid(z) * (1.f / 16.f); bc[i] = run; }
        GSUM[tg * 128 + dk] = run;
    }
    __syncthreads();
    float off = 0.f, blast = 0.f;
#pragma unroll
    for (int g = 0; g < 4; ++g) { const float s = GSUM[g * 128 + dk]; blast += s; if (g < tg) off += s; }
    if (MODE == 0) {
        float kd[16];
#pragma unroll
        for (int i = 0; i < 16; ++i) { const float b = bc[i] + off; kd[i] = bf2f(kraw[i]) * __expf(blast - b); }
        u32x4 o0, o1; o0.x = pk(kd[0], kd[1]); o0.y = pk(kd[2], kd[3]); o0.z = pk(kd[4], kd[5]); o0.w = pk(kd[6], kd[7]);
        o1.x = pk(kd[8], kd[9]); o1.y = pk(kd[10], kd[11]); o1.z = pk(kd[12], kd[13]); o1.w = pk(kd[14], kd[15]);
        *(LAS u32x4*)(KDT + dk * VTS + 16 * tg) = o0; *(LAS u32x4*)(KDT + dk * VTS + 16 * tg + 8) = o1;
        if (tg == 0) { const float d = __expf(blast); DECS[dk] = d; if (prompt) ((float*)(a.ws + WS_DEC))[(size_t)(cid * 4 + h) * 128 + dk] = d; }
    } else {
#pragma unroll
        for (int i = 0; i < 16; ++i) { const float b = bc[i] + off; const int t = 16 * tg + i;
            const float qe = bf2f(qraw[i]) * __expf(b) * 0.08838834764831845f, ke = bf2f(kraw[i]) * __expf(-b);
            QE[t * QES + dk] = (bf16_t)f2bf(qe); KE[t * QES + dk] = (bf16_t)f2bf(ke); }
    }
    __syncthreads();
    if (MODE == 0) {
        bf16x8 vf[4];
#pragma unroll
        for (int ks = 0; ks < 4; ++ks) vf[ks] = *(const LAS bf16x8*)(VT + (32 * w + l31) * VTS + 16 * ks + 8 * hi);
        f32x16 acc[4];
#pragma unroll
        for (int d = 0; d < 4; ++d) acc[d] = f32x16{};
#pragma unroll
        for (int d = 0; d < 4; ++d)
#pragma unroll
            for (int ks = 0; ks < 4; ++ks) { const bf16x8 kf = *(const LAS bf16x8*)(KDT + (32 * d + l31) * VTS + 16 * ks + 8 * hi);
                acc[d] = prompt ? MFMA32(vf[ks], kf, acc[d]) : MFMA32(kf, vf[ks], acc[d]); }
        if (prompt) {
            bf16_t* dst = (bf16_t*)(a.ws + WS_DST) + ((size_t)(cid * 4 + h) * 256 + 32 * w) * 128;
#pragma unroll
            for (int d = 0; d < 4; ++d)
#pragma unroll
                for (int r = 0; r < 16; ++r) dst[(size_t)crow(r, hi) * 128 + 32 * d + l31] = (bf16_t)f2bf(acc[d][r]);
        } else {
            const size_t base = ((size_t)((cid - 256) * 4 + h) * 128) * 256;
            float* outs = a.out + O_GSS;
#pragma unroll
            for (int d = 0; d < 4; ++d)
#pragma unroll
                for (int r = 0; r < 16; ++r) { const int dkk = 32 * d + crow(r, hi); const size_t idx = base + (size_t)dkk * 256 + 32 * w + l31; outs[idx] = state[idx] * DECS[dkk] + acc[d][r]; }
        }
    } else {
        u32x2 rraw[8];
#pragma unroll
        for (int i = 0; i < 8; ++i) rraw[i] = *(const u32x2*)(P + (size_t)(8 * w + i) * NPJ + 2048 + h * 256 + 4 * lane);
        f32x16 o[2]; o[0] = f32x16{}; o[1] = f32x16{};
#pragma unroll
        for (int tb = 0; tb < 2; ++tb)
#pragma unroll
            for (int ks = 0; ks < 8; ++ks) { const bf16x8 qa = *(const LAS bf16x8*)(QE + (32 * tb + l31) * QES + 16 * ks + 8 * hi); o[tb] = MFMA32(qa, sfr[ks], o[tb]); }
        if (w < 3) {
            const int tb = (w > 0) ? 1 : 0, sb = (w == 2) ? 1 : 0;
            f32x16 am = f32x16{};
#pragma unroll
            for (int ks = 0; ks < 8; ++ks) { const bf16x8 qa = *(const LAS bf16x8*)(QE + (32 * tb + l31) * QES + 16 * ks + 8 * hi), kb = *(const LAS bf16x8*)(KE + (32 * sb + l31) * QES + 16 * ks + 8 * hi);
                am = MFMA32(qa, kb, am); }
#pragma unroll
            for (int r = 0; r < 16; ++r) { const int tl = crow(r, hi); float v = am[r]; if (tb == sb && l31 > tl) v = 0.f; AL[(32 * tb + tl) * VTS + 32 * sb + l31] = (bf16_t)f2bf(v); }
        }
        __syncthreads();
#pragma unroll
        for (int tb = 0; tb < 2; ++tb)
#pragma unroll
            for (int ks = 0; ks < 4; ++ks) { if (tb == 0 && ks >= 2) continue;
                const bf16x8 aa = *(const LAS bf16x8*)(AL + (32 * tb + l31) * VTS + 16 * ks + 8 * hi), vb = *(const LAS bf16x8*)(VT + (32 * w + l31) * VTS + 16 * ks + 8 * hi);
                o[tb] = MFMA32(aa, vb, o[tb]); }
        __syncthreads();
        LAS float* OL = (LAS float*)(lds + OL_OFF);
#pragma unroll
        for (int tb = 0; tb < 2; ++tb)
#pragma unroll
            for (int r = 0; r < 16; ++r) OL[(32 * tb + crow(r, hi)) * OLS + 32 * w + l31] = o[tb][r];
        __syncthreads();
        const f32x4 ng = *(const f32x4*)(a.in[I_GNORM] + h * 256 + 4 * lane);
        bf16_t* OG = (bf16_t*)(a.ws + WS_OG);
#pragma unroll
        for (int i = 0; i < 8; ++i) { const int t = 8 * w + i; const f32x4 v = *(const LAS f32x4*)(OL + t * OLS + 4 * lane);
            const float rs = rsqrtf(wave_sum(dot4(v)) * (1.f / 256.f) + EPS);
            const u32x2 rr = rraw[i];
            float rv[4] = {bf2f(rr.x & 0xffffu), bf2f(rr.x >> 16), bf2f(rr.y & 0xffffu), bf2f(rr.y >> 16)}; float y[4];
#pragma unroll
            for (int j = 0; j < 4; ++j) y[j] = v[j] * rs * ng[j] * rv[j] * __builtin_amdgcn_rcpf(1.f + __expf(-rv[j]));
            u32x2 ov; ov.x = pk(y[0], y[1]); ov.y = pk(y[2], y[3]);
            *(u32x2*)(OG + (size_t)(row0 + t) * DM + h * 256 + 4 * lane) = ov; }
    }
    __syncthreads();
}

__device__ __forceinline__ void gla_scan(const Args& a, int vcu, int G) {
    const int gt = vcu * 512 + threadIdx.x, NT_ = G * 512;
    const bf16_t* DST = (const bf16_t*)(a.ws + WS_DST); const float* DEC = (const float*)(a.ws + WS_DEC); bf16_t* SP = (bf16_t*)(a.ws + WS_SPREV);
    for (int it0 = gt; it0 < 32 * 8192; it0 += 2 * NT_) {
        const int it1 = it0 + NT_; const bool two = it1 < 32 * 8192;
        const int bhA = it0 >> 13, eA = it0 & 8191, dvA = eA >> 5, dkA = (eA & 31) * 4;
        const int itB = two ? it1 : it0; const int bhB = itB >> 13, eB = itB & 8191, dvB = eB >> 5, dkB = (eB & 31) * 4;
        f32x4 SA = (f32x4){0.f, 0.f, 0.f, 0.f}, SB = SA;
#pragma unroll 8
        for (int c = 0; c < 32; ++c) {
            const size_t chA = (size_t)(((bhA >> 2) * 32 + c) * 4 + (bhA & 3)), chB = (size_t)(((bhB >> 2) * 32 + c) * 4 + (bhB & 3));
            const size_t baseA = (chA * 256 + dvA) * 128 + dkA, baseB = (chB * 256 + dvB) * 128 + dkB;
            const u32x2 rA = *(const u32x2*)(DST + baseA), rB = *(const u32x2*)(DST + baseB);
            const f32x4 deA = *(const f32x4*)(DEC + chA * 128 + dkA), deB = *(const f32x4*)(DEC + chB * 128 + dkB);
            const f32x4 dsA = (f32x4){bf2f(rA.x & 0xffffu), bf2f(rA.x >> 16), bf2f(rA.y & 0xffffu), bf2f(rA.y >> 16)};
            const f32x4 dsB = (f32x4){bf2f(rB.x & 0xffffu), bf2f(rB.x >> 16), bf2f(rB.y & 0xffffu), bf2f(rB.y >> 16)};
            u32x2 o; o.x = pk(SA[0], SA[1]); o.y = pk(SA[2], SA[3]); *(u32x2*)(SP + baseA) = o;
            if (two) { o.x = pk(SB[0], SB[1]); o.y = pk(SB[2], SB[3]); *(u32x2*)(SP + baseB) = o; }
            SA = SA * deA + dsA; SB = SB * deB + dsB;
        }
        float* ogA = a.out + O_GSP + ((size_t)bhA * 128 + dkA) * 256 + dvA;
#pragma unroll
        for (int i = 0; i < 4; ++i) ogA[(size_t)i * 256] = SA[i];
        if (two) { float* ogB = a.out + O_GSP + ((size_t)bhB * 128 + dkB) * 256 + dvB;
#pragma unroll
            for (int i = 0; i < 4; ++i) ogB[(size_t)i * 256] = SB[i]; }
    }
}

template <int L, int C> __device__ __forceinline__ void cumsum_item(const float* src0, const float* src1, float* dst, LAS float* SEG, int hh, int seg) {
    float s = 0.f;
#pragma unroll 1
    for (int c0 = 0; c0 < L; c0 += C) { float v[C];
#pragma unroll
        for (int i = 0; i < C; ++i) { const int t = seg * L + c0 + i; v[i] = (t < 2048) ? src0[(unsigned)(t * 16 + hh)] : src1[(unsigned)((t - 2048) * 16 + hh)]; }
#pragma unroll
        for (int i = 0; i < C; ++i) s += v[i]; }
    SEG[seg * 16 + hh] = s;
    __syncthreads();
    float run = 0.f;
    for (int g = 0; g < seg; ++g) run += SEG[g * 16 + hh];
#pragma unroll 1
    for (int c0 = 0; c0 < L; c0 += C) { float v[C];
#pragma unroll
        for (int i = 0; i < C; ++i) { const int t = seg * L + c0 + i; v[i] = (t < 2048) ? src0[(unsigned)(t * 16 + hh)] : src1[(unsigned)((t - 2048) * 16 + hh)]; }
#pragma unroll
        for (int i = 0; i < C; ++i) { run += v[i]; dst[seg * L + c0 + i] = run; } }
    __syncthreads();
}
__device__ __forceinline__ void fox_cumsum(const Args& a, LAS unsigned char* lds, int vcu, int G) {
    const int tid = threadIdx.x, hh = tid & 15, seg = tid >> 4;
    LAS float* SEG = (LAS float*)lds;
    for (int it = vcu; it < 40; it += G) {
        const bool prompt = it < 8; const int b = prompt ? it : it - 8;
        const float* src0 = prompt ? a.out + O_FLP + (size_t)b * 2048 * 16 : a.in[I_CLF] + (size_t)b * 2048 * 16;
        const float* src1 = a.out + O_FLS + (size_t)b * 64 * 16;
        if (prompt) cumsum_item<64, 32>(src0, src1, (float*)(a.ws + WS_CP) + (size_t)(b * 16 + hh) * 2048, SEG, hh, seg);
        else cumsum_item<66, 22>(src0, src1, (float*)(a.ws + WS_CS) + (size_t)(b * 16 + hh) * 2112, SEG, hh, seg);
    }
}

constexpr int AT_KS = 72, AT_VS = 68, AT_BUF = 18432, AT_VOFF = 9216, AT_COFF = 17920;
struct TileRegs { u32x4 k0, k1, v0, v1; float ck; };

template <bool SAMPLE> __device__ __forceinline__ void attn_load(TileRegs& R, const Args& a, int b, int h, int t, const float* cbase, int tid) {
    const int kvl = tid >> 3, ch = tid & 7, kp = tid >> 4, c4 = tid & 15;
    if (SAMPLE && t < 32) {
        const float* kptr = a.in[I_CK] + (((size_t)b * 2048 + 64 * t + kvl) * 16 + h) * 64 + 8 * ch;
        R.k0 = *(const u32x4*)kptr; R.k1 = *(const u32x4*)(kptr + 4);
        const float* vptr = a.in[I_CV] + (((size_t)b * 2048 + 64 * t + 2 * kp) * 16 + h) * 64 + 4 * c4;
        R.v0 = *(const u32x4*)vptr; R.v1 = *(const u32x4*)(vptr + 1024);
    } else {
        const size_t rowbase = SAMPLE ? (size_t)(MP + b * 64) : (size_t)(b * 2048 + 64 * t);
        const bf16_t* qkv = (const bf16_t*)(a.ws + WS_PROJ);
        R.k0 = *(const u32x4*)(qkv + (rowbase + kvl) * NPJ + 1024 + h * 64 + 8 * ch);
        const bf16_t* vptr = qkv + (rowbase + 2 * kp) * NPJ + 2048 + h * 64 + 4 * c4;
        const u32x2 x0 = *(const u32x2*)vptr, x1 = *(const u32x2*)(vptr + NPJ);
        R.v0.x = x0.x; R.v0.y = x0.y; R.v1.x = x1.x; R.v1.y = x1.y;
    }
    R.ck = cbase[64 * t + (tid & 63)];
}
__device__ __forceinline__ void attn_store(const TileRegs& R, LAS unsigned char* buf, bool f32src, int tid) {
    const int kvl = tid >> 3, ch = tid & 7, kp = tid >> 4, c4 = tid & 15;
    LAS unsigned* VT32 = (LAS unsigned*)(buf + AT_VOFF);
    if (f32src) {
        u32x4 o; o.x = pk(__uint_as_float(R.k0.x), __uint_as_float(R.k0.y)); o.y = pk(__uint_as_float(R.k0.z), __uint_as_float(R.k0.w));
        o.z = pk(__uint_as_float(R.k1.x), __uint_as_float(R.k1.y)); o.w = pk(__uint_as_float(R.k1.z), __uint_as_float(R.k1.w));
        *(LAS u32x4*)(buf + (kvl * AT_KS + 8 * ch) * 2) = o;
#pragma unroll
        for (int i = 0; i < 4; ++i) VT32[(4 * c4 + i) * (AT_VS / 2) + kp] = pk(__uint_as_float(R.v0[i]), __uint_as_float(R.v1[i]));
    } else {
        *(LAS u32x4*)(buf + (kvl * AT_KS + 8 * ch) * 2) = R.k0;
        VT32[(4 * c4 + 0) * (AT_VS / 2) + kp] = (R.v0.x & 0xffffu) | (R.v1.x << 16);
        VT32[(4 * c4 + 1) * (AT_VS / 2) + kp] = (R.v0.x >> 16) | (R.v1.x & 0xffff0000u);
        VT32[(4 * c4 + 2) * (AT_VS / 2) + kp] = (R.v0.y & 0xffffu) | (R.v1.y << 16);
        VT32[(4 * c4 + 3) * (AT_VS / 2) + kp] = (R.v0.y >> 16) | (R.v1.y & 0xffff0000u);
    }
    if (tid < 64) { const float c = -R.ck * LOG2E; const unsigned h1 = f2bf(c); const float r1 = c - bf2f(h1); const unsigned h2 = f2bf(r1); const unsigned h3 = f2bf(r1 - bf2f(h2));
        u32x2 o; o.x = h1 | (h2 << 16); o.y = h3; ((LAS u32x2*)(buf + AT_COFF))[tid] = o; }
}

template <bool QLDS> __device__ __forceinline__ void attn_tile(const LAS unsigned char* buf, const bf16x8 (&qf)[4], const LAS bf16x8* qlds, float cq2, int qpos, int kv0, bool diag, float& mrun, float& lrun, f32x16 (&ot)[2], int l31, int hi) {
    const LAS bf16_t* Ks = (const LAS bf16_t*)buf; const LAS bf16_t* VTs = (const LAS bf16_t*)(buf + AT_VOFF); const LAS u32x2* CKs = (const LAS u32x2*)(buf + AT_COFF);
    f32x16 p0, p1;
#pragma unroll
    for (int r = 0; r < 16; ++r) { p0[r] = cq2; p1[r] = cq2; }
    {
        const u32x2 b0 = CKs[l31], b1 = CKs[32 + l31];
        const unsigned msk = hi ? 0u : 0xffffffffu;
        u32x4 x0; x0.x = b0.x & msk; x0.y = b0.y & msk; x0.z = 0u; x0.w = 0u;
        u32x4 x1; x1.x = b1.x & msk; x1.y = b1.y & msk; x1.z = 0u; x1.w = 0u;
        u32x4 qx; qx.x = 0x3F803F80u & msk; qx.y = 0x00003F80u & msk; qx.z = 0u; qx.w = 0u;
        p0 = MFMA32(__builtin_bit_cast(bf16x8, x0), __builtin_bit_cast(bf16x8, qx), p0); p1 = MFMA32(__builtin_bit_cast(bf16x8, x1), __builtin_bit_cast(bf16x8, qx), p1);
    }
#pragma unroll
    for (int ks = 0; ks < 4; ++ks) { const bf16x8 k0 = *(const LAS bf16x8*)(Ks + l31 * AT_KS + 16 * ks + 8 * hi), k1 = *(const LAS bf16x8*)(Ks + (32 + l31) * AT_KS + 16 * ks + 8 * hi);
        const bf16x8 qq = QLDS ? qlds[ks * 64] : qf[ks];
        p0 = MFMA32(k0, qq, p0); p1 = MFMA32(k1, qq, p1); }
    __builtin_amdgcn_sched_barrier(0);
    if (diag) {
        int qp = qpos - kv0; asm volatile("" : "+v"(qp));
#pragma unroll
        for (int r = 0; r < 16; ++r) { const int kv = crow(r, hi); if (kv > qp) p0[r] = -INFINITY; if (kv + 32 > qp) p1[r] = -INFINITY; }
    }
    float rm = fmaxf(p0[0], p1[0]);
#pragma unroll
    for (int r = 1; r < 16; ++r) rm = fmaxf(rm, fmaxf(p0[r], p1[r]));
    rm = fmaxf(rm, __shfl_xor(rm, 32));
    if (__all(rm < mrun - 40.f)) return;
    const float mn = fmaxf(mrun, rm);
    if (__any(mn > mrun)) {
        const float alpha = __builtin_amdgcn_exp2f(mrun - mn);
        lrun *= alpha;
#pragma unroll
        for (int r = 0; r < 16; ++r) { ot[0][r] *= alpha; ot[1][r] *= alpha; }
        mrun = mn;
    }
    float rs = 0.f;
#pragma unroll
    for (int r = 0; r < 16; ++r) { p0[r] = __builtin_amdgcn_exp2f(p0[r] - mrun); p1[r] = __builtin_amdgcn_exp2f(p1[r] - mrun); rs += p0[r] + p1[r]; }
    lrun += rs;
    bf16x8 pf[4];
    { u32x4 x; x.x = pk(p0[0], p0[1]); x.y = pk(p0[2], p0[3]); x.z = pk(p0[4], p0[5]); x.w = pk(p0[6], p0[7]); pf[0] = __builtin_bit_cast(bf16x8, x);
      x.x = pk(p0[8], p0[9]); x.y = pk(p0[10], p0[11]); x.z = pk(p0[12], p0[13]); x.w = pk(p0[14], p0[15]); pf[1] = __builtin_bit_cast(bf16x8, x);
      x.x = pk(p1[0], p1[1]); x.y = pk(p1[2], p1[3]); x.z = pk(p1[4], p1[5]); x.w = pk(p1[6], p1[7]); pf[2] = __builtin_bit_cast(bf16x8, x);
      x.x = pk(p1[8], p1[9]); x.y = pk(p1[10], p1[11]); x.z = pk(p1[12], p1[13]); x.w = pk(p1[14], p1[15]); pf[3] = __builtin_bit_cast(bf16x8, x); }
    __builtin_amdgcn_sched_barrier(0);
#pragma unroll
    for (int db = 0; db < 2; ++db)
#pragma unroll
        for (int ks = 0; ks < 4; ++ks) { const LAS bf16_t* vp = VTs + (32 * db + l31) * AT_VS + 16 * ks + 4 * hi;
            const u32x2 lo = *(const LAS u32x2*)vp, hh2 = *(const LAS u32x2*)(vp + 8);
            u32x4 x; x.x = lo.x; x.y = lo.y; x.z = hh2.x; x.w = hh2.y;
            ot[db] = MFMA32(__builtin_bit_cast(bf16x8, x), pf[ks], ot[db]); }
}

__device__ __forceinline__ void gld16(u32x4& d, const void* p) { asm volatile("global_load_dwordx4 %0, %1, off" : "=v"(d) : "v"(p)); }
__device__ __forceinline__ void gld8(u32x2& d, const void* p) { asm volatile("global_load_dwordx2 %0, %1, off" : "=v"(d) : "v"(p)); }
__device__ __forceinline__ void gld4(float& d, const void* p) { asm volatile("global_load_dword %0, %1, off" : "=v"(d) : "v"(p)); }
struct PRegs { u32x4 k; u32x2 v0, v1; float ck; };
__device__ __forceinline__ void pload_a(PRegs& R, const Args& a, int b, int h, int t, const float* cbase, int tid) {
    const int kvl = tid >> 3, ch = tid & 7, kp = tid >> 4, c4 = tid & 15;
    const size_t rowbase = (size_t)(b * 2048 + 64 * t);
    const bf16_t* qkv = (const bf16_t*)(a.ws + WS_PROJ);
    gld16(R.k, qkv + (rowbase + kvl) * NPJ + 1024 + h * 64 + 8 * ch);
    const bf16_t* vptr = qkv + (rowbase + 2 * kp) * NPJ + 2048 + h * 64 + 4 * c4;
    gld8(R.v0, vptr); gld8(R.v1, vptr + NPJ);
    gld4(R.ck, cbase + 64 * t + (tid & 63));
}
#define WAIT_P(N, R) asm volatile("s_waitcnt vmcnt(" #N ")" : "+v"(R.k), "+v"(R.v0), "+v"(R.v1), "+v"(R.ck))
__device__ __forceinline__ void pstore(const PRegs& R, LAS unsigned char* buf, int tid) {
    const int kvl = tid >> 3, ch = tid & 7, kp = tid >> 4, c4 = tid & 15;
    LAS unsigned* VT32 = (LAS unsigned*)(buf + AT_VOFF);
    *(LAS u32x4*)(buf + (kvl * AT_KS + 8 * ch) * 2) = R.k;
    VT32[(4 * c4 + 0) * (AT_VS / 2) + kp] = (R.v0.x & 0xffffu) | (R.v1.x << 16);
    VT32[(4 * c4 + 1) * (AT_VS / 2) + kp] = (R.v0.x >> 16) | (R.v1.x & 0xffff0000u);
    VT32[(4 * c4 + 2) * (AT_VS / 2) + kp] = (R.v0.y & 0xffffu) | (R.v1.y << 16);
    VT32[(4 * c4 + 3) * (AT_VS / 2) + kp] = (R.v0.y >> 16) | (R.v1.y & 0xffff0000u);
    if (tid < 64) { const float c = -R.ck * LOG2E; const unsigned h1 = f2bf(c); const float r1 = c - bf2f(h1); const unsigned h2 = f2bf(r1); const unsigned h3 = f2bf(r1 - bf2f(h2));
        u32x2 o; o.x = h1 | (h2 << 16); o.y = h3; ((LAS u32x2*)(buf + AT_COFF))[tid] = o; }
}
__device__ __forceinline__ void attn_unit_prompt(const Args& a, LAS unsigned char* lds, int b, int h, int qb) {
    int tid_ = threadIdx.x; asm volatile("" : "+v"(tid_));
    const int tid = tid_, lane = tid & 63, w = __builtin_amdgcn_readfirstlane(tid >> 6), l31 = lane & 31, hi = lane >> 5;
    const int NT = 4 * (qb + 1);
    const int qpos = 256 * qb + 32 * w + l31;
    const size_t qrow = (size_t)(b * 2048 + qpos);
    const float* cbase = (const float*)(a.ws + WS_CP) + (size_t)(b * 16 + h) * 2048;
    const bf16_t* qkv = (const bf16_t*)(a.ws + WS_PROJ);
    bf16x8 qf[4];
#pragma unroll
    for (int ks = 0; ks < 4; ++ks) qf[ks] = *(const bf16x8*)(qkv + qrow * NPJ + h * 64 + 16 * ks + 8 * hi);
    const float cq2 = cbase[qpos] * LOG2E;
    const int qmax_w = 256 * qb + 32 * w + 31;
    PRegs R0, R1, R2;
    pload_a(R0, a, b, h, NT - 1, cbase, tid); pload_a(R1, a, b, h, NT - 2, cbase, tid); pload_a(R2, a, b, h, NT - 3, cbase, tid);
    WAIT_P(8, R0); pstore(R0, lds, tid);
    pload_a(R0, a, b, h, NT - 4, cbase, tid);
    __syncthreads();
    float mrun = -INFINITY, lrun = 0.f;
    f32x16 ot[2]; ot[0] = f32x16{}; ot[1] = f32x16{};
#define PSTEP(tt, RR) do { if ((tt) < NT) { const int ti_ = NT - 1 - (tt); if (64 * ti_ <= qmax_w) attn_tile<false>(lds + ((tt) & 1) * AT_BUF, qf, nullptr, cq2, qpos, 64 * ti_, ti_ >= 4 * qb, mrun, lrun, ot, l31, hi); \
        { WAIT_P(8, RR); pstore(RR, lds + (((tt) + 1) & 1) * AT_BUF, tid); pload_a(RR, a, b, h, (NT - 5 - (tt)) > 0 ? NT - 5 - (tt) : 0, cbase, tid); } \
        __syncthreads(); } } while (0)
#pragma unroll 1
    for (int t = 0; t < NT; t += 3) { PSTEP(t, R1); PSTEP(t + 1, R2); PSTEP(t + 2, R0); }
#undef PSTEP
    WAIT_P(0, R0); WAIT_P(0, R1); WAIT_P(0, R2);
    lrun += __shfl_xor(lrun, 32);
    const float inv = 1.f / lrun;
    bf16_t* og = (bf16_t*)(a.ws + WS_OG) + qrow * DM + h * 64;
#pragma unroll
    for (int db = 0; db < 2; ++db)
#pragma unroll
        for (int j = 0; j < 4; ++j) { u32x2 o; o.x = pk(ot[db][4 * j] * inv, ot[db][4 * j + 1] * inv); o.y = pk(ot[db][4 * j + 2] * inv, ot[db][4 * j + 3] * inv);
            *(u32x2*)(og + 32 * db + 8 * j + 4 * hi) = o; }
}

struct TileRegs2 { u32x4 k[4], v[4]; float ck; };
__device__ __forceinline__ void sload2(TileRegs2& R, const Args& a, int b, int h, int t, const float* cbase, int st) {
#pragma unroll
    for (int q = 0; q < 2; ++q) {
        const int item = st + 256 * q, kvl = item >> 3, ch = item & 7, kp = item >> 4, c4 = item & 15;
        if (t < 32) {
            const float* kptr = a.in[I_CK] + (((size_t)b * 2048 + 64 * t + kvl) * 16 + h) * 64 + 8 * ch;
            R.k[2 * q] = *(const u32x4*)kptr; R.k[2 * q + 1] = *(const u32x4*)(kptr + 4);
            const float* vptr = a.in[I_CV] + (((size_t)b * 2048 + 64 * t + 2 * kp) * 16 + h) * 64 + 4 * c4;
            R.v[2 * q] = *(const u32x4*)vptr; R.v[2 * q + 1] = *(const u32x4*)(vptr + 1024);
        } else {
            const size_t rowbase = (size_t)(MP + b * 64);
            const bf16_t* qkv = (const bf16_t*)(a.ws + WS_PROJ);
            R.k[2 * q] = *(const u32x4*)(qkv + (rowbase + kvl) * NPJ + 1024 + h * 64 + 8 * ch);
            const bf16_t* vptr = qkv + (rowbase + 2 * kp) * NPJ + 2048 + h * 64 + 4 * c4;
            const u32x2 x0 = *(const u32x2*)vptr, x1 = *(const u32x2*)(vptr + NPJ);
            R.v[2 * q].x = x0.x; R.v[2 * q].y = x0.y; R.v[2 * q + 1].x = x1.x; R.v[2 * q + 1].y = x1.y;
        }
    }
    R.ck = cbase[64 * t + (st & 63)];
}
__device__ __forceinline__ void sload2a(TileRegs2& R, const Args& a, int b, int h, int t, const float* cbase, int st) {
#pragma unroll
    for (int q = 0; q < 2; ++q) {
        const int item = st + 256 * q, kvl = item >> 3, ch = item & 7, kp = item >> 4, c4 = item & 15;
        const float* kptr = a.in[I_CK] + (((size_t)b * 2048 + 64 * t + kvl) * 16 + h) * 64 + 8 * ch;
        gld16(R.k[2 * q], kptr); gld16(R.k[2 * q + 1], kptr + 4);
        const float* vptr = a.in[I_CV] + (((size_t)b * 2048 + 64 * t + 2 * kp) * 16 + h) * 64 + 4 * c4;
        gld16(R.v[2 * q], vptr); gld16(R.v[2 * q + 1], vptr + 1024);
    }
    gld4(R.ck, cbase + 64 * t + (st & 63));
}
#define WAIT_R2(N, R) asm volatile("s_waitcnt vmcnt(" #N ")" : "+v"(R.k[0]), "+v"(R.k[1]), "+v"(R.k[2]), "+v"(R.k[3]), "+v"(R.v[0]), "+v"(R.v[1]), "+v"(R.v[2]), "+v"(R.v[3]), "+v"(R.ck))
__device__ __forceinline__ void sstore2(const TileRegs2& R, LAS unsigned char* buf, bool f32src, int st) {
    LAS unsigned* VT32 = (LAS unsigned*)(buf + AT_VOFF);
#pragma unroll
    for (int q = 0; q < 2; ++q) {
        const int item = st + 256 * q, kvl = item >> 3, ch = item & 7, kp = item >> 4, c4 = item & 15;
        if (f32src) {
            const u32x4 k0 = R.k[2 * q], k1 = R.k[2 * q + 1];
            u32x4 o; o.x = pk(__uint_as_float(k0.x), __uint_as_float(k0.y)); o.y = pk(__uint_as_float(k0.z), __uint_as_float(k0.w));
            o.z = pk(__uint_as_float(k1.x), __uint_as_float(k1.y)); o.w = pk(__uint_as_float(k1.z), __uint_as_float(k1.w));
            *(LAS u32x4*)(buf + (kvl * AT_KS + 8 * ch) * 2) = o;
#pragma unroll
            for (int i = 0; i < 4; ++i) VT32[(4 * c4 + i) * (AT_VS / 2) + kp] = pk(__uint_as_float(R.v[2 * q][i]), __uint_as_float(R.v[2 * q + 1][i]));
        } else {
            *(LAS u32x4*)(buf + (kvl * AT_KS + 8 * ch) * 2) = R.k[2 * q];
            const u32x4 v0 = R.v[2 * q], v1 = R.v[2 * q + 1];
            VT32[(4 * c4 + 0) * (AT_VS / 2) + kp] = (v0.x & 0xffffu) | (v1.x << 16);
            VT32[(4 * c4 + 1) * (AT_VS / 2) + kp] = (v0.x >> 16) | (v1.x & 0xffff0000u);
            VT32[(4 * c4 + 2) * (AT_VS / 2) + kp] = (v0.y & 0xffffu) | (v1.y << 16);
            VT32[(4 * c4 + 3) * (AT_VS / 2) + kp] = (v0.y >> 16) | (v1.y & 0xffff0000u);
        }
    }
    if (st < 64) { const float c = -R.ck * LOG2E; const unsigned h1 = f2bf(c); const float r1 = c - bf2f(h1); const unsigned h2 = f2bf(r1); const unsigned h3 = f2bf(r1 - bf2f(h2));
        u32x2 o; o.x = h1 | (h2 << 16); o.y = h3; ((LAS u32x2*)(buf + AT_COFF))[st] = o; }
}
__device__ __forceinline__ void attn_unit_sample(const Args& a, LAS unsigned char* lds, int b, int h) {
    int tid_ = threadIdx.x; asm volatile("" : "+v"(tid_));
    const int tid = tid_, lane = tid & 63, w = __builtin_amdgcn_readfirstlane(tid >> 6), l31 = lane & 31, hi = lane >> 5;
    const float* cbase = (const float*)(a.ws + WS_CS) + (size_t)(b * 16 + h) * 2112;
    if (w >= 2 && w < 6) {
        const int st = tid - 128;
        TileRegs2 R0, R1, R2, R3;
        sload2(R0, a, b, h, 32, cbase, st); sload2a(R1, a, b, h, 31, cbase, st); sload2a(R2, a, b, h, 30, cbase, st); sload2a(R3, a, b, h, 29, cbase, st);
        sstore2(R0, lds, false, st);
        sload2a(R0, a, b, h, 28, cbase, st);
        __syncthreads();
#define SSTEP(tt, RR) do { WAIT_R2(27, RR); sstore2(RR, lds + (((tt) + 1) & 1) * AT_BUF, true, st); sload2a(RR, a, b, h, (27 - (tt)) > 0 ? 27 - (tt) : 0, cbase, st); __syncthreads(); } while (0)
#pragma unroll 1
        for (int t = 0; t < 32; t += 4) { SSTEP(t, R1); SSTEP(t + 1, R2); SSTEP(t + 2, R3); SSTEP(t + 3, R0); }
        SSTEP(32, R1);
#undef SSTEP
        WAIT_R2(0, R0); WAIT_R2(0, R1); WAIT_R2(0, R2); WAIT_R2(0, R3);
    } else {
        const bool active = w < 2;
        const int qpos = 2048 + 32 * (w & 1) + l31;
        const size_t qrow = (size_t)(MP + b * 64 + 32 * (w & 1) + l31);
        const bf16_t* qkv = (const bf16_t*)(a.ws + WS_PROJ);
        bf16x8 qf[4];
#pragma unroll
        for (int ks = 0; ks < 4; ++ks) qf[ks] = *(const bf16x8*)(qkv + qrow * NPJ + h * 64 + 16 * ks + 8 * hi);
        const float cq2 = cbase[qpos] * LOG2E;
        float mrun = -INFINITY, lrun = 0.f;
        f32x16 ot[2]; ot[0] = f32x16{}; ot[1] = f32x16{};
        __syncthreads();
#pragma unroll 1
        for (int tt = 0; tt < 33; ++tt) {
            if (active) attn_tile<false>(lds + (tt & 1) * AT_BUF, qf, nullptr, cq2, qpos, 64 * (32 - tt), tt == 0, mrun, lrun, ot, l31, hi);
            __syncthreads();
        }
        if (active) {
            lrun += __shfl_xor(lrun, 32);
            const float inv = 1.f / lrun;
            bf16_t* og = (bf16_t*)(a.ws + WS_OG) + qrow * DM + h * 64;
#pragma unroll
            for (int db = 0; db < 2; ++db)
#pragma unroll
                for (int j = 0; j < 4; ++j) { u32x2 o; o.x = pk(ot[db][4 * j] * inv, ot[db][4 * j + 1] * inv); o.y = pk(ot[db][4 * j + 2] * inv, ot[db][4 * j + 3] * inv);
                    *(u32x2*)(og + 32 * db + 8 * j + 4 * hi) = o; }
        }
    }
}

__device__ __forceinline__ void fox_attention(const Args& a, LAS unsigned char* lds, int vcu, int G) {
#pragma unroll 1
    for (int pass = 0; pass < 2; ++pass) {
        if ((pass ^ (vcu & 1)) == 0) {
#ifdef ATT_DUP_PROMPT
          for (int rep2_ = 0; rep2_ < 2; ++rep2_)
#endif
            if (G == 256) {
                const int bh = vcu >> 1, s0 = 2 * (vcu & 1);
#pragma unroll 1
                for (int i = 0; i < 4; ++i) attn_unit_prompt(a, lds, bh >> 4, bh & 15, (i & 1) ? s0 + (i >> 1) : 7 - s0 - (i >> 1));
            } else {
#pragma unroll 1
                for (int u = vcu; u < 1024; u += G) attn_unit_prompt(a, lds, (u & 127) >> 4, u & 15, 7 - (u >> 7));
            }
        } else {
#ifdef ATT_DUP_SAMPLE
            for (int rep3_ = 0; rep3_ < 2; ++rep3_)
#endif
#pragma unroll 1
            for (int u = vcu; u < 512; u += G) attn_unit_sample(a, lds, u >> 4, u & 15);
        }
    }
}

#ifndef PH_MASK
#define PH_MASK 0x7fff
#endif
#define IN(k) (((PH_MASK >> (k)) & 1) && a.ph_lo <= (k) && (k) < a.ph_hi)
#define SEAM(k) do { if (IN(k) && IN((k) + 1)) { if ((k) == 0 && a.ph_hi < 0) cg::this_grid().sync(); xcd_barrier(xbar); } } while (0)
#ifndef DUP_MASK
#define DUP_MASK 0
#endif
#define REP(k) _Pragma("unroll 1") for (int rep_ = 0; rep_ < ((((DUP_MASK) >> (k)) & 1) ? 2 : 1); ++rep_)
#define REPSYNC(k) do { if ((((DUP_MASK) >> (k)) & 1)) xcd_barrier(xbar); } while (0)
struct SliceOrder {
    int pm, pn;
    __device__ __forceinline__ bool next(int i, pg8::Unit& u) const { if (i > 0) return false; u.pm = pm; u.pn = pn; return true; }
    __device__ __forceinline__ void a_ready(const pg8::Unit&) const {}
    __device__ __forceinline__ void done(const pg8::Unit&) const {}
};
struct EpiPartial {
    static constexpr bool PERM = true, AFTER_DRAIN = false;
    float* part;
    __device__ __forceinline__ void operator()(const pg8::f32x4 (&acc)[2][2][4][2], const pg8::Unit& u, int wr, int wc, int fr, int fq) const {
#pragma unroll
        for (int ai = 0; ai < 2; ++ai)
#pragma unroll
            for (int m = 0; m < 4; ++m) { float* rowp = part + (size_t)(ai * 128 + wr * 64 + m * 16 + fr) * 256 + wc * 32 + 8 * fq;
#pragma unroll
                for (int bj = 0; bj < 2; ++bj) { *(f32x4*)(rowp + bj * 128) = acc[ai][bj][m][0]; *(f32x4*)(rowp + bj * 128 + 4) = acc[ai][bj][m][1]; } }
    }
};
__device__ __forceinline__ void ffd_sample_rows(const Args& a, int vcu, int G, float* ssout) {
    const int tid = threadIdx.x, lane = tid & 63, wave = tid >> 6;
    const int gw = vcu * 8 + wave, NGW = G * 8;
    float* XR = (float*)(a.ws + WS_XR); bf16_t* XB = (bf16_t*)(a.ws + WS_XB); const float* PART = (const float*)(a.ws + WS_PART);
    for (int r = gw; r < MS; r += NGW) {
        const int pml = r >> 8, rr = r & 255; const size_t row = (size_t)(MP + r);
        f32x4 acc[4];
#pragma unroll
        for (int pn = 0; pn < 4; ++pn) { acc[pn] = *(const f32x4*)(XR + row * DM + pn * 256 + 4 * lane);
#pragma unroll
            for (int sl = 0; sl < 8; ++sl) acc[pn] += *(const f32x4*)(PART + ((size_t)((pml * 4 + pn) * 8 + sl) * 256 + rr) * 256 + 4 * lane); }
        float sq = 0.f;
#pragma unroll
        for (int pn = 0; pn < 4; ++pn) { sq += dot4(acc[pn]); *(f32x4*)(XR + row * DM + pn * 256 + 4 * lane) = acc[pn];
            u32x2 o; o.x = pk(acc[pn][0], acc[pn][1]); o.y = pk(acc[pn][2], acc[pn][3]); *(u32x2*)(XB + row * DM + pn * 256 + 4 * lane) = o; }
        sq = wave_sum(sq);
        if (lane == 0) ssout[row] = sq;
    }
}
template <int L> __device__ __forceinline__ void common_gemms(const Args& a, LAS unsigned char* lds, int G, int bx, const XcdBarrier& xbar) {
    unsigned char* ws = a.ws;
    float* SS = (float*)(ws + WS_SS);
    bf16_t* XB = (bf16_t*)(ws + WS_XB); float* XR = (float*)(ws + WS_XR); bf16_t* OG = (bf16_t*)(ws + WS_OG); bf16_t* ACT = (bf16_t*)(ws + WS_ACT);
    constexpr int po = L ? 11 : 5;
    if (IN(po)) { const int mrows = (L == 0 && G == 256 && !MK_MULTI) ? MP : MT;
        pg8::Gemm g{OG, (const bf16_t*)(ws + (L ? WS_WFOUT : WS_WGOUT)), mrows, DM, DM}; pg8::StaticOrder S; S.init(mrows, DM, G, bx);
        EpiResid E{L ? XR : a.in[I_XP], L ? XR + (size_t)MP * DM : a.in[I_XS], XR, XB, SS + (L ? 3 : 1) * 32768};
        pg8::gemm_phase<EpiResid, pg8::StaticOrder, true, true>(lds, g, S, E); }
    SEAM(po);
    if (IN(po + 1)) REP(po + 1) { pg8::Gemm g{XB, (const bf16_t*)(ws + WS_WFFI + (size_t)L * 11 * MiB), MT, 2 * DFF, DM}; pg8::StaticOrder S; S.init(MT, 2 * DFF, G, bx);
        EpiSwiglu E{SS + (L ? 3 : 1) * 32768, ACT}; pg8::gemm_phase<EpiSwiglu, pg8::StaticOrder, true, true>(lds, g, S, E);
        if (L == 0 && G == 256 && !MK_MULTI && bx >= 48) convert_weights(a, lds, 1, (bx - 48) * 8 + (int)(threadIdx.x >> 6), 208 * 8);
        REPSYNC(po + 1); }
    SEAM(po + 1);
    if (IN(po + 2)) {
        const bf16_t* W = (const bf16_t*)(ws + WS_WFFD + (size_t)L * 6 * MiB);
        if (G == 256 && !MK_MULTI) {
            { pg8::Gemm g{ACT, W, MP, DM, DFF, 0}; pg8::StaticOrder S; S.init(MP, DM, G, bx);
              EpiResid E{XR, XR + (size_t)MP * DM, XR, XB, SS + (L ? 4 : 2) * 32768};
              pg8::gemm_phase<EpiResid, pg8::StaticOrder, true, true>(lds, g, S, E); }
            { const int un = bx >> 3, sl = bx & 7, kb0 = (sl < 6) ? 3 * sl : 18 + 2 * (sl - 6), kbn = (sl < 6) ? 3 : 2;
              pg8::Gemm g{ACT + 128 * kb0, W + 128 * kb0, MT, DM, 128 * kbn, DFF}; SliceOrder S{64 + (un >> 2), un & 3};
              EpiPartial E{(float*)(ws + WS_PART) + (size_t)(un * 8 + sl) * 65536};
              pg8::gemm_phase<EpiPartial, SliceOrder, true, true>(lds, g, S, E); }
            xcd_barrier(xbar);
            ffd_sample_rows(a, (bx % 8) * (G / 8) + bx / 8, G, SS + (L ? 4 : 2) * 32768);
        } else {
            pg8::Gemm g{ACT, W, MT, DM, DFF, 0}; pg8::StaticOrder S; S.init(MT, DM, G, bx);
            EpiResid E{XR, XR + (size_t)MP * DM, XR, XB, SS + (L ? 4 : 2) * 32768};
            pg8::gemm_phase<EpiResid, pg8::StaticOrder, true, true>(lds, g, S, E);
        }
    }
    SEAM(po + 2);
}
constexpr int NPH = 15;
__global__ void __launch_bounds__(512, 2) fwd(Args a) {
    extern __shared__ __attribute__((aligned(16))) unsigned char lds_raw[];
    LAS unsigned char* lds = (LAS unsigned char*)lds_raw;
    const int G = gridDim.x, bx = blockIdx.x;
    const int vcu = (G % 8 == 0) ? (bx % 8) * (G / 8) + bx / 8 : bx;
    unsigned char* ws = a.ws;
    float* SS = (float*)(ws + WS_SS);
    bf16_t* XB = (bf16_t*)(ws + WS_XB); bf16_t* PROJ = (bf16_t*)(ws + WS_PROJ);

    volatile LAS unsigned* MISC = (volatile LAS unsigned*)(lds + 131072);
    if (threadIdx.x < 64) MISC[threadIdx.x] = 0u;
    __syncthreads();
    XcdBarrier xbar; xbar.bar = (unsigned*)ws; xbar.x = 0; xbar.st = nullptr;
    if (a.ph_hi - a.ph_lo > 1) xbar = xcd_barrier_post((unsigned*)ws, MISC + 8);
    if (IN(0)) REP(0) { p0_prologue(a, lds, vcu, G); REPSYNC(0); }
    SEAM(0);
    if (IN(1)) { pg8::Gemm g{XB, (const bf16_t*)(ws + WS_WGIN), MT, NPROJ, DM}; pg8::StaticOrder S; S.init(MT, NPROJ, G, bx);
        EpiGlaProj E{SS, PROJ, (float*)(ws + WS_GL)}; pg8::gemm_phase<EpiGlaProj, pg8::StaticOrder, true, true>(lds, g, S, E); }
    SEAM(1);
    if (IN(2)) REP(2) {
        if (G == 256 && !MK_MULTI) {
            GlaPre pf; gla_prefetch(pf, a, vcu >> 2, vcu & 3);
            const int it4 = 1024 + (vcu & 127);
#pragma unroll 1
            for (int it = vcu; it < 1024; it += G) gla_item<0>(a, lds, it >> 2, it & 3, pf, (it + G < 1024) ? it + G : it4);
            if (vcu < 128) gla_item<0>(a, lds, it4 >> 2, it4 & 3, pf, -1);
            else gla_item<1>(a, lds, it4 >> 2, it4 & 3, pf, -1);
        } else {
            GlaPre pf; if (vcu < 1152) gla_prefetch(pf, a, vcu >> 2, vcu & 3);
#pragma unroll 1
            for (int it = vcu; it < 1152; it += G) gla_item<0>(a, lds, it >> 2, it & 3, pf, (it + G < 1152) ? it + G : -1);
        }
        REPSYNC(2); }
    SEAM(2);
    if (IN(3)) REP(3) {
        if (G == 256 && !MK_MULTI) {
            if (bx < 32) { pg8::Gemm g{(const bf16_t*)(ws + WS_OG), (const bf16_t*)(ws + WS_WGOUT), MT, DM, DM, 0}; SliceOrder S{64 + (bx >> 2), bx & 3};
                EpiResid E{a.in[I_XP], a.in[I_XS], (float*)(ws + WS_XR), XB, SS + 32768};
                pg8::gemm_phase<EpiResid, SliceOrder, true, true>(lds, g, S, E); }
            else gla_scan(a, bx - 32, 224);
        } else gla_scan(a, vcu, G);
        REPSYNC(3); }
    SEAM(3);
    if (IN(4)) REP(4) {
        { const int nit = (G == 256 && !MK_MULTI) ? 1024 : 1152;
        GlaPre pf; if (vcu < nit) gla_prefetch(pf, a, vcu >> 2, vcu & 3);
#pragma unroll 1
        for (int it = vcu; it < nit; it += G) gla_item<1>(a, lds, it >> 2, it & 3, pf, (it + G < nit) ? it + G : -1); }
        REPSYNC(4); }
    SEAM(4);
    common_gemms<0>(a, lds, G, bx, xbar);
    if (IN(8)) { pg8::Gemm g{XB, (const bf16_t*)(ws + WS_WFIN), MT, NPROJ, DM}; pg8::StaticOrder S; S.init(MT, NPROJ, G, bx);
        EpiFoxProj E{SS + 2 * 32768, PROJ, a.out, a.in[I_FBF]}; pg8::gemm_phase<EpiFoxProj, pg8::StaticOrder, true, true>(lds, g, S, E); }
    SEAM(8);
    if (IN(9)) REP(9) { fox_cumsum(a, lds, vcu, G); REPSYNC(9); }
    SEAM(9);
    if (IN(10)) REP(10) { fox_attention(a, lds, vcu, G); REPSYNC(10); }
    SEAM(10);
    common_gemms<1>(a, lds, G, bx, xbar);
#ifdef EXTRA_SYNCS
    for (int i_ = 0; i_ < EXTRA_SYNCS; ++i_) xcd_barrier(xbar);
#endif
    if (IN(14)) p_final(a, vcu, G);
#undef IN
#undef SEAM
}

extern "C" void kernel_launch(void* const* d_in, const int* in_sizes, int n_in, void* d_out, int out_size, void* d_ws, size_t ws_size, hipStream_t stream) {
    static int grid = 0;
    if (grid == 0) {
        if (n_in != 19 || ws_size < WS_END || out_size != 62160896) { fprintf(stderr, "kernel_launch: unexpected problem shape (n_in %d, out %d, ws %zu)\n", n_in, out_size, ws_size); grid = -1; return; }
        if (hipFuncSetAttribute((const void*)fwd, hipFuncAttributeMaxDynamicSharedMemorySize, LDS_BYTES) != hipSuccess) { fprintf(stderr, "kernel_launch: hipFuncSetAttribute failed\n"); grid = -1; return; }
        int dev = 0, cus = 0, per_cu = 0;
        (void)hipGetDevice(&dev); (void)hipDeviceGetAttribute(&cus, hipDeviceAttributeMultiprocessorCount, dev);
        (void)hipOccupancyMaxActiveBlocksPerMultiprocessor(&per_cu, (const void*)fwd, 512, LDS_BYTES);
        (void)hipGetLastError();
        if (per_cu < 1) per_cu = 1;
        grid = cus * 1;
        if (grid <= 0) grid = 256;
    }
    if (grid < 0) return;
    (void)hipMemsetAsync((char*)d_ws + WS_CTL, 0, CTL_BYTES, stream);
    Args a{};
    for (int i = 0; i < 19; ++i) a.in[i] = (const float*)d_in[i];
    a.out = (float*)d_out; a.ws = (unsigned char*)d_ws;
#if MK_MULTI
    for (int ph = 0; ph < NPH; ++ph) { a.ph_lo = ph; a.ph_hi = ph + 1; hipLaunchKernelGGL(fwd, dim3(grid), dim3(512), LDS_BYTES, stream, a); }
#else
    a.ph_lo = 0; a.ph_hi = NPH;
    void* args[] = {&a};
    hipError_t e = hipLaunchCooperativeKernel((const void*)fwd, dim3(grid), dim3(512), args, LDS_BYTES, stream);
    if (e != hipSuccess) fprintf(stderr, "kernel_launch: cooperative launch failed: %s (grid %d)\n", hipGetErrorString(e), grid);
#endif
}
```

```cpp
#include <hip/hip_runtime.h>
#include <hip/hip_cooperative_groups.h>
#include <cstdio>
#include <cstdint>
#include <cmath>
namespace cg = cooperative_groups;
#define MK_MULTI 0
namespace pg8 {
#define PG8_LAS __attribute__((address_space(3)))
typedef unsigned short bf16_t;
typedef short bf16x8 __attribute__((ext_vector_type(8)));
typedef float f32x4 __attribute__((ext_vector_type(4)));
typedef unsigned u32x4 __attribute__((ext_vector_type(4)));
constexpr int BM = 256, BK = 64, HALF = 128, HTB = HALF * BK * 2  , STAGE_BYTES = 8 * HTB, NXCD = 8, WGM = 8;

__host__ __device__ __forceinline__ int lds_byte(int r, int c) { const int st = (r >> 4) * 2 + (c >> 5), rr = r & 15, cc = c & 31, ob = rr * 64 + cc * 2; return st * 1024 + (ob ^ (((ob >> 9) & 1) << 5)); }
__host__ __device__ __forceinline__ void stage_rc(int b, int& R, int& C) { const int st = b / 1024, sb = b % 1024, swz = sb ^ (((sb >> 9) & 1) << 5); R = (st >> 1) * 16 + swz / 64; C = (st & 1) * 32 + (swz % 64) / 2; }
__host__ __device__ __forceinline__ int perm32(int rho) { const int n = rho >> 4, i = rho & 15; return 8 * (i >> 2) + 4 * n + (i & 3); }

struct Unit { int pm, pn; };
struct Gemm { const bf16_t* A; const bf16_t* Bt; int M, N, K; int ld; };

struct StaticOrder {
    int nM, nN, nwg, G, c;
    __host__ __device__ void init(int M, int N, int G_, int c_) { nM = M / BM; nN = N / BM; nwg = nM * nN; G = G_; c = c_; }
    __host__ __device__ bool next(int i, Unit& u) const {
        const long L = (long)i * G + c; if (L >= nwg) return false;
        int wgid = (int)L; { const int q = nwg / NXCD, r = nwg % NXCD, xcd = wgid % NXCD, off = wgid / NXCD; wgid = (xcd < r ? xcd * (q + 1) : r * (q + 1) + (xcd - r) * q) + off; }
        const int nig = WGM * nN, gid = wgid / nig, fm = gid * WGM, gsz = (nM - fm) < WGM ? (nM - fm) : WGM;
        u.pm = fm + ((wgid % nig) % gsz); u.pn = (wgid % nig) / gsz; return true;
    }
    __device__ __forceinline__ void a_ready(const Unit&) const {}
    __device__ __forceinline__ void done(const Unit&) const {}
};

__device__ __forceinline__ unsigned cvt_pk_bf16(float lo, float hi) { unsigned r; asm volatile("v_cvt_pk_bf16_f32 %0, %1, %2" : "=v"(r) : "v"(lo), "v"(hi)); return r; }
template <class Epi, class Sched, bool ALIGN_EPI = false, bool SP2 = false>
__device__ __forceinline__ void gemm_phase(PG8_LAS unsigned char* lds, const Gemm g, const Sched& S, const Epi& E) {
    const int tid = threadIdx.x, wid = __builtin_amdgcn_readfirstlane(tid >> 6), lane = tid & 63, wr = wid >> 2, wc = wid & 3, fr = lane & 15, fq = lane >> 4;
    const int K = g.ld ? g.ld : g.K, nt = g.K / BK;
    unsigned voffA[2], voffB[2];
#pragma unroll
    for (int i = 0; i < 2; ++i) { int R, C; stage_rc(tid * 16 + i * 8192, R, C); const int Rb = Epi::PERM ? ((R & ~31) + perm32(R & 31)) : R;
        voffA[i] = (unsigned)(R * K + C) * 2u; voffB[i] = (unsigned)(Rb * K + C) * 2u; }
    const size_t kstep = (size_t)(BK * 2);
    const size_t hstep = (size_t)HALF * K * 2;
    const size_t tstep = 2 * hstep;
    const unsigned ldsw = (unsigned)wid * 1024u;
    const int aoff = lds_byte(wr * 64 + fr, fq * 8), boff = lds_byte(wc * 32 + fr, fq * 8);
#define PG8_SA(b, h) (((b) * 2 + (h)) * HTB)
#define PG8_SB(b, h) ((4 + (b) * 2 + (h)) * HTB)
#define PG8_STAGE(bufoff, gbase, voff) do { _Pragma("unroll") for (int _i = 0; _i < 2; ++_i) \
        __builtin_amdgcn_global_load_lds((const unsigned*)((const char*)(gbase) + (voff)[_i]), (PG8_LAS unsigned*)(lds + (bufoff) + ldsw + _i * 8192), 16, 0, 0); } while (0)
#define PG8_LDA(dst, b, h) do { _Pragma("unroll") for (int m = 0; m < 4; ++m) _Pragma("unroll") for (int k = 0; k < 2; ++k) dst[m][k] = *(const PG8_LAS bf16x8*)(lds + PG8_SA(b, h) + aoff + m * 2048 + k * 1024); } while (0)
#define PG8_LDB(dst, b, h) do { _Pragma("unroll") for (int n = 0; n < 2; ++n) _Pragma("unroll") for (int k = 0; k < 2; ++k) dst[n][k] = *(const PG8_LAS bf16x8*)(lds + PG8_SB(b, h) + boff + n * 2048 + k * 1024); } while (0)
#define PG8_MMA(ai, bj, At, Bt) do { __builtin_amdgcn_s_setprio(1); _Pragma("unroll") for (int m = 0; m < 4; ++m) _Pragma("unroll") for (int n = 0; n < 2; ++n) _Pragma("unroll") for (int k = 0; k < 2; ++k) \
        acc[ai][bj][m][n] = __builtin_amdgcn_mfma_f32_16x16x32_bf16(Bt[n][k], At[m][k], acc[ai][bj][m][n], 0, 0, 0); __builtin_amdgcn_s_setprio(0); } while (0)
#define PG8_WAIT_V(n) asm volatile("s_waitcnt vmcnt(" #n ")" ::: "memory")
#define PG8_WAIT_L(n) asm volatile("s_waitcnt lgkmcnt(" #n ")" ::: "memory")
#define PG8_BAR __builtin_amdgcn_s_barrier()
#define PG8_SCHED __builtin_amdgcn_sched_barrier(0)
    Unit cur, nxt; int ui = 0;
    if (!S.next(0, cur)) return;
    f32x4 acc[2][2][4][2];
#pragma unroll
    for (int a = 0; a < 2; ++a)
#pragma unroll
        for (int b = 0; b < 2; ++b)
#pragma unroll
            for (int m = 0; m < 4; ++m)
#pragma unroll
                for (int n = 0; n < 2; ++n) acc[a][b][m][n] = (f32x4){0.f, 0.f, 0.f, 0.f};
    bf16x8 At[4][2], B0[2][2], B1[2][2];
    const char* cA = (const char*)g.A + (size_t)cur.pm * tstep; const char* cB = (const char*)g.Bt + (size_t)cur.pn * tstep;
    S.a_ready(cur);
    if constexpr (SP2) {
        PG8_STAGE(PG8_SB(0, 0), cB, voffB); PG8_STAGE(PG8_SB(0, 1), cB + hstep, voffB); PG8_STAGE(PG8_SA(0, 0), cA, voffA); PG8_STAGE(PG8_SA(0, 1), cA + hstep, voffA);
        if (wr == 1) PG8_BAR;
        PG8_WAIT_V(2); PG8_BAR;
        PG8_STAGE(PG8_SB(1, 0), cB + kstep, voffB); PG8_STAGE(PG8_SA(1, 0), cA + kstep, voffA); PG8_STAGE(PG8_SB(1, 1), cB + hstep + kstep, voffB);
        PG8_WAIT_V(6); PG8_BAR;
    } else {
        PG8_STAGE(PG8_SB(0, 0), cB, voffB); PG8_STAGE(PG8_SA(0, 0), cA, voffA); PG8_STAGE(PG8_SB(0, 1), cB + hstep, voffB); PG8_STAGE(PG8_SA(0, 1), cA + hstep, voffA);
        if (wr == 1) PG8_BAR;
        PG8_WAIT_V(4); PG8_BAR;
        PG8_STAGE(PG8_SB(1, 0), cB + kstep, voffB); PG8_STAGE(PG8_SA(1, 0), cA + kstep, voffA); PG8_STAGE(PG8_SB(1, 1), cB + hstep + kstep, voffB);
        PG8_WAIT_V(6); PG8_BAR;
    }
    for (;;) {
        const bool has_next = S.next(ui + 1, nxt);
        const char* nA = has_next ? (const char*)g.A + (size_t)nxt.pm * tstep : cA; const char* nB = has_next ? (const char*)g.Bt + (size_t)nxt.pn * tstep : cB;
        for (int t = 0; t < nt; t += 2) {
            const bool last = (t == nt - 2);
            const char* a1 = cA + (size_t)(t + 1) * kstep;
            const char* a2 = last ? nA : cA + (size_t)(t + 2) * kstep; const char* b2 = last ? nB : cB + (size_t)(t + 2) * kstep;
            const char* a3 = a2 + kstep; const char* b3 = b2 + kstep;
            if (last && has_next) S.a_ready(nxt);
            if constexpr (SP2) {
            PG8_LDB(B0, 0, 0); PG8_LDB(B1, 0, 1); PG8_SCHED; PG8_LDA(At, 0, 0); PG8_STAGE(PG8_SA(1, 1), a1 + hstep, voffA);
            PG8_WAIT_V(8); PG8_WAIT_L(0); PG8_BAR; PG8_MMA(0, 0, At, B0); PG8_MMA(0, 1, At, B1); PG8_BAR; PG8_SCHED;
            PG8_LDA(At, 0, 1); PG8_STAGE(PG8_SB(0, 0), b2, voffB); PG8_STAGE(PG8_SB(0, 1), b2 + hstep, voffB); PG8_STAGE(PG8_SA(0, 0), a2, voffA);
            PG8_WAIT_V(8); PG8_WAIT_L(0); PG8_BAR; PG8_MMA(1, 0, At, B0); PG8_MMA(1, 1, At, B1); PG8_BAR; PG8_SCHED;
            PG8_LDB(B0, 1, 0); PG8_LDB(B1, 1, 1); PG8_SCHED; PG8_LDA(At, 1, 0); PG8_STAGE(PG8_SA(0, 1), a2 + hstep, voffA);
            PG8_WAIT_V(8); PG8_WAIT_L(0); PG8_BAR; PG8_MMA(0, 0, At, B0); PG8_MMA(0, 1, At, B1); PG8_BAR; PG8_SCHED;
            PG8_LDA(At, 1, 1); PG8_STAGE(PG8_SB(1, 0), b3, voffB); PG8_STAGE(PG8_SB(1, 1), b3 + hstep, voffB); PG8_STAGE(PG8_SA(1, 0), a3, voffA);
            PG8_WAIT_V(8); PG8_WAIT_L(0); PG8_BAR; PG8_MMA(1, 0, At, B0); PG8_MMA(1, 1, At, B1); PG8_BAR; PG8_SCHED;
            } else {
            PG8_LDB(B0, 0, 0); PG8_SCHED; PG8_LDA(At, 0, 0); PG8_STAGE(PG8_SA(1, 1), a1 + hstep, voffA);
            PG8_WAIT_L(8); PG8_BAR; PG8_WAIT_L(0); PG8_MMA(0, 0, At, B0); PG8_BAR; PG8_SCHED;
            PG8_LDB(B1, 0, 1); PG8_STAGE(PG8_SB(0, 0), b2, voffB);
            PG8_BAR; PG8_WAIT_L(0); PG8_MMA(0, 1, At, B1); PG8_BAR;
            PG8_LDA(At, 0, 1); PG8_STAGE(PG8_SA(0, 0), a2, voffA);
            PG8_BAR; PG8_WAIT_L(0); PG8_MMA(1, 0, At, B0); PG8_BAR; PG8_SCHED;
            PG8_STAGE(PG8_SB(0, 1), b2 + hstep, voffB);
            PG8_WAIT_V(6); PG8_BAR; PG8_MMA(1, 1, At, B1); PG8_BAR;
            PG8_LDB(B0, 1, 0); PG8_SCHED; PG8_LDA(At, 1, 0); PG8_STAGE(PG8_SA(0, 1), a2 + hstep, voffA);
            PG8_WAIT_L(8); PG8_BAR; PG8_WAIT_L(0); PG8_MMA(0, 0, At, B0); PG8_BAR; PG8_SCHED;
            PG8_LDB(B1, 1, 1); PG8_STAGE(PG8_SB(1, 0), b3, voffB);
            PG8_BAR; PG8_WAIT_L(0); PG8_MMA(0, 1, At, B1); PG8_BAR;
            PG8_LDA(At, 1, 1); PG8_STAGE(PG8_SA(1, 0), a3, voffA);
            PG8_BAR; PG8_WAIT_L(0); PG8_MMA(1, 0, At, B0); PG8_BAR; PG8_SCHED;
            PG8_STAGE(PG8_SB(1, 1), b3 + hstep, voffB);
            PG8_WAIT_V(6); PG8_BAR; PG8_MMA(1, 1, At, B1); PG8_BAR;
            }
        }
        if constexpr (ALIGN_EPI) { if (wr == 0) PG8_BAR; }
        if constexpr (!Epi::AFTER_DRAIN) { E(acc, cur, wr, wc, fr, fq); S.done(cur); }
        if (!has_next) break;
#pragma unroll
        for (int a = 0; a < 2; ++a)
#pragma unroll
            for (int b = 0; b < 2; ++b)
#pragma unroll
                for (int m = 0; m < 4; ++m)
#pragma unroll
                    for (int n = 0; n < 2; ++n) acc[a][b][m][n] = (f32x4){0.f, 0.f, 0.f, 0.f};
        cur = nxt; cA = nA; cB = nB; ++ui;
        if constexpr (ALIGN_EPI) { if (wr == 1) PG8_BAR; }
    }
    PG8_WAIT_V(0);
    if constexpr (!ALIGN_EPI) { if (wr == 0) PG8_BAR; }
    PG8_BAR;
    if constexpr (Epi::AFTER_DRAIN) { E.fused(acc, cur, wr, wc, fr, fq, lds, wid, lane); S.done(cur); }
#undef PG8_SA
#undef PG8_SB
#undef PG8_STAGE
#undef PG8_LDA
#undef PG8_LDB
#undef PG8_MMA
#undef PG8_WAIT_V
#undef PG8_WAIT_L
#undef PG8_BAR
#undef PG8_SCHED
}
}

#define LAS __attribute__((address_space(3)))
typedef unsigned short bf16_t;
typedef short bf16x8 __attribute__((ext_vector_type(8)));
typedef float f32x4 __attribute__((ext_vector_type(4)));
typedef float f32x16 __attribute__((ext_vector_type(16)));
typedef unsigned u32x4 __attribute__((ext_vector_type(4)));
typedef unsigned u32x2 __attribute__((ext_vector_type(2)));

#ifndef MK_MULTI
#define MK_MULTI 0
#endif

constexpr int DM = 1024, MP = 16384, MS = 2048, MT = MP + MS;
constexpr int NPROJ = 3328, NPJ = 3072, DFF = 2816;
constexpr float EPS = 1e-6f;
constexpr float LOG2E = 1.4426950408889634f;
constexpr float QSCALE2 = 0.125f * LOG2E;
constexpr size_t O_Y = 0, O_GSP = 18874368, O_FKP = 19922944, O_FVP = 36700160, O_FLP = 53477376, O_GSS = 53739520, O_FKS = 57933824, O_FVS = 60030976, O_FLS = 62128128;
constexpr size_t MiB = 1u << 20;
constexpr size_t WS_CTL = 0, CTL_BYTES = 2 * MiB;
constexpr size_t WS_SS = 65536;
constexpr size_t WS_WGIN = 2 * MiB, WS_WFIN = 9 * MiB, WS_WGOUT = 16 * MiB, WS_WFOUT = 18 * MiB, WS_WFFI = 20 * MiB  , WS_WFFD = 42 * MiB  ;
constexpr size_t WS_XB = 54 * MiB, WS_XR = 90 * MiB, WS_PROJ = 162 * MiB, WS_GL = 270 * MiB, WS_DST = 272 * MiB, WS_DEC = 400 * MiB, WS_SPREV = 401 * MiB;
constexpr size_t WS_OG = 465 * MiB, WS_ACT = 501 * MiB, WS_CP = 600 * MiB, WS_CS = 601 * MiB, WS_PART = 606 * MiB  , WS_END = 672 * MiB;
constexpr int LDS_BYTES = 135168;

struct Args {
    const float* in[19];
    float* out; unsigned char* ws;
    int ph_lo, ph_hi;
};
enum { I_XP = 0, I_XS, I_STATE, I_CK, I_CV, I_CLF, I_NMIX, I_GWIN, I_GWG2, I_GBG, I_GNORM, I_GWOUT, I_FWIN, I_FBF, I_FWOUT, I_NFFN, I_FFIN, I_FFDN, I_NFIN };

__device__ __forceinline__ float bf2f(unsigned u) { return __uint_as_float(u << 16); }
__device__ __forceinline__ unsigned f2bf(float f) { unsigned u = __float_as_uint(f); return (u + 0x7fffu + ((u >> 16) & 1u)) >> 16; }
__device__ __forceinline__ unsigned pk(float lo, float hi) { return pg8::cvt_pk_bf16(lo, hi); }
__device__ __forceinline__ float wave_sum(float v) {
#pragma unroll
    for (int o = 1; o < 64; o <<= 1) v += __shfl_xor(v, o);
    return v;
}
__device__ __forceinline__ float log_sigmoid(float z) { return fminf(z, 0.f) - __logf(1.f + __expf(-fabsf(z))); }
__device__ __forceinline__ int crow(int r, int hi) { return (r & 3) + 8 * (r >> 2) + 4 * hi; }
__device__ __forceinline__ float dot4(f32x4 v) { return (v[0] * v[0] + v[1] * v[1]) + (v[2] * v[2] + v[3] * v[3]); }
#define MFMA32(a, b, c) __builtin_amdgcn_mfma_f32_32x32x16_bf16((a), (b), (c), 0, 0, 0)

#define XB_TMO      128
#define XB_XCNT(j)  (256  + 64 * (j))
#define XB_XSUB(j)  (1280 + 64 * (j))
#define XB_XGEN(j)  (2304 + 64 * (j))
#define XB_TOP      3328
#define XB_TOPGEN   3392
#define XCD_BAR_WORDS 3456
#define XB_SPIN_CAP (1u << 18)

__device__ __forceinline__ unsigned xb_ld(unsigned* p)              { return __hip_atomic_load(p, __ATOMIC_RELAXED, __HIP_MEMORY_SCOPE_AGENT); }
__device__ __forceinline__ unsigned xb_add(unsigned* p, unsigned v) { return __hip_atomic_fetch_add(p, v, __ATOMIC_RELAXED, __HIP_MEMORY_SCOPE_AGENT); }
__device__ __forceinline__ unsigned xb_xcc_id() { return (unsigned)__builtin_amdgcn_s_getreg((3 << 11) | 20) & 0xFu; }
#define XB_SPIN(cond, bar) do { unsigned _sp = 0; while (cond) { __builtin_amdgcn_s_sleep(1); \
    if ((++_sp & 255u) == 0u) { if (xb_ld(&(bar)[XB_TMO])) break; if (_sp > XB_SPIN_CAP) { atomicAdd(&(bar)[XB_TMO], 1u); break; } } } } while (0)

struct XcdBarrier {
    unsigned* bar; unsigned x;
    volatile LAS unsigned* st;
};

__device__ __forceinline__ XcdBarrier xcd_barrier_post(unsigned* bar, volatile LAS unsigned* st) {
    XcdBarrier b; b.bar = bar; b.x = xb_xcc_id(); b.st = st;
    if (threadIdx.x == 0) (void)xb_add(&bar[XB_XCNT(b.x)], 1u);
    return b;
}
__device__ __forceinline__ void xcd_barrier_complete(unsigned* bar, unsigned x, unsigned& nloc, unsigned& nx) {
    const unsigned G = gridDim.x * gridDim.y * gridDim.z;
    unsigned sum, cnt, mine, sp = 0u;
    for (;;) {
        sum = 0u; cnt = 0u; mine = 0u;
#pragma unroll
        for (unsigned j = 0; j < 16; ++j) { const unsigned c = xb_ld(&bar[XB_XCNT(j)]); sum += c; cnt += (c > 0u) ? 1u : 0u; mine = (j == x) ? c : mine; }
        if (sum == G) break;
        __builtin_amdgcn_s_sleep(1);
        if ((++sp & 255u) == 0u) { if (xb_ld(&bar[XB_TMO])) break; if (sp > XB_SPIN_CAP) { atomicAdd(&bar[XB_TMO], 1u); break; } }
    }
    nloc = mine > 0u ? mine : 1u; nx = cnt > 0u ? cnt : 1u;
}

__device__ __forceinline__ void xcd_barrier(const XcdBarrier& b) {
    asm volatile("s_waitcnt vmcnt(0)" ::: "memory");
    __syncthreads();
    if (threadIdx.x == 0) {
        unsigned* bar = b.bar;
        __builtin_amdgcn_s_waitcnt(0);
        unsigned nloc = b.st[0], nx = b.st[1];
        if (nloc == 0u) { xcd_barrier_complete(bar, b.x, nloc, nx); b.st[0] = nloc; b.st[1] = nx; }
        const unsigned old = xb_add(&bar[XB_XSUB(b.x)], 1u);
        const unsigned gen = old / nloc;
        if (old + 1u == (gen + 1u) * nloc) {
            __builtin_amdgcn_fence(__ATOMIC_RELEASE, "agent");
            asm volatile("s_waitcnt vmcnt(0)" ::: "memory");
            const unsigned og = xb_add(&bar[XB_TOP], 1u);
            const unsigned tg = og / nx;
            if (og + 1u == (tg + 1u) * nx) xb_add(&bar[XB_TOPGEN], 1u);
            else XB_SPIN(xb_ld(&bar[XB_TOPGEN]) == tg, bar);
            __builtin_amdgcn_fence(__ATOMIC_ACQUIRE, "agent");
            xb_add(&bar[XB_XGEN(b.x)], 1u);
            asm volatile("s_waitcnt vmcnt(0)" ::: "memory");
        } else {
            XB_SPIN(xb_ld(&bar[XB_XGEN(b.x)]) == gen, bar);
            __builtin_amdgcn_fence(__ATOMIC_ACQUIRE, "agent");
            asm volatile("s_waitcnt vmcnt(0)" ::: "memory");
        }
    }
    __syncthreads();
}

__device__ __forceinline__ void tr_item(const float* __restrict__ W, int K, int N, int nsrc0, bf16_t* WT, int drow0, const float* __restrict__ gain, LAS float* scr, int k0, int lane) {
    const int n = nsrc0 + (lane & 31);
    float wv_[32];
    const float* wp_ = W + (size_t)(k0 + (lane >> 5)) * N + ((n < N) ? n : 0);
#pragma unroll
    for (int i = 0; i < 32; ++i) wv_[i] = wp_[(size_t)(2 * i) * N];
#pragma unroll
    for (int i = 0; i < 32; ++i) {
        const int kk = 2 * i + (lane >> 5);
        float v = (n < N) ? wv_[i] : 0.f;
        if (gain) v *= gain[k0 + kk];
        scr[kk * 33 + (lane & 31)] = v;
    }
    asm volatile("s_waitcnt lgkmcnt(0)" ::: "memory");
    const int c = lane & 7;
#pragma unroll
    for (int j = 0; j < 4; ++j) {
        const int nn = (lane >> 3) + 8 * j; const LAS float* s = scr + (8 * c) * 33 + nn;
        u32x4 o; o.x = pk(s[0 * 33], s[1 * 33]); o.y = pk(s[2 * 33], s[3 * 33]); o.z = pk(s[4 * 33], s[5 * 33]); o.w = pk(s[6 * 33], s[7 * 33]);
        *(u32x4*)(WT + (size_t)(drow0 + nn) * K + k0 + 8 * c) = o;
    }
    asm volatile("s_waitcnt lgkmcnt(0)" ::: "memory");
}

__device__ __forceinline__ void convert_weights(const Args& a, LAS unsigned char* lds, int sel, int gw, int NGW) {
    const int tid = threadIdx.x, lane = tid & 63, wave = tid >> 6;
    LAS float* scr = (LAS float*)(lds + wave * 16384);
    unsigned char* ws = a.ws;
    constexpr int I_IN = 16 * 104, I_OUT = 16 * 32, I_FI = 16 * 176, I_FD = 44 * 32;
    constexpr int NITEMS = I_IN + I_OUT + I_FI + I_FD;
    for (int it = gw; it < NITEMS; it += NGW) {
        int r = it;
        if (r < I_IN) { const int kb = r / 104, nb = r % 104; tr_item(a.in[sel ? I_FWIN : I_GWIN], 1024, 3088, 32 * nb, (bf16_t*)(ws + (sel ? WS_WFIN : WS_WGIN)), 32 * nb, a.in[I_NMIX] + sel * 1024, scr, 64 * kb, lane); continue; } r -= I_IN;
        if (r < I_OUT) { const int kb = r / 32, nb = r % 32; tr_item(a.in[sel ? I_FWOUT : I_GWOUT], 1024, 1024, 32 * nb, (bf16_t*)(ws + (sel ? WS_WFOUT : WS_WGOUT)), 32 * nb, nullptr, scr, 64 * kb, lane); continue; } r -= I_OUT;
        if (r < I_FI) { const int kb = r / 176, nb = r % 176, ns = 32 * nb, bj = ns / DFF, j = ns % DFF, drow = 256 * (j / 128) + 128 * bj + (j % 128);
            tr_item(a.in[I_FFIN] + (size_t)sel * 1024 * 5632, 1024, 5632, ns, (bf16_t*)(ws + WS_WFFI + (size_t)sel * 11 * MiB), drow, a.in[I_NFFN] + sel * 1024, scr, 64 * kb, lane); continue; } r -= I_FI;
        { const int kb = r / 32, nb = r % 32;
            tr_item(a.in[I_FFDN] + (size_t)sel * DFF * 1024, DFF, 1024, 32 * nb, (bf16_t*)(ws + WS_WFFD + (size_t)sel * 6 * MiB), 32 * nb, nullptr, scr, 64 * kb, lane); }
    }
}
__device__ __forceinline__ void p0_prologue(const Args& a, LAS unsigned char* lds, int vcu, int G) {
    const int tid = threadIdx.x, lane = tid & 63, wave = tid >> 6;
    const int gw = vcu * 8 + wave, NGW = G * 8;
    unsigned char* ws = a.ws;
    convert_weights(a, lds, 0, gw, NGW);
    if (G != 256 || MK_MULTI) convert_weights(a, lds, 1, gw, NGW);
    float* ss0 = (float*)(ws + WS_SS);
    bf16_t* XB = (bf16_t*)(ws + WS_XB);
    for (int m0 = gw; m0 < MT; m0 += 3 * NGW) {
        f32x4 v[3][4];
#pragma unroll
        for (int q = 0; q < 3; ++q) { const int m = m0 + q * NGW; if (m < MT) { const float* xr = (m < MP) ? a.in[I_XP] + (size_t)m * DM : a.in[I_XS] + (size_t)(m - MP) * DM;
#pragma unroll
            for (int j = 0; j < 4; ++j) v[q][j] = ((const f32x4*)xr)[lane + 64 * j]; } }
#pragma unroll
        for (int q = 0; q < 3; ++q) { const int m = m0 + q * NGW; if (m < MT) { float s = 0.f;
#pragma unroll
            for (int j = 0; j < 4; ++j) s += dot4(v[q][j]);
            s = wave_sum(s);
            if (lane == 0) ss0[m] = s;
#pragma unroll
            for (int j = 0; j < 4; ++j) { u32x2 o; o.x = pk(v[q][j][0], v[q][j][1]); o.y = pk(v[q][j][2], v[q][j][3]); ((u32x2*)(XB + (size_t)m * DM))[lane + 64 * j] = o; } } }
    }
}

__device__ __forceinline__ void p_final(const Args& a, int vcu, int G) {
    const int tid = threadIdx.x, lane = tid & 63, wave = tid >> 6;
    const int gw = vcu * 8 + wave, NGW = G * 8;
    const float* ss = (const float*)(a.ws + WS_SS + 4 * 131072);
    const float* XR = (const float*)(a.ws + WS_XR);
    const float* g = a.in[I_NFIN];
    f32x4 gv[4];
#pragma unroll
    for (int j = 0; j < 4; ++j) gv[j] = ((const f32x4*)g)[lane + 64 * j];
    for (int m0 = gw; m0 < MT; m0 += 3 * NGW) {
        f32x4 v[3][4]; float rs[3];
#pragma unroll
        for (int q = 0; q < 3; ++q) { const int m = m0 + q * NGW; if (m < MT) { rs[q] = rsqrtf(ss[m] * (1.f / DM) + EPS);
#pragma unroll
            for (int j = 0; j < 4; ++j) v[q][j] = ((const f32x4*)(XR + (size_t)m * DM))[lane + 64 * j]; } }
#pragma unroll
        for (int q = 0; q < 3; ++q) { const int m = m0 + q * NGW; if (m < MT) {
#pragma unroll
            for (int j = 0; j < 4; ++j) __builtin_nontemporal_store(v[q][j] * rs[q] * gv[j], (f32x4*)(a.out + O_Y + (size_t)m * DM) + lane + 64 * j); } }
    }
}

struct EpiGlaProj {
    static constexpr bool PERM = true, AFTER_DRAIN = false;
    const float* ss; bf16_t* proj; float* gl;
    __device__ __forceinline__ void operator()(const pg8::f32x4 (&acc)[2][2][4][2], const pg8::Unit& u, int wr, int wc, int fr, int fq) const {
        const int row0 = u.pm * 256 + wr * 64 + fr;
#pragma unroll
        for (int ai = 0; ai < 2; ++ai)
#pragma unroll
            for (int m = 0; m < 4; ++m) {
                const int row = row0 + ai * 128 + m * 16; const float rs = rsqrtf(ss[row] * (1.f / DM) + EPS);
                if (u.pn < 12) {
#pragma unroll
                    for (int bj = 0; bj < 2; ++bj) { const f32x4 v0 = acc[ai][bj][m][0] * rs, v1 = acc[ai][bj][m][1] * rs;
                        u32x4 w; w.x = pk(v0[0], v0[1]); w.y = pk(v0[2], v0[3]); w.z = pk(v1[0], v1[1]); w.w = pk(v1[2], v1[3]);
                        *(u32x4*)(proj + (size_t)row * NPJ + u.pn * 256 + bj * 128 + wc * 32 + 8 * fq) = w; }
                } else if (wc == 0 && fq < 2) {
#pragma unroll
                    for (int n = 0; n < 2; ++n) *(f32x4*)(gl + (size_t)row * 16 + 8 * fq + 4 * n) = acc[ai][0][m][n] * rs;
                }
            }
    }
};
struct EpiResid {
    static constexpr bool PERM = true, AFTER_DRAIN = false;
    const float* xin_p; const float* xin_s; float* xout; bf16_t* xb; float* ssout;
    __device__ __forceinline__ void operator()(const pg8::f32x4 (&acc)[2][2][4][2], const pg8::Unit& u, int wr, int wc, int fr, int fq) const {
        const int row0 = u.pm * 256 + wr * 64 + fr;
#pragma unroll
        for (int ai = 0; ai < 2; ++ai)
#pragma unroll
            for (int m = 0; m < 4; ++m) {
                const int row = row0 + ai * 128 + m * 16;
                const float* xi = (row < MP) ? xin_p + (size_t)row * DM : xin_s + (size_t)(row - MP) * DM;
                float sq = 0.f;
#pragma unroll
                for (int bj = 0; bj < 2; ++bj) { const int col = u.pn * 256 + bj * 128 + wc * 32 + 8 * fq;
                    const f32x4 a0 = *(const f32x4*)(xi + col) + acc[ai][bj][m][0], a1 = *(const f32x4*)(xi + col + 4) + acc[ai][bj][m][1];
                    *(f32x4*)(xout + (size_t)row * DM + col) = a0; *(f32x4*)(xout + (size_t)row * DM + col + 4) = a1;
                    u32x4 w; w.x = pk(a0[0], a0[1]); w.y = pk(a0[2], a0[3]); w.z = pk(a1[0], a1[1]); w.w = pk(a1[2], a1[3]);
                    *(u32x4*)(xb + (size_t)row * DM + col) = w;
                    sq += dot4(a0) + dot4(a1); }
                sq += __shfl_xor(sq, 16); sq += __shfl_xor(sq, 32);
                if (fq == 0) atomicAdd(ssout + row, sq);
            }
    }
};
struct EpiSwiglu {
    static constexpr bool PERM = true, AFTER_DRAIN = false;
    const float* ss; bf16_t* act;
    __device__ __forceinline__ void operator()(const pg8::f32x4 (&acc)[2][2][4][2], const pg8::Unit& u, int wr, int wc, int fr, int fq) const {
        const int row0 = u.pm * 256 + wr * 64 + fr;
#pragma unroll
        for (int ai = 0; ai < 2; ++ai)
#pragma unroll
            for (int m = 0; m < 4; ++m) {
                const int row = row0 + ai * 128 + m * 16; const float rs = rsqrtf(ss[row] * (1.f / DM) + EPS);
                float y[8];
#pragma unroll
                for (int n = 0; n < 2; ++n)
#pragma unroll
                    for (int i = 0; i < 4; ++i) { const float g = acc[ai][0][m][n][i] * rs, up = acc[ai][1][m][n][i] * rs; y[4 * n + i] = g * up * __builtin_amdgcn_rcpf(1.f + __expf(-g)); }
                u32x4 w; w.x = pk(y[0], y[1]); w.y = pk(y[2], y[3]); w.z = pk(y[4], y[5]); w.w = pk(y[6], y[7]);
                *(u32x4*)(act + (size_t)row * DFF + u.pn * 128 + wc * 32 + 8 * fq) = w;
            }
    }
};
struct EpiFoxProj {
    static constexpr bool PERM = true, AFTER_DRAIN = false;
    const float* ss; bf16_t* qkv; float* out; const float* bf;
    __device__ __forceinline__ void operator()(const pg8::f32x4 (&acc)[2][2][4][2], const pg8::Unit& u, int wr, int wc, int fr, int fq) const {
        const int row0 = u.pm * 256 + wr * 64 + fr;
        const int sect = u.pn >> 2;
#pragma unroll
        for (int ai = 0; ai < 2; ++ai)
#pragma unroll
            for (int m = 0; m < 4; ++m) {
                const int row = row0 + ai * 128 + m * 16; const float rs = rsqrtf(ss[row] * (1.f / DM) + EPS);
                if (u.pn < 12) {
                    const float sc = (sect == 0) ? rs * QSCALE2 : rs;
                    float* fdst = nullptr;
                    if (sect == 1) fdst = (row < MP) ? out + O_FKP + (size_t)row * DM : out + O_FKS + (size_t)(row - MP) * DM;
                    if (sect == 2) fdst = (row < MP) ? out + O_FVP + (size_t)row * DM : out + O_FVS + (size_t)(row - MP) * DM;
#pragma unroll
                    for (int bj = 0; bj < 2; ++bj) { const f32x4 v0 = acc[ai][bj][m][0] * sc, v1 = acc[ai][bj][m][1] * sc;
                        u32x4 w; w.x = pk(v0[0], v0[1]); w.y = pk(v0[2], v0[3]); w.z = pk(v1[0], v1[1]); w.w = pk(v1[2], v1[3]);
                        const int cl = bj * 128 + wc * 32 + 8 * fq;
                        *(u32x4*)(qkv + (size_t)row * NPJ + u.pn * 256 + cl) = w;
                        if (sect > 0) { float* d = fdst + (u.pn & 3) * 256 + cl; __builtin_nontemporal_store(v0, (f32x4*)d); __builtin_nontemporal_store(v1, (f32x4*)(d + 4)); } }
                } else if (wc == 0 && fq < 2) {
                    float* d = (row < MP) ? out + O_FLP + (size_t)row * 16 : out + O_FLS + (size_t)(row - MP) * 16;
#pragma unroll
                    for (int n = 0; n < 2; ++n) { const f32x4 v = acc[ai][0][m][n] * rs; f32x4 o;
#pragma unroll
                        for (int i = 0; i < 4; ++i) o[i] = log_sigmoid(v[i] + bf[8 * fq + 4 * n + i]);
                        *(f32x4*)(d + 8 * fq + 4 * n) = o; }
                }
            }
    }
};

constexpr int GL_OFF = 0, GSUM_OFF = 4096, DECS_OFF = 6144, QE_OFF = 8192, KE_OFF = 25600, VT_OFF = 43008, AL_OFF = 79872, KDT_OFF = 8192, OL_OFF = 8192;
constexpr int QES = 136, VTS = 72, OLS = 260;

struct GlaPre { unsigned v[32]; f32x4 gl; };
__device__ __forceinline__ void gla_prefetch(GlaPre& pf, const Args& a, int cid, int h) {
    const int tid = threadIdx.x, dvv = tid & 255, th = tid >> 8, row0 = cid * 64;
    const bf16_t* vp = (const bf16_t*)(a.ws + WS_PROJ) + (size_t)(row0 + 32 * th) * NPJ + 1024 + h * 256 + dvv;
#pragma unroll
    for (int i = 0; i < 32; ++i) pf.v[i] = vp[(size_t)i * NPJ];
    pf.gl = *(const f32x4*)((const float*)(a.ws + WS_GL) + (size_t)(row0 + ((tid & 255) >> 2)) * 16 + (tid & 3) * 4);
}
template <int MODE> __device__ __forceinline__ void gla_item(const Args& a, LAS unsigned char* lds, int cid, int h, GlaPre& pf, int next) {
    int tid_ = threadIdx.x; asm volatile("" : "+v"(tid_));
    const int tid = tid_, lane = tid & 63, w = __builtin_amdgcn_readfirstlane(tid >> 6), l31 = lane & 31, hi = lane >> 5;
    const int row0 = cid * 64;
    const bool prompt = cid < 256;
    LAS float* GLs = (LAS float*)(lds + GL_OFF); LAS float* GSUM = (LAS float*)(lds + GSUM_OFF); LAS float* DECS = (LAS float*)(lds + DECS_OFF);
    LAS bf16_t* QE = (LAS bf16_t*)(lds + QE_OFF); LAS bf16_t* KE = (LAS bf16_t*)(lds + KE_OFF); LAS bf16_t* VT = (LAS bf16_t*)(lds + VT_OFF);
    LAS bf16_t* AL = (LAS bf16_t*)(lds + AL_OFF); LAS bf16_t* KDT = (LAS bf16_t*)(lds + KDT_OFF);
    const bf16_t* P = (const bf16_t*)(a.ws + WS_PROJ) + (size_t)row0 * NPJ;
    const float* GL = (const float*)(a.ws + WS_GL);
    const float* state = a.in[I_STATE];

    bf16x8 sfr[8];
    if (MODE == 1) {
        if (prompt) {
            const bf16_t* sp = (const bf16_t*)(a.ws + WS_SPREV) + ((size_t)(cid * 4 + h) * 256 + 32 * w + l31) * 128 + 8 * hi;
#pragma unroll
            for (int ks = 0; ks < 8; ++ks) sfr[ks] = *(const bf16x8*)(sp + 16 * ks);
        } else {
            const float* s0 = state + ((size_t)((cid - 256) * 4 + h) * 128) * 256 + 32 * w + l31;
#pragma unroll
            for (int ks = 0; ks < 8; ++ks) { float f[8];
#pragma unroll
                for (int j = 0; j < 8; ++j) f[j] = s0[(size_t)(16 * ks + 8 * hi + j) * 256];
                u32x4 o; o.x = pk(f[0], f[1]); o.y = pk(f[2], f[3]); o.z = pk(f[4], f[5]); o.w = pk(f[6], f[7]); sfr[ks] = __builtin_bit_cast(bf16x8, o); }
        }
    }
    unsigned kraw[16], qraw[16];
    {
        const int dk_ = tid & 127, tg_ = tid >> 7;
        const bf16_t* kp_ = P + (size_t)(16 * tg_) * NPJ + 512 + h * 128 + dk_;
#pragma unroll
        for (int i = 0; i < 16; ++i) kraw[i] = kp_[(size_t)i * NPJ];
        if (MODE == 1) { const bf16_t* qp_ = P + (size_t)(16 * tg_) * NPJ + h * 128 + dk_;
#pragma unroll
            for (int i = 0; i < 16; ++i) qraw[i] = qp_[(size_t)i * NPJ]; }
    }
    float wv[16];
#pragma unroll
    for (int j = 0; j < 16; ++j) wv[j] = a.in[I_GWG2][j * 512 + h * 128 + (tid & 127)];
    const float bias = a.in[I_GBG][h * 128 + (tid & 127)];
    if (tid < 256) ((LAS f32x4*)GLs)[tid] = pf.gl;
    {
        const int dvv = tid & 255, th = tid >> 8;
#pragma unroll
        for (int q4 = 0; q4 < 4; ++q4) { u32x4 o; o.x = pf.v[8 * q4] | (pf.v[8 * q4 + 1] << 16); o.y = pf.v[8 * q4 + 2] | (pf.v[8 * q4 + 3] << 16);
            o.z = pf.v[8 * q4 + 4] | (pf.v[8 * q4 + 5] << 16); o.w = pf.v[8 * q4 + 6] | (pf.v[8 * q4 + 7] << 16);
            *(LAS u32x4*)(VT + dvv * VTS + 32 * th + 8 * q4) = o; }
    }
    if (next >= 0) gla_prefetch(pf, a, next >> 2, next & 3);
    __syncthreads();
    const int dk = tid & 127, tg = tid >> 7;
    float bc[16];
    {
        float run = 0.f;
#pragma unroll
        for (int i = 0; i < 16; ++i) { const LAS f32x4* gp = (const LAS f32x4*)(GLs + (16 * tg + i) * 16); float z = bias;
#pragma unroll
            for (int j4 = 0; j4 < 4; ++j4) { const f32x4 gq = gp[j4]; z += gq[0] * wv[4 * j4] + gq[1] * wv[4 * j4 + 1] + gq[2] * wv[4 * j4 + 2] + gq[3] * wv[4 * j4 + 3]; }
            run += log_sigmoid(z) * (1.f / 16.f); bc[i] = run; }
        GSUM[tg * 128 + dk] = run;
    }
    __syncthreads();
    float off = 0.f, blast = 0.f;
#pragma unroll
    for (int g = 0; g < 4; ++g) { const float s = GSUM[g * 128 + dk]; blast += s; if (g < tg) off += s; }
    if (MODE == 0) {
        float kd[16];
#pragma unroll
        for (int i = 0; i < 16; ++i) { const float b = bc[i] + off; kd[i] = bf2f(kraw[i]) * __expf(blast - b); }
        u32x4 o0, o1; o0.x = pk(kd[0], kd[1]); o0.y = pk(kd[2], kd[3]); o0.z = pk(kd[4], kd[5]); o0.w = pk(kd[6], kd[7]);
        o1.x = pk(kd[8], kd[9]); o1.y = pk(kd[10], kd[11]); o1.z = pk(kd[12], kd[13]); o1.w = pk(kd[14], kd[15]);
        *(LAS u32x4*)(KDT + dk * VTS + 16 * tg) = o0; *(LAS u32x4*)(KDT + dk * VTS + 16 * tg + 8) = o1;
        if (tg == 0) { const float d = __expf(blast); DECS[dk] = d; if (prompt) ((float*)(a.ws + WS_DEC))[(size_t)(cid * 4 + h) * 128 + dk] = d; }
    } else {
#pragma unroll
        for (int i = 0; i < 16; ++i) { const float b = bc[i] + off; const int t = 16 * tg + i;
            const float qe = bf2f(qraw[i]) * __expf(b) * 0.08838834764831845f, ke = bf2f(kraw[i]) * __expf(-b);
            QE[t * QES + dk] = (bf16_t)f2bf(qe); KE[t * QES + dk] = (bf16_t)f2bf(ke); }
    }
    __syncthreads();
    if (MODE == 0) {
        bf16x8 vf[4];
#pragma unroll
        for (int ks = 0; ks < 4; ++ks) vf[ks] = *(const LAS bf16x8*)(VT + (32 * w + l31) * VTS + 16 * ks + 8 * hi);
        f32x16 acc[4];
#pragma unroll
        for (int d = 0; d < 4; ++d) acc[d] = f32x16{};
#pragma unroll
        for (int d = 0; d < 4; ++d)
#pragma unroll
            for (int ks = 0; ks < 4; ++ks) { const bf16x8 kf = *(const LAS bf16x8*)(KDT + (32 * d + l31) * VTS + 16 * ks + 8 * hi);
                acc[d] = prompt ? MFMA32(vf[ks], kf, acc[d]) : MFMA32(kf, vf[ks], acc[d]); }
        if (prompt) {
            bf16_t* dst = (bf16_t*)(a.ws + WS_DST) + ((size_t)(cid * 4 + h) * 256 + 32 * w) * 128;
#pragma unroll
            for (int d = 0; d < 4; ++d)
#pragma unroll
                for (int r = 0; r < 16; ++r) dst[(size_t)crow(r, hi) * 128 + 32 * d + l31] = (bf16_t)f2bf(acc[d][r]);
        } else {
            const size_t base = ((size_t)((cid - 256) * 4 + h) * 128) * 256;
            float* outs = a.out + O_GSS;
#pragma unroll
            for (int d = 0; d < 4; ++d)
#pragma unroll
                for (int r = 0; r < 16; ++r) { const int dkk = 32 * d + crow(r, hi); const size_t idx = base + (size_t)dkk * 256 + 32 * w + l31; outs[idx] = state[idx] * DECS[dkk] + acc[d][r]; }
        }
    } else {
        u32x2 rraw[8];
#pragma unroll
        for (int i = 0; i < 8; ++i) rraw[i] = *(const u32x2*)(P + (size_t)(8 * w + i) * NPJ + 2048 + h * 256 + 4 * lane);
        f32x16 o[2]; o[0] = f32x16{}; o[1] = f32x16{};
#pragma unroll
        for (int tb = 0; tb < 2; ++tb)
#pragma unroll
            for (int ks = 0; ks < 8; ++ks) { const bf16x8 qa = *(const LAS bf16x8*)(QE + (32 * tb + l31) * QES + 16 * ks + 8 * hi); o[tb] = MFMA32(qa, sfr[ks], o[tb]); }
        if (w < 3) {
            const int tb = (w > 0) ? 1 : 0, sb = (w == 2) ? 1 : 0;
            f32x16 am = f32x16{};
#pragma unroll
            for (int ks = 0; ks < 8; ++ks) { const bf16x8 qa = *(const LAS bf16x8*)(QE + (32 * tb + l31) * QES + 16 * ks + 8 * hi), kb = *(const LAS bf16x8*)(KE + (32 * sb + l31) * QES + 16 * ks + 8 * hi);
                am = MFMA32(qa, kb, am); }
#pragma unroll
            for (int r = 0; r < 16; ++r) { const int tl = crow(r, hi); float v = am[r]; if (tb == sb && l31 > tl) v = 0.f; AL[(32 * tb + tl) * VTS + 32 * sb + l31] = (bf16_t)f2bf(v); }
        }
        __syncthreads();
#pragma unroll
        for (int tb = 0; tb < 2; ++tb)
#pragma unroll
            for (int ks = 0; ks < 4; ++ks) { if (tb == 0 && ks >= 2) continue;
                const bf16x8 aa = *(const LAS bf16x8*)(AL + (32 * tb + l31) * VTS + 16 * ks + 8 * hi), vb = *(const LAS bf16x8*)(VT + (32 * w + l31) * VTS + 16 * ks + 8 * hi);
                o[tb] = MFMA32(aa, vb, o[tb]); }
        __syncthreads();
        LAS float* OL = (LAS float*)(lds + OL_OFF);
#pragma unroll
        for (int tb = 0; tb < 2; ++tb)
#pragma unroll
            for (int r = 0; r < 16; ++r) OL[(32 * tb + crow(r, hi)) * OLS + 32 * w + l31] = o[tb][r];
        __syncthreads();
        const f32x4 ng = *(const f32x4*)(a.in[I_GNORM] + h * 256 + 4 * lane);
        bf16_t* OG = (bf16_t*)(a.ws + WS_OG);
#pragma unroll
        for (int i = 0; i < 8; ++i) { const int t = 8 * w + i; const f32x4 v = *(const LAS f32x4*)(OL + t * OLS + 4 * lane);
            const float rs = rsqrtf(wave_sum(dot4(v)) * (1.f / 256.f) + EPS);
            const u32x2 rr = rraw[i];
            float rv[4] = {bf2f(rr.x & 0xffffu), bf2f(rr.x >> 16), bf2f(rr.y & 0xffffu), bf2f(rr.y >> 16)}; float y[4];
#pragma unroll
            for (int j = 0; j < 4; ++j) y[j] = v[j] * rs * ng[j] * rv[j] * __builtin_amdgcn_rcpf(1.f + __expf(-rv[j]));
            u32x2 ov; ov.x = pk(y[0], y[1]); ov.y = pk(y[2], y[3]);
            *(u32x2*)(OG + (size_t)(row0 + t) * DM + h * 256 + 4 * lane) = ov; }
    }
    __syncthreads();
}

__device__ __forceinline__ void gla_scan(const Args& a, int vcu, int G) {
    const int gt = vcu * 512 + threadIdx.x, NT_ = G * 512;
    const bf16_t* DST = (const bf16_t*)(a.ws + WS_DST); const float* DEC = (const float*)(a.ws + WS_DEC); bf16_t* SP = (bf16_t*)(a.ws + WS_SPREV);
    for (int it0 = gt; it0 < 32 * 8192; it0 += 2 * NT_) {
        const int it1 = it0 + NT_; const bool two = it1 < 32 * 8192;
        const int bhA = it0 >> 13, eA = it0 & 8191, dvA = eA >> 5, dkA = (eA & 31) * 4;
        const int itB = two ? it1 : it0; const int bhB = itB >> 13, eB = itB & 8191, dvB = eB >> 5, dkB = (eB & 31) * 4;
        f32x4 SA = (f32x4){0.f, 0.f, 0.f, 0.f}, SB = SA;
#pragma unroll 8
        for (int c = 0; c < 32; ++c) {
            const size_t chA = (size_t)(((bhA >> 2) * 32 + c) * 4 + (bhA & 3)), chB = (size_t)(((bhB >> 2) * 32 + c) * 4 + (bhB & 3));
            const size_t baseA = (chA * 256 + dvA) * 128 + dkA, baseB = (chB * 256 + dvB) * 128 + dkB;
            const u32x2 rA = *(const u32x2*)(DST + baseA), rB = *(const u32x2*)(DST + baseB);
            const f32x4 deA = *(const f32x4*)(DEC + chA * 128 + dkA), deB = *(const f32x4*)(DEC + chB * 128 + dkB);
            const f32x4 dsA = (f32x4){bf2f(rA.x & 0xffffu), bf2f(rA.x >> 16), bf2f(rA.y & 0xffffu), bf2f(rA.y >> 16)};
            const f32x4 dsB = (f32x4){bf2f(rB.x & 0xffffu), bf2f(rB.x >> 16), bf2f(rB.y & 0xffffu), bf2f(rB.y >> 16)};
            u32x2 o; o.x = pk(SA[0], SA[1]); o.y = pk(SA[2], SA[3]); *(u32x2*)(SP + baseA) = o;
            if (two) { o.x = pk(SB[0], SB[1]); o.y = pk(SB[2], SB[3]); *(u32x2*)(SP + baseB) = o; }
            SA = SA * deA + dsA; SB = SB * deB + dsB;
        }
        float* ogA = a.out + O_GSP + ((size_t)bhA * 128 + dkA) * 256 + dvA;
#pragma unroll
        for (int i = 0; i < 4; ++i) ogA[(size_t)i * 256] = SA[i];
        if (two) { float* ogB = a.out + O_GSP + ((size_t)bhB * 128 + dkB) * 256 + dvB;
#pragma unroll
            for (int i = 0; i < 4; ++i) ogB[(size_t)i * 256] = SB[i]; }
    }
}

template <int L, int C> __device__ __forceinline__ void cumsum_item(const float* src0, const float* src1, float* dst, LAS float* SEG, int hh, int seg) {
    float s = 0.f;
#pragma unroll 1
    for (int c0 = 0; c0 < L; c0 += C) { float v[C];
#pragma unroll
        for (int i = 0; i < C; ++i) { const int t = seg * L + c0 + i; v[i] = (t < 2048) ? src0[(unsigned)(t * 16 + hh)] : src1[(unsigned)((t - 2048) * 16 + hh)]; }
#pragma unroll
        for (int i = 0; i < C; ++i) s += v[i]; }
    SEG[seg * 16 + hh] = s;
    __syncthreads();
    float run = 0.f;
    for (int g = 0; g < seg; ++g) run += SEG[g * 16 + hh];
#pragma unroll 1
    for (int c0 = 0; c0 < L; c0 += C) { float v[C];
#pragma unroll
        for (int i = 0; i < C; ++i) { const int t = seg * L + c0 + i; v[i] = (t < 2048) ? src0[(unsigned)(t * 16 + hh)] : src1[(unsigned)((t - 2048) * 16 + hh)]; }
#pragma unroll
        for (int i = 0; i < C; ++i) { run += v[i]; dst[seg * L + c0 + i] = run; } }
    __syncthreads();
}
__device__ __forceinline__ void fox_cumsum(const Args& a, LAS unsigned char* lds, int vcu, int G) {
    const int tid = threadIdx.x, hh = tid & 15, seg = tid >> 4;
    LAS float* SEG = (LAS float*)lds;
    for (int it = vcu; it < 40; it += G) {
        const bool prompt = it < 8; const int b = prompt ? it : it - 8;
        const float* src0 = prompt ? a.out + O_FLP + (size_t)b * 2048 * 16 : a.in[I_CLF] + (size_t)b * 2048 * 16;
        const float* src1 = a.out + O_FLS + (size_t)b * 64 * 16;
        if (prompt) cumsum_item<64, 32>(src0, src1, (float*)(a.ws + WS_CP) + (size_t)(b * 16 + hh) * 2048, SEG, hh, seg);
        else cumsum_item<66, 22>(src0, src1, (float*)(a.ws + WS_CS) + (size_t)(b * 16 + hh) * 2112, SEG, hh, seg);
    }
}

constexpr int AT_KS = 72, AT_VS = 68, AT_BUF = 18432, AT_VOFF = 9216, AT_COFF = 17920;
struct TileRegs { u32x4 k0, k1, v0, v1; float ck; };

template <bool SAMPLE> __device__ __forceinline__ void attn_load(TileRegs& R, const Args& a, int b, int h, int t, const float* cbase, int tid) {
    const int kvl = tid >> 3, ch = tid & 7, kp = tid >> 4, c4 = tid & 15;
    if (SAMPLE && t < 32) {
        const float* kptr = a.in[I_CK] + (((size_t)b * 2048 + 64 * t + kvl) * 16 + h) * 64 + 8 * ch;
        R.k0 = *(const u32x4*)kptr; R.k1 = *(const u32x4*)(kptr + 4);
        const float* vptr = a.in[I_CV] + (((size_t)b * 2048 + 64 * t + 2 * kp) * 16 + h) * 64 + 4 * c4;
        R.v0 = *(const u32x4*)vptr; R.v1 = *(const u32x4*)(vptr + 1024);
    } else {
        const size_t rowbase = SAMPLE ? (size_t)(MP + b * 64) : (size_t)(b * 2048 + 64 * t);
        const bf16_t* qkv = (const bf16_t*)(a.ws + WS_PROJ);
        R.k0 = *(const u32x4*)(qkv + (rowbase + kvl) * NPJ + 1024 + h * 64 + 8 * ch);
        const bf16_t* vptr = qkv + (rowbase + 2 * kp) * NPJ + 2048 + h * 64 + 4 * c4;
        const u32x2 x0 = *(const u32x2*)vptr, x1 = *(const u32x2*)(vptr + NPJ);
        R.v0.x = x0.x; R.v0.y = x0.y; R.v1.x = x1.x; R.v1.y = x1.y;
    }
    R.ck = cbase[64 * t + (tid & 63)];
}
__device__ __forceinline__ void attn_store(const TileRegs& R, LAS unsigned char* buf, bool f32src, int tid) {
    const int kvl = tid >> 3, ch = tid & 7, kp = tid >> 4, c4 = tid & 15;
    LAS unsigned* VT32 = (LAS unsigned*)(buf + AT_VOFF);
    if (f32src) {
        u32x4 o; o.x = pk(__uint_as_float(R.k0.x), __uint_as_float(R.k0.y)); o.y = pk(__uint_as_float(R.k0.z), __uint_as_float(R.k0.w));
        o.z = pk(__uint_as_float(R.k1.x), __uint_as_float(R.k1.y)); o.w = pk(__uint_as_float(R.k1.z), __uint_as_float(R.k1.w));
        *(LAS u32x4*)(buf + (kvl * AT_KS + 8 * ch) * 2) = o;
#pragma unroll
        for (int i = 0; i < 4; ++i) VT32[(4 * c4 + i) * (AT_VS / 2) + kp] = pk(__uint_as_float(R.v0[i]), __uint_as_float(R.v1[i]));
    } else {
        *(LAS u32x4*)(buf + (kvl * AT_KS + 8 * ch) * 2) = R.k0;
        VT32[(4 * c4 + 0) * (AT_VS / 2) + kp] = (R.v0.x & 0xffffu) | (R.v1.x << 16);
        VT32[(4 * c4 + 1) * (AT_VS / 2) + kp] = (R.v0.x >> 16) | (R.v1.x & 0xffff0000u);
        VT32[(4 * c4 + 2) * (AT_VS / 2) + kp] = (R.v0.y & 0xffffu) | (R.v1.y << 16);
        VT32[(4 * c4 + 3) * (AT_VS / 2) + kp] = (R.v0.y >> 16) | (R.v1.y & 0xffff0000u);
    }
    if (tid < 64) { const float c = -R.ck * LOG2E; const unsigned h1 = f2bf(c); const float r1 = c - bf2f(h1); const unsigned h2 = f2bf(r1); const unsigned h3 = f2bf(r1 - bf2f(h2));
        u32x2 o; o.x = h1 | (h2 << 16); o.y = h3; ((LAS u32x2*)(buf + AT_COFF))[tid] = o; }
}

template <bool QLDS> __device__ __forceinline__ void attn_tile(const LAS unsigned char* buf, const bf16x8 (&qf)[4], const LAS bf16x8* qlds, float cq2, int qpos, int kv0, bool diag, float& mrun, float& lrun, f32x16 (&ot)[2], int l31, int hi) {
    const LAS bf16_t* Ks = (const LAS bf16_t*)buf; const LAS bf16_t* VTs = (const LAS bf16_t*)(buf + AT_VOFF); const LAS u32x2* CKs = (const LAS u32x2*)(buf + AT_COFF);
    f32x16 p0, p1;
#pragma unroll
    for (int r = 0; r < 16; ++r) { p0[r] = cq2; p1[r] = cq2; }
    {
        const u32x2 b0 = CKs[l31], b1 = CKs[32 + l31];
        const unsigned msk = hi ? 0u : 0xffffffffu;
        u32x4 x0; x0.x = b0.x & msk; x0.y = b0.y & msk; x0.z = 0u; x0.w = 0u;
        u32x4 x1; x1.x = b1.x & msk; x1.y = b1.y & msk; x1.z = 0u; x1.w = 0u;
        u32x4 qx; qx.x = 0x3F803F80u & msk; qx.y = 0x00003F80u & msk; qx.z = 0u; qx.w = 0u;
        p0 = MFMA32(__builtin_bit_cast(bf16x8, x0), __builtin_bit_cast(bf16x8, qx), p0); p1 = MFMA32(__builtin_bit_cast(bf16x8, x1), __builtin_bit_cast(bf16x8, qx), p1);
    }
#pragma unroll
    for (int ks = 0; ks < 4; ++ks) { const bf16x8 k0 = *(const LAS bf16x8*)(Ks + l31 * AT_KS + 16 * ks + 8 * hi), k1 = *(const LAS bf16x8*)(Ks + (32 + l31) * AT_KS + 16 * ks + 8 * hi);
        const bf16x8 qq = QLDS ? qlds[ks * 64] : qf[ks];
        p0 = MFMA32(k0, qq, p0); p1 = MFMA32(k1, qq, p1); }
    __builtin_amdgcn_sched_barrier(0);
    if (diag) {
        int qp = qpos - kv0; asm volatile("" : "+v"(qp));
#pragma unroll
        for (int r = 0; r < 16; ++r) { const int kv = crow(r, hi); if (kv > qp) p0[r] = -INFINITY; if (kv + 32 > qp) p1[r] = -INFINITY; }
    }
    float rm = fmaxf(p0[0], p1[0]);
#pragma unroll
    for (int r = 1; r < 16; ++r) rm = fmaxf(rm, fmaxf(p0[r], p1[r]));
    rm = fmaxf(rm, __shfl_xor(rm, 32));
    if (__all(rm < mrun - 40.f)) return;
    const float mn = fmaxf(mrun, rm);
    if (__any(mn > mrun)) {
        const float alpha = __builtin_amdgcn_exp2f(mrun - mn);
        lrun *= alpha;
#pragma unroll
        for (int r = 0; r < 16; ++r) { ot[0][r] *= alpha; ot[1][r] *= alpha; }
        mrun = mn;
    }
    float rs = 0.f;
#pragma unroll
    for (int r = 0; r < 16; ++r) { p0[r] = __builtin_amdgcn_exp2f(p0[r] - mrun); p1[r] = __builtin_amdgcn_exp2f(p1[r] - mrun); rs += p0[r] + p1[r]; }
    lrun += rs;
    bf16x8 pf[4];
    { u32x4 x; x.x = pk(p0[0], p0[1]); x.y = pk(p0[2], p0[3]); x.z = pk(p0[4], p0[5]); x.w = pk(p0[6], p0[7]); pf[0] = __builtin_bit_cast(bf16x8, x);
      x.x = pk(p0[8], p0[9]); x.y = pk(p0[10], p0[11]); x.z = pk(p0[12], p0[13]); x.w = pk(p0[14], p0[15]); pf[1] = __builtin_bit_cast(bf16x8, x);
      x.x = pk(p1[0], p1[1]); x.y = pk(p1[2], p1[3]); x.z = pk(p1[4], p1[5]); x.w = pk(p1[6], p1[7]); pf[2] = __builtin_bit_cast(bf16x8, x);
      x.x = pk(p1[8], p1[9]); x.y = pk(p1[10], p1[11]); x.z = pk(p1[12], p1[13]); x.w = pk(p1[14], p1[15]); pf[3] = __builtin_bit_cast(bf16x8, x); }
    __builtin_amdgcn_sched_barrier(0);
#pragma unroll
    for (int db = 0; db < 2; ++db)
#pragma unroll
        for (int ks = 0; ks < 4; ++ks) { const LAS bf16_t* vp = VTs + (32 * db + l31) * AT_VS + 16 * ks + 4 * hi;
            const u32x2 lo = *(const LAS u32x2*)vp, hh2 = *(const LAS u32x2*)(vp + 8);
            u32x4 x; x.x = lo.x; x.y = lo.y; x.z = hh2.x; x.w = hh2.y;
            ot[db] = MFMA32(__builtin_bit_cast(bf16x8, x), pf[ks], ot[db]); }
}

__device__ __forceinline__ void gld16(u32x4& d, const void* p) { asm volatile("global_load_dwordx4 %0, %1, off" : "=v"(d) : "v"(p)); }
__device__ __forceinline__ void gld16_nt(u32x4& d, const void* p) { asm volatile("global_load_dwordx4 %0, %1, off nt" : "=v"(d) : "v"(p)); }
__device__ __forceinline__ void gld8(u32x2& d, const void* p) { asm volatile("global_load_dwordx2 %0, %1, off" : "=v"(d) : "v"(p)); }
__device__ __forceinline__ void gld4(float& d, const void* p) { asm volatile("global_load_dword %0, %1, off" : "=v"(d) : "v"(p)); }
struct PRegs { u32x4 k; u32x2 v0, v1; float ck; };
__device__ __forceinline__ void pload_a(PRegs& R, const Args& a, int b, int h, int t, const float* cbase, int tid) {
    const int kvl = tid >> 3, ch = tid & 7, kp = tid >> 4, c4 = tid & 15;
    const size_t rowbase = (size_t)(b * 2048 + 64 * t);
    const bf16_t* qkv = (const bf16_t*)(a.ws + WS_PROJ);
    gld16(R.k, qkv + (rowbase + kvl) * NPJ + 1024 + h * 64 + 8 * ch);
    const bf16_t* vptr = qkv + (rowbase + 2 * kp) * NPJ + 2048 + h * 64 + 4 * c4;
    gld8(R.v0, vptr); gld8(R.v1, vptr + NPJ);
    gld4(R.ck, cbase + 64 * t + (tid & 63));
}
#define WAIT_P(N, R) asm volatile("s_waitcnt vmcnt(" #N ")" : "+v"(R.k), "+v"(R.v0), "+v"(R.v1), "+v"(R.ck))
__device__ __forceinline__ void pstore(const PRegs& R, LAS unsigned char* buf, int tid) {
    const int kvl = tid >> 3, ch = tid & 7, kp = tid >> 4, c4 = tid & 15;
    LAS unsigned* VT32 = (LAS unsigned*)(buf + AT_VOFF);
    *(LAS u32x4*)(buf + (kvl * AT_KS + 8 * ch) * 2) = R.k;
    VT32[(4 * c4 + 0) * (AT_VS / 2) + kp] = (R.v0.x & 0xffffu) | (R.v1.x << 16);
    VT32[(4 * c4 + 1) * (AT_VS / 2) + kp] = (R.v0.x >> 16) | (R.v1.x & 0xffff0000u);
    VT32[(4 * c4 + 2) * (AT_VS / 2) + kp] = (R.v0.y & 0xffffu) | (R.v1.y << 16);
    VT32[(4 * c4 + 3) * (AT_VS / 2) + kp] = (R.v0.y >> 16) | (R.v1.y & 0xffff0000u);
    if (tid < 64) { const float c = -R.ck * LOG2E; const unsigned h1 = f2bf(c); const float r1 = c - bf2f(h1); const unsigned h2 = f2bf(r1); const unsigned h3 = f2bf(r1 - bf2f(h2));
        u32x2 o; o.x = h1 | (h2 << 16); o.y = h3; ((LAS u32x2*)(buf + AT_COFF))[tid] = o; }
}
__device__ __forceinline__ void attn_unit_prompt(const Args& a, LAS unsigned char* lds, int b, int h, int qb) {
    int tid_ = threadIdx.x; asm volatile("" : "+v"(tid_));
    const int tid = tid_, lane = tid & 63, w = __builtin_amdgcn_readfirstlane(tid >> 6), l31 = lane & 31, hi = lane >> 5;
    const int NT = 4 * (qb + 1);
    const int qpos = 256 * qb + 32 * w + l31;
    const size_t qrow = (size_t)(b * 2048 + qpos);
    const float* cbase = (const float*)(a.ws + WS_CP) + (size_t)(b * 16 + h) * 2048;
    const bf16_t* qkv = (const bf16_t*)(a.ws + WS_PROJ);
    bf16x8 qf[4];
#pragma unroll
    for (int ks = 0; ks < 4; ++ks) qf[ks] = *(const bf16x8*)(qkv + qrow * NPJ + h * 64 + 16 * ks + 8 * hi);
    const float cq2 = cbase[qpos] * LOG2E;
    const int qmax_w = 256 * qb + 32 * w + 31;
    PRegs R0, R1, R2;
    pload_a(R0, a, b, h, NT - 1, cbase, tid); pload_a(R1, a, b, h, NT - 2, cbase, tid); pload_a(R2, a, b, h, NT - 3, cbase, tid);
    WAIT_P(8, R0); pstore(R0, lds, tid);
    pload_a(R0, a, b, h, NT - 4, cbase, tid);
    __syncthreads();
    float mrun = -INFINITY, lrun = 0.f;
    f32x16 ot[2]; ot[0] = f32x16{}; ot[1] = f32x16{};
#define PSTEP(tt, RR) do { if ((tt) < NT) { const int ti_ = NT - 1 - (tt); if (64 * ti_ <= qmax_w) attn_tile<false>(lds + ((tt) & 1) * AT_BUF, qf, nullptr, cq2, qpos, 64 * ti_, ti_ >= 4 * qb, mrun, lrun, ot, l31, hi); \
        { WAIT_P(8, RR); pstore(RR, lds + (((tt) + 1) & 1) * AT_BUF, tid); pload_a(RR, a, b, h, (NT - 5 - (tt)) > 0 ? NT - 5 - (tt) : 0, cbase, tid); } \
        __syncthreads(); } } while (0)
#pragma unroll 1
    for (int t = 0; t < NT; t += 3) { PSTEP(t, R1); PSTEP(t + 1, R2); PSTEP(t + 2, R0); }
#undef PSTEP
    WAIT_P(0, R0); WAIT_P(0, R1); WAIT_P(0, R2);
    lrun += __shfl_xor(lrun, 32);
    const float inv = 1.f / lrun;
    bf16_t* og = (bf16_t*)(a.ws + WS_OG) + qrow * DM + h * 64;
#pragma unroll
    for (int db = 0; db < 2; ++db)
#pragma unroll
        for (int j = 0; j < 4; ++j) { u32x2 o; o.x = pk(ot[db][4 * j] * inv, ot[db][4 * j + 1] * inv); o.y = pk(ot[db][4 * j + 2] * inv, ot[db][4 * j + 3] * inv);
            *(u32x2*)(og + 32 * db + 8 * j + 4 * hi) = o; }
}

struct TileRegs2 { u32x4 k[4], v[4]; float ck; };
__device__ __forceinline__ void sload2(TileRegs2& R, const Args& a, int b, int h, int t, const float* cbase, int st) {
#pragma unroll
    for (int q = 0; q < 2; ++q) {
        const int item = st + 256 * q, kvl = item >> 3, ch = item & 7, kp = item >> 4, c4 = item & 15;
        if (t < 32) {
            const float* kptr = a.in[I_CK] + (((size_t)b * 2048 + 64 * t + kvl) * 16 + h) * 64 + 8 * ch;
            R.k[2 * q] = *(const u32x4*)kptr; R.k[2 * q + 1] = *(const u32x4*)(kptr + 4);
            const float* vptr = a.in[I_CV] + (((size_t)b * 2048 + 64 * t + 2 * kp) * 16 + h) * 64 + 4 * c4;
            R.v[2 * q] = *(const u32x4*)vptr; R.v[2 * q + 1] = *(const u32x4*)(vptr + 1024);
        } else {
            const size_t rowbase = (size_t)(MP + b * 64);
            const bf16_t* qkv = (const bf16_t*)(a.ws + WS_PROJ);
            R.k[2 * q] = *(const u32x4*)(qkv + (rowbase + kvl) * NPJ + 1024 + h * 64 + 8 * ch);
            const bf16_t* vptr = qkv + (rowbase + 2 * kp) * NPJ + 2048 + h * 64 + 4 * c4;
            const u32x2 x0 = *(const u32x2*)vptr, x1 = *(const u32x2*)(vptr + NPJ);
            R.v[2 * q].x = x0.x; R.v[2 * q].y = x0.y; R.v[2 * q + 1].x = x1.x; R.v[2 * q + 1].y = x1.y;
        }
    }
    R.ck = cbase[64 * t + (st & 63)];
}
__device__ __forceinline__ void sload2a(TileRegs2& R, const Args& a, int b, int h, int t, const float* cbase, int st) {
#pragma unroll
    for (int q = 0; q < 2; ++q) {
        const int item = st + 256 * q, kvl = item >> 3, ch = item & 7, kp = item >> 4, c4 = item & 15;
        const float* kptr = a.in[I_CK] + (((size_t)b * 2048 + 64 * t + kvl) * 16 + h) * 64 + 8 * ch;
        gld16_nt(R.k[2 * q], kptr); gld16_nt(R.k[2 * q + 1], kptr + 4);
        const float* vptr = a.in[I_CV] + (((size_t)b * 2048 + 64 * t + 2 * kp) * 16 + h) * 64 + 4 * c4;
        gld16_nt(R.v[2 * q], vptr); gld16_nt(R.v[2 * q + 1], vptr + 1024);
    }
    gld4(R.ck, cbase + 64 * t + (st & 63));
}
#define WAIT_R2(N, R) asm volatile("s_waitcnt vmcnt(" #N ")" : "+v"(R.k[0]), "+v"(R.k[1]), "+v"(R.k[2]), "+v"(R.k[3]), "+v"(R.v[0]), "+v"(R.v[1]), "+v"(R.v[2]), "+v"(R.v[3]), "+v"(R.ck))
__device__ __forceinline__ void sstore2(const TileRegs2& R, LAS unsigned char* buf, bool f32src, int st) {
    LAS unsigned* VT32 = (LAS unsigned*)(buf + AT_VOFF);
#pragma unroll
    for (int q = 0; q < 2; ++q) {
        const int item = st + 256 * q, kvl = item >> 3, ch = item & 7, kp = item >> 4, c4 = item & 15;
        if (f32src) {
            const u32x4 k0 = R.k[2 * q], k1 = R.k[2 * q + 1];
            u32x4 o; o.x = pk(__uint_as_float(k0.x), __uint_as_float(k0.y)); o.y = pk(__uint_as_float(k0.z), __uint_as_float(k0.w));
            o.z = pk(__uint_as_float(k1.x), __uint_as_float(k1.y)); o.w = pk(__uint_as_float(k1.z), __uint_as_float(k1.w));
            *(LAS u32x4*)(buf + (kvl * AT_KS + 8 * ch) * 2) = o;
#pragma unroll
            for (int i = 0; i < 4; ++i) VT32[(4 * c4 + i) * (AT_VS / 2) + kp] = pk(__uint_as_float(R.v[2 * q][i]), __uint_as_float(R.v[2 * q + 1][i]));
        } else {
            *(LAS u32x4*)(buf + (kvl * AT_KS + 8 * ch) * 2) = R.k[2 * q];
            const u32x4 v0 = R.v[2 * q], v1 = R.v[2 * q + 1];
            VT32[(4 * c4 + 0) * (AT_VS / 2) + kp] = (v0.x & 0xffffu) | (v1.x << 16);
            VT32[(4 * c4 + 1) * (AT_VS / 2) + kp] = (v0.x >> 16) | (v1.x & 0xffff0000u);
            VT32[(4 * c4 + 2) * (AT_VS / 2) + kp] = (v0.y & 0xffffu) | (v1.y << 16);
            VT32[(4 * c4 + 3) * (AT_VS / 2) + kp] = (v0.y >> 16) | (v1.y & 0xffff0000u);
        }
    }
    if (st < 64) { const float c = -R.ck * LOG2E; const unsigned h1 = f2bf(c); const float r1 = c - bf2f(h1); const unsigned h2 = f2bf(r1); const unsigned h3 = f2bf(r1 - bf2f(h2));
        u32x2 o; o.x = h1 | (h2 << 16); o.y = h3; ((LAS u32x2*)(buf + AT_COFF))[st] = o; }
}
__device__ __forceinline__ void attn_unit_sample(const Args& a, LAS unsigned char* lds, int b, int h) {
    int tid_ = threadIdx.x; asm volatile("" : "+v"(tid_));
    const int tid = tid_, lane = tid & 63, w = __builtin_amdgcn_readfirstlane(tid >> 6), l31 = lane & 31, hi = lane >> 5;
    const float* cbase = (const float*)(a.ws + WS_CS) + (size_t)(b * 16 + h) * 2112;
    if (w >= 2 && w < 6) {
        const int st = tid - 128;
        TileRegs2 R0, R1, R2, R3;
        sload2(R0, a, b, h, 32, cbase, st); sload2a(R1, a, b, h, 31, cbase, st); sload2a(R2, a, b, h, 30, cbase, st); sload2a(R3, a, b, h, 29, cbase, st);
        sstore2(R0, lds, false, st);
        sload2a(R0, a, b, h, 28, cbase, st);
        __syncthreads();
#define SSTEP(tt, RR) do { WAIT_R2(27, RR); sstore2(RR, lds + (((tt) + 1) & 1) * AT_BUF, true, st); sload2a(RR, a, b, h, (27 - (tt)) > 0 ? 27 - (tt) : 0, cbase, st); __syncthreads(); } while (0)
#pragma unroll 1
        for (int t = 0; t < 32; t += 4) { SSTEP(t, R1); SSTEP(t + 1, R2); SSTEP(t + 2, R3); SSTEP(t + 3, R0); }
        SSTEP(32, R1);
#undef SSTEP
        WAIT_R2(0, R0); WAIT_R2(0, R1); WAIT_R2(0, R2); WAIT_R2(0, R3);
    } else {
        const bool active = w < 2;
        const int qpos = 2048 + 32 * (w & 1) + l31;
        const size_t qrow = (size_t)(MP + b * 64 + 32 * (w & 1) + l31);
        const bf16_t* qkv = (const bf16_t*)(a.ws + WS_PROJ);
        bf16x8 qf[4];
#pragma unroll
        for (int ks = 0; ks < 4; ++ks) qf[ks] = *(const bf16x8*)(qkv + qrow * NPJ + h * 64 + 16 * ks + 8 * hi);
        const float cq2 = cbase[qpos] * LOG2E;
        float mrun = -INFINITY, lrun = 0.f;
        f32x16 ot[2]; ot[0] = f32x16{}; ot[1] = f32x16{};
        __syncthreads();
#pragma unroll 1
        for (int tt = 0; tt < 33; ++tt) {
            if (active) attn_tile<false>(lds + (tt & 1) * AT_BUF, qf, nullptr, cq2, qpos, 64 * (32 - tt), tt == 0, mrun, lrun, ot, l31, hi);
            __syncthreads();
        }
        if (active) {
            lrun += __shfl_xor(lrun, 32);
            const float inv = 1.f / lrun;
            bf16_t* og = (bf16_t*)(a.ws + WS_OG) + qrow * DM + h * 64;
#pragma unroll
            for (int db = 0; db < 2; ++db)
#pragma unroll
                for (int j = 0; j < 4; ++j) { u32x2 o; o.x = pk(ot[db][4 * j] * inv, ot[db][4 * j + 1] * inv); o.y = pk(ot[db][4 * j + 2] * inv, ot[db][4 * j + 3] * inv);
                    *(u32x2*)(og + 32 * db + 8 * j + 4 * hi) = o; }
        }
    }
}

__device__ __forceinline__ void fox_attention(const Args& a, LAS unsigned char* lds, int vcu, int G) {
#pragma unroll 1
    for (int pass = 0; pass < 2; ++pass) {
        if ((pass ^ (vcu & 1)) == 0) {
#ifdef ATT_DUP_PROMPT
          for (int rep2_ = 0; rep2_ < 2; ++rep2_)
#endif
            if (G == 256) {
                const int bh = vcu >> 1, s0 = 2 * (vcu & 1);
#pragma unroll 1
                for (int i = 0; i < 4; ++i) attn_unit_prompt(a, lds, bh >> 4, bh & 15, (i & 1) ? s0 + (i >> 1) : 7 - s0 - (i >> 1));
            } else {
#pragma unroll 1
                for (int u = vcu; u < 1024; u += G) attn_unit_prompt(a, lds, (u & 127) >> 4, u & 15, 7 - (u >> 7));
            }
        } else {
#ifdef ATT_DUP_SAMPLE
            for (int rep3_ = 0; rep3_ < 2; ++rep3_)
#endif
#pragma unroll 1
            for (int u = vcu; u < 512; u += G) attn_unit_sample(a, lds, u >> 4, u & 15);
        }
    }
}

#ifndef PH_MASK
#define PH_MASK 0x7fff
#endif
#define IN(k) (((PH_MASK >> (k)) & 1) && a.ph_lo <= (k) && (k) < a.ph_hi)
#define SEAM(k) do { if (IN(k) && IN((k) + 1)) { if ((k) == 0 && a.ph_hi < 0) cg::this_grid().sync(); xcd_barrier(xbar); } } while (0)
#ifndef DUP_MASK
#define DUP_MASK 0
#endif
#define REP(k) _Pragma("unroll 1") for (int rep_ = 0; rep_ < ((((DUP_MASK) >> (k)) & 1) ? 2 : 1); ++rep_)
#define REPSYNC(k) do { if ((((DUP_MASK) >> (k)) & 1)) xcd_barrier(xbar); } while (0)
struct SliceOrder {
    int pm, pn;
    __device__ __forceinline__ bool next(int i, pg8::Unit& u) const { if (i > 0) return false; u.pm = pm; u.pn = pn; return true; }
    __device__ __forceinline__ void a_ready(const pg8::Unit&) const {}
    __device__ __forceinline__ void done(const pg8::Unit&) const {}
};
struct EpiPartial {
    static constexpr bool PERM = true, AFTER_DRAIN = false;
    float* part;
    __device__ __forceinline__ void operator()(const pg8::f32x4 (&acc)[2][2][4][2], const pg8::Unit& u, int wr, int wc, int fr, int fq) const {
#pragma unroll
        for (int ai = 0; ai < 2; ++ai)
#pragma unroll
            for (int m = 0; m < 4; ++m) { float* rowp = part + (size_t)(ai * 128 + wr * 64 + m * 16 + fr) * 256 + wc * 32 + 8 * fq;
#pragma unroll
                for (int bj = 0; bj < 2; ++bj) { *(f32x4*)(rowp + bj * 128) = acc[ai][bj][m][0]; *(f32x4*)(rowp + bj * 128 + 4) = acc[ai][bj][m][1]; } }
    }
};
__device__ __forceinline__ void ffd_sample_rows(const Args& a, int vcu, int G, float* ssout) {
    const int tid = threadIdx.x, lane = tid & 63, wave = tid >> 6;
    const int gw = vcu * 8 + wave, NGW = G * 8;
    float* XR = (float*)(a.ws + WS_XR); bf16_t* XB = (bf16_t*)(a.ws + WS_XB); const float* PART = (const float*)(a.ws + WS_PART);
    for (int r = gw; r < MS; r += NGW) {
        const int pml = r >> 8, rr = r & 255; const size_t row = (size_t)(MP + r);
        f32x4 acc[4];
#pragma unroll
        for (int pn = 0; pn < 4; ++pn) { acc[pn] = *(const f32x4*)(XR + row * DM + pn * 256 + 4 * lane);
#pragma unroll
            for (int sl = 0; sl < 8; ++sl) acc[pn] += *(const f32x4*)(PART + ((size_t)((pml * 4 + pn) * 8 + sl) * 256 + rr) * 256 + 4 * lane); }
        float sq = 0.f;
#pragma unroll
        for (int pn = 0; pn < 4; ++pn) { sq += dot4(acc[pn]); *(f32x4*)(XR + row * DM + pn * 256 + 4 * lane) = acc[pn];
            u32x2 o; o.x = pk(acc[pn][0], acc[pn][1]); o.y = pk(acc[pn][2], acc[pn][3]); *(u32x2*)(XB + row * DM + pn * 256 + 4 * lane) = o; }
        sq = wave_sum(sq);
        if (lane == 0) ssout[row] = sq;
    }
}
template <int L> __device__ __forceinline__ void common_gemms(const Args& a, LAS unsigned char* lds, int G, int bx, const XcdBarrier& xbar) {
    unsigned char* ws = a.ws;
    float* SS = (float*)(ws + WS_SS);
    bf16_t* XB = (bf16_t*)(ws + WS_XB); float* XR = (float*)(ws + WS_XR); bf16_t* OG = (bf16_t*)(ws + WS_OG); bf16_t* ACT = (bf16_t*)(ws + WS_ACT);
    constexpr int po = L ? 11 : 5;
    if (IN(po)) { const int mrows = (L == 0 && G == 256 && !MK_MULTI) ? MP : MT;
        pg8::Gemm g{OG, (const bf16_t*)(ws + (L ? WS_WFOUT : WS_WGOUT)), mrows, DM, DM}; pg8::StaticOrder S; S.init(mrows, DM, G, bx);
        EpiResid E{L ? XR : a.in[I_XP], L ? XR + (size_t)MP * DM : a.in[I_XS], XR, XB, SS + (L ? 3 : 1) * 32768};
        pg8::gemm_phase<EpiResid, pg8::StaticOrder, true, true>(lds, g, S, E); }
    SEAM(po);
    if (IN(po + 1)) REP(po + 1) { pg8::Gemm g{XB, (const bf16_t*)(ws + WS_WFFI + (size_t)L * 11 * MiB), MT, 2 * DFF, DM}; pg8::StaticOrder S; S.init(MT, 2 * DFF, G, bx);
        EpiSwiglu E{SS + (L ? 3 : 1) * 32768, ACT}; pg8::gemm_phase<EpiSwiglu, pg8::StaticOrder, true, true>(lds, g, S, E);
        if (L == 0 && G == 256 && !MK_MULTI && bx >= 48) convert_weights(a, lds, 1, (bx - 48) * 8 + (int)(threadIdx.x >> 6), 208 * 8);
        REPSYNC(po + 1); }
    SEAM(po + 1);
    if (IN(po + 2)) {
        const bf16_t* W = (const bf16_t*)(ws + WS_WFFD + (size_t)L * 6 * MiB);
        if (G == 256 && !MK_MULTI) {
            { pg8::Gemm g{ACT, W, MP, DM, DFF, 0}; pg8::StaticOrder S; S.init(MP, DM, G, bx);
              EpiResid E{XR, XR + (size_t)MP * DM, XR, XB, SS + (L ? 4 : 2) * 32768};
              pg8::gemm_phase<EpiResid, pg8::StaticOrder, true, true>(lds, g, S, E); }
            { const int un = bx >> 3, sl = bx & 7, kb0 = (sl < 6) ? 3 * sl : 18 + 2 * (sl - 6), kbn = (sl < 6) ? 3 : 2;
              pg8::Gemm g{ACT + 128 * kb0, W + 128 * kb0, MT, DM, 128 * kbn, DFF}; SliceOrder S{64 + (un >> 2), un & 3};
              EpiPartial E{(float*)(ws + WS_PART) + (size_t)(un * 8 + sl) * 65536};
              pg8::gemm_phase<EpiPartial, SliceOrder, true, true>(lds, g, S, E); }
            xcd_barrier(xbar);
            ffd_sample_rows(a, (bx % 8) * (G / 8) + bx / 8, G, SS + (L ? 4 : 2) * 32768);
        } else {
            pg8::Gemm g{ACT, W, MT, DM, DFF, 0}; pg8::StaticOrder S; S.init(MT, DM, G, bx);
            EpiResid E{XR, XR + (size_t)MP * DM, XR, XB, SS + (L ? 4 : 2) * 32768};
            pg8::gemm_phase<EpiResid, pg8::StaticOrder, true, true>(lds, g, S, E);
        }
    }
    SEAM(po + 2);
}
constexpr int NPH = 15;
__global__ void __launch_bounds__(512, 2) fwd(Args a) {
    extern __shared__ __attribute__((aligned(16))) unsigned char lds_raw[];
    LAS unsigned char* lds = (LAS unsigned char*)lds_raw;
    const int G = gridDim.x, bx = blockIdx.x;
    const int vcu = (G % 8 == 0) ? (bx % 8) * (G / 8) + bx / 8 : bx;
    unsigned char* ws = a.ws;
    float* SS = (float*)(ws + WS_SS);
    bf16_t* XB = (bf16_t*)(ws + WS_XB); bf16_t* PROJ = (bf16_t*)(ws + WS_PROJ);

    volatile LAS unsigned* MISC = (volatile LAS unsigned*)(lds + 131072);
    if (threadIdx.x < 64) MISC[threadIdx.x] = 0u;
    __syncthreads();
    XcdBarrier xbar; xbar.bar = (unsigned*)ws; xbar.x = 0; xbar.st = nullptr;
    if (a.ph_hi - a.ph_lo > 1) xbar = xcd_barrier_post((unsigned*)ws, MISC + 8);
    if (IN(0)) REP(0) { p0_prologue(a, lds, vcu, G); REPSYNC(0); }
    SEAM(0);
    if (IN(1)) { pg8::Gemm g{XB, (const bf16_t*)(ws + WS_WGIN), MT, NPROJ, DM}; pg8::StaticOrder S; S.init(MT, NPROJ, G, bx);
        EpiGlaProj E{SS, PROJ, (float*)(ws + WS_GL)}; pg8::gemm_phase<EpiGlaProj, pg8::StaticOrder, true, true>(lds, g, S, E); }
    SEAM(1);
    if (IN(2)) REP(2) {
        if (G == 256 && !MK_MULTI) {
            GlaPre pf; gla_prefetch(pf, a, vcu >> 2, vcu & 3);
            const int it4 = 1024 + (vcu & 127);
#pragma unroll 1
            for (int it = vcu; it < 1024; it += G) gla_item<0>(a, lds, it >> 2, it & 3, pf, (it + G < 1024) ? it + G : it4);
            if (vcu < 128) gla_item<0>(a, lds, it4 >> 2, it4 & 3, pf, -1);
            else gla_item<1>(a, lds, it4 >> 2, it4 & 3, pf, -1);
        } else {
            GlaPre pf; if (vcu < 1152) gla_prefetch(pf, a, vcu >> 2, vcu & 3);
#pragma unroll 1
            for (int it = vcu; it < 1152; it += G) gla_item<0>(a, lds, it >> 2, it & 3, pf, (it + G < 1152) ? it + G : -1);
        }
        REPSYNC(2); }
    SEAM(2);
    if (IN(3)) REP(3) {
        if (G == 256 && !MK_MULTI) {
            if (bx < 32) { pg8::Gemm g{(const bf16_t*)(ws + WS_OG), (const bf16_t*)(ws + WS_WGOUT), MT, DM, DM, 0}; SliceOrder S{64 + (bx >> 2), bx & 3};
                EpiResid E{a.in[I_XP], a.in[I_XS], (float*)(ws + WS_XR), XB, SS + 32768};
                pg8::gemm_phase<EpiResid, SliceOrder, true, true>(lds, g, S, E); }
            else gla_scan(a, bx - 32, 224);
        } else gla_scan(a, vcu, G);
        REPSYNC(3); }
    SEAM(3);
    if (IN(4)) REP(4) {
        { const int nit = (G == 256 && !MK_MULTI) ? 1024 : 1152;
        GlaPre pf; if (vcu < nit) gla_prefetch(pf, a, vcu >> 2, vcu & 3);
#pragma unroll 1
        for (int it = vcu; it < nit; it += G) gla_item<1>(a, lds, it >> 2, it & 3, pf, (it + G < nit) ? it + G : -1); }
        REPSYNC(4); }
    SEAM(4);
    common_gemms<0>(a, lds, G, bx, xbar);
    if (IN(8)) { pg8::Gemm g{XB, (const bf16_t*)(ws + WS_WFIN), MT, NPROJ, DM}; pg8::StaticOrder S; S.init(MT, NPROJ, G, bx);
        EpiFoxProj E{SS + 2 * 32768, PROJ, a.out, a.in[I_FBF]}; pg8::gemm_phase<EpiFoxProj, pg8::StaticOrder, true, true>(lds, g, S, E); }
    SEAM(8);
    if (IN(9)) REP(9) { fox_cumsum(a, lds, vcu, G); REPSYNC(9); }
    SEAM(9);
    if (IN(10)) REP(10) { fox_attention(a, lds, vcu, G); REPSYNC(10); }
    SEAM(10);
    common_gemms<1>(a, lds, G, bx, xbar);
#ifdef EXTRA_SYNCS
    for (int i_ = 0; i_ < EXTRA_SYNCS; ++i_) xcd_barrier(xbar);
#endif
    if (IN(14)) p_final(a, vcu, G);
#undef IN
#undef SEAM
}

extern "C" void kernel_launch(void* const* d_in, const int* in_sizes, int n_in, void* d_out, int out_size, void* d_ws, size_t ws_size, hipStream_t stream) {
    static int grid = 0;
    if (grid == 0) {
        if (n_in != 19 || ws_size < WS_END || out_size != 62160896) { fprintf(stderr, "kernel_launch: unexpected problem shape (n_in %d, out %d, ws %zu)\n", n_in, out_size, ws_size); grid = -1; return; }
        if (hipFuncSetAttribute((const void*)fwd, hipFuncAttributeMaxDynamicSharedMemorySize, LDS_BYTES) != hipSuccess) { fprintf(stderr, "kernel_launch: hipFuncSetAttribute failed\n"); grid = -1; return; }
        int dev = 0, cus = 0, per_cu = 0;
        (void)hipGetDevice(&dev); (void)hipDeviceGetAttribute(&cus, hipDeviceAttributeMultiprocessorCount, dev);
        (void)hipOccupancyMaxActiveBlocksPerMultiprocessor(&per_cu, (const void*)fwd, 512, LDS_BYTES);
        (void)hipGetLastError();
        if (per_cu < 1) per_cu = 1;
        grid = cus * 1;
        if (grid <= 0) grid = 256;
    }
    if (grid < 0) return;
    (void)hipMemsetAsync((char*)d_ws + WS_CTL, 0, CTL_BYTES, stream);
    Args a{};
    for (int i = 0; i < 19; ++i) a.in[i] = (const float*)d_in[i];
    a.out = (float*)d_out; a.ws = (unsigned char*)d_ws;
#if MK_MULTI
    for (int ph = 0; ph < NPH; ++ph) { a.ph_lo = ph; a.ph_hi = ph + 1; hipLaunchKernelGGL(fwd, dim3(grid), dim3(512), LDS_BYTES, stream, a); }
#else
    a.ph_lo = 0; a.ph_hi = NPH;
    void* args[] = {&a};
    hipError_t e = hipLaunchCooperativeKernel((const void*)fwd, dim3(grid), dim3(512), args, LDS_BYTES, stream);
    if (e != hipSuccess) fprintf(stderr, "kernel_launch: cooperative launch failed: %s (grid %d)\n", hipGetErrorString(e), grid);
#endif
}
```

```cpp
#include <hip/hip_runtime.h>
#include <hip/hip_cooperative_groups.h>
#include <cstdio>
#include <cstdint>
#include <cmath>
namespace cg = cooperative_groups;
#define MK_MULTI 0
namespace pg8 {
#define PG8_LAS __attribute__((address_space(3)))
typedef unsigned short bf16_t;
typedef short bf16x8 __attribute__((ext_vector_type(8)));
typedef float f32x4 __attribute__((ext_vector_type(4)));
typedef unsigned u32x4 __attribute__((ext_vector_type(4)));
constexpr int BM = 256, BK = 64, HALF = 128, HTB = HALF * BK * 2  , STAGE_BYTES = 8 * HTB, NXCD = 8, WGM = 8;

__host__ __device__ __forceinline__ int lds_byte(int r, int c) { const int st = (r >> 4) * 2 + (c >> 5), rr = r & 15, cc = c & 31, ob = rr * 64 + cc * 2; return st * 1024 + (ob ^ (((ob >> 9) & 1) << 5)); }
__host__ __device__ __forceinline__ void stage_rc(int b, int& R, int& C) { const int st = b / 1024, sb = b % 1024, swz = sb ^ (((sb >> 9) & 1) << 5); R = (st >> 1) * 16 + swz / 64; C = (st & 1) * 32 + (swz % 64) / 2; }
__host__ __device__ __forceinline__ int perm32(int rho) { const int n = rho >> 4, i = rho & 15; return 8 * (i >> 2) + 4 * n + (i & 3); }

struct Unit { int pm, pn; };
struct Gemm { const bf16_t* A; const bf16_t* Bt; int M, N, K; int ld; };

struct StaticOrder {
    int nM, nN, nwg, G, c;
    __host__ __device__ void init(int M, int N, int G_, int c_) { nM = M / BM; nN = N / BM; nwg = nM * nN; G = G_; c = c_; }
    __host__ __device__ bool next(int i, Unit& u) const {
        const long L = (long)i * G + c; if (L >= nwg) return false;
        int wgid = (int)L; { const int q = nwg / NXCD, r = nwg % NXCD, xcd = wgid % NXCD, off = wgid / NXCD; wgid = (xcd < r ? xcd * (q + 1) : r * (q + 1) + (xcd - r) * q) + off; }
        const int nig = WGM * nN, gid = wgid / nig, fm = gid * WGM, gsz = (nM - fm) < WGM ? (nM - fm) : WGM;
        u.pm = fm + ((wgid % nig) % gsz); u.pn = (wgid % nig) / gsz; return true;
    }
    __device__ __forceinline__ void a_ready(const Unit&) const {}
    __device__ __forceinline__ void done(const Unit&) const {}
};

__device__ __forceinline__ unsigned cvt_pk_bf16(float lo, float hi) { unsigned r; asm volatile("v_cvt_pk_bf16_f32 %0, %1, %2" : "=v"(r) : "v"(lo), "v"(hi)); return r; }
template <class Epi, class Sched, bool ALIGN_EPI = false, bool SP2 = false>
__device__ __forceinline__ void gemm_phase(PG8_LAS unsigned char* lds, const Gemm g, const Sched& S, const Epi& E) {
    const int tid = threadIdx.x, wid = __builtin_amdgcn_readfirstlane(tid >> 6), lane = tid & 63, wr = wid >> 2, wc = wid & 3, fr = lane & 15, fq = lane >> 4;
    const int K = g.ld ? g.ld : g.K, nt = g.K / BK;
    unsigned voffA[2], voffB[2];
#pragma unroll
    for (int i = 0; i < 2; ++i) { int R, C; stage_rc(tid * 16 + i * 8192, R, C); const int Rb = Epi::PERM ? ((R & ~31) + perm32(R & 31)) : R;
        voffA[i] = (unsigned)(R * K + C) * 2u; voffB[i] = (unsigned)(Rb * K + C) * 2u; }
    const size_t kstep = (size_t)(BK * 2);
    const size_t hstep = (size_t)HALF * K * 2;
    const size_t tstep = 2 * hstep;
    const unsigned ldsw = (unsigned)wid * 1024u;
    const int aoff = lds_byte(wr * 64 + fr, fq * 8), boff = lds_byte(wc * 32 + fr, fq * 8);
#define PG8_SA(b, h) (((b) * 2 + (h)) * HTB)
#define PG8_SB(b, h) ((4 + (b) * 2 + (h)) * HTB)
#define PG8_STAGE(bufoff, gbase, voff) do { _Pragma("unroll") for (int _i = 0; _i < 2; ++_i) \
        __builtin_amdgcn_global_load_lds((const unsigned*)((const char*)(gbase) + (voff)[_i]), (PG8_LAS unsigned*)(lds + (bufoff) + ldsw + _i * 8192), 16, 0, 0); } while (0)
#define PG8_LDA(dst, b, h) do { _Pragma("unroll") for (int m = 0; m < 4; ++m) _Pragma("unroll") for (int k = 0; k < 2; ++k) dst[m][k] = *(const PG8_LAS bf16x8*)(lds + PG8_SA(b, h) + aoff + m * 2048 + k * 1024); } while (0)
#define PG8_LDB(dst, b, h) do { _Pragma("unroll") for (int n = 0; n < 2; ++n) _Pragma("unroll") for (int k = 0; k < 2; ++k) dst[n][k] = *(const PG8_LAS bf16x8*)(lds + PG8_SB(b, h) + boff + n * 2048 + k * 1024); } while (0)
#define PG8_MMA(ai, bj, At, Bt) do { __builtin_amdgcn_s_setprio(1); _Pragma("unroll") for (int m = 0; m < 4; ++m) _Pragma("unroll") for (int n = 0; n < 2; ++n) _Pragma("unroll") for (int k = 0; k < 2; ++k) \
        acc[ai][bj][m][n] = __builtin_amdgcn_mfma_f32_16x16x32_bf16(Bt[n][k], At[m][k], acc[ai][bj][m][n], 0, 0, 0); __builtin_amdgcn_s_setprio(0); } while (0)
#define PG8_WAIT_V(n) asm volatile("s_waitcnt vmcnt(" #n ")" ::: "memory")
#define PG8_WAIT_L(n) asm volatile("s_waitcnt lgkmcnt(" #n ")" ::: "memory")
#define PG8_BAR __builtin_amdgcn_s_barrier()
#define PG8_SCHED __builtin_amdgcn_sched_barrier(0)
    Unit cur, nxt; int ui = 0;
    if (!S.next(0, cur)) return;
    f32x4 acc[2][2][4][2];
#pragma unroll
    for (int a = 0; a < 2; ++a)
#pragma unroll
        for (int b = 0; b < 2; ++b)
#pragma unroll
            for (int m = 0; m < 4; ++m)
#pragma unroll
                for (int n = 0; n < 2; ++n) acc[a][b][m][n] = (f32x4){0.f, 0.f, 0.f, 0.f};
    bf16x8 At[4][2], B0[2][2], B1[2][2];
    const char* cA = (const char*)g.A + (size_t)cur.pm * tstep; const char* cB = (const char*)g.Bt + (size_t)cur.pn * tstep;
    S.a_ready(cur);
    if constexpr (SP2) {
        PG8_STAGE(PG8_SB(0, 0), cB, voffB); PG8_STAGE(PG8_SB(0, 1), cB + hstep, voffB); PG8_STAGE(PG8_SA(0, 0), cA, voffA); PG8_STAGE(PG8_SA(0, 1), cA + hstep, voffA);
        if (wr == 1) PG8_BAR;
        PG8_WAIT_V(2); PG8_BAR;
        PG8_STAGE(PG8_SB(1, 0), cB + kstep, voffB); PG8_STAGE(PG8_SA(1, 0), cA + kstep, voffA); PG8_STAGE(PG8_SB(1, 1), cB + hstep + kstep, voffB);
        PG8_WAIT_V(6); PG8_BAR;
    } else {
        PG8_STAGE(PG8_SB(0, 0), cB, voffB); PG8_STAGE(PG8_SA(0, 0), cA, voffA); PG8_STAGE(PG8_SB(0, 1), cB + hstep, voffB); PG8_STAGE(PG8_SA(0, 1), cA + hstep, voffA);
        if (wr == 1) PG8_BAR;
        PG8_WAIT_V(4); PG8_BAR;
        PG8_STAGE(PG8_SB(1, 0), cB + kstep, voffB); PG8_STAGE(PG8_SA(1, 0), cA + kstep, voffA); PG8_STAGE(PG8_SB(1, 1), cB + hstep + kstep, voffB);
        PG8_WAIT_V(6); PG8_BAR;
    }
    for (;;) {
        const bool has_next = S.next(ui + 1, nxt);
        const char* nA = has_next ? (const char*)g.A + (size_t)nxt.pm * tstep : cA; const char* nB = has_next ? (const char*)g.Bt + (size_t)nxt.pn * tstep : cB;
        for (int t = 0; t < nt; t += 2) {
            const bool last = (t == nt - 2);
            const char* a1 = cA + (size_t)(t + 1) * kstep;
            const char* a2 = last ? nA : cA + (size_t)(t + 2) * kstep; const char* b2 = last ? nB : cB + (size_t)(t + 2) * kstep;
            const char* a3 = a2 + kstep; const char* b3 = b2 + kstep;
            if (last && has_next) S.a_ready(nxt);
            if constexpr (SP2) {
            PG8_LDB(B0, 0, 0); PG8_LDB(B1, 0, 1); PG8_SCHED; PG8_LDA(At, 0, 0); PG8_STAGE(PG8_SA(1, 1), a1 + hstep, voffA);
            PG8_WAIT_V(8); PG8_WAIT_L(0); PG8_BAR; PG8_MMA(0, 0, At, B0); PG8_MMA(0, 1, At, B1); PG8_BAR; PG8_SCHED;
            PG8_LDA(At, 0, 1); PG8_STAGE(PG8_SB(0, 0), b2, voffB); PG8_STAGE(PG8_SB(0, 1), b2 + hstep, voffB); PG8_STAGE(PG8_SA(0, 0), a2, voffA);
            PG8_WAIT_V(8); PG8_WAIT_L(0); PG8_BAR; PG8_MMA(1, 0, At, B0); PG8_MMA(1, 1, At, B1); PG8_BAR; PG8_SCHED;
            PG8_LDB(B0, 1, 0); PG8_LDB(B1, 1, 1); PG8_SCHED; PG8_LDA(At, 1, 0); PG8_STAGE(PG8_SA(0, 1), a2 + hstep, voffA);
            PG8_WAIT_V(8); PG8_WAIT_L(0); PG8_BAR; PG8_MMA(0, 0, At, B0); PG8_MMA(0, 1, At, B1); PG8_BAR; PG8_SCHED;
            PG8_LDA(At, 1, 1); PG8_STAGE(PG8_SB(1, 0), b3, voffB); PG8_STAGE(PG8_SB(1, 1), b3 + hstep, voffB); PG8_STAGE(PG8_SA(1, 0), a3, voffA);
            PG8_WAIT_V(8); PG8_WAIT_L(0); PG8_BAR; PG8_MMA(1, 0, At, B0); PG8_MMA(1, 1, At, B1); PG8_BAR; PG8_SCHED;
            } else {
            PG8_LDB(B0, 0, 0); PG8_SCHED; PG8_LDA(At, 0, 0); PG8_STAGE(PG8_SA(1, 1), a1 + hstep, voffA);
            PG8_WAIT_L(8); PG8_BAR; PG8_WAIT_L(0); PG8_MMA(0, 0, At, B0); PG8_BAR; PG8_SCHED;
            PG8_LDB(B1, 0, 1); PG8_STAGE(PG8_SB(0, 0), b2, voffB);
            PG8_BAR; PG8_WAIT_L(0); PG8_MMA(0, 1, At, B1); PG8_BAR;
            PG8_LDA(At, 0, 1); PG8_STAGE(PG8_SA(0, 0), a2, voffA);
            PG8_BAR; PG8_WAIT_L(0); PG8_MMA(1, 0, At, B0); PG8_BAR; PG8_SCHED;
            PG8_STAGE(PG8_SB(0, 1), b2 + hstep, voffB);
            PG8_WAIT_V(6); PG8_BAR; PG8_MMA(1, 1, At, B1); PG8_BAR;
            PG8_LDB(B0, 1, 0); PG8_SCHED; PG8_LDA(At, 1, 0); PG8_STAGE(PG8_SA(0, 1), a2 + hstep, voffA);
            PG8_WAIT_L(8); PG8_BAR; PG8_WAIT_L(0); PG8_MMA(0, 0, At, B0); PG8_BAR; PG8_SCHED;
            PG8_LDB(B1, 1, 1); PG8_STAGE(PG8_SB(1, 0), b3, voffB);
            PG8_BAR; PG8_WAIT_L(0); PG8_MMA(0, 1, At, B1); PG8_BAR;
            PG8_LDA(At, 1, 1); PG8_STAGE(PG8_SA(1, 0), a3, voffA);
            PG8_BAR; PG8_WAIT_L(0); PG8_MMA(1, 0, At, B0); PG8_BAR; PG8_SCHED;
            PG8_STAGE(PG8_SB(1, 1), b3 + hstep, voffB);
            PG8_WAIT_V(6); PG8_BAR; PG8_MMA(1, 1, At, B1); PG8_BAR;
            }
        }
        if constexpr (ALIGN_EPI) { if (wr == 0) PG8_BAR; }
        if constexpr (!Epi::AFTER_DRAIN) { E(acc, cur, wr, wc, fr, fq); S.done(cur); }
        if (!has_next) break;
#pragma unroll
        for (int a = 0; a < 2; ++a)
#pragma unroll
            for (int b = 0; b < 2; ++b)
#pragma unroll
                for (int m = 0; m < 4; ++m)
#pragma unroll
                    for (int n = 0; n < 2; ++n) acc[a][b][m][n] = (f32x4){0.f, 0.f, 0.f, 0.f};
        cur = nxt; cA = nA; cB = nB; ++ui;
        if constexpr (ALIGN_EPI) { if (wr == 1) PG8_BAR; }
    }
    PG8_WAIT_V(0);
    if constexpr (!ALIGN_EPI) { if (wr == 0) PG8_BAR; }
    PG8_BAR;
    if constexpr (Epi::AFTER_DRAIN) { E.fused(acc, cur, wr, wc, fr, fq, lds, wid, lane); S.done(cur); }
#undef PG8_SA
#undef PG8_SB
#undef PG8_STAGE
#undef PG8_LDA
#undef PG8_LDB
#undef PG8_MMA
#undef PG8_WAIT_V
#undef PG8_WAIT_L
#undef PG8_BAR
#undef PG8_SCHED
}
}

#define LAS __attribute__((address_space(3)))
typedef unsigned short bf16_t;
typedef short bf16x8 __attribute__((ext_vector_type(8)));
typedef float f32x4 __attribute__((ext_vector_type(4)));
typedef float f32x16 __attribute__((ext_vector_type(16)));
typedef unsigned u32x4 __attribute__((ext_vector_type(4)));
typedef unsigned u32x2 __attribute__((ext_vector_type(2)));

#ifndef MK_MULTI
#define MK_MULTI 0
#endif

constexpr int DM = 1024, MP = 16384, MS = 2048, MT = MP + MS;
constexpr int NPROJ = 3328, NPJ = 3072, DFF = 2816;
constexpr float EPS = 1e-6f;
constexpr float LOG2E = 1.4426950408889634f;
constexpr float QSCALE2 = 0.125f * LOG2E;
constexpr size_t O_Y = 0, O_GSP = 18874368, O_FKP = 19922944, O_FVP = 36700160, O_FLP = 53477376, O_GSS = 53739520, O_FKS = 57933824, O_FVS = 60030976, O_FLS = 62128128;
constexpr size_t MiB = 1u << 20;
constexpr size_t WS_CTL = 0, CTL_BYTES = 2 * MiB;
constexpr size_t WS_SS = 65536;
constexpr size_t WS_WGIN = 2 * MiB, WS_WFIN = 9 * MiB, WS_WGOUT = 16 * MiB, WS_WFOUT = 18 * MiB, WS_WFFI = 20 * MiB  , WS_WFFD = 42 * MiB  ;
constexpr size_t WS_XB = 54 * MiB, WS_XR = 90 * MiB, WS_PROJ = 162 * MiB, WS_GL = 270 * MiB, WS_DST = 272 * MiB, WS_DEC = 400 * MiB, WS_SPREV = 401 * MiB;
constexpr size_t WS_OG = 465 * MiB, WS_ACT = 501 * MiB, WS_CP = 600 * MiB, WS_CS = 601 * MiB, WS_PART = 606 * MiB  , WS_END = 672 * MiB;
constexpr int LDS_BYTES = 135168;

struct Args {
    const float* in[19];
    float* out; unsigned char* ws;
    int ph_lo, ph_hi;
};
enum { I_XP = 0, I_XS, I_STATE, I_CK, I_CV, I_CLF, I_NMIX, I_GWIN, I_GWG2, I_GBG, I_GNORM, I_GWOUT, I_FWIN, I_FBF, I_FWOUT, I_NFFN, I_FFIN, I_FFDN, I_NFIN };

__device__ __forceinline__ float bf2f(unsigned u) { return __uint_as_float(u << 16); }
__device__ __forceinline__ unsigned f2bf(float f) { unsigned u = __float_as_uint(f); return (u + 0x7fffu + ((u >> 16) & 1u)) >> 16; }
__device__ __forceinline__ unsigned pk(float lo, float hi) { return pg8::cvt_pk_bf16(lo, hi); }
__device__ __forceinline__ float wave_sum(float v) {
#pragma unroll
    for (int o = 1; o < 64; o <<= 1) v += __shfl_xor(v, o);
    return v;
}
__device__ __forceinline__ float log_sigmoid(float z) { return fminf(z, 0.f) - __logf(1.f + __expf(-fabsf(z))); }
__device__ __forceinline__ int crow(int r, int hi) { return (r & 3) + 8 * (r >> 2) + 4 * hi; }
__device__ __forceinline__ float dot4(f32x4 v) { return (v[0] * v[0] + v[1] * v[1]) + (v[2] * v[2] + v[3] * v[3]); }
#define MFMA32(a, b, c) __builtin_amdgcn_mfma_f32_32x32x16_bf16((a), (b), (c), 0, 0, 0)

#define XB_TMO      128
#define XB_XCNT(j)  (256  + 64 * (j))
#define XB_XSUB(j)  (1280 + 64 * (j))
#define XB_XGEN(j)  (2304 + 64 * (j))
#define XB_TOP      3328
#define XB_TOPGEN   3392
#define XCD_BAR_WORDS 3456
#define XB_SPIN_CAP (1u << 18)

__device__ __forceinline__ unsigned xb_ld(unsigned* p)              { return __hip_atomic_load(p, __ATOMIC_RELAXED, __HIP_MEMORY_SCOPE_AGENT); }
__device__ __forceinline__ unsigned xb_add(unsigned* p, unsigned v) { return __hip_atomic_fetch_add(p, v, __ATOMIC_RELAXED, __HIP_MEMORY_SCOPE_AGENT); }
__device__ __forceinline__ unsigned xb_xcc_id() { return (unsigned)__builtin_amdgcn_s_getreg((3 << 11) | 20) & 0xFu; }
#define XB_SPIN(cond, bar) do { unsigned _sp = 0; while (cond) { __builtin_amdgcn_s_sleep(1); \
    if ((++_sp & 255u) == 0u) { if (xb_ld(&(bar)[XB_TMO])) break; if (_sp > XB_SPIN_CAP) { atomicAdd(&(bar)[XB_TMO], 1u); break; } } } } while (0)

struct XcdBarrier {
    unsigned* bar; unsigned x;
    volatile LAS unsigned* st;
};

__device__ __forceinline__ XcdBarrier xcd_barrier_post(unsigned* bar, volatile LAS unsigned* st) {
    XcdBarrier b; b.bar = bar; b.x = xb_xcc_id(); b.st = st;
    if (threadIdx.x == 0) (void)xb_add(&bar[XB_XCNT(b.x)], 1u);
    return b;
}
__device__ __forceinline__ void xcd_barrier_complete(unsigned* bar, unsigned x, unsigned& nloc, unsigned& nx) {
    const unsigned G = gridDim.x * gridDim.y * gridDim.z;
    unsigned sum, cnt, mine, sp = 0u;
    for (;;) {
        sum = 0u; cnt = 0u; mine = 0u;
#pragma unroll
        for (unsigned j = 0; j < 16; ++j) { const unsigned c = xb_ld(&bar[XB_XCNT(j)]); sum += c; cnt += (c > 0u) ? 1u : 0u; mine = (j == x) ? c : mine; }
        if (sum == G) break;
        __builtin_amdgcn_s_sleep(1);
        if ((++sp & 255u) == 0u) { if (xb_ld(&bar[XB_TMO])) break; if (sp > XB_SPIN_CAP) { atomicAdd(&bar[XB_TMO], 1u); break; } }
    }
    nloc = mine > 0u ? mine : 1u; nx = cnt > 0u ? cnt : 1u;
}

__device__ __forceinline__ void xcd_barrier(const XcdBarrier& b) {
    asm volatile("s_waitcnt vmcnt(0)" ::: "memory");
    __syncthreads();
    if (threadIdx.x == 0) {
        unsigned* bar = b.bar;
        __builtin_amdgcn_s_waitcnt(0);
        unsigned nloc = b.st[0], nx = b.st[1];
        if (nloc == 0u) { xcd_barrier_complete(bar, b.x, nloc, nx); b.st[0] = nloc; b.st[1] = nx; }
        const unsigned old = xb_add(&bar[XB_XSUB(b.x)], 1u);
        const unsigned gen = old / nloc;
        if (old + 1u == (gen + 1u) * nloc) {
            __builtin_amdgcn_fence(__ATOMIC_RELEASE, "agent");
            asm volatile("s_waitcnt vmcnt(0)" ::: "memory");
            const unsigned og = xb_add(&bar[XB_TOP], 1u);
            const unsigned tg = og / nx;
            if (og + 1u == (tg + 1u) * nx) xb_add(&bar[XB_TOPGEN], 1u);
            else XB_SPIN(xb_ld(&bar[XB_TOPGEN]) == tg, bar);
            __builtin_amdgcn_fence(__ATOMIC_ACQUIRE, "agent");
            xb_add(&bar[XB_XGEN(b.x)], 1u);
            asm volatile("s_waitcnt vmcnt(0)" ::: "memory");
        } else {
            XB_SPIN(xb_ld(&bar[XB_XGEN(b.x)]) == gen, bar);
            __builtin_amdgcn_fence(__ATOMIC_ACQUIRE, "agent");
            asm volatile("s_waitcnt vmcnt(0)" ::: "memory");
        }
    }
    __syncthreads();
}

__device__ __forceinline__ void tr_item(const float* __restrict__ W, int K, int N, int nsrc0, bf16_t* WT, int drow0, const float* __restrict__ gain, LAS float* scr, int k0, int lane) {
    const int n = nsrc0 + (lane & 31);
    float wv_[32];
    const float* wp_ = W + (size_t)(k0 + (lane >> 5)) * N + ((n < N) ? n : 0);
#pragma unroll
    for (int i = 0; i < 32; ++i) wv_[i] = __builtin_nontemporal_load(wp_ + (size_t)(2 * i) * N);
#pragma unroll
    for (int i = 0; i < 32; ++i) {
        const int kk = 2 * i + (lane >> 5);
        float v = (n < N) ? wv_[i] : 0.f;
        if (gain) v *= gain[k0 + kk];
        scr[kk * 33 + (lane & 31)] = v;
    }
    asm volatile("s_waitcnt lgkmcnt(0)" ::: "memory");
    const int c = lane & 7;
#pragma unroll
    for (int j = 0; j < 4; ++j) {
        const int nn = (lane >> 3) + 8 * j; const LAS float* s = scr + (8 * c) * 33 + nn;
        u32x4 o; o.x = pk(s[0 * 33], s[1 * 33]); o.y = pk(s[2 * 33], s[3 * 33]); o.z = pk(s[4 * 33], s[5 * 33]); o.w = pk(s[6 * 33], s[7 * 33]);
        *(u32x4*)(WT + (size_t)(drow0 + nn) * K + k0 + 8 * c) = o;
    }
    asm volatile("s_waitcnt lgkmcnt(0)" ::: "memory");
}

__device__ __forceinline__ void convert_weights(const Args& a, LAS unsigned char* lds, int sel, int gw, int NGW) {
    const int tid = threadIdx.x, lane = tid & 63, wave = tid >> 6;
    LAS float* scr = (LAS float*)(lds + wave * 16384);
    unsigned char* ws = a.ws;
    constexpr int I_IN = 16 * 104, I_OUT = 16 * 32, I_FI = 16 * 176, I_FD = 44 * 32;
    constexpr int NITEMS = I_IN + I_OUT + I_FI + I_FD;
    for (int it = gw; it < NITEMS; it += NGW) {
        int r = it;
        if (r < I_IN) { const int kb = r / 104, nb = r % 104; tr_item(a.in[sel ? I_FWIN : I_GWIN], 1024, 3088, 32 * nb, (bf16_t*)(ws + (sel ? WS_WFIN : WS_WGIN)), 32 * nb, a.in[I_NMIX] + sel * 1024, scr, 64 * kb, lane); continue; } r -= I_IN;
        if (r < I_OUT) { const int kb = r / 32, nb = r % 32; tr_item(a.in[sel ? I_FWOUT : I_GWOUT], 1024, 1024, 32 * nb, (bf16_t*)(ws + (sel ? WS_WFOUT : WS_WGOUT)), 32 * nb, nullptr, scr, 64 * kb, lane); continue; } r -= I_OUT;
        if (r < I_FI) { const int kb = r / 176, nb = r % 176, ns = 32 * nb, bj = ns / DFF, j = ns % DFF, drow = 256 * (j / 128) + 128 * bj + (j % 128);
            tr_item(a.in[I_FFIN] + (size_t)sel * 1024 * 5632, 1024, 5632, ns, (bf16_t*)(ws + WS_WFFI + (size_t)sel * 11 * MiB), drow, a.in[I_NFFN] + sel * 1024, scr, 64 * kb, lane); continue; } r -= I_FI;
        { const int kb = r / 32, nb = r % 32;
            tr_item(a.in[I_FFDN] + (size_t)sel * DFF * 1024, DFF, 1024, 32 * nb, (bf16_t*)(ws + WS_WFFD + (size_t)sel * 6 * MiB), 32 * nb, nullptr, scr, 64 * kb, lane); }
    }
}
__device__ __forceinline__ void p0_prologue(const Args& a, LAS unsigned char* lds, int vcu, int G) {
    const int tid = threadIdx.x, lane = tid & 63, wave = tid >> 6;
    const int gw = vcu * 8 + wave, NGW = G * 8;
    unsigned char* ws = a.ws;
    convert_weights(a, lds, 0, gw, NGW);
    if (G != 256 || MK_MULTI) convert_weights(a, lds, 1, gw, NGW);
    float* ss0 = (float*)(ws + WS_SS);
    bf16_t* XB = (bf16_t*)(ws + WS_XB);
    for (int m0 = gw; m0 < MT; m0 += 3 * NGW) {
        f32x4 v[3][4];
#pragma unroll
        for (int q = 0; q < 3; ++q) { const int m = m0 + q * NGW; if (m < MT) { const float* xr = (m < MP) ? a.in[I_XP] + (size_t)m * DM : a.in[I_XS] + (size_t)(m - MP) * DM;
#pragma unroll
            for (int j = 0; j < 4; ++j) v[q][j] = __builtin_nontemporal_load((const f32x4*)xr + lane + 64 * j); } }
#pragma unroll
        for (int q = 0; q < 3; ++q) { const int m = m0 + q * NGW; if (m < MT) { float s = 0.f;
#pragma unroll
            for (int j = 0; j < 4; ++j) s += dot4(v[q][j]);
            s = wave_sum(s);
            if (lane == 0) ss0[m] = s;
#pragma unroll
            for (int j = 0; j < 4; ++j) { u32x2 o; o.x = pk(v[q][j][0], v[q][j][1]); o.y = pk(v[q][j][2], v[q][j][3]); ((u32x2*)(XB + (size_t)m * DM))[lane + 64 * j] = o; } } }
    }
}

__device__ __forceinline__ void p_final(const Args& a, int vcu, int G) {
    const int tid = threadIdx.x, lane = tid & 63, wave = tid >> 6;
    const int gw = vcu * 8 + wave, NGW = G * 8;
    const float* ss = (const float*)(a.ws + WS_SS + 4 * 131072);
    const float* XR = (const float*)(a.ws + WS_XR);
    const float* g = a.in[I_NFIN];
    f32x4 gv[4];
#pragma unroll
    for (int j = 0; j < 4; ++j) gv[j] = ((const f32x4*)g)[lane + 64 * j];
    for (int m0 = gw; m0 < MT; m0 += 3 * NGW) {
        f32x4 v[3][4]; float rs[3];
#pragma unroll
        for (int q = 0; q < 3; ++q) { const int m = m0 + q * NGW; if (m < MT) { rs[q] = rsqrtf(ss[m] * (1.f / DM) + EPS);
#pragma unroll
            for (int j = 0; j < 4; ++j) v[q][j] = __builtin_nontemporal_load((const f32x4*)(XR + (size_t)m * DM) + lane + 64 * j); } }
#pragma unroll
        for (int q = 0; q < 3; ++q) { const int m = m0 + q * NGW; if (m < MT) {
#pragma unroll
            for (int j = 0; j < 4; ++j) __builtin_nontemporal_store(v[q][j] * rs[q] * gv[j], (f32x4*)(a.out + O_Y + (size_t)m * DM) + lane + 64 * j); } }
    }
}

struct EpiGlaProj {
    static constexpr bool PERM = true, AFTER_DRAIN = false;
    const float* ss; bf16_t* proj; float* gl;
    __device__ __forceinline__ void operator()(const pg8::f32x4 (&acc)[2][2][4][2], const pg8::Unit& u, int wr, int wc, int fr, int fq) const {
        const int row0 = u.pm * 256 + wr * 64 + fr;
#pragma unroll
        for (int ai = 0; ai < 2; ++ai)
#pragma unroll
            for (int m = 0; m < 4; ++m) {
                const int row = row0 + ai * 128 + m * 16; const float rs = rsqrtf(ss[row] * (1.f / DM) + EPS);
                if (u.pn < 12) {
#pragma unroll
                    for (int bj = 0; bj < 2; ++bj) { const f32x4 v0 = acc[ai][bj][m][0] * rs, v1 = acc[ai][bj][m][1] * rs;
                        u32x4 w; w.x = pk(v0[0], v0[1]); w.y = pk(v0[2], v0[3]); w.z = pk(v1[0], v1[1]); w.w = pk(v1[2], v1[3]);
                        *(u32x4*)(proj + (size_t)row * NPJ + u.pn * 256 + bj * 128 + wc * 32 + 8 * fq) = w; }
                } else if (wc == 0 && fq < 2) {
#pragma unroll
                    for (int n = 0; n < 2; ++n) *(f32x4*)(gl + (size_t)row * 16 + 8 * fq + 4 * n) = acc[ai][0][m][n] * rs;
                }
            }
    }
};
struct EpiResid {
    static constexpr bool PERM = true, AFTER_DRAIN = false;
    const float* xin_p; const float* xin_s; float* xout; bf16_t* xb; float* ssout;
    __device__ __forceinline__ void operator()(const pg8::f32x4 (&acc)[2][2][4][2], const pg8::Unit& u, int wr, int wc, int fr, int fq) const {
        const int row0 = u.pm * 256 + wr * 64 + fr;
#pragma unroll
        for (int ai = 0; ai < 2; ++ai)
#pragma unroll
            for (int m = 0; m < 4; ++m) {
                const int row = row0 + ai * 128 + m * 16;
                const float* xi = (row < MP) ? xin_p + (size_t)row * DM : xin_s + (size_t)(row - MP) * DM;
                float sq = 0.f;
#pragma unroll
                for (int bj = 0; bj < 2; ++bj) { const int col = u.pn * 256 + bj * 128 + wc * 32 + 8 * fq;
                    const f32x4 a0 = *(const f32x4*)(xi + col) + acc[ai][bj][m][0], a1 = *(const f32x4*)(xi + col + 4) + acc[ai][bj][m][1];
                    *(f32x4*)(xout + (size_t)row * DM + col) = a0; *(f32x4*)(xout + (size_t)row * DM + col + 4) = a1;
                    u32x4 w; w.x = pk(a0[0], a0[1]); w.y = pk(a0[2], a0[3]); w.z = pk(a1[0], a1[1]); w.w = pk(a1[2], a1[3]);
                    *(u32x4*)(xb + (size_t)row * DM + col) = w;
                    sq += dot4(a0) + dot4(a1); }
                sq += __shfl_xor(sq, 16); sq += __shfl_xor(sq, 32);
                if (fq == 0) atomicAdd(ssout + row, sq);
            }
    }
};
struct EpiSwiglu {
    static constexpr bool PERM = true, AFTER_DRAIN = false;
    const float* ss; bf16_t* act;
    __device__ __forceinline__ void operator()(const pg8::f32x4 (&acc)[2][2][4][2], const pg8::Unit& u, int wr, int wc, int fr, int fq) const {
        const int row0 = u.pm * 256 + wr * 64 + fr;
#pragma unroll
        for (int ai = 0; ai < 2; ++ai)
#pragma unroll
            for (int m = 0; m < 4; ++m) {
                const int row = row0 + ai * 128 + m * 16; const float rs = rsqrtf(ss[row] * (1.f / DM) + EPS);
                float y[8];
#pragma unroll
                for (int n = 0; n < 2; ++n)
#pragma unroll
                    for (int i = 0; i < 4; ++i) { const float g = acc[ai][0][m][n][i] * rs, up = acc[ai][1][m][n][i] * rs; y[4 * n + i] = g * up * __builtin_amdgcn_rcpf(1.f + __expf(-g)); }
                u32x4 w; w.x = pk(y[0], y[1]); w.y = pk(y[2], y[3]); w.z = pk(y[4], y[5]); w.w = pk(y[6], y[7]);
                *(u32x4*)(act + (size_t)row * DFF + u.pn * 128 + wc * 32 + 8 * fq) = w;
            }
    }
};
struct EpiFoxProj {
    static constexpr bool PERM = true, AFTER_DRAIN = false;
    const float* ss; bf16_t* qkv; float* out; const float* bf;
    __device__ __forceinline__ void operator()(const pg8::f32x4 (&acc)[2][2][4][2], const pg8::Unit& u, int wr, int wc, int fr, int fq) const {
        const int row0 = u.pm * 256 + wr * 64 + fr;
        const int sect = u.pn >> 2;
#pragma unroll
        for (int ai = 0; ai < 2; ++ai)
#pragma unroll
            for (int m = 0; m < 4; ++m) {
                const int row = row0 + ai * 128 + m * 16; const float rs = rsqrtf(ss[row] * (1.f / DM) + EPS);
                if (u.pn < 12) {
                    const float sc = (sect == 0) ? rs * QSCALE2 : rs;
                    float* fdst = nullptr;
                    if (sect == 1) fdst = (row < MP) ? out + O_FKP + (size_t)row * DM : out + O_FKS + (size_t)(row - MP) * DM;
                    if (sect == 2) fdst = (row < MP) ? out + O_FVP + (size_t)row * DM : out + O_FVS + (size_t)(row - MP) * DM;
#pragma unroll
                    for (int bj = 0; bj < 2; ++bj) { const f32x4 v0 = acc[ai][bj][m][0] * sc, v1 = acc[ai][bj][m][1] * sc;
                        u32x4 w; w.x = pk(v0[0], v0[1]); w.y = pk(v0[2], v0[3]); w.z = pk(v1[0], v1[1]); w.w = pk(v1[2], v1[3]);
                        const int cl = bj * 128 + wc * 32 + 8 * fq;
                        *(u32x4*)(qkv + (size_t)row * NPJ + u.pn * 256 + cl) = w;
                        if (sect > 0) { float* d = fdst + (u.pn & 3) * 256 + cl; __builtin_nontemporal_store(v0, (f32x4*)d); __builtin_nontemporal_store(v1, (f32x4*)(d + 4)); } }
                } else if (wc == 0 && fq < 2) {
                    float* d = (row < MP) ? out + O_FLP + (size_t)row * 16 : out + O_FLS + (size_t)(row - MP) * 16;
#pragma unroll
                    for (int n = 0; n < 2; ++n) { const f32x4 v = acc[ai][0][m][n] * rs; f32x4 o;
#pragma unroll
                        for (int i = 0; i < 4; ++i) o[i] = log_sigmoid(v[i] + bf[8 * fq + 4 * n + i]);
                        *(f32x4*)(d + 8 * fq + 4 * n) = o; }
                }
            }
    }
};

constexpr int GL_OFF = 0, GSUM_OFF = 4096, DECS_OFF = 6144, QE_OFF = 8192, KE_OFF = 25600, VT_OFF = 43008, AL_OFF = 79872, KDT_OFF = 8192, OL_OFF = 8192;
constexpr int QES = 136, VTS = 72, OLS = 260;

struct GlaPre { unsigned v[32]; f32x4 gl; };
__device__ __forceinline__ void gla_prefetch(GlaPre& pf, const Args& a, int cid, int h) {
    const int tid = threadIdx.x, dvv = tid & 255, th = tid >> 8, row0 = cid * 64;
    const bf16_t* vp = (const bf16_t*)(a.ws + WS_PROJ) + (size_t)(row0 + 32 * th) * NPJ + 1024 + h * 256 + dvv;
#pragma unroll
    for (int i = 0; i < 32; ++i) pf.v[i] = vp[(size_t)i * NPJ];
    pf.gl = *(const f32x4*)((const float*)(a.ws + WS_GL) + (size_t)(row0 + ((tid & 255) >> 2)) * 16 + (tid & 3) * 4);
}
template <int MODE> __device__ __forceinline__ void gla_item(const Args& a, LAS unsigned char* lds, int cid, int h, GlaPre& pf, int next) {
    int tid_ = threadIdx.x; asm volatile("" : "+v"(tid_));
    const int tid = tid_, lane = tid & 63, w = __builtin_amdgcn_readfirstlane(tid >> 6), l31 = lane & 31, hi = lane >> 5;
    const int row0 = cid * 64;
    const bool prompt = cid < 256;
    LAS float* GLs = (LAS float*)(lds + GL_OFF); LAS float* GSUM = (LAS float*)(lds + GSUM_OFF); LAS float* DECS = (LAS float*)(lds + DECS_OFF);
    LAS bf16_t* QE = (LAS bf16_t*)(lds + QE_OFF); LAS bf16_t* KE = (LAS bf16_t*)(lds + KE_OFF); LAS bf16_t* VT = (LAS bf16_t*)(lds + VT_OFF);
    LAS bf16_t* AL = (LAS bf16_t*)(lds + AL_OFF); LAS bf16_t* KDT = (LAS bf16_t*)(lds + KDT_OFF);
    const bf16_t* P = (const bf16_t*)(a.ws + WS_PROJ) + (size_t)row0 * NPJ;
    const float* GL = (const float*)(a.ws + WS_GL);
    const float* state = a.in[I_STATE];

    bf16x8 sfr[8];
    if (MODE == 1) {
        if (prompt) {
            const bf16_t* sp = (const bf16_t*)(a.ws + WS_SPREV) + ((size_t)(cid * 4 + h) * 256 + 32 * w + l31) * 128 + 8 * hi;
#pragma unroll
            for (int ks = 0; ks < 8; ++ks) sfr[ks] = *(const bf16x8*)(sp + 16 * ks);
        } else {
            const float* s0 = state + ((size_t)((cid - 256) * 4 + h) * 128) * 256 + 32 * w + l31;
#pragma unroll
            for (int ks = 0; ks < 8; ++ks) { float f[8];
#pragma unroll
                for (int j = 0; j < 8; ++j) f[j] = s0[(size_t)(16 * ks + 8 * hi + j) * 256];
                u32x4 o; o.x = pk(f[0], f[1]); o.y = pk(f[2], f[3]); o.z = pk(f[4], f[5]); o.w = pk(f[6], f[7]); sfr[ks] = __builtin_bit_cast(bf16x8, o); }
        }
    }
    unsigned kraw[16], qraw[16];
    {
        const int dk_ = tid & 127, tg_ = tid >> 7;
        const bf16_t* kp_ = P + (size_t)(16 * tg_) * NPJ + 512 + h * 128 + dk_;
#pragma unroll
        for (int i = 0; i < 16; ++i) kraw[i] = kp_[(size_t)i * NPJ];
        if (MODE == 1) { const bf16_t* qp_ = P + (size_t)(16 * tg_) * NPJ + h * 128 + dk_;
#pragma unroll
            for (int i = 0; i < 16; ++i) qraw[i] = qp_[(size_t)i * NPJ]; }
    }
    float wv[16];
#pragma unroll
    for (int j = 0; j < 16; ++j) wv[j] = a.in[I_GWG2][j * 512 + h * 128 + (tid & 127)];
    const float bias = a.in[I_GBG][h * 128 + (tid & 127)];
    if (tid < 256) ((LAS f32x4*)GLs)[tid] = pf.gl;
    {
        const int dvv = tid & 255, th = tid >> 8;
#pragma unroll
        for (int q4 = 0; q4 < 4; ++q4) { u32x4 o; o.x = pf.v[8 * q4] | (pf.v[8 * q4 + 1] << 16); o.y = pf.v[8 * q4 + 2] | (pf.v[8 * q4 + 3] << 16);
            o.z = pf.v[8 * q4 + 4] | (pf.v[8 * q4 + 5] << 16); o.w = pf.v[8 * q4 + 6] | (pf.v[8 * q4 + 7] << 16);
            *(LAS u32x4*)(VT + dvv * VTS + 32 * th + 8 * q4) = o; }
    }
    if (next >= 0) gla_prefetch(pf, a, next >> 2, next & 3);
    __syncthreads();
    const int dk = tid & 127, tg = tid >> 7;
    float bc[16];
    {
        float run = 0.f;
#pragma unroll
        for (int i = 0; i < 16; ++i) { const LAS f32x4* gp = (const LAS f32x4*)(GLs + (16 * tg + i) * 16); float z = bias;
#pragma unroll
            for (int j4 = 0; j4 < 4; ++j4) { const f32x4 gq = gp[j4]; z += gq[0] * wv[4 * j4] + gq[1] * wv[4 * j4 + 1] + gq[2] * wv[4 * j4 + 2] + gq[3] * wv[4 * j4 + 3]; }
            run += log_sigmoid(z) * (1.f / 16.f); bc[i] = run; }
        GSUM[tg * 128 + dk] = run;
    }
    __syncthreads();
    float off = 0.f, blast = 0.f;
#pragma unroll
    for (int g = 0; g < 4; ++g) { const float s = GSUM[g * 128 + dk]; blast += s; if (g < tg) off += s; }
    if (MODE == 0) {
        float kd[16];
#pragma unroll
        for (int i = 0; i < 16; ++i) { const float b = bc[i] + off; kd[i] = bf2f(kraw[i]) * __expf(blast - b); }
        u32x4 o0, o1; o0.x = pk(kd[0], kd[1]); o0.y = pk(kd[2], kd[3]); o0.z = pk(kd[4], kd[5]); o0.w = pk(kd[6], kd[7]);
        o1.x = pk(kd[8], kd[9]); o1.y = pk(kd[10], kd[11]); o1.z = pk(kd[12], kd[13]); o1.w = pk(kd[14], kd[15]);
        *(LAS u32x4*)(KDT + dk * VTS + 16 * tg) = o0; *(LAS u32x4*)(KDT + dk * VTS + 16 * tg + 8) = o1;
        if (tg == 0) { const float d = __expf(blast); DECS[dk] = d; if (prompt) ((float*)(a.ws + WS_DEC))[(size_t)(cid * 4 + h) * 128 + dk] = d; }
    } else {
#pragma unroll
        for (int i = 0; i < 16; ++i) { const float b = bc[i] + off; const int t = 16 * tg + i;
            const float qe = bf2f(qraw[i]) * __expf(b) * 0.08838834764831845f, ke = bf2f(kraw[i]) * __expf(-b);
            QE[t * QES + dk] = (bf16_t)f2bf(qe); KE[t * QES + dk] = (bf16_t)f2bf(ke); }
    }
    __syncthreads();
    if (MODE == 0) {
        bf16x8 vf[4];
#pragma unroll
        for (int ks = 0; ks < 4; ++ks) vf[ks] = *(const LAS bf16x8*)(VT + (32 * w + l31) * VTS + 16 * ks + 8 * hi);
        f32x16 acc[4];
#pragma unroll
        for (int d = 0; d < 4; ++d) acc[d] = f32x16{};
#pragma unroll
        for (int d = 0; d < 4; ++d)
#pragma unroll
            for (int ks = 0; ks < 4; ++ks) { const bf16x8 kf = *(const LAS bf16x8*)(KDT + (32 * d + l31) * VTS + 16 * ks + 8 * hi);
                acc[d] = prompt ? MFMA32(vf[ks], kf, acc[d]) : MFMA32(kf, vf[ks], acc[d]); }
        if (prompt) {
            bf16_t* dst = (bf16_t*)(a.ws + WS_DST) + ((size_t)(cid * 4 + h) * 256 + 32 * w) * 128;
#pragma unroll
            for (int d = 0; d < 4; ++d)
#pragma unroll
                for (int r = 0; r < 16; ++r) dst[(size_t)crow(r, hi) * 128 + 32 * d + l31] = (bf16_t)f2bf(acc[d][r]);
        } else {
            const size_t base = ((size_t)((cid - 256) * 4 + h) * 128) * 256;
            float* outs = a.out + O_GSS;
#pragma unroll
            for (int d = 0; d < 4; ++d)
#pragma unroll
                for (int r = 0; r < 16; ++r) { const int dkk = 32 * d + crow(r, hi); const size_t idx = base + (size_t)dkk * 256 + 32 * w + l31; __builtin_nontemporal_store(__builtin_nontemporal_load(state + idx) * DECS[dkk] + acc[d][r], outs + idx); }
        }
    } else {
        u32x2 rraw[8];
#pragma unroll
        for (int i = 0; i < 8; ++i) rraw[i] = *(const u32x2*)(P + (size_t)(8 * w + i) * NPJ + 2048 + h * 256 + 4 * lane);
        f32x16 o[2]; o[0] = f32x16{}; o[1] = f32x16{};
#pragma unroll
        for (int tb = 0; tb < 2; ++tb)
#pragma unroll
            for (int ks = 0; ks < 8; ++ks) { const bf16x8 qa = *(const LAS bf16x8*)(QE + (32 * tb + l31) * QES + 16 * ks + 8 * hi); o[tb] = MFMA32(qa, sfr[ks], o[tb]); }
        if (w < 3) {
            const int tb = (w > 0) ? 1 : 0, sb = (w == 2) ? 1 : 0;
            f32x16 am = f32x16{};
#pragma unroll
            for (int ks = 0; ks < 8; ++ks) { const bf16x8 qa = *(const LAS bf16x8*)(QE + (32 * tb + l31) * QES + 16 * ks + 8 * hi), kb = *(const LAS bf16x8*)(KE + (32 * sb + l31) * QES + 16 * ks + 8 * hi);
                am = MFMA32(qa, kb, am); }
#pragma unroll
            for (int r = 0; r < 16; ++r) { const int tl = crow(r, hi); float v = am[r]; if (tb == sb && l31 > tl) v = 0.f; AL[(32 * tb + tl) * VTS + 32 * sb + l31] = (bf16_t)f2bf(v); }
        }
        __syncthreads();
#pragma unroll
        for (int tb = 0; tb < 2; ++tb)
#pragma unroll
            for (int ks = 0; ks < 4; ++ks) { if (tb == 0 && ks >= 2) continue;
                const bf16x8 aa = *(const LAS bf16x8*)(AL + (32 * tb + l31) * VTS + 16 * ks + 8 * hi), vb = *(const LAS bf16x8*)(VT + (32 * w + l31) * VTS + 16 * ks + 8 * hi);
                o[tb] = MFMA32(aa, vb, o[tb]); }
        __syncthreads();
        LAS float* OL = (LAS float*)(lds + OL_OFF);
#pragma unroll
        for (int tb = 0; tb < 2; ++tb)
#pragma unroll
            for (int r = 0; r < 16; ++r) OL[(32 * tb + crow(r, hi)) * OLS + 32 * w + l31] = o[tb][r];
        __syncthreads();
        const f32x4 ng = *(const f32x4*)(a.in[I_GNORM] + h * 256 + 4 * lane);
        bf16_t* OG = (bf16_t*)(a.ws + WS_OG);
#pragma unroll
        for (int i = 0; i < 8; ++i) { const int t = 8 * w + i; const f32x4 v = *(const LAS f32x4*)(OL + t * OLS + 4 * lane);
            const float rs = rsqrtf(wave_sum(dot4(v)) * (1.f / 256.f) + EPS);
            const u32x2 rr = rraw[i];
            float rv[4] = {bf2f(rr.x & 0xffffu), bf2f(rr.x >> 16), bf2f(rr.y & 0xffffu), bf2f(rr.y >> 16)}; float y[4];
#pragma unroll
            for (int j = 0; j < 4; ++j) y[j] = v[j] * rs * ng[j] * rv[j] * __builtin_amdgcn_rcpf(1.f + __expf(-rv[j]));
            u32x2 ov; ov.x = pk(y[0], y[1]); ov.y = pk(y[2], y[3]);
            *(u32x2*)(OG + (size_t)(row0 + t) * DM + h * 256 + 4 * lane) = ov; }
    }
    __syncthreads();
}

__device__ __forceinline__ void gla_scan(const Args& a, int vcu, int G) {
    const int gt = vcu * 512 + threadIdx.x, NT_ = G * 512;
    const bf16_t* DST = (const bf16_t*)(a.ws + WS_DST); const float* DEC = (const float*)(a.ws + WS_DEC); bf16_t* SP = (bf16_t*)(a.ws + WS_SPREV);
    for (int it0 = gt; it0 < 32 * 8192; it0 += 2 * NT_) {
        const int it1 = it0 + NT_; const bool two = it1 < 32 * 8192;
        const int bhA = it0 >> 13, eA = it0 & 8191, dvA = eA >> 5, dkA = (eA & 31) * 4;
        const int itB = two ? it1 : it0; const int bhB = itB >> 13, eB = itB & 8191, dvB = eB >> 5, dkB = (eB & 31) * 4;
        f32x4 SA = (f32x4){0.f, 0.f, 0.f, 0.f}, SB = SA;
#pragma unroll 8
        for (int c = 0; c < 32; ++c) {
            const size_t chA = (size_t)(((bhA >> 2) * 32 + c) * 4 + (bhA & 3)), chB = (size_t)(((bhB >> 2) * 32 + c) * 4 + (bhB & 3));
            const size_t baseA = (chA * 256 + dvA) * 128 + dkA, baseB = (chB * 256 + dvB) * 128 + dkB;
            const u32x2 rA = __builtin_nontemporal_load((const u32x2*)(DST + baseA)), rB = __builtin_nontemporal_load((const u32x2*)(DST + baseB));
            const f32x4 deA = *(const f32x4*)(DEC + chA * 128 + dkA), deB = *(const f32x4*)(DEC + chB * 128 + dkB);
            const f32x4 dsA = (f32x4){bf2f(rA.x & 0xffffu), bf2f(rA.x >> 16), bf2f(rA.y & 0xffffu), bf2f(rA.y >> 16)};
            const f32x4 dsB = (f32x4){bf2f(rB.x & 0xffffu), bf2f(rB.x >> 16), bf2f(rB.y & 0xffffu), bf2f(rB.y >> 16)};
            u32x2 o; o.x = pk(SA[0], SA[1]); o.y = pk(SA[2], SA[3]); *(u32x2*)(SP + baseA) = o;
            if (two) { o.x = pk(SB[0], SB[1]); o.y = pk(SB[2], SB[3]); *(u32x2*)(SP + baseB) = o; }
            SA = SA * deA + dsA; SB = SB * deB + dsB;
        }
        float* ogA = a.out + O_GSP + ((size_t)bhA * 128 + dkA) * 256 + dvA;
#pragma unroll
        for (int i = 0; i < 4; ++i) __builtin_nontemporal_store(SA[i], ogA + (size_t)i * 256);
        if (two) { float* ogB = a.out + O_GSP + ((size_t)bhB * 128 + dkB) * 256 + dvB;
#pragma unroll
            for (int i = 0; i < 4; ++i) __builtin_nontemporal_store(SB[i], ogB + (size_t)i * 256); }
    }
}

template <int L, int C> __device__ __forceinline__ void cumsum_item(const float* src0, const float* src1, float* dst, LAS float* SEG, int hh, int seg) {
    float s = 0.f;
#pragma unroll 1
    for (int c0 = 0; c0 < L; c0 += C) { float v[C];
#pragma unroll
        for (int i = 0; i < C; ++i) { const int t = seg * L + c0 + i; v[i] = (t < 2048) ? src0[(unsigned)(t * 16 + hh)] : src1[(unsigned)((t - 2048) * 16 + hh)]; }
#pragma unroll
        for (int i = 0; i < C; ++i) s += v[i]; }
    SEG[seg * 16 + hh] = s;
    __syncthreads();
    float run = 0.f;
    for (int g = 0; g < seg; ++g) run += SEG[g * 16 + hh];
#pragma unroll 1
    for (int c0 = 0; c0 < L; c0 += C) { float v[C];
#pragma unroll
        for (int i = 0; i < C; ++i) { const int t = seg * L + c0 + i; v[i] = (t < 2048) ? src0[(unsigned)(t * 16 + hh)] : src1[(unsigned)((t - 2048) * 16 + hh)]; }
#pragma unroll
        for (int i = 0; i < C; ++i) { run += v[i]; dst[seg * L + c0 + i] = run; } }
    __syncthreads();
}
__device__ __forceinline__ void fox_cumsum(const Args& a, LAS unsigned char* lds, int vcu, int G) {
    const int tid = threadIdx.x, hh = tid & 15, seg = tid >> 4;
    LAS float* SEG = (LAS float*)lds;
    for (int it = vcu; it < 40; it += G) {
        const bool prompt = it < 8; const int b = prompt ? it : it - 8;
        const float* src0 = prompt ? a.out + O_FLP + (size_t)b * 2048 * 16 : a.in[I_CLF] + (size_t)b * 2048 * 16;
        const float* src1 = a.out + O_FLS + (size_t)b * 64 * 16;
        if (prompt) cumsum_item<64, 32>(src0, src1, (float*)(a.ws + WS_CP) + (size_t)(b * 16 + hh) * 2048, SEG, hh, seg);
        else cumsum_item<66, 22>(src0, src1, (float*)(a.ws + WS_CS) + (size_t)(b * 16 + hh) * 2112, SEG, hh, seg);
    }
}

constexpr int AT_KS = 72, AT_VS = 68, AT_BUF = 18432, AT_VOFF = 9216, AT_COFF = 17920;
struct TileRegs { u32x4 k0, k1, v0, v1; float ck; };

template <bool SAMPLE> __device__ __forceinline__ void attn_load(TileRegs& R, const Args& a, int b, int h, int t, const float* cbase, int tid) {
    const int kvl = tid >> 3, ch = tid & 7, kp = tid >> 4, c4 = tid & 15;
    if (SAMPLE && t < 32) {
        const float* kptr = a.in[I_CK] + (((size_t)b * 2048 + 64 * t + kvl) * 16 + h) * 64 + 8 * ch;
        R.k0 = *(const u32x4*)kptr; R.k1 = *(const u32x4*)(kptr + 4);
        const float* vptr = a.in[I_CV] + (((size_t)b * 2048 + 64 * t + 2 * kp) * 16 + h) * 64 + 4 * c4;
        R.v0 = *(const u32x4*)vptr; R.v1 = *(const u32x4*)(vptr + 1024);
    } else {
        const size_t rowbase = SAMPLE ? (size_t)(MP + b * 64) : (size_t)(b * 2048 + 64 * t);
        const bf16_t* qkv = (const bf16_t*)(a.ws + WS_PROJ);
        R.k0 = *(const u32x4*)(qkv + (rowbase + kvl) * NPJ + 1024 + h * 64 + 8 * ch);
        const bf16_t* vptr = qkv + (rowbase + 2 * kp) * NPJ + 2048 + h * 64 + 4 * c4;
        const u32x2 x0 = *(const u32x2*)vptr, x1 = *(const u32x2*)(vptr + NPJ);
        R.v0.x = x0.x; R.v0.y = x0.y; R.v1.x = x1.x; R.v1.y = x1.y;
    }
    R.ck = cbase[64 * t + (tid & 63)];
}
__device__ __forceinline__ void attn_store(const TileRegs& R, LAS unsigned char* buf, bool f32src, int tid) {
    const int kvl = tid >> 3, ch = tid & 7, kp = tid >> 4, c4 = tid & 15;
    LAS unsigned* VT32 = (LAS unsigned*)(buf + AT_VOFF);
    if (f32src) {
        u32x4 o; o.x = pk(__uint_as_float(R.k0.x), __uint_as_float(R.k0.y)); o.y = pk(__uint_as_float(R.k0.z), __uint_as_float(R.k0.w));
        o.z = pk(__uint_as_float(R.k1.x), __uint_as_float(R.k1.y)); o.w = pk(__uint_as_float(R.k1.z), __uint_as_float(R.k1.w));
        *(LAS u32x4*)(buf + (kvl * AT_KS + 8 * ch) * 2) = o;
#pragma unroll
        for (int i = 0; i < 4; ++i) VT32[(4 * c4 + i) * (AT_VS / 2) + kp] = pk(__uint_as_float(R.v0[i]), __uint_as_float(R.v1[i]));
    } else {
        *(LAS u32x4*)(buf + (kvl * AT_KS + 8 * ch) * 2) = R.k0;
        VT32[(4 * c4 + 0) * (AT_VS / 2) + kp] = (R.v0.x & 0xffffu) | (R.v1.x << 16);
        VT32[(4 * c4 + 1) * (AT_VS / 2) + kp] = (R.v0.x >> 16) | (R.v1.x & 0xffff0000u);
        VT32[(4 * c4 + 2) * (AT_VS / 2) + kp] = (R.v0.y & 0xffffu) | (R.v1.y << 16);
        VT32[(4 * c4 + 3) * (AT_VS / 2) + kp] = (R.v0.y >> 16) | (R.v1.y & 0xffff0000u);
    }
    if (tid < 64) { const float c = -R.ck * LOG2E; const unsigned h1 = f2bf(c); const float r1 = c - bf2f(h1); const unsigned h2 = f2bf(r1); const unsigned h3 = f2bf(r1 - bf2f(h2));
        u32x2 o; o.x = h1 | (h2 << 16); o.y = h3; ((LAS u32x2*)(buf + AT_COFF))[tid] = o; }
}

template <bool QLDS> __device__ __forceinline__ void attn_tile(const LAS unsigned char* buf, const bf16x8 (&qf)[4], const LAS bf16x8* qlds, float cq2, int qpos, int kv0, bool diag, float& mrun, float& lrun, f32x16 (&ot)[2], int l31, int hi) {
    const LAS bf16_t* Ks = (const LAS bf16_t*)buf; const LAS bf16_t* VTs = (const LAS bf16_t*)(buf + AT_VOFF); const LAS u32x2* CKs = (const LAS u32x2*)(buf + AT_COFF);
    f32x16 p0, p1;
#pragma unroll
    for (int r = 0; r < 16; ++r) { p0[r] = cq2; p1[r] = cq2; }
    {
        const u32x2 b0 = CKs[l31], b1 = CKs[32 + l31];
        const unsigned msk = hi ? 0u : 0xffffffffu;
        u32x4 x0; x0.x = b0.x & msk; x0.y = b0.y & msk; x0.z = 0u; x0.w = 0u;
        u32x4 x1; x1.x = b1.x & msk; x1.y = b1.y & msk; x1.z = 0u; x1.w = 0u;
        u32x4 qx; qx.x = 0x3F803F80u & msk; qx.y = 0x00003F80u & msk; qx.z = 0u; qx.w = 0u;
        p0 = MFMA32(__builtin_bit_cast(bf16x8, x0), __builtin_bit_cast(bf16x8, qx), p0); p1 = MFMA32(__builtin_bit_cast(bf16x8, x1), __builtin_bit_cast(bf16x8, qx), p1);
    }
#pragma unroll
    for (int ks = 0; ks < 4; ++ks) { const bf16x8 k0 = *(const LAS bf16x8*)(Ks + l31 * AT_KS + 16 * ks + 8 * hi), k1 = *(const LAS bf16x8*)(Ks + (32 + l31) * AT_KS + 16 * ks + 8 * hi);
        const bf16x8 qq = QLDS ? qlds[ks * 64] : qf[ks];
        p0 = MFMA32(k0, qq, p0); p1 = MFMA32(k1, qq, p1); }
    __builtin_amdgcn_sched_barrier(0);
    if (diag) {
        int qp = qpos - kv0; asm volatile("" : "+v"(qp));
#pragma unroll
        for (int r = 0; r < 16; ++r) { const int kv = crow(r, hi); if (kv > qp) p0[r] = -INFINITY; if (kv + 32 > qp) p1[r] = -INFINITY; }
    }
    float rm = fmaxf(p0[0], p1[0]);
#pragma unroll
    for (int r = 1; r < 16; ++r) rm = fmaxf(rm, fmaxf(p0[r], p1[r]));
    rm = fmaxf(rm, __shfl_xor(rm, 32));
    if (__all(rm < mrun - 40.f)) return;
    const float mn = fmaxf(mrun, rm);
    if (__any(mn > mrun)) {
        const float alpha = __builtin_amdgcn_exp2f(mrun - mn);
        lrun *= alpha;
#pragma unroll
        for (int r = 0; r < 16; ++r) { ot[0][r] *= alpha; ot[1][r] *= alpha; }
        mrun = mn;
    }
    float rs = 0.f;
#pragma unroll
    for (int r = 0; r < 16; ++r) { p0[r] = __builtin_amdgcn_exp2f(p0[r] - mrun); p1[r] = __builtin_amdgcn_exp2f(p1[r] - mrun); rs += p0[r] + p1[r]; }
    lrun += rs;
    bf16x8 pf[4];
    { u32x4 x; x.x = pk(p0[0], p0[1]); x.y = pk(p0[2], p0[3]); x.z = pk(p0[4], p0[5]); x.w = pk(p0[6], p0[7]); pf[0] = __builtin_bit_cast(bf16x8, x);
      x.x = pk(p0[8], p0[9]); x.y = pk(p0[10], p0[11]); x.z = pk(p0[12], p0[13]); x.w = pk(p0[14], p0[15]); pf[1] = __builtin_bit_cast(bf16x8, x);
      x.x = pk(p1[0], p1[1]); x.y = pk(p1[2], p1[3]); x.z = pk(p1[4], p1[5]); x.w = pk(p1[6], p1[7]); pf[2] = __builtin_bit_cast(bf16x8, x);
      x.x = pk(p1[8], p1[9]); x.y = pk(p1[10], p1[11]); x.z = pk(p1[12], p1[13]); x.w = pk(p1[14], p1[15]); pf[3] = __builtin_bit_cast(bf16x8, x); }
    __builtin_amdgcn_sched_barrier(0);
#pragma unroll
    for (int db = 0; db < 2; ++db)
#pragma unroll
        for (int ks = 0; ks < 4; ++ks) { const LAS bf16_t* vp = VTs + (32 * db + l31) * AT_VS + 16 * ks + 4 * hi;
            const u32x2 lo = *(const LAS u32x2*)vp, hh2 = *(const LAS u32x2*)(vp + 8);
            u32x4 x; x.x = lo.x; x.y = lo.y; x.z = hh2.x; x.w = hh2.y;
            ot[db] = MFMA32(__builtin_bit_cast(bf16x8, x), pf[ks], ot[db]); }
}

__device__ __forceinline__ void gld16(u32x4& d, const void* p) { asm volatile("global_load_dwordx4 %0, %1, off" : "=v"(d) : "v"(p)); }
__device__ __forceinline__ void gld16_nt(u32x4& d, const void* p) { asm volatile("global_load_dwordx4 %0, %1, off nt" : "=v"(d) : "v"(p)); }
__device__ __forceinline__ void gld8(u32x2& d, const void* p) { asm volatile("global_load_dwordx2 %0, %1, off" : "=v"(d) : "v"(p)); }
__device__ __forceinline__ void gld4(float& d, const void* p) { asm volatile("global_load_dword %0, %1, off" : "=v"(d) : "v"(p)); }
struct PRegs { u32x4 k; u32x2 v0, v1; float ck; };
__device__ __forceinline__ void pload_a(PRegs& R, const Args& a, int b, int h, int t, const float* cbase, int tid) {
    const int kvl = tid >> 3, ch = tid & 7, kp = tid >> 4, c4 = tid & 15;
    const size_t rowbase = (size_t)(b * 2048 + 64 * t);
    const bf16_t* qkv = (const bf16_t*)(a.ws + WS_PROJ);
    gld16(R.k, qkv + (rowbase + kvl) * NPJ + 1024 + h * 64 + 8 * ch);
    const bf16_t* vptr = qkv + (rowbase + 2 * kp) * NPJ + 2048 + h * 64 + 4 * c4;
    gld8(R.v0, vptr); gld8(R.v1, vptr + NPJ);
    gld4(R.ck, cbase + 64 * t + (tid & 63));
}
#define WAIT_P(N, R) asm volatile("s_waitcnt vmcnt(" #N ")" : "+v"(R.k), "+v"(R.v0), "+v"(R.v1), "+v"(R.ck))
__device__ __forceinline__ void pstore(const PRegs& R, LAS unsigned char* buf, int tid) {
    const int kvl = tid >> 3, ch = tid & 7, kp = tid >> 4, c4 = tid & 15;
    LAS unsigned* VT32 = (LAS unsigned*)(buf + AT_VOFF);
    *(LAS u32x4*)(buf + (kvl * AT_KS + 8 * ch) * 2) = R.k;
    VT32[(4 * c4 + 0) * (AT_VS / 2) + kp] = (R.v0.x & 0xffffu) | (R.v1.x << 16);
    VT32[(4 * c4 + 1) * (AT_VS / 2) + kp] = (R.v0.x >> 16) | (R.v1.x & 0xffff0000u);
    VT32[(4 * c4 + 2) * (AT_VS / 2) + kp] = (R.v0.y & 0xffffu) | (R.v1.y << 16);
    VT32[(4 * c4 + 3) * (AT_VS / 2) + kp] = (R.v0.y >> 16) | (R.v1.y & 0xffff0000u);
    if (tid < 64) { const float c = -R.ck * LOG2E; const unsigned h1 = f2bf(c); const float r1 = c - bf2f(h1); const unsigned h2 = f2bf(r1); const unsigned h3 = f2bf(r1 - bf2f(h2));
        u32x2 o; o.x = h1 | (h2 << 16); o.y = h3; ((LAS u32x2*)(buf + AT_COFF))[tid] = o; }
}
__device__ __forceinline__ void attn_unit_prompt(const Args& a, LAS unsigned char* lds, int b, int h, int qb) {
    int tid_ = threadIdx.x; asm volatile("" : "+v"(tid_));
    const int tid = tid_, lane = tid & 63, w = __builtin_amdgcn_readfirstlane(tid >> 6), l31 = lane & 31, hi = lane >> 5;
    const int NT = 4 * (qb + 1);
    const int qpos = 256 * qb + 32 * w + l31;
    const size_t qrow = (size_t)(b * 2048 + qpos);
    const float* cbase = (const float*)(a.ws + WS_CP) + (size_t)(b * 16 + h) * 2048;
    const bf16_t* qkv = (const bf16_t*)(a.ws + WS_PROJ);
    bf16x8 qf[4];
#pragma unroll
    for (int ks = 0; ks < 4; ++ks) qf[ks] = *(const bf16x8*)(qkv + qrow * NPJ + h * 64 + 16 * ks + 8 * hi);
    const float cq2 = cbase[qpos] * LOG2E;
    const int qmax_w = 256 * qb + 32 * w + 31;
    PRegs R0, R1, R2;
    pload_a(R0, a, b, h, NT - 1, cbase, tid); pload_a(R1, a, b, h, NT - 2, cbase, tid); pload_a(R2, a, b, h, NT - 3, cbase, tid);
    WAIT_P(8, R0); pstore(R0, lds, tid);
    pload_a(R0, a, b, h, NT - 4, cbase, tid);
    __syncthreads();
    float mrun = -INFINITY, lrun = 0.f;
    f32x16 ot[2]; ot[0] = f32x16{}; ot[1] = f32x16{};
#define PSTEP(tt, RR) do { if ((tt) < NT) { const int ti_ = NT - 1 - (tt); if (64 * ti_ <= qmax_w) attn_tile<false>(lds + ((tt) & 1) * AT_BUF, qf, nullptr, cq2, qpos, 64 * ti_, ti_ >= 4 * qb, mrun, lrun, ot, l31, hi); \
        { WAIT_P(8, RR); pstore(RR, lds + (((tt) + 1) & 1) * AT_BUF, tid); pload_a(RR, a, b, h, (NT - 5 - (tt)) > 0 ? NT - 5 - (tt) : 0, cbase, tid); } \
        __syncthreads(); } } while (0)
#pragma unroll 1
    for (int t = 0; t < NT; t += 3) { PSTEP(t, R1); PSTEP(t + 1, R2); PSTEP(t + 2, R0); }
#undef PSTEP
    WAIT_P(0, R0); WAIT_P(0, R1); WAIT_P(0, R2);
    lrun += __shfl_xor(lrun, 32);
    const float inv = 1.f / lrun;
    bf16_t* og = (bf16_t*)(a.ws + WS_OG) + qrow * DM + h * 64;
#pragma unroll
    for (int db = 0; db < 2; ++db)
#pragma unroll
        for (int j = 0; j < 4; ++j) { u32x2 o; o.x = pk(ot[db][4 * j] * inv, ot[db][4 * j + 1] * inv); o.y = pk(ot[db][4 * j + 2] * inv, ot[db][4 * j + 3] * inv);
            *(u32x2*)(og + 32 * db + 8 * j + 4 * hi) = o; }
}

struct TileRegs2 { u32x4 k[4], v[4]; float ck; };
__device__ __forceinline__ void sload2(TileRegs2& R, const Args& a, int b, int h, int t, const float* cbase, int st) {
#pragma unroll
    for (int q = 0; q < 2; ++q) {
        const int item = st + 256 * q, kvl = item >> 3, ch = item & 7, kp = item >> 4, c4 = item & 15;
        if (t < 32) {
            const float* kptr = a.in[I_CK] + (((size_t)b * 2048 + 64 * t + kvl) * 16 + h) * 64 + 8 * ch;
            R.k[2 * q] = *(const u32x4*)kptr; R.k[2 * q + 1] = *(const u32x4*)(kptr + 4);
            const float* vptr = a.in[I_CV] + (((size_t)b * 2048 + 64 * t + 2 * kp) * 16 + h) * 64 + 4 * c4;
            R.v[2 * q] = *(const u32x4*)vptr; R.v[2 * q + 1] = *(const u32x4*)(vptr + 1024);
        } else {
            const size_t rowbase = (size_t)(MP + b * 64);
            const bf16_t* qkv = (const bf16_t*)(a.ws + WS_PROJ);
            R.k[2 * q] = *(const u32x4*)(qkv + (rowbase + kvl) * NPJ + 1024 + h * 64 + 8 * ch);
            const bf16_t* vptr = qkv + (rowbase + 2 * kp) * NPJ + 2048 + h * 64 + 4 * c4;
            const u32x2 x0 = *(const u32x2*)vptr, x1 = *(const u32x2*)(vptr + NPJ);
            R.v[2 * q].x = x0.x; R.v[2 * q].y = x0.y; R.v[2 * q + 1].x = x1.x; R.v[2 * q + 1].y = x1.y;
        }
    }
    R.ck = cbase[64 * t + (st & 63)];
}
__device__ __forceinline__ void sload2a(TileRegs2& R, const Args& a, int b, int h, int t, const float* cbase, int st) {
#pragma unroll
    for (int q = 0; q < 2; ++q) {
        const int item = st + 256 * q, kvl = item >> 3, ch = item & 7, kp = item >> 4, c4 = item & 15;
        const float* kptr = a.in[I_CK] + (((size_t)b * 2048 + 64 * t + kvl) * 16 + h) * 64 + 8 * ch;
        gld16_nt(R.k[2 * q], kptr); gld16_nt(R.k[2 * q + 1], kptr + 4);
        const float* vptr = a.in[I_CV] + (((size_t)b * 2048 + 64 * t + 2 * kp) * 16 + h) * 64 + 4 * c4;
        gld16_nt(R.v[2 * q], vptr); gld16_nt(R.v[2 * q + 1], vptr + 1024);
    }
    gld4(R.ck, cbase + 64 * t + (st & 63));
}
#define WAIT_R2(N, R) asm volatile("s_waitcnt vmcnt(" #N ")" : "+v"(R.k[0]), "+v"(R.k[1]), "+v"(R.k[2]), "+v"(R.k[3]), "+v"(R.v[0]), "+v"(R.v[1]), "+v"(R.v[2]), "+v"(R.v[3]), "+v"(R.ck))
__device__ __forceinline__ void sstore2(const TileRegs2& R, LAS unsigned char* buf, bool f32src, int st) {
    LAS unsigned* VT32 = (LAS unsigned*)(buf + AT_VOFF);
#pragma unroll
    for (int q = 0; q < 2; ++q) {
        const int item = st + 256 * q, kvl = item >> 3, ch = item & 7, kp = item >> 4, c4 = item & 15;
        if (f32src) {
            const u32x4 k0 = R.k[2 * q], k1 = R.k[2 * q + 1];
            u32x4 o; o.x = pk(__uint_as_float(k0.x), __uint_as_float(k0.y)); o.y = pk(__uint_as_float(k0.z), __uint_as_float(k0.w));
            o.z = pk(__uint_as_float(k1.x), __uint_as_float(k1.y)); o.w = pk(__uint_as_float(k1.z), __uint_as_float(k1.w));
            *(LAS u32x4*)(buf + (kvl * AT_KS + 8 * ch) * 2) = o;
#pragma unroll
            for (int i = 0; i < 4; ++i) VT32[(4 * c4 + i) * (AT_VS / 2) + kp] = pk(__uint_as_float(R.v[2 * q][i]), __uint_as_float(R.v[2 * q + 1][i]));
        } else {
            *(LAS u32x4*)(buf + (kvl * AT_KS + 8 * ch) * 2) = R.k[2 * q];
            const u32x4 v0 = R.v[2 * q], v1 = R.v[2 * q + 1];
            VT32[(4 * c4 + 0) * (AT_VS / 2) + kp] = (v0.x & 0xffffu) | (v1.x << 16);
            VT32[(4 * c4 + 1) * (AT_VS / 2) + kp] = (v0.x >> 16) | (v1.x & 0xffff0000u);
            VT32[(4 * c4 + 2) * (AT_VS / 2) + kp] = (v0.y & 0xffffu) | (v1.y << 16);
            VT32[(4 * c4 + 3) * (AT_VS / 2) + kp] = (v0.y >> 16) | (v1.y & 0xffff0000u);
        }
    }
    if (st < 64) { const float c = -R.ck * LOG2E; const unsigned h1 = f2bf(c); const float r1 = c - bf2f(h1); const unsigned h2 = f2bf(r1); const unsigned h3 = f2bf(r1 - bf2f(h2));
        u32x2 o; o.x = h1 | (h2 << 16); o.y = h3; ((LAS u32x2*)(buf + AT_COFF))[st] = o; }
}
__device__ __forceinline__ void attn_unit_sample(const Args& a, LAS unsigned char* lds, int b, int h) {
    int tid_ = threadIdx.x; asm volatile("" : "+v"(tid_));
    const int tid = tid_, lane = tid & 63, w = __builtin_amdgcn_readfirstlane(tid >> 6), l31 = lane & 31, hi = lane >> 5;
    const float* cbase = (const float*)(a.ws + WS_CS) + (size_t)(b * 16 + h) * 2112;
    if (w >= 2 && w < 6) {
        const int st = tid - 128;
        TileRegs2 R0, R1, R2, R3;
        sload2(R0, a, b, h, 32, cbase, st); sload2a(R1, a, b, h, 31, cbase, st); sload2a(R2, a, b, h, 30, cbase, st); sload2a(R3, a, b, h, 29, cbase, st);
        sstore2(R0, lds, false, st);
        sload2a(R0, a, b, h, 28, cbase, st);
        __syncthreads();
#define SSTEP(tt, RR) do { WAIT_R2(27, RR); sstore2(RR, lds + (((tt) + 1) & 1) * AT_BUF, true, st); sload2a(RR, a, b, h, (27 - (tt)) > 0 ? 27 - (tt) : 0, cbase, st); __syncthreads(); } while (0)
#pragma unroll 1
        for (int t = 0; t < 32; t += 4) { SSTEP(t, R1); SSTEP(t + 1, R2); SSTEP(t + 2, R3); SSTEP(t + 3, R0); }
        SSTEP(32, R1);
#undef SSTEP
        WAIT_R2(0, R0); WAIT_R2(0, R1); WAIT_R2(0, R2); WAIT_R2(0, R3);
    } else {
        const bool active = w < 2;
        const int qpos = 2048 + 32 * (w & 1) + l31;
        const size_t qrow = (size_t)(MP + b * 64 + 32 * (w & 1) + l31);
        const bf16_t* qkv = (const bf16_t*)(a.ws + WS_PROJ);
        bf16x8 qf[4];
#pragma unroll
        for (int ks = 0; ks < 4; ++ks) qf[ks] = *(const bf16x8*)(qkv + qrow * NPJ + h * 64 + 16 * ks + 8 * hi);
        const float cq2 = cbase[qpos] * LOG2E;
        float mrun = -INFINITY, lrun = 0.f;
        f32x16 ot[2]; ot[0] = f32x16{}; ot[1] = f32x16{};
        __syncthreads();
#pragma unroll 1
        for (int tt = 0; tt < 33; ++tt) {
            if (active) attn_tile<false>(lds + (tt & 1) * AT_BUF, qf, nullptr, cq2, qpos, 64 * (32 - tt), tt == 0, mrun, lrun, ot, l31, hi);
            __syncthreads();
        }
        if (active) {
            lrun += __shfl_xor(lrun, 32);
            const float inv = 1.f / lrun;
            bf16_t* og = (bf16_t*)(a.ws + WS_OG) + qrow * DM + h * 64;
#pragma unroll
            for (int db = 0; db < 2; ++db)
#pragma unroll
                for (int j = 0; j < 4; ++j) { u32x2 o; o.x = pk(ot[db][4 * j] * inv, ot[db][4 * j + 1] * inv); o.y = pk(ot[db][4 * j + 2] * inv, ot[db][4 * j + 3] * inv);
                    *(u32x2*)(og + 32 * db + 8 * j + 4 * hi) = o; }
        }
    }
}

__device__ __forceinline__ void fox_attention(const Args& a, LAS unsigned char* lds, int vcu, int G) {
#pragma unroll 1
    for (int pass = 0; pass < 2; ++pass) {
        if ((pass ^ (vcu & 1)) == 0) {
#ifdef ATT_DUP_PROMPT
          for (int rep2_ = 0; rep2_ < 2; ++rep2_)
#endif
            if (G == 256) {
                const int bh = vcu >> 1, s0 = 2 * (vcu & 1);
#pragma unroll 1
                for (int i = 0; i < 4; ++i) attn_unit_prompt(a, lds, bh >> 4, bh & 15, (i & 1) ? s0 + (i >> 1) : 7 - s0 - (i >> 1));
            } else {
#pragma unroll 1
                for (int u = vcu; u < 1024; u += G) attn_unit_prompt(a, lds, (u & 127) >> 4, u & 15, 7 - (u >> 7));
            }
        } else {
#ifdef ATT_DUP_SAMPLE
            for (int rep3_ = 0; rep3_ < 2; ++rep3_)
#endif
#pragma unroll 1
            for (int u = vcu; u < 512; u += G) attn_unit_sample(a, lds, u >> 4, u & 15);
        }
    }
}

#ifndef PH_MASK
#define PH_MASK 0x7fff
#endif
#define IN(k) (((PH_MASK >> (k)) & 1) && a.ph_lo <= (k) && (k) < a.ph_hi)
#define SEAM(k) do { if (IN(k) && IN((k) + 1)) { if ((k) == 0 && a.ph_hi < 0) cg::this_grid().sync(); xcd_barrier(xbar); } } while (0)
#ifndef DUP_MASK
#define DUP_MASK 0
#endif
#define REP(k) _Pragma("unroll 1") for (int rep_ = 0; rep_ < ((((DUP_MASK) >> (k)) & 1) ? 2 : 1); ++rep_)
#define REPSYNC(k) do { if ((((DUP_MASK) >> (k)) & 1)) xcd_barrier(xbar); } while (0)
struct SliceOrder {
    int pm, pn;
    __device__ __forceinline__ bool next(int i, pg8::Unit& u) const { if (i > 0) return false; u.pm = pm; u.pn = pn; return true; }
    __device__ __forceinline__ void a_ready(const pg8::Unit&) const {}
    __device__ __forceinline__ void done(const pg8::Unit&) const {}
};
struct EpiPartial {
    static constexpr bool PERM = true, AFTER_DRAIN = false;
    float* part;
    __device__ __forceinline__ void operator()(const pg8::f32x4 (&acc)[2][2][4][2], const pg8::Unit& u, int wr, int wc, int fr, int fq) const {
#pragma unroll
        for (int ai = 0; ai < 2; ++ai)
#pragma unroll
            for (int m = 0; m < 4; ++m) { float* rowp = part + (size_t)(ai * 128 + wr * 64 + m * 16 + fr) * 256 + wc * 32 + 8 * fq;
#pragma unroll
                for (int bj = 0; bj < 2; ++bj) { *(f32x4*)(rowp + bj * 128) = acc[ai][bj][m][0]; *(f32x4*)(rowp + bj * 128 + 4) = acc[ai][bj][m][1]; } }
    }
};
__device__ __forceinline__ void ffd_sample_rows(const Args& a, int vcu, int G, float* ssout) {
    const int tid = threadIdx.x, lane = tid & 63, wave = tid >> 6;
    const int gw = vcu * 8 + wave, NGW = G * 8;
    float* XR = (float*)(a.ws + WS_XR); bf16_t* XB = (bf16_t*)(a.ws + WS_XB); const float* PART = (const float*)(a.ws + WS_PART);
    for (int r = gw; r < MS; r += NGW) {
        const int pml = r >> 8, rr = r & 255; const size_t row = (size_t)(MP + r);
        f32x4 acc[4];
#pragma unroll
        for (int pn = 0; pn < 4; ++pn) { acc[pn] = *(const f32x4*)(XR + row * DM + pn * 256 + 4 * lane);
#pragma unroll
            for (int sl = 0; sl < 8; ++sl) acc[pn] += *(const f32x4*)(PART + ((size_t)((pml * 4 + pn) * 8 + sl) * 256 + rr) * 256 + 4 * lane); }
        float sq = 0.f;
#pragma unroll
        for (int pn = 0; pn < 4; ++pn) { sq += dot4(acc[pn]); *(f32x4*)(XR + row * DM + pn * 256 + 4 * lane) = acc[pn];
            u32x2 o; o.x = pk(acc[pn][0], acc[pn][1]); o.y = pk(acc[pn][2], acc[pn][3]); *(u32x2*)(XB + row * DM + pn * 256 + 4 * lane) = o; }
        sq = wave_sum(sq);
        if (lane == 0) ssout[row] = sq;
    }
}
template <int L> __device__ __forceinline__ void common_gemms(const Args& a, LAS unsigned char* lds, int G, int bx, const XcdBarrier& xbar) {
    unsigned char* ws = a.ws;
    float* SS = (float*)(ws + WS_SS);
    bf16_t* XB = (bf16_t*)(ws + WS_XB); float* XR = (float*)(ws + WS_XR); bf16_t* OG = (bf16_t*)(ws + WS_OG); bf16_t* ACT = (bf16_t*)(ws + WS_ACT);
    constexpr int po = L ? 11 : 5;
    if (IN(po)) { const int mrows = (L == 0 && G == 256 && !MK_MULTI) ? MP : MT;
        pg8::Gemm g{OG, (const bf16_t*)(ws + (L ? WS_WFOUT : WS_WGOUT)), mrows, DM, DM}; pg8::StaticOrder S; S.init(mrows, DM, G, bx);
        EpiResid E{L ? XR : a.in[I_XP], L ? XR + (size_t)MP * DM : a.in[I_XS], XR, XB, SS + (L ? 3 : 1) * 32768};
        pg8::gemm_phase<EpiResid, pg8::StaticOrder, true, true>(lds, g, S, E); }
    SEAM(po);
    if (IN(po + 1)) REP(po + 1) { pg8::Gemm g{XB, (const bf16_t*)(ws + WS_WFFI + (size_t)L * 11 * MiB), MT, 2 * DFF, DM}; pg8::StaticOrder S; S.init(MT, 2 * DFF, G, bx);
        EpiSwiglu E{SS + (L ? 3 : 1) * 32768, ACT}; pg8::gemm_phase<EpiSwiglu, pg8::StaticOrder, true, true>(lds, g, S, E);
        if (L == 0 && G == 256 && !MK_MULTI && bx >= 48) convert_weights(a, lds, 1, (bx - 48) * 8 + (int)(threadIdx.x >> 6), 208 * 8);
        REPSYNC(po + 1); }
    SEAM(po + 1);
    if (IN(po + 2)) {
        const bf16_t* W = (const bf16_t*)(ws + WS_WFFD + (size_t)L * 6 * MiB);
        if (G == 256 && !MK_MULTI) {
            { pg8::Gemm g{ACT, W, MP, DM, DFF, 0}; pg8::StaticOrder S; S.init(MP, DM, G, bx);
              EpiResid E{XR, XR + (size_t)MP * DM, XR, XB, SS + (L ? 4 : 2) * 32768};
              pg8::gemm_phase<EpiResid, pg8::StaticOrder, true, true>(lds, g, S, E); }
            { const int un = bx >> 3, sl = bx & 7, kb0 = (sl < 6) ? 3 * sl : 18 + 2 * (sl - 6), kbn = (sl < 6) ? 3 : 2;
              pg8::Gemm g{ACT + 128 * kb0, W + 128 * kb0, MT, DM, 128 * kbn, DFF}; SliceOrder S{64 + (un >> 2), un & 3};
              EpiPartial E{(float*)(ws + WS_PART) + (size_t)(un * 8 + sl) * 65536};
              pg8::gemm_phase<EpiPartial, SliceOrder, true, true>(lds, g, S, E); }
            xcd_barrier(xbar);
            ffd_sample_rows(a, (bx % 8) * (G / 8) + bx / 8, G, SS + (L ? 4 : 2) * 32768);
        } else {
            pg8::Gemm g{ACT, W, MT, DM, DFF, 0}; pg8::StaticOrder S; S.init(MT, DM, G, bx);
            EpiResid E{XR, XR + (size_t)MP * DM, XR, XB, SS + (L ? 4 : 2) * 32768};
            pg8::gemm_phase<EpiResid, pg8::StaticOrder, true, true>(lds, g, S, E);
        }
    }
    SEAM(po + 2);
}
constexpr int NPH = 15;
__global__ void __launch_bounds__(512, 2) fwd(Args a) {
    extern __shared__ __attribute__((aligned(16))) unsigned char lds_raw[];
    LAS unsigned char* lds = (LAS unsigned char*)lds_raw;
    const int G = gridDim.x, bx = blockIdx.x;
    const int vcu = (G % 8 == 0) ? (bx % 8) * (G / 8) + bx / 8 : bx;
    unsigned char* ws = a.ws;
    float* SS = (float*)(ws + WS_SS);
    bf16_t* XB = (bf16_t*)(ws + WS_XB); bf16_t* PROJ = (bf16_t*)(ws + WS_PROJ);

    volatile LAS unsigned* MISC = (volatile LAS unsigned*)(lds + 131072);
    if (threadIdx.x < 64) MISC[threadIdx.x] = 0u;
    __syncthreads();
    XcdBarrier xbar; xbar.bar = (unsigned*)ws; xbar.x = 0; xbar.st = nullptr;
    if (a.ph_hi - a.ph_lo > 1) xbar = xcd_barrier_post((unsigned*)ws, MISC + 8);
    if (IN(0)) REP(0) { p0_prologue(a, lds, vcu, G); REPSYNC(0); }
    SEAM(0);
    if (IN(1)) { pg8::Gemm g{XB, (const bf16_t*)(ws + WS_WGIN), MT, NPROJ, DM}; pg8::StaticOrder S; S.init(MT, NPROJ, G, bx);
        EpiGlaProj E{SS, PROJ, (float*)(ws + WS_GL)}; pg8::gemm_phase<EpiGlaProj, pg8::StaticOrder, true, true>(lds, g, S, E); }
    SEAM(1);
    if (IN(2)) REP(2) {
        if (G == 256 && !MK_MULTI) {
            GlaPre pf; gla_prefetch(pf, a, vcu >> 2, vcu & 3);
            const int it4 = 1024 + (vcu & 127);
#pragma unroll 1
            for (int it = vcu; it < 1024; it += G) gla_item<0>(a, lds, it >> 2, it & 3, pf, (it + G < 1024) ? it + G : it4);
            if (vcu < 128) gla_item<0>(a, lds, it4 >> 2, it4 & 3, pf, -1);
            else gla_item<1>(a, lds, it4 >> 2, it4 & 3, pf, -1);
        } else {
            GlaPre pf; if (vcu < 1152) gla_prefetch(pf, a, vcu >> 2, vcu & 3);
#pragma unroll 1
            for (int it = vcu; it < 1152; it += G) gla_item<0>(a, lds, it >> 2, it & 3, pf, (it + G < 1152) ? it + G : -1);
        }
        REPSYNC(2); }
    SEAM(2);
    if (IN(3)) REP(3) {
        if (G == 256 && !MK_MULTI) {
            if (bx < 32) { pg8::Gemm g{(const bf16_t*)(ws + WS_OG), (const bf16_t*)(ws + WS_WGOUT), MT, DM, DM, 0}; SliceOrder S{64 + (bx >> 2), bx & 3};
                EpiResid E{a.in[I_XP], a.in[I_XS], (float*)(ws + WS_XR), XB, SS + 32768};
                pg8::gemm_phase<EpiResid, SliceOrder, true, true>(lds, g, S, E); }
            else gla_scan(a, bx - 32, 224);
        } else gla_scan(a, vcu, G);
        REPSYNC(3); }
    SEAM(3);
    if (IN(4)) REP(4) {
        { const int nit = (G == 256 && !MK_MULTI) ? 1024 : 1152;
        GlaPre pf; if (vcu < nit) gla_prefetch(pf, a, vcu >> 2, vcu & 3);
#pragma unroll 1
        for (int it = vcu; it < nit; it += G) gla_item<1>(a, lds, it >> 2, it & 3, pf, (it + G < nit) ? it + G : -1); }
        REPSYNC(4); }
    SEAM(4);
    common_gemms<0>(a, lds, G, bx, xbar);
    if (IN(8)) { pg8::Gemm g{XB, (const bf16_t*)(ws + WS_WFIN), MT, NPROJ, DM}; pg8::StaticOrder S; S.init(MT, NPROJ, G, bx);
        EpiFoxProj E{SS + 2 * 32768, PROJ, a.out, a.in[I_FBF]}; pg8::gemm_phase<EpiFoxProj, pg8::StaticOrder, true, true>(lds, g, S, E); }
    SEAM(8);
    if (IN(9)) REP(9) { fox_cumsum(a, lds, vcu, G); REPSYNC(9); }
    SEAM(9);
    if (IN(10)) REP(10) { fox_attention(a, lds, vcu, G); REPSYNC(10); }
    SEAM(10);
    common_gemms<1>(a, lds, G, bx, xbar);
#ifdef EXTRA_SYNCS
    for (int i_ = 0; i_ < EXTRA_SYNCS; ++i_) xcd_barrier(xbar);
#endif
    if (IN(14)) p_final(a, vcu, G);
#undef IN
#undef SEAM
}

extern "C" void kernel_launch(void* const* d_in, const int* in_sizes, int n_in, void* d_out, int out_size, void* d_ws, size_t ws_size, hipStream_t stream) {
    static int grid = 0;
    if (grid == 0) {
        if (n_in != 19 || ws_size < WS_END || out_size != 62160896) { fprintf(stderr, "kernel_launch: unexpected problem shape (n_in %d, out %d, ws %zu)\n", n_in, out_size, ws_size); grid = -1; return; }
        if (hipFuncSetAttribute((const void*)fwd, hipFuncAttributeMaxDynamicSharedMemorySize, LDS_BYTES) != hipSuccess) { fprintf(stderr, "kernel_launch: hipFuncSetAttribute failed\n"); grid = -1; return; }
        int dev = 0, cus = 0, per_cu = 0;
        (void)hipGetDevice(&dev); (void)hipDeviceGetAttribute(&cus, hipDeviceAttributeMultiprocessorCount, dev);
        (void)hipOccupancyMaxActiveBlocksPerMultiprocessor(&per_cu, (const void*)fwd, 512, LDS_BYTES);
        (void)hipGetLastError();
        if (per_cu < 1) per_cu = 1;
        grid = cus * 1;
        if (grid <= 0) grid = 256;
    }
    if (grid < 0) return;
    (void)hipMemsetAsync((char*)d_ws + WS_CTL, 0, CTL_BYTES, stream);
    Args a{};
    for (int i = 0; i < 19; ++i) a.in[i] = (const float*)d_in[i];
    a.out = (float*)d_out; a.ws = (unsigned char*)d_ws;
#if MK_MULTI
    for (int ph = 0; ph < NPH; ++ph) { a.ph_lo = ph; a.ph_hi = ph + 1; hipLaunchKernelGGL(fwd, dim3(grid), dim3(512), LDS_BYTES, stream, a); }
#else
    a.ph_lo = 0; a.ph_hi = NPH;
    void* args[] = {&a};
    hipError_t e = hipLaunchCooperativeKernel((const void*)fwd, dim3(grid), dim3(512), args, LDS_BYTES, stream);
    if (e != hipSuccess) fprintf(stderr, "kernel_launch: cooperative launch failed: %s (grid %d)\n", hipGetErrorString(e), grid);
#endif
}
```
